# Optimizing an MI355X kernel written in HIP

```python
import math
import jax, jax.numpy as jnp
from jax import lax
import numpy as np

D_MODEL = 1024
BATCH = 8
SEQ = 8192
DEPTH = 1

EPS = 1e-5
ROPE_THETA = 10000.0
GLA_HEADS = 4
GLA_DK = 64
GLA_DV = 128
GLA_GATE_RANK = 16
GLA_GATE_TEMP = 16.0
GLA_CHUNK = 64
GLA_QK = GLA_HEADS * GLA_DK
GLA_V = GLA_HEADS * GLA_DV
DIL_PAIRS = ((128, 1), (512, 4), (2048, 16))
DIL_GROUPS = 3
DIL_HEADS = 4
DIL_HEAD_DIM = 128
DIL_BLOCK = 128
DIL_W = DIL_GROUPS * DIL_HEADS * DIL_HEAD_DIM
DIL_OUT = DIL_HEADS * DIL_HEAD_DIM
N_BRANCHES = 2
MEM_LEN = 256
XATTN_HEADS = 4
XATTN_HEAD_DIM = 128
N_EXPERTS = 32
TOP_K = 4
D_FF = D_MODEL
SWIGLU_ALPHA = 1.702
SWIGLU_LIMIT = 7.0
MOE_BLOCK = 256
IN_SIZES = (GLA_QK, GLA_QK, GLA_V, GLA_V, GLA_GATE_RANK, DIL_W, DIL_W, DIL_W)
D_IN = 2 * GLA_QK + 2 * GLA_V + GLA_GATE_RANK + 3 * DIL_W

kernel_name = "hybrid_gla_dilated_moe_block"


def rms_norm(x, g):
    xf = x.astype(jnp.float32)
    y = xf * lax.rsqrt(jnp.mean(xf * xf, axis=-1, keepdims=True) + EPS)
    return (y * g.astype(jnp.float32)).astype(x.dtype)


def apply_rotary(t, positions):
    half = t.shape[-1] // 2
    inv_freq = ROPE_THETA ** (-jnp.arange(half, dtype=jnp.float32) / half)
    ang = positions.astype(jnp.float32)[..., None] * inv_freq
    ang = ang.reshape(ang.shape[:2] + (1,) * (t.ndim - 3) + (half,))
    cos, sin = jnp.cos(ang), jnp.sin(ang)
    tf = t.astype(jnp.float32)
    t1, t2 = tf[..., :half], tf[..., half:]
    return jnp.concatenate([t1 * cos - t2 * sin, t2 * cos + t1 * sin], axis=-1).astype(t.dtype)


def gla_chunked(q, k, v, log_a):
    B_, S_, H, dk = q.shape
    dv = v.shape[-1]
    n = S_ // GLA_CHUNK

    def chunks(t):
        return t.astype(jnp.float32).reshape(B_, n, GLA_CHUNK, H, t.shape[-1]).transpose(1, 0, 3, 2, 4)

    causal = jnp.tril(jnp.ones((GLA_CHUNK, GLA_CHUNK), dtype=bool))

    def step(state, xs):
        qc, kc, vc, lac = xs
        bcum = jnp.cumsum(lac, axis=2)
        blast = bcum[:, :, -1]
        inter = jnp.einsum('bhck,bhkv->bhcv', qc * jnp.exp(bcum), state)
        diff = bcum[:, :, :, None, :] - bcum[:, :, None, :, :]
        decay = jnp.exp(jnp.where(causal[None, None, :, :, None], diff, -jnp.inf))
        scores = jnp.einsum('bhtsk,bhsk->bhts', qc[:, :, :, None, :] * decay, kc)
        intra = jnp.einsum('bhts,bhsv->bhtv', scores, vc)
        k_dec = kc * jnp.exp(blast[:, :, None, :] - bcum)
        new_state = jnp.exp(blast)[..., None] * state + jnp.einsum('bhsk,bhsv->bhkv', k_dec, vc)
        return new_state, inter + intra

    state0 = jnp.zeros((B_, H, dk, dv), jnp.float32)
    _, o = lax.scan(step, state0, (chunks(q), chunks(k), chunks(v), chunks(log_a)))
    return o.transpose(1, 0, 3, 2, 4).reshape(B_, S_, H, dv)


def dilated_window_attention(q, k, v, window, dilation):
    B_, S_, H, dh = q.shape
    span = window // dilation
    L = S_ // dilation
    nb = -(-L // DIL_BLOCK)
    Lp = nb * DIL_BLOCK

    def to_blocks(t):
        t = t.reshape(B_, L, dilation, H, dh).transpose(0, 2, 1, 3, 4)
        t = jnp.pad(t, ((0, 0), (0, 0), (0, Lp - L), (0, 0), (0, 0)))
        return t.reshape(B_, dilation, nb, DIL_BLOCK, H, dh)

    def with_prev(t):
        prev = jnp.pad(t[:, :, :-1], ((0, 0), (0, 0), (1, 0), (0, 0), (0, 0), (0, 0)))
        return jnp.concatenate([prev, t], axis=3)

    qb = to_blocks(q)
    kc = with_prev(to_blocks(k))
    vc = with_prev(to_blocks(v))
    s = jnp.einsum('bpnqhd,bpnkhd->bpnhqk', qb, kc).astype(jnp.float32)
    qi = jnp.arange(DIL_BLOCK)[:, None] + DIL_BLOCK
    kj = jnp.arange(2 * DIL_BLOCK)[None, :]
    dist = qi - kj
    band = (dist >= 0) & (dist <= span)
    has_prev = (jnp.arange(nb)[:, None, None] > 0) | (kj >= DIL_BLOCK)[None]
    mask = band[None] & has_prev
    s = jnp.where(mask[None, None, :, None], s, -jnp.inf)
    lse = jax.nn.logsumexp(s, axis=-1)
    p = jnp.exp(s - lse[..., None])
    o = jnp.einsum('bpnhqk,bpnkhd->bpnqhd', p.astype(v.dtype), vc)
    o = o.reshape(B_, dilation, Lp, H, dh)[:, :, :L].transpose(0, 2, 1, 3, 4).reshape(B_, S_, H, dh)
    lse = lse.transpose(0, 1, 2, 4, 3).reshape(B_, dilation, Lp, H)[:, :, :L]
    lse = lse.transpose(0, 2, 1, 3).reshape(B_, S_, H)
    return o, lse


def hybrid_mixer(a, positions, w_in, w_gla_a2, b_gla_a2, gla_norm_g, w_branch_gla, w_branch_dil,
                 w_branch_gate, b_branch_gate, w_mix_out):
    B_, S_, _ = a.shape
    proj = a @ w_in
    offs = [int(o) for o in np.cumsum(IN_SIZES)[:-1]]
    q_g, k_g, v_g, r_g, a_lr, q_d, k_d, v_d = jnp.split(proj, offs, axis=-1)

    q_g = q_g.reshape(B_, S_, GLA_HEADS, GLA_DK) * (GLA_DK ** -0.5)
    k_g = k_g.reshape(B_, S_, GLA_HEADS, GLA_DK)
    v_g = v_g.reshape(B_, S_, GLA_HEADS, GLA_DV)
    gate_logit = (a_lr @ w_gla_a2 + b_gla_a2).astype(jnp.float32)
    log_a = (jax.nn.log_sigmoid(gate_logit) / GLA_GATE_TEMP).reshape(B_, S_, GLA_HEADS, GLA_DK)
    o_g = gla_chunked(q_g, k_g, v_g, log_a)
    o_g = o_g * lax.rsqrt(jnp.mean(o_g * o_g, axis=-1, keepdims=True) + EPS)
    o_g = o_g.reshape(B_, S_, GLA_V) * gla_norm_g.astype(jnp.float32)
    o_g = (o_g * jax.nn.silu(r_g.astype(jnp.float32))).astype(a.dtype)

    shp = (B_, S_, DIL_GROUPS, DIL_HEADS, DIL_HEAD_DIM)
    q_d = apply_rotary(q_d.reshape(shp), positions) * (DIL_HEAD_DIM ** -0.5)
    k_d = apply_rotary(k_d.reshape(shp), positions)
    v_d = v_d.reshape(shp)
    outs, lses = [], []
    for g, (window, dilation) in enumerate(DIL_PAIRS):
        o_i, lse_i = dilated_window_attention(q_d[:, :, g], k_d[:, :, g], v_d[:, :, g], window, dilation)
        outs.append(o_i)
        lses.append(lse_i)
    o_all = jnp.stack(outs, axis=2)
    wts = jax.nn.softmax(jnp.stack(lses, axis=2), axis=2)
    o_d = jnp.sum(wts[..., None] * o_all.astype(jnp.float32), axis=2)
    o_d = o_d.reshape(B_, S_, DIL_OUT).astype(a.dtype)

    gates = jax.nn.sigmoid((a @ w_branch_gate + b_branch_gate).astype(jnp.float32))
    g_gla, g_dil = gates[..., :D_MODEL], gates[..., D_MODEL:]
    merged = g_gla * (o_g @ w_branch_gla).astype(jnp.float32) + g_dil * (o_d @ w_branch_dil).astype(jnp.float32)
    return merged.astype(a.dtype) @ w_mix_out


def memory_cross_attention(c, mem, mem_norm_g, w_xq, w_xkv, w_xo):
    B_, S_, _ = c.shape
    q = (c @ w_xq).reshape(B_, S_, XATTN_HEADS, XATTN_HEAD_DIM) * (XATTN_HEAD_DIM ** -0.5)
    kv = (rms_norm(mem, mem_norm_g) @ w_xkv).reshape(B_, MEM_LEN, 2, XATTN_HEADS, XATTN_HEAD_DIM)
    k, v = kv[:, :, 0], kv[:, :, 1]
    s = jnp.einsum('bshd,bmhd->bhsm', q, k).astype(jnp.float32)
    p = jax.nn.softmax(s, axis=-1)
    o = jnp.einsum('bhsm,bmhd->bshd', p.astype(v.dtype), v).reshape(B_, S_, XATTN_HEADS * XATTN_HEAD_DIM)
    return o @ w_xo


def clamped_swiglu(glu, lin):
    glu = jnp.minimum(glu, SWIGLU_LIMIT)
    lin = jnp.clip(lin, -SWIGLU_LIMIT, SWIGLU_LIMIT)
    return glu * jax.nn.sigmoid(SWIGLU_ALPHA * glu) * (lin + 1.0)


def moe_ffn(f, w_router, b_router, w_gate, b_gate, w_up, b_up, w_down, b_down):
    B_, S_, D = f.shape
    M = B_ * S_
    hf = f.reshape(M, D)
    logits = (hf @ w_router).astype(jnp.float32) + b_router.astype(jnp.float32)
    top_logit, top_e = lax.top_k(logits, TOP_K)
    gate = jax.nn.softmax(top_logit, axis=-1)
    P = M * TOP_K
    e_flat = top_e.reshape(P)
    tok_flat = jnp.arange(P, dtype=jnp.int32) // TOP_K
    g_flat = gate.reshape(P)
    order = jnp.argsort(e_flat)
    e_sorted = e_flat[order]
    counts = jnp.bincount(e_flat, length=N_EXPERTS)
    start = jnp.cumsum(counts) - counts
    padded = ((counts + MOE_BLOCK - 1) // MOE_BLOCK) * MOE_BLOCK
    pend = jnp.cumsum(padded)
    pstart = pend - padded
    dest = pstart[e_sorted] + (jnp.arange(P) - start[e_sorted])
    L = (-(-P // MOE_BLOCK) + N_EXPERTS) * MOE_BLOCK
    row_tok = jnp.full((L,), M, jnp.int32).at[dest].set(tok_flat[order])
    row_gate = jnp.zeros((L,), jnp.float32).at[dest].set(g_flat[order])
    n_blocks = L // MOE_BLOCK
    block_e = jnp.minimum(jnp.searchsorted(pend, jnp.arange(n_blocks) * MOE_BLOCK, side='right'),
                          N_EXPERTS - 1)
    h_pad = jnp.concatenate([hf, jnp.zeros((1, D), hf.dtype)], axis=0)
    xs = h_pad[row_tok].reshape(n_blocks, MOE_BLOCK, D)

    def expert_block(args):
        xb, e = args
        glu = xb @ w_gate[e] + b_gate[e]
        lin = xb @ w_up[e] + b_up[e]
        return clamped_swiglu(glu, lin) @ w_down[e] + b_down[e]

    ys = lax.map(expert_block, (xs, block_e)).reshape(L, D).astype(jnp.float32) * row_gate[:, None]
    out = jnp.zeros((M + 1, D), jnp.float32).at[row_tok].add(ys)[:M]
    return out.reshape(B_, S_, D).astype(f.dtype)


def setup_inputs(seed: int = 0) -> dict:
    key = jax.random.key(seed)
    ks = jax.random.split(key, 32)
    D = D_MODEL
    nrm = lambda k, shape, fan_in: jax.random.normal(k, shape, jnp.float32) * (fan_in ** -0.5)
    gain = lambda k, shape: 1.0 + 0.02 * jax.random.normal(k, shape, jnp.float32)
    bias = lambda k, shape, s=0.02: s * jax.random.normal(k, shape, jnp.float32)
    x = jax.random.normal(ks[0], (BATCH, SEQ, D), jnp.float32)
    mem = jax.random.normal(ks[1], (BATCH, MEM_LEN, D), jnp.float32)
    offset = jax.random.randint(ks[2], (BATCH, 1), 0, 1024, dtype=jnp.int32)
    positions = jnp.arange(SEQ, dtype=jnp.int32)[None, :] + offset
    return {
        "x": x,
        "mem": mem,
        "positions": positions,
        "norm1_g": gain(ks[3], (DEPTH, D)),
        "w_in": nrm(ks[4], (DEPTH, D, D_IN), D),
        "w_gla_a2": nrm(ks[5], (DEPTH, GLA_GATE_RANK, GLA_QK), GLA_GATE_RANK),
        "b_gla_a2": bias(ks[6], (DEPTH, GLA_QK), 0.1),
        "gla_norm_g": gain(ks[7], (DEPTH, GLA_V)),
        "w_branch_gla": nrm(ks[8], (DEPTH, GLA_V, D), GLA_V),
        "w_branch_dil": nrm(ks[9], (DEPTH, DIL_OUT, D), DIL_OUT),
        "w_branch_gate": nrm(ks[10], (DEPTH, D, N_BRANCHES * D), D),
        "b_branch_gate": bias(ks[11], (DEPTH, N_BRANCHES * D)),
        "w_mix_out": nrm(ks[12], (DEPTH, D, D), D),
        "norm2_g": gain(ks[13], (DEPTH, D)),
        "mem_norm_g": gain(ks[14], (DEPTH, D)),
        "w_xq": nrm(ks[15], (DEPTH, D, XATTN_HEADS * XATTN_HEAD_DIM), D),
        "w_xkv": nrm(ks[16], (DEPTH, D, 2 * XATTN_HEADS * XATTN_HEAD_DIM), D),
        "w_xo": nrm(ks[17], (DEPTH, XATTN_HEADS * XATTN_HEAD_DIM, D), XATTN_HEADS * XATTN_HEAD_DIM),
        "norm3_g": gain(ks[18], (DEPTH, D)),
        "w_router": nrm(ks[19], (DEPTH, D, N_EXPERTS), D),
        "b_router": bias(ks[20], (DEPTH, N_EXPERTS), 0.01),
        "w_gate": nrm(ks[21], (DEPTH, N_EXPERTS, D, D_FF), D),
        "b_gate": bias(ks[22], (DEPTH, N_EXPERTS, D_FF)),
        "w_up": nrm(ks[23], (DEPTH, N_EXPERTS, D, D_FF), D),
        "b_up": bias(ks[24], (DEPTH, N_EXPERTS, D_FF)),
        "w_down": nrm(ks[25], (DEPTH, N_EXPERTS, D_FF, D), D_FF),
        "b_down": bias(ks[26], (DEPTH, N_EXPERTS, D)),
        "final_norm_g": gain(ks[27], (D,)),
    }


def reference(x, mem, positions, norm1_g, w_in, w_gla_a2, b_gla_a2, gla_norm_g, w_branch_gla,
              w_branch_dil, w_branch_gate, b_branch_gate, w_mix_out, norm2_g, mem_norm_g, w_xq, w_xkv,
              w_xo, norm3_g, w_router, b_router, w_gate, b_gate, w_up, b_up, w_down, b_down,
              final_norm_g):
    h = x
    for l in range(DEPTH):
        a = rms_norm(h, norm1_g[l])
        h = h + hybrid_mixer(a, positions, w_in[l], w_gla_a2[l], b_gla_a2[l], gla_norm_g[l],
                             w_branch_gla[l], w_branch_dil[l], w_branch_gate[l], b_branch_gate[l],
                             w_mix_out[l])
        c = rms_norm(h, norm2_g[l])
        h = h + memory_cross_attention(c, mem, mem_norm_g[l], w_xq[l], w_xkv[l], w_xo[l])
        f = rms_norm(h, norm3_g[l])
        h = h + moe_ffn(f, w_router[l], b_router[l], w_gate[l], b_gate[l], w_up[l], b_up[l],
                        w_down[l], b_down[l])
    return rms_norm(h, final_norm_g)
```

```cpp
#include <hip/hip_runtime.h>
#include <cstdio>
#include <cstdint>

#define LAS __attribute__((address_space(3)))
#define GAS __attribute__((address_space(1)))
typedef unsigned short bf16;
typedef short bf16x8 __attribute__((ext_vector_type(8)));
typedef short s16x4 __attribute__((ext_vector_type(4)));
typedef float f32x4 __attribute__((ext_vector_type(4)));
typedef float f32x16 __attribute__((ext_vector_type(16)));
typedef unsigned u32x4 __attribute__((ext_vector_type(4)));
typedef unsigned u32x2 __attribute__((ext_vector_type(2)));

typedef float f32x2 __attribute__((ext_vector_type(2)));
typedef __bf16 b16x2 __attribute__((ext_vector_type(2)));
__device__ __forceinline__ unsigned cvt_pk_bf16(float lo, float hi) { const f32x2 v = {lo, hi}; const b16x2 r = __builtin_convertvector(v, b16x2); return __builtin_bit_cast(unsigned, r); }
__device__ __forceinline__ float bf2f(unsigned b) { return __uint_as_float(b << 16); }
__device__ __forceinline__ float bflo(unsigned w) { return __uint_as_float(w << 16); }
__device__ __forceinline__ float bfhi(unsigned w) { return __uint_as_float(w & 0xffff0000u); }
__device__ __forceinline__ unsigned f2bf(float f) { unsigned u = __float_as_uint(f); return (u + 0x7fffu + ((u >> 16) & 1u)) >> 16; }
__device__ __forceinline__ unsigned pk2(float lo, float hi) { return f2bf(lo) | (f2bf(hi) << 16); }

namespace pg8 {
constexpr int BM = 256, BK = 64, HALF = 128, HTB = HALF * BK * 2, STAGE_BYTES = 8 * HTB, NXCD = 8, WGM = 8;
__host__ __device__ __forceinline__ int lds_byte(int r, int c) { const int st = (r >> 4) * 2 + (c >> 5), rr = r & 15, cc = c & 31, ob = rr * 64 + cc * 2; return st * 1024 + (ob ^ (((ob >> 9) & 1) << 5)); }
__host__ __device__ __forceinline__ void stage_rc(int b, int& R, int& C) { const int st = b / 1024, sb = b % 1024, swz = sb ^ (((sb >> 9) & 1) << 5); R = (st >> 1) * 16 + swz / 64; C = (st & 1) * 32 + (swz % 64) / 2; }
__host__ __device__ __forceinline__ int perm32(int rho) { const int n = rho >> 4, i = rho & 15; return 8 * (i >> 2) + 4 * n + (i & 3); }

struct Unit { int pm, pn, pb; };
struct Gemm { const bf16* A; const bf16* Bt; int K; const int* rowmap; };

struct StaticOrder {
    int nM, nN, nwg, G, c;
    __device__ void init(int nM_, int nN_, int G_, int c_) { nM = nM_; nN = nN_; nwg = nM * nN; G = G_; c = c_; }
    __device__ bool next(int i, Unit& u) const {
        const long L = (long)i * G + c; if (L >= nwg) return false;
        int wgid = (int)L; { const int q = nwg / NXCD, r = nwg % NXCD, xcd = wgid % NXCD, off = wgid / NXCD; wgid = (xcd < r ? xcd * (q + 1) : r * (q + 1) + (xcd - r) * q) + off; }
        const int nig = WGM * nN, gid = wgid / nig, fm = gid * WGM, gsz = (nM - fm) < WGM ? (nM - fm) : WGM;
        u.pm = fm + ((wgid % nig) % gsz); u.pn = (wgid % nig) / gsz; u.pb = u.pn; return true;
    }
};
struct MoeOrder : StaticOrder {
    const LAS int* blk_e;
    __device__ bool next(int i, Unit& u) const { if (!StaticOrder::next(i, u)) return false; u.pb = blk_e[u.pm] * nN + u.pn; return true; }
};

template <class Epi, class Sched, bool GATHER>
__device__ __forceinline__ void gemm_phase(LAS unsigned char* lds, const Gemm g, const Sched& S, const Epi& E) {
    const int tid = threadIdx.x, wid = __builtin_amdgcn_readfirstlane(tid >> 6), lane = tid & 63, wr = wid >> 2, wc = wid & 3, fr = lane & 15, fq = lane >> 4;
    const int K = g.K, nt = K / BK;
    unsigned voffA[2], voffB[2]; int rA[2], cA2[2];
#pragma unroll
    for (int i = 0; i < 2; ++i) { int R, C; stage_rc(tid * 16 + i * 8192, R, C); const int Rb = Epi::PERM ? ((R & ~31) + perm32(R & 31)) : R;
        voffA[i] = (unsigned)(R * K + C) * 2u; voffB[i] = (unsigned)(Rb * K + C) * 2u; rA[i] = R; cA2[i] = C * 2; }
    const size_t kstep = (size_t)(BK * 2);
    const size_t hstep = (size_t)HALF * K * 2;
    const size_t tstep = 2 * hstep;
    const unsigned ldsw = (unsigned)wid * 1024u;
    const int aoff = lds_byte(wr * 64 + fr, fq * 8), boff = lds_byte(wc * 32 + fr, fq * 8);
#define PG8_SA(b, h) (((b) * 2 + (h)) * HTB)
#define PG8_SB(b, h) ((4 + (b) * 2 + (h)) * HTB)
#define PG8_STAGE(bufoff, gbase, voff) do { _Pragma("unroll") for (int _i = 0; _i < 2; ++_i) \
        __builtin_amdgcn_global_load_lds((const unsigned*)((const char*)(gbase) + (voff)[_i]), (LAS unsigned*)(lds + (bufoff) + ldsw + _i * 8192), 16, 0, 0); } while (0)
#define PG8_STAGE_G(bufoff, o0, o1, kb) do { \
        __builtin_amdgcn_global_load_lds((const unsigned*)((const char*)g.A + (size_t)(o0) + (kb)), (LAS unsigned*)(lds + (bufoff) + ldsw), 16, 0, 0); \
        __builtin_amdgcn_global_load_lds((const unsigned*)((const char*)g.A + (size_t)(o1) + (kb)), (LAS unsigned*)(lds + (bufoff) + ldsw + 8192), 16, 0, 0); } while (0)
#define PG8_LDA(dst, b, h) do { _Pragma("unroll") for (int m = 0; m < 4; ++m) _Pragma("unroll") for (int k = 0; k < 2; ++k) dst[m][k] = *(const LAS bf16x8*)(lds + PG8_SA(b, h) + aoff + m * 2048 + k * 1024); } while (0)
#define PG8_LDB(dst, b, h) do { _Pragma("unroll") for (int n = 0; n < 2; ++n) _Pragma("unroll") for (int k = 0; k < 2; ++k) dst[n][k] = *(const LAS bf16x8*)(lds + PG8_SB(b, h) + boff + n * 2048 + k * 1024); } while (0)
#define PG8_MMA(ai, bj, At, Bt) do { __builtin_amdgcn_s_setprio(1); _Pragma("unroll") for (int m = 0; m < 4; ++m) _Pragma("unroll") for (int n = 0; n < 2; ++n) _Pragma("unroll") for (int k = 0; k < 2; ++k) \
        acc[ai][bj][m][n] = __builtin_amdgcn_mfma_f32_16x16x32_bf16(Bt[n][k], At[m][k], acc[ai][bj][m][n], 0, 0, 0); __builtin_amdgcn_s_setprio(0); } while (0)
#define PG8_WAIT_V(n) asm volatile("s_waitcnt vmcnt(" #n ")" ::: "memory")
#define PG8_WAIT_L(n) asm volatile("s_waitcnt lgkmcnt(" #n ")" ::: "memory")
#define PG8_BAR __builtin_amdgcn_s_barrier()
#define PG8_SCHED __builtin_amdgcn_sched_barrier(0)
#define PG8_ROWOFF(dst, U) do { _Pragma("unroll") for (int _h = 0; _h < 2; ++_h) _Pragma("unroll") for (int _i = 0; _i < 2; ++_i) \
        dst[_h][_i] = (unsigned)g.rowmap[(U).pm * BM + _h * HALF + rA[_i]] * (unsigned)(K * 2) + (unsigned)cA2[_i]; } while (0)
    Unit cur, nxt; int ui = 0;
    if (!S.next(0, cur)) return;
    f32x4 acc[2][2][4][2];
#pragma unroll
    for (int a = 0; a < 2; ++a)
#pragma unroll
        for (int b = 0; b < 2; ++b)
#pragma unroll
            for (int m = 0; m < 4; ++m)
#pragma unroll
                for (int n = 0; n < 2; ++n) acc[a][b][m][n] = (f32x4){0.f, 0.f, 0.f, 0.f};
    bf16x8 At[4][2], B0[2][2], B1[2][2];
    const char* cA = (const char*)g.A + (size_t)cur.pm * tstep; const char* cB = (const char*)g.Bt + (size_t)cur.pb * tstep;
    unsigned cO[2][2] = {{0u, 0u}, {0u, 0u}}, nO[2][2] = {{0u, 0u}, {0u, 0u}};
    bool has_next = S.next(1, nxt);
    if constexpr (GATHER) { PG8_ROWOFF(cO, cur); if (has_next) { PG8_ROWOFF(nO, nxt); } else { _Pragma("unroll") for (int h = 0; h < 2; ++h) _Pragma("unroll") for (int i = 0; i < 2; ++i) nO[h][i] = cO[h][i]; } }
    if constexpr (GATHER) {
        PG8_STAGE(PG8_SB(0, 0), cB, voffB); PG8_STAGE_G(PG8_SA(0, 0), cO[0][0], cO[0][1], 0); PG8_STAGE(PG8_SB(0, 1), cB + hstep, voffB); PG8_STAGE_G(PG8_SA(0, 1), cO[1][0], cO[1][1], 0);
        if (wr == 1) PG8_BAR;
        PG8_WAIT_V(4); PG8_BAR;
        PG8_STAGE(PG8_SB(1, 0), cB + kstep, voffB); PG8_STAGE_G(PG8_SA(1, 0), cO[0][0], cO[0][1], kstep); PG8_STAGE(PG8_SB(1, 1), cB + hstep + kstep, voffB);
        PG8_WAIT_V(6); PG8_BAR;
    } else {
        PG8_STAGE(PG8_SB(0, 0), cB, voffB); PG8_STAGE(PG8_SA(0, 0), cA, voffA); PG8_STAGE(PG8_SB(0, 1), cB + hstep, voffB); PG8_STAGE(PG8_SA(0, 1), cA + hstep, voffA);
        if (wr == 1) PG8_BAR;
        PG8_WAIT_V(4); PG8_BAR;
        PG8_STAGE(PG8_SB(1, 0), cB + kstep, voffB); PG8_STAGE(PG8_SA(1, 0), cA + kstep, voffA); PG8_STAGE(PG8_SB(1, 1), cB + hstep + kstep, voffB);
        PG8_WAIT_V(6); PG8_BAR;
    }
    for (;;) {
        const char* nA = has_next ? (const char*)g.A + (size_t)nxt.pm * tstep : cA; const char* nB = has_next ? (const char*)g.Bt + (size_t)nxt.pb * tstep : cB;
        for (int t = 0; t < nt; t += 2) {
            const bool last = (t == nt - 2);
            const char* a1 = cA + (size_t)(t + 1) * kstep;
            const char* a2 = last ? nA : cA + (size_t)(t + 2) * kstep; const char* b2 = last ? nB : cB + (size_t)(t + 2) * kstep;
            const char* a3 = a2 + kstep; const char* b3 = b2 + kstep;
            const size_t k1 = (size_t)(t + 1) * kstep, k2 = last ? 0 : (size_t)(t + 2) * kstep, k3 = k2 + kstep;
            unsigned x00 = 0, x01 = 0, x10 = 0, x11 = 0;
            if constexpr (GATHER) { x00 = last ? nO[0][0] : cO[0][0]; x01 = last ? nO[0][1] : cO[0][1]; x10 = last ? nO[1][0] : cO[1][0]; x11 = last ? nO[1][1] : cO[1][1]; }
            PG8_LDB(B0, 0, 0); PG8_SCHED; PG8_LDA(At, 0, 0);
            if constexpr (GATHER) PG8_STAGE_G(PG8_SA(1, 1), cO[1][0], cO[1][1], k1); else PG8_STAGE(PG8_SA(1, 1), a1 + hstep, voffA);
            PG8_WAIT_L(8); PG8_BAR; PG8_WAIT_L(0); PG8_MMA(0, 0, At, B0); PG8_BAR; PG8_SCHED;
            PG8_LDB(B1, 0, 1); PG8_STAGE(PG8_SB(0, 0), b2, voffB);
            PG8_BAR; PG8_WAIT_L(0); PG8_MMA(0, 1, At, B1); PG8_BAR;
            PG8_LDA(At, 0, 1);
            if constexpr (GATHER) PG8_STAGE_G(PG8_SA(0, 0), x00, x01, k2); else PG8_STAGE(PG8_SA(0, 0), a2, voffA);
            PG8_BAR; PG8_WAIT_L(0); PG8_MMA(1, 0, At, B0); PG8_BAR; PG8_SCHED;
            PG8_STAGE(PG8_SB(0, 1), b2 + hstep, voffB);
            PG8_WAIT_V(6); PG8_BAR; PG8_MMA(1, 1, At, B1); PG8_BAR;
            PG8_LDB(B0, 1, 0); PG8_SCHED; PG8_LDA(At, 1, 0);
            if constexpr (GATHER) PG8_STAGE_G(PG8_SA(0, 1), x10, x11, k2); else PG8_STAGE(PG8_SA(0, 1), a2 + hstep, voffA);
            PG8_WAIT_L(8); PG8_BAR; PG8_WAIT_L(0); PG8_MMA(0, 0, At, B0); PG8_BAR; PG8_SCHED;
            PG8_LDB(B1, 1, 1); PG8_STAGE(PG8_SB(1, 0), b3, voffB);
            PG8_BAR; PG8_WAIT_L(0); PG8_MMA(0, 1, At, B1); PG8_BAR;
            PG8_LDA(At, 1, 1);
            if constexpr (GATHER) PG8_STAGE_G(PG8_SA(1, 0), x00, x01, k3); else PG8_STAGE(PG8_SA(1, 0), a3, voffA);
            PG8_BAR; PG8_WAIT_L(0); PG8_MMA(1, 0, At, B0); PG8_BAR; PG8_SCHED;
            PG8_STAGE(PG8_SB(1, 1), b3 + hstep, voffB);
            PG8_WAIT_V(6); PG8_BAR; PG8_MMA(1, 1, At, B1); PG8_BAR;
        }
        Unit nn = cur; const bool has_nn = has_next && S.next(ui + 2, nn);
        unsigned tO[2][2] = {{0u, 0u}, {0u, 0u}};
        if constexpr (GATHER) { if (has_nn) { PG8_ROWOFF(tO, nn); } }
        E(acc, cur, wr, wc, fr, fq);
        if (!has_next) break;
#pragma unroll
        for (int a = 0; a < 2; ++a)
#pragma unroll
            for (int b = 0; b < 2; ++b)
#pragma unroll
                for (int m = 0; m < 4; ++m)
#pragma unroll
                    for (int n = 0; n < 2; ++n) acc[a][b][m][n] = (f32x4){0.f, 0.f, 0.f, 0.f};
        if constexpr (GATHER) {
#pragma unroll
            for (int h = 0; h < 2; ++h)
#pragma unroll
                for (int i = 0; i < 2; ++i) { cO[h][i] = nO[h][i]; nO[h][i] = has_nn ? tO[h][i] : nO[h][i]; } }
        cur = nxt; cA = nA; cB = nB; ++ui; nxt = nn; has_next = has_nn;
    }
    PG8_WAIT_V(0);
    if (wr == 0) PG8_BAR;
    PG8_BAR;
#undef PG8_SA
#undef PG8_SB
#undef PG8_STAGE
#undef PG8_STAGE_G
#undef PG8_LDA
#undef PG8_LDB
#undef PG8_MMA
#undef PG8_WAIT_V
#undef PG8_WAIT_L
#undef PG8_BAR
#undef PG8_SCHED
#undef PG8_ROWOFF
}
}

namespace att {
constexpr float SCALE = 0.08838834764831845f;
constexpr int NW = 8, QBLK = 32, KVBLK = 64, QB = NW * QBLK, D = 128;
constexpr int SHM_V = KVBLK * D * 2, SHM_K = KVBLK * D * 2;
constexpr int LDS_BYTES = 2 * SHM_V + 2 * SHM_K + NW * 64 * 4;
constexpr float THR = 8.f;
#define KSWZ(row, colB) ((row) * 256 + ((colB) ^ (((row) & 7) << 4)))
#define SBAR() __builtin_amdgcn_sched_barrier(0)
__device__ __forceinline__ int v_st(int k, int c) { const int kk = (k & ~0xC) | ((k & 4) << 1) | ((k & 8) >> 1); return ((kk >> 3) * 4 + (c >> 5)) * 512 + ((kk & 7) * 32 + (c & 31)) * 2; }
__device__ __forceinline__ int v_rd_base(int lane) { return ((lane & 3) << 3) | (((lane >> 2) & 3) << 6) | (((lane >> 4) & 1) << 5) | (((lane >> 5) & 1) << 8); }
constexpr int v_rd_off(int d0, int ks, int half) { return d0 * 512 + ks * 4096 + half * 2048; }
__device__ __forceinline__ int crow(int r, int hi) { return (r & 3) + 8 * (r >> 2) + 4 * hi; }
__device__ __forceinline__ unsigned cvtpk(float lo, float hi) { return cvt_pk_bf16(lo, hi); }
__device__ __forceinline__ bf16x8 load8(const bf16* p) { return *reinterpret_cast<const bf16x8*>(p); }
__device__ __forceinline__ void mask_tile(f32x16& p0, f32x16& p1, int dq, unsigned W) {
    const float NEG = -__builtin_inff();
#pragma unroll
    for (int r = 0; r < 16; ++r) {
        const int c = (r & 3) + 8 * (r >> 2);
        if ((unsigned)(dq - c) >= W) p0[r] = NEG;
        if ((unsigned)(dq - c - 32) >= W) p1[r] = NEG;
    }
}
__device__ __forceinline__ void partialSM(f32x16& p0, f32x16& p1, float& m_reg, float& mn, float& alpha) {
    float pmax = p0[0]; for (int r = 1; r < 16; ++r) pmax = fmaxf(pmax, p0[r]); for (int r = 0; r < 16; ++r) pmax = fmaxf(pmax, p1[r]);
    { auto rr = __builtin_amdgcn_permlane32_swap(__float_as_uint(pmax), __float_as_uint(pmax), false, false);
      pmax = fmaxf(__uint_as_float(rr[0]), __uint_as_float(rr[1])); }
    constexpr float C2 = 1.4426950408889634f * SCALE;
    if (__builtin_expect(__all((pmax - m_reg) * SCALE <= THR), 1)) { mn = m_reg; alpha = 1.f; }
    else { mn = fmaxf(m_reg, pmax); alpha = __builtin_amdgcn_exp2f((m_reg - mn) * C2); m_reg = mn; }
    const float mnL = -mn * C2;
    for (int r = 0; r < 16; ++r) p0[r] = fmaf(p0[r], C2, mnL); for (int r = 0; r < 16; ++r) p1[r] = fmaf(p1[r], C2, mnL);
    for (int r = 0; r < 16; ++r) p0[r] = __builtin_amdgcn_exp2f(p0[r]);
}
__device__ __forceinline__ void finishSM(f32x16& p0, f32x16& p1, float alpha, float& l_reg, bf16x8& pa0, bf16x8& pa1, bf16x8& pa2, bf16x8& pa3) {
    for (int r = 0; r < 16; ++r) p1[r] = __builtin_amdgcn_exp2f(p1[r]);
    float ps = 0; for (int r = 0; r < 16; ++r) ps += p0[r]; for (int r = 0; r < 16; ++r) ps += p1[r];
    { auto rr = __builtin_amdgcn_permlane32_swap(__float_as_uint(ps), __float_as_uint(ps), false, false);
      ps = __uint_as_float(rr[0]) + __uint_as_float(rr[1]); }
    l_reg = l_reg * alpha + ps;
#define PK4(P, B_, OUT) do { unsigned a0 = cvtpk(P[B_+0], P[B_+1]), a1 = cvtpk(P[B_+2], P[B_+3]);                          \
        unsigned b0 = cvtpk(P[B_+4], P[B_+5]), b1 = cvtpk(P[B_+6], P[B_+7]);                                             \
        auto r0 = __builtin_amdgcn_permlane32_swap(a0, b0, false, false); auto r1 = __builtin_amdgcn_permlane32_swap(a1, b1, false, false); \
        u32x4 w = {r0[0], r1[0], r0[1], r1[1]}; OUT = *reinterpret_cast<bf16x8*>(&w); } while (0)
    PK4(p0, 0, pa0); PK4(p0, 8, pa1); PK4(p1, 0, pa2); PK4(p1, 8, pa3);
#undef PK4
}
template <int KB, bool SK>
__device__ __forceinline__ void qkt(f32x16& p0, f32x16& p1, const char* K_lds, int r32, int hi, const bf16x8* qr, bool act) {
    if (SK && !act) { const float NEG = -__builtin_inff();
#pragma unroll
        for (int r = 0; r < 16; ++r) { p0[r] = NEG; p1[r] = NEG; } return; }
    p0 = f32x16{}; p1 = f32x16{};
    const char* kb[4];
#pragma unroll
    for (int dd = 0; dd < 4; ++dd) kb[dd] = K_lds + KB * SHM_K + KSWZ(r32, (dd * 16 + hi * 8) * 2);
#pragma unroll
    for (int d0 = 0; d0 < 8; ++d0) { const char* a = kb[d0 & 3] + (d0 >> 2) * 128;
        bf16x8 b0 = *reinterpret_cast<const bf16x8*>(a);
        bf16x8 b1 = *reinterpret_cast<const bf16x8*>(a + 32 * 256);
        p0 = __builtin_amdgcn_mfma_f32_32x32x16_bf16(b0, qr[d0], p0, 0, 0, 0);
        p1 = __builtin_amdgcn_mfma_f32_32x32x16_bf16(b1, qr[d0], p1, 0, 0, 0); }
}
template <int VB, bool SK>
__device__ __forceinline__ void pv_tile(f32x16* o, int vb0, bf16x8 pa0, bf16x8 pa1, bf16x8 pa2, bf16x8 pa3, bool act) {
    if (SK && !act) return;
#define TRRD(dst, off) asm volatile("ds_read_b64_tr_b16 %0, %1 offset:%2" : "=&v"(dst) : "v"(vb0), "i"(off) : "memory")
#define PV_D0(d0) do { s16x4 l0, l1, l2, l3, h0, h1, h2, h3; constexpr int b_ = VB * SHM_V + v_rd_off(d0, 0, 0); \
        TRRD(l0, b_); TRRD(h0, b_ + 2048); TRRD(l1, b_ + 4096); TRRD(h1, b_ + 6144); TRRD(l2, b_ + 8192); TRRD(h2, b_ + 10240); TRRD(l3, b_ + 12288); TRRD(h3, b_ + 14336); \
        asm volatile("s_waitcnt lgkmcnt(0)" ::: "memory"); SBAR();   \
        o[d0] = __builtin_amdgcn_mfma_f32_32x32x16_bf16(pa0, (bf16x8){l0[0], l0[1], l0[2], l0[3], h0[0], h0[1], h0[2], h0[3]}, o[d0], 0, 0, 0);   \
        o[d0] = __builtin_amdgcn_mfma_f32_32x32x16_bf16(pa1, (bf16x8){l1[0], l1[1], l1[2], l1[3], h1[0], h1[1], h1[2], h1[3]}, o[d0], 0, 0, 0);   \
        o[d0] = __builtin_amdgcn_mfma_f32_32x32x16_bf16(pa2, (bf16x8){l2[0], l2[1], l2[2], l2[3], h2[0], h2[1], h2[2], h2[3]}, o[d0], 0, 0, 0);   \
        o[d0] = __builtin_amdgcn_mfma_f32_32x32x16_bf16(pa3, (bf16x8){l3[0], l3[1], l3[2], l3[3], h3[0], h3[1], h3[2], h3[3]}, o[d0], 0, 0, 0); } while (0)
    PV_D0(0); PV_D0(1); PV_D0(2); PV_D0(3);
#undef PV_D0
#undef TRRD
}
struct BlockRef { bf16* Q; const bf16* K; float* L; int P0, qs, ks, ls, skv; };
struct Seam { bf16x8 qr[8]; bf16x8 st_v0, st_v1, st_k0, st_k1; };
__device__ __forceinline__ int swa_jlo(int P0, int W) { const int lowk = P0 - W + 1; return lowk > 0 ? lowk / KVBLK : 0; }
#define ROW(p, KS_, k0, rr) ((p) + (size_t)((k0) + (rr)) * (KS_) + sc)
#define VMW() asm volatile("s_waitcnt vmcnt(0)" ::: "memory")
#define VMWN(n) asm volatile("s_waitcnt vmcnt(%0)" :: "i"(n) : "memory")
#define SLOAD_H(Kp, Vp, KS_, k0) do { S.st_v0 = load8(ROW(Vp, KS_, k0, sr)); S.st_v1 = load8(ROW(Vp, KS_, k0, 32 + sr));              \
                         S.st_k0 = load8(ROW(Kp, KS_, k0, sr)); S.st_k1 = load8(ROW(Kp, KS_, k0, 32 + sr)); } while (0)
#define SWRITE_HK(bf) do { *(bf16x8*)(K_lds + (bf) * SHM_K + kws) = S.st_k0; *(bf16x8*)(K_lds + (bf) * SHM_K + kws + 32 * 256) = S.st_k1; } while (0)
#define SWRITE_HV(bf) do { *(bf16x8*)(V_lds + (bf) * SHM_V + vst0) = S.st_v0; *(bf16x8*)(V_lds + (bf) * SHM_V + vst1) = S.st_v1; } while (0)
#define SWRITE_H(bf) do { SWRITE_HV(bf); SWRITE_HK(bf); } while (0)
template <long VOFF>
__device__ __forceinline__ void prime(const BlockRef& cur, int W, char* lds, Seam& S) {
    const int tid = threadIdx.x, wid = __builtin_amdgcn_readfirstlane(tid >> 6), lane = tid & 63, r32 = lane & 31, hi = lane >> 5;
    const int sr = tid >> 4, sc = (tid & 15) * 8, kws = KSWZ(sr, sc * 2); char* K_lds = lds + 2 * SHM_V;
    const int kb0 = swa_jlo(cur.P0, W) * KVBLK;
    for (int d0 = 0; d0 < 8; ++d0) S.qr[d0] = load8(cur.Q + (size_t)(wid * QBLK + r32) * cur.qs + d0 * 16 + hi * 8);
    SLOAD_H(cur.K, cur.K + VOFF, cur.ks, kb0); VMW(); SWRITE_HK(0);
    __syncthreads();
}
template <bool SK, long VOFF>
__device__ __forceinline__ void block(const BlockRef& cur, const BlockRef& nxt, int W, char* lds, Seam& S) {
    const int tid = threadIdx.x, wid = __builtin_amdgcn_readfirstlane(tid >> 6), lane = tid & 63, r32 = lane & 31, hi = lane >> 5;
    const int skv = cur.skv;
    const int j_lo = swa_jlo(cur.P0, W);
    int j_hi = (cur.P0 + QB - 1) / KVBLK + 1; if (j_hi > skv / KVBLK) j_hi = skv / KVBLK;
    const int NT = j_hi - j_lo;
    const int kbn = swa_jlo(nxt.P0, W) * KVBLK;
    const int qlo = cur.P0 + wid * QBLK, qm = qlo + r32 - 4 * hi;
    char* V_lds = lds; char* K_lds = lds + 2 * SHM_V;
    float* ws = (float*)(lds + 2 * SHM_V + 2 * SHM_K) + wid * 64; float* li_l = ws, * al_l = ws + 32;
    float m_reg = -1e30f, l_reg = 0; f32x16 o[4] = {};
    const int sr = tid >> 4, sc = (tid & 15) * 8, vst0 = v_st(sr, sc), vst1 = v_st(32 + sr, sc), kws = KSWZ(sr, sc * 2);
    const int vb0 = (int)(uintptr_t)V_lds + v_rd_base(lane);
    const bf16* Kh = cur.K; const bf16* Vh = cur.K + VOFF; const int KS = cur.ks;
#define RESC(a) do { if (__any((a) < 1.f)) { if (hi == 0) al_l[r32] = (a); asm volatile("s_waitcnt lgkmcnt(0)" ::: "memory");              \
                     for (int d_ = 0; d_ < 4; ++d_) for (int r = 0; r < 16; ++r) o[d_][r] *= al_l[crow(r, hi)]; } } while (0)
#define KBASE(t) ((j_lo + (t)) * KVBLK)
#define ACT(t) (KBASE(t) <= qlo + QBLK - 1 && KBASE(t) + KVBLK - 1 >= qlo - W + 1)
#define MASKT(P0_, P1_, t) do { const int kb_ = KBASE(t); if ((!SK || ACT(t)) && (kb_ + KVBLK - 1 > qlo || kb_ <= qlo + QBLK - 1 - W)) mask_tile(P0_, P1_, qm - kb_, (unsigned)W); } while (0)
    constexpr int NQL = 8;
#define SEAM_K0() do { VMWN(NQL); SWRITE_HK(0); SBAR(); } while (0)
    f32x16 pA0, pA1, pB0, pB1; float mnA, mnB, alA, alB; bf16x8 pa0, pa1, pa2, pa3;
    SWRITE_HV(0); SBAR();
    if (NT > 1) { SLOAD_H(Kh, Vh, KS, KBASE(1)); }
    SBAR(); qkt<0, SK>(pA0, pA1, K_lds, r32, hi, S.qr, ACT(0));
    MASKT(pA0, pA1, 0); partialSM(pA0, pA1, m_reg, mnA, alA);
    if (NT > 1) { VMW(); SWRITE_H(1); }
    __syncthreads();
#define HALF_STEP(PX0, PX1, mnX, alX, PY0, PY1, alY, t, KB, VB, SB) do {                                                      \
        SBAR(); qkt<KB, SK>(PX0, PX1, K_lds, r32, hi, S.qr, ACT(t));                                             \
        finishSM(PY0, PY1, alY, l_reg, pa0, pa1, pa2, pa3); SBAR();                                                           \
        if ((t) + 1 < NT) { SLOAD_H(Kh, Vh, KS, KBASE((t) + 1)); SBAR(); }                                               \
        pv_tile<VB, SK>(o, vb0, pa0, pa1, pa2, pa3, ACT((t) - 1)); MASKT(PX0, PX1, (t)); partialSM(PX0, PX1, m_reg, mnX, alX);                                        \
        __syncthreads();                                                                                                      \
        if ((t) + 1 < NT) { VMW(); SWRITE_H(SB); }                                                                          \
        RESC(alX); __syncthreads(); } while (0)
    for (int t = 1; t + 1 < NT; t += 2) {
        HALF_STEP(pB0, pB1, mnB, alB, pA0, pA1, alA, t, 1, 0, 0);
        HALF_STEP(pA0, pA1, mnA, alA, pB0, pB1, alB, t + 1, 0, 1, 1);
    }
    const bool even = (NT & 1) == 0;
    if (even) { SBAR(); qkt<1, SK>(pB0, pB1, K_lds, r32, hi, S.qr, ACT(NT - 1)); SBAR(); }
    { SLOAD_H(nxt.K, nxt.K + VOFF, nxt.ks, kbn); SBAR();
#pragma unroll
      for (int d0 = 0; d0 < 8; ++d0) S.qr[d0] = load8(nxt.Q + (size_t)(wid * QBLK + r32) * nxt.qs + d0 * 16 + hi * 8); }
    SBAR();
    finishSM(pA0, pA1, alA, l_reg, pa0, pa1, pa2, pa3); SBAR();
    pv_tile<0, SK>(o, vb0, pa0, pa1, pa2, pa3, ACT(even ? NT - 2 : NT - 1));
    if (even) { MASKT(pB0, pB1, NT - 1); partialSM(pB0, pB1, m_reg, mnB, alB); __syncthreads(); RESC(alB);
        finishSM(pB0, pB1, alB, l_reg, pa0, pa1, pa2, pa3); SBAR(); pv_tile<1, SK>(o, vb0, pa0, pa1, pa2, pa3, ACT(NT - 1)); }
    SBAR(); SEAM_K0();
    if (hi == 0) li_l[r32] = l_reg; asm volatile("s_waitcnt lgkmcnt(0)" ::: "memory");
    if (cur.L != nullptr && hi == 0) cur.L[(size_t)(wid * QBLK + r32) * cur.ls] = m_reg * SCALE + __logf(l_reg);
    float rli[16];
#pragma unroll
    for (int r = 0; r < 16; ++r) rli[r] = __builtin_amdgcn_rcpf(li_l[crow(r, hi)]);
    bf16* Op = cur.Q + (size_t)(wid * QBLK + 4 * hi) * cur.qs + r32; const size_t qstep = (size_t)cur.qs;
#pragma unroll
    for (int r = 0; r < 16; ++r) {
        asm volatile("" : "+v"(Op));
#pragma unroll
        for (int d0 = 0; d0 < 4; ++d0) { const float v = o[d0][r] * rli[r];
            const float vn = __shfl_xor(v, 1);
            if ((r32 & 1) == 0) *(unsigned*)(Op + d0 * 32) = cvtpk(v, vn); }
        Op += ((r & 3) == 3) ? 5 * qstep : qstep; }
    __syncthreads();
#undef RESC
#undef KBASE
#undef ACT
#undef MASKT
#undef SEAM_K0
#undef HALF_STEP
}
#undef ROW
#undef VMW
#undef VMWN
#undef SLOAD_H
#undef SWRITE_HK
#undef SWRITE_HV
#undef SWRITE_H
#undef KSWZ
}

constexpr int NWAVES = 8, NTHR = 512;
constexpr int M = 65536, DM = 1024, SEQ = 8192, NBATCH = 8;
constexpr int N1 = 6400;
constexpr int ROPE_POS = 9216;
constexpr float EPS = 1e-5f;
constexpr int NEXP = 32, HALF_TOK = 32768, RT_CAP = 139264;
constexpr int MAXBLK = 544;
constexpr int NPH = 19;
#ifndef MK_DIAG
#define MK_DIAG 0
#endif
#ifndef MK_PER_PHASE
#define MK_PER_PHASE 1
#endif

constexpr size_t MiB = 1u << 20;
constexpr size_t WS_CTL = 0, CTL_ZERO_BYTES = 1 * MiB;
constexpr size_t WS_WIN = 1 * MiB, WS_WGATE = 14 * MiB, WS_WBG = 18 * MiB, WS_WBD = 19 * MiB, WS_WMIX = 20 * MiB, WS_WXQ = 22 * MiB, WS_WXKV = 23 * MiB, WS_WXO = 25 * MiB, WS_WR = 26 * MiB;
constexpr size_t WS_ROPE = 27 * MiB, WS_MEMN = 32 * MiB, WS_KVM = 36 * MiB, WS_DECAY = 40 * MiB;
constexpr size_t WS_TOPE = 41 * MiB, WS_TGATE = 42 * MiB, WS_TSLOT = 43 * MiB, WS_RTOK = 44 * MiB, WS_RGATE = 46 * MiB;
constexpr size_t WS_A = 49 * MiB;
constexpr size_t WS_QG = 177 * MiB, WS_KG = 209 * MiB, WS_VG = 241 * MiB, WS_RG = 305 * MiB, WS_ALR = 369 * MiB, WS_LSE = 373 * MiB;
constexpr size_t WS_QD = 376 * MiB, WS_KD = 568 * MiB, WS_VD = 760 * MiB, WS_END = 952 * MiB;
constexpr size_t WS_GATES = WS_KD, WS_MERGED = 824 * MiB;
constexpr size_t WS_QX = WS_QD;
constexpr size_t WS_WGU = 177 * MiB, WS_WDN = 305 * MiB;
constexpr size_t WS_H = 376 * MiB, WS_Y = 648 * MiB;
static_assert(WS_Y + (size_t)RT_CAP * 2048 <= WS_END && WS_H + (size_t)RT_CAP * 2048 <= WS_Y && WS_RTOK + 2 * (size_t)RT_CAP * 4 <= WS_RGATE && WS_RGATE + 2 * (size_t)RT_CAP * 4 <= WS_A, "ws map");
constexpr size_t DO_OG = 0, DO_OD = 64 * MiB, DO_ST = 128 * MiB;
constexpr int CW_BAR = 4096, CW_CNT = 8192, CW_CUR = 8320;
constexpr int RING_BYTES = 131072, MISC_OFF = RING_BYTES, TAB_OFF = RING_BYTES + 1024, LDS_BYTES = 147456;

#define XB_TMO      128
#define XB_XCNT(j)  (256  + 64 * (j))
#define XB_XSUB(j)  (1280 + 64 * (j))
#define XB_XGEN(j)  (2304 + 64 * (j))
#define XB_TOP      3328
#define XB_TOPGEN   3392
#define XCD_BAR_WORDS 3456
#define XB_SPIN_CAP (1u << 18)
__device__ __forceinline__ unsigned xb_ld(unsigned* p)              { return __hip_atomic_load(p, __ATOMIC_RELAXED, __HIP_MEMORY_SCOPE_AGENT); }
__device__ __forceinline__ unsigned xb_add(unsigned* p, unsigned v) { return __hip_atomic_fetch_add(p, v, __ATOMIC_RELAXED, __HIP_MEMORY_SCOPE_AGENT); }
__device__ __forceinline__ unsigned xb_xcc_id() { return (unsigned)__builtin_amdgcn_s_getreg((3 << 11) | 20) & 0xFu; }
#define XB_SPIN(cond, bar) do { unsigned _sp = 0; while (cond) { __builtin_amdgcn_s_sleep(1); \
    if ((++_sp & 255u) == 0u) { if (xb_ld(&(bar)[XB_TMO])) break; if (_sp > XB_SPIN_CAP) { atomicAdd(&(bar)[XB_TMO], 1u); break; } } } } while (0)
struct XcdBarrier { unsigned* bar; unsigned x; volatile LAS unsigned* st; };
__device__ __forceinline__ XcdBarrier xcd_barrier_post(unsigned* bar, volatile LAS unsigned* st) {
    XcdBarrier b; b.bar = bar; b.x = xb_xcc_id(); b.st = st;
    if (threadIdx.x == 0) (void)xb_add(&bar[XB_XCNT(b.x)], 1u);
    return b;
}
__device__ __forceinline__ void xcd_barrier_complete(unsigned* bar, unsigned x, unsigned& nloc, unsigned& nx) {
    const unsigned G = gridDim.x * gridDim.y * gridDim.z;
    unsigned sum, cnt, mine, sp = 0u;
    for (;;) {
        sum = 0u; cnt = 0u; mine = 0u;
#pragma unroll
        for (unsigned j = 0; j < 16; ++j) { const unsigned c = xb_ld(&bar[XB_XCNT(j)]); sum += c; cnt += (c > 0u) ? 1u : 0u; mine = (j == x) ? c : mine; }
        if (sum == G) break;
        __builtin_amdgcn_s_sleep(1);
        if ((++sp & 255u) == 0u) { if (xb_ld(&bar[XB_TMO])) break; if (sp > XB_SPIN_CAP) { atomicAdd(&bar[XB_TMO], 1u); break; } }
    }
    nloc = mine > 0u ? mine : 1u; nx = cnt > 0u ? cnt : 1u;
}
__device__ __forceinline__ void xcd_barrier(const XcdBarrier& b) {
    asm volatile("s_waitcnt vmcnt(0)" ::: "memory");
    __syncthreads();
    if (threadIdx.x == 0) {
        unsigned* bar = b.bar;
        __builtin_amdgcn_s_waitcnt(0);
        unsigned nloc = b.st[0], nx = b.st[1];
        if (nloc == 0u) { xcd_barrier_complete(bar, b.x, nloc, nx); b.st[0] = nloc; b.st[1] = nx; }
        const unsigned old = xb_add(&bar[XB_XSUB(b.x)], 1u);
        const unsigned gen = old / nloc;
        if (old + 1u == (gen + 1u) * nloc) {
            __builtin_amdgcn_fence(__ATOMIC_RELEASE, "agent");
            asm volatile("s_waitcnt vmcnt(0)" ::: "memory");
            const unsigned og = xb_add(&bar[XB_TOP], 1u);
            const unsigned tg = og / nx;
            if (og + 1u == (tg + 1u) * nx) xb_add(&bar[XB_TOPGEN], 1u);
            else XB_SPIN(xb_ld(&bar[XB_TOPGEN]) == tg, bar);
            __builtin_amdgcn_fence(__ATOMIC_ACQUIRE, "agent");
            xb_add(&bar[XB_XGEN(b.x)], 1u);
            asm volatile("s_waitcnt vmcnt(0)" ::: "memory");
        } else {
            XB_SPIN(xb_ld(&bar[XB_XGEN(b.x)]) == gen, bar);
            __builtin_amdgcn_fence(__ATOMIC_ACQUIRE, "agent");
            asm volatile("s_waitcnt vmcnt(0)" ::: "memory");
        }
    }
    __syncthreads();
}

struct Frame {
    LAS unsigned char* lds; char* ldsg;
    unsigned* ctl; unsigned char* ws; unsigned char* dout;
    int tid, lane, wave, G, bid;
};
struct Args { const void* in[28]; float* out; unsigned char* ws; int ph_lo, ph_hi; };
#define INP(k) ((const float*)A.in[k])
#define LDS_WAIT() asm volatile("s_waitcnt lgkmcnt(0)" ::: "memory")
__device__ __forceinline__ float wave_sum(float v) {
#pragma unroll
    for (int o = 1; o < 64; o <<= 1) v += __shfl_xor(v, o);
    return v;
}
template <class RM>
__device__ __forceinline__ void transpose_item(const float* W, int K, int N, bf16* WT, const RM& rm, LAS float* scr, int item, int lane) {
    const int nblk = (N + 31) / 32, kb = item / nblk, nb = item % nblk, k0 = 64 * kb, n0 = 32 * nb;
    const int ncol = n0 + (lane & 31);
#pragma unroll 8
    for (int i = 0; i < 32; ++i) { const int kk = 2 * i + (lane >> 5); scr[kk * 33 + (lane & 31)] = ncol < N ? W[(size_t)(k0 + kk) * N + ncol] : 0.f; }
    LDS_WAIT(); asm volatile("" ::: "memory");
    const int c = lane & 7;
#pragma unroll
    for (int j = 0; j < 4; ++j) { const int n = (lane >> 3) + 8 * j; const LAS float* s = scr + (8 * c) * 33 + n;
        u32x4 o; o.x = pk2(s[0 * 33], s[1 * 33]); o.y = pk2(s[2 * 33], s[3 * 33]); o.z = pk2(s[4 * 33], s[5 * 33]); o.w = pk2(s[6 * 33], s[7 * 33]);
        const int dr = (n0 + n < N) ? rm(n0 + n) : -1;
        if (dr >= 0) *(u32x4*)(WT + (size_t)dr * K + k0 + 8 * c) = o; }
    LDS_WAIT(); asm volatile("" ::: "memory");
}
struct RmId { int off; __device__ int operator()(int n) const { return off + n; } };
struct RmWin { __device__ int operator()(int n) const {
    if (n < 1536) return n;
    if (n < 1552) return 6144 + (n - 1536);
    if (n < 4624) { const int j = n - 1552, seg = j / 1536, jj = j % 1536, hd = jj >> 7, i = jj & 127; return 1536 + seg * 1536 + hd * 128 + ((i < 64) ? 2 * i : 2 * (i - 64) + 1); }
    return 4608 + (n - 4624); } };
struct RmGU { int base; __device__ int operator()(int n) const { return base + (n >> 7) * 256 + (n & 127); } };

__device__ __forceinline__ void rms_row_to_bf16(const float* xrow, const float* g, bf16* orow, int lane) {
    const f32x4* xr = (const f32x4*)xrow + lane; const f32x4* gr = (const f32x4*)g + lane;
    f32x4 v[4]; float s = 0.f;
#pragma unroll
    for (int j = 0; j < 4; ++j) { v[j] = xr[64 * j]; s += (v[j].x * v[j].x + v[j].y * v[j].y) + (v[j].z * v[j].z + v[j].w * v[j].w); }
    const float rstd = 1.f / sqrtf(wave_sum(s) * (1.f / DM) + EPS);
    u32x2* o8 = (u32x2*)orow + lane;
#pragma unroll
    for (int j = 0; j < 4; ++j) { const f32x4 gg = gr[64 * j]; u32x2 w; w.x = cvt_pk_bf16(v[j].x * rstd * gg.x, v[j].y * rstd * gg.y); w.y = cvt_pk_bf16(v[j].z * rstd * gg.z, v[j].w * rstd * gg.w); o8[64 * j] = w; }
}

__device__ __forceinline__ void p0_prologue(Frame& F, const Args& A) {
    LAS float* scr = (LAS float*)(F.lds + F.wave * 16384);
    const int gw = F.bid * NWAVES + F.wave, NGW = F.G * NWAVES;
    unsigned char* ws = F.ws;
    constexpr int I_IN = 16 * 193, I_GATE = 16 * 64, I_BG = 8 * 32, I_MIX = 16 * 32, I_XQ = 16 * 16, I_XKV = 16 * 32, I_XO = 8 * 32;
    constexpr int NIT = I_IN + I_GATE + 2 * I_BG + I_MIX + I_XQ + I_XKV + I_XO;
    for (int it = gw; it < NIT; it += NGW) {
        int r = it;
        if (r < I_IN) { transpose_item(INP(4), 1024, 6160, (bf16*)(ws + WS_WIN), RmWin{}, scr, r, F.lane); continue; } r -= I_IN;
        if (r < I_GATE) { transpose_item(INP(10), 1024, 2048, (bf16*)(ws + WS_WGATE), RmId{0}, scr, r, F.lane); continue; } r -= I_GATE;
        if (r < I_BG) { transpose_item(INP(8), 512, 1024, (bf16*)(ws + WS_WBG), RmId{0}, scr, r, F.lane); continue; } r -= I_BG;
        if (r < I_BG) { transpose_item(INP(9), 512, 1024, (bf16*)(ws + WS_WBD), RmId{0}, scr, r, F.lane); continue; } r -= I_BG;
        if (r < I_MIX) { transpose_item(INP(12), 1024, 1024, (bf16*)(ws + WS_WMIX), RmId{0}, scr, r, F.lane); continue; } r -= I_MIX;
        if (r < I_XQ) { transpose_item(INP(15), 1024, 512, (bf16*)(ws + WS_WXQ), RmId{0}, scr, r, F.lane); continue; } r -= I_XQ;
        if (r < I_XKV) { transpose_item(INP(16), 1024, 1024, (bf16*)(ws + WS_WXKV), RmId{0}, scr, r, F.lane); continue; } r -= I_XKV;
        transpose_item(INP(17), 512, 1024, (bf16*)(ws + WS_WXO), RmId{0}, scr, r, F.lane);
    }
    const int gt = F.bid * NTHR + F.tid, NGT = F.G * NTHR;
    { u32x4* z = (u32x4*)((bf16*)(ws + WS_WIN) + (size_t)6160 * 1024); for (int i = gt; i < 240 * 1024 / 8; i += NGT) z[i] = (u32x4){0u, 0u, 0u, 0u}; }
    { bf16* wr = (bf16*)(ws + WS_WR); const float* w = INP(19); const float* g3 = INP(18);
      for (int i = gt; i < NEXP * 1024; i += NGT) { const int e = i >> 10, k = i & 1023; wr[i] = (bf16)f2bf(g3[k] * w[k * NEXP + e]); } }
    { float* tab = (float*)(ws + WS_ROPE);
      for (int i = gt; i < ROPE_POS * 64; i += NGT) { const int pos = i >> 6, fi = i & 63;
          const float inv = (float)exp2(-(double)fi * (13.287712379549449 / 64.0));
          const float ang = (float)pos * inv;
          const double a = (double)ang, n = rint(a * 0.15915494309189535), rr = a - n * 6.283185307179586;
          const float rf = (float)rr;
          tab[2 * i] = cosf(rf); tab[2 * i + 1] = sinf(rf); } }
    for (int m = gw; m < NBATCH * 256; m += NGW) rms_row_to_bf16(INP(1) + (size_t)m * DM, INP(14), (bf16*)(ws + WS_MEMN) + (size_t)m * DM, F.lane);
    for (int m = gw; m < M; m += NGW) rms_row_to_bf16(INP(0) + (size_t)m * DM, INP(3), (bf16*)(ws + WS_A) + (size_t)m * DM, F.lane);
}

#define EPI_ROWS(ai, m) (u.pm * 256 + wr * 64 + fr + (ai) * 128 + (m) * 16)
__device__ __forceinline__ u32x4 pack8f(const f32x4& a, const f32x4& b) { u32x4 w; w.x = cvt_pk_bf16(a[0], a[1]); w.y = cvt_pk_bf16(a[2], a[3]); w.z = cvt_pk_bf16(b[0], b[1]); w.w = cvt_pk_bf16(b[2], b[3]); return w; }
__device__ __forceinline__ void unpack8f(const u32x4& w, f32x4& a, f32x4& b) { a = (f32x4){bflo(w.x), bfhi(w.x), bflo(w.y), bfhi(w.y)}; b = (f32x4){bflo(w.z), bfhi(w.z), bflo(w.w), bfhi(w.w)}; }

struct EpiProj {
    static constexpr bool PERM = true;
    unsigned char* ws; const int* pos;
    __device__ __forceinline__ void operator()(const f32x4 (&acc)[2][2][4][2], const pg8::Unit& u, int wr, int wc, int fr, int fq) const {
        const int pn = u.pn, cw = wc * 32 + 8 * fq;
        if (pn == 24) {
            if (wc == 0 && fq < 2) { float* alr = (float*)(ws + WS_ALR);
#pragma unroll
                for (int ai = 0; ai < 2; ++ai)
#pragma unroll
                    for (int m = 0; m < 4; ++m) { float* p = alr + (size_t)EPI_ROWS(ai, m) * 16 + 8 * fq; *(f32x4*)p = acc[ai][0][m][0]; *(f32x4*)(p + 4) = acc[ai][0][m][1]; } }
            return;
        }
        bf16* base; int ldc, coff; float sc = 1.f; bool rope = false;
        if (pn == 0) { base = (bf16*)(ws + WS_QG); ldc = 256; coff = 0; sc = 0.125f; }
        else if (pn == 1) { base = (bf16*)(ws + WS_KG); ldc = 256; coff = 0; }
        else if (pn < 4) { base = (bf16*)(ws + WS_VG); ldc = 512; coff = (pn - 2) * 256; }
        else if (pn < 6) { base = (bf16*)(ws + WS_RG); ldc = 512; coff = (pn - 4) * 256; }
        else if (pn < 12) { base = (bf16*)(ws + WS_QD); ldc = 1536; coff = (pn - 6) * 256; rope = true; }
        else if (pn < 18) { base = (bf16*)(ws + WS_KD); ldc = 1536; coff = (pn - 12) * 256; rope = true; }
        else { base = (bf16*)(ws + WS_VD); ldc = 1536; coff = (pn - 18) * 256; }
        const float* tab = (const float*)(ws + WS_ROPE);
#pragma unroll
        for (int ai = 0; ai < 2; ++ai)
#pragma unroll
            for (int m = 0; m < 4; ++m) { const int row = EPI_ROWS(ai, m); bf16* rowp = base + (size_t)row * ldc + coff + cw;
                f32x4 cs0 = {1.f, 0.f, 1.f, 0.f}, cs1 = {1.f, 0.f, 1.f, 0.f};
                if (rope) { int p = pos[row]; p = p < 0 ? 0 : (p >= ROPE_POS ? ROPE_POS - 1 : p); const float* tp = tab + ((size_t)p * 64 + 16 * wc + 4 * fq) * 2; cs0 = *(const f32x4*)tp; cs1 = *(const f32x4*)(tp + 4); }
#pragma unroll
                for (int bj = 0; bj < 2; ++bj) { f32x4 v0 = acc[ai][bj][m][0] * sc, v1 = acc[ai][bj][m][1] * sc;
                    if (rope) {
                        v0 = (f32x4){v0[0] * cs0[0] - v0[1] * cs0[1], v0[1] * cs0[0] + v0[0] * cs0[1], v0[2] * cs0[2] - v0[3] * cs0[3], v0[3] * cs0[2] + v0[2] * cs0[3]};
                        v1 = (f32x4){v1[0] * cs1[0] - v1[1] * cs1[1], v1[1] * cs1[0] + v1[0] * cs1[1], v1[2] * cs1[2] - v1[3] * cs1[3], v1[3] * cs1[2] + v1[2] * cs1[3]}; }
                    *(u32x4*)(rowp + bj * 128) = pack8f(v0, v1); } }
    }
};
template <int ACT  > struct EpiBf16 {
    static constexpr bool PERM = true;
    bf16* O; int ldc; const float* bias; float scale;
    __device__ __forceinline__ void operator()(const f32x4 (&acc)[2][2][4][2], const pg8::Unit& u, int wr, int wc, int fr, int fq) const {
        const int col0 = u.pn * 256 + wc * 32 + 8 * fq;
        f32x4 bv[2][2];
#pragma unroll
        for (int bj = 0; bj < 2; ++bj)
#pragma unroll
            for (int n = 0; n < 2; ++n) bv[bj][n] = bias ? *(const f32x4*)(bias + col0 + bj * 128 + 4 * n) : (f32x4){0.f, 0.f, 0.f, 0.f};
#pragma unroll
        for (int ai = 0; ai < 2; ++ai)
#pragma unroll
            for (int m = 0; m < 4; ++m) { bf16* rowp = O + (size_t)EPI_ROWS(ai, m) * ldc + col0;
#pragma unroll
                for (int bj = 0; bj < 2; ++bj) { f32x4 v0 = acc[ai][bj][m][0] * scale + bv[bj][0], v1 = acc[ai][bj][m][1] * scale + bv[bj][1];
                    if (ACT == 1) {
#pragma unroll
                        for (int j = 0; j < 4; ++j) { v0[j] = __builtin_amdgcn_rcpf(1.f + __expf(-v0[j])); v1[j] = __builtin_amdgcn_rcpf(1.f + __expf(-v1[j])); } }
                    *(u32x4*)(rowp + bj * 128) = pack8f(v0, v1); } }
    }
};
template <int SECOND> struct EpiBranch {
    static constexpr bool PERM = true;
    bf16* mg; const bf16* gates; int goff;
    __device__ __forceinline__ void operator()(const f32x4 (&acc)[2][2][4][2], const pg8::Unit& u, int wr, int wc, int fr, int fq) const {
        const int col0 = u.pn * 256 + wc * 32 + 8 * fq;
#pragma unroll
        for (int ai = 0; ai < 2; ++ai)
#pragma unroll
            for (int m = 0; m < 4; ++m) { const size_t row = EPI_ROWS(ai, m);
#pragma unroll
                for (int bj = 0; bj < 2; ++bj) { const int col = col0 + bj * 128;
                    f32x4 g0, g1; unpack8f(*(const u32x4*)(gates + row * 2048 + goff + col), g0, g1);
                    f32x4 v0 = acc[ai][bj][m][0] * g0, v1 = acc[ai][bj][m][1] * g1;
                    if (SECOND) { f32x4 p0, p1; unpack8f(*(const u32x4*)(mg + row * 1024 + col), p0, p1); v0 += p0; v1 += p1; }
                    *(u32x4*)(mg + row * 1024 + col) = pack8f(v0, v1); } }
    }
};
struct EpiResF32 {
    static constexpr bool PERM = false;
    const float* res; float* out;
    __device__ __forceinline__ void operator()(const f32x4 (&acc)[2][2][4][2], const pg8::Unit& u, int wr, int wc, int fr, int fq) const {
        const int col0 = u.pn * 256 + wc * 32 + 4 * fq;
#pragma unroll
        for (int ai = 0; ai < 2; ++ai)
#pragma unroll
            for (int m = 0; m < 4; ++m) { const size_t off = (size_t)EPI_ROWS(ai, m) * DM + col0;
#pragma unroll
                for (int bj = 0; bj < 2; ++bj)
#pragma unroll
                    for (int n = 0; n < 2; ++n) { const f32x4 r = *(const f32x4*)(res + off + bj * 128 + n * 16); *(f32x4*)(out + off + bj * 128 + n * 16) = r + acc[ai][bj][m][n]; } }
    }
};
struct EpiSwiglu {
    static constexpr bool PERM = true;
    bf16* H; const float* bg; const float* bu; int nN;
    __device__ __forceinline__ void operator()(const f32x4 (&acc)[2][2][4][2], const pg8::Unit& u, int wr, int wc, int fr, int fq) const {
        const int e = u.pb / nN, c0 = u.pn * 128 + wc * 32 + 8 * fq;
        const f32x4 g0 = *(const f32x4*)(bg + e * 1024 + c0), g1 = *(const f32x4*)(bg + e * 1024 + c0 + 4), u0 = *(const f32x4*)(bu + e * 1024 + c0), u1 = *(const f32x4*)(bu + e * 1024 + c0 + 4);
#pragma unroll
        for (int ai = 0; ai < 2; ++ai)
#pragma unroll
            for (int m = 0; m < 4; ++m) { f32x4 a0 = acc[ai][0][m][0] + g0, a1 = acc[ai][0][m][1] + g1, b0 = acc[ai][1][m][0] + u0, b1 = acc[ai][1][m][1] + u1, r0, r1;
#pragma unroll
                for (int j = 0; j < 4; ++j) {
                    float gl = fminf(a0[j], 7.f), ln = fminf(fmaxf(b0[j], -7.f), 7.f); r0[j] = gl * __builtin_amdgcn_rcpf(1.f + __expf(-1.702f * gl)) * (ln + 1.f);
                    gl = fminf(a1[j], 7.f); ln = fminf(fmaxf(b1[j], -7.f), 7.f); r1[j] = gl * __builtin_amdgcn_rcpf(1.f + __expf(-1.702f * gl)) * (ln + 1.f); }
                *(u32x4*)(H + (size_t)EPI_ROWS(ai, m) * 1024 + c0) = pack8f(r0, r1); }
    }
};
struct EpiDown {
    static constexpr bool PERM = true;
    bf16* Y; const float* bd; const float* rgate; int nN;
    __device__ __forceinline__ void operator()(const f32x4 (&acc)[2][2][4][2], const pg8::Unit& u, int wr, int wc, int fr, int fq) const {
        const int e = u.pb / nN, col0 = u.pn * 256 + wc * 32 + 8 * fq;
        f32x4 bv[2][2];
#pragma unroll
        for (int bj = 0; bj < 2; ++bj)
#pragma unroll
            for (int n = 0; n < 2; ++n) bv[bj][n] = *(const f32x4*)(bd + e * 1024 + col0 + bj * 128 + 4 * n);
#pragma unroll
        for (int ai = 0; ai < 2; ++ai)
#pragma unroll
            for (int m = 0; m < 4; ++m) { const int row = EPI_ROWS(ai, m); const float gt = rgate[row];
#pragma unroll
                for (int bj = 0; bj < 2; ++bj) *(u32x4*)(Y + (size_t)row * 1024 + col0 + bj * 128) = pack8f((acc[ai][bj][m][0] + bv[bj][0]) * gt, (acc[ai][bj][m][1] + bv[bj][1]) * gt); }
    }
};

__device__ __forceinline__ bf16x8 frag_n(const LAS unsigned char* base, int pitch, int r0, int k0, int lane) {
    return *(const LAS bf16x8*)(base + (r0 + (lane & 15)) * pitch + (k0 + 8 * (lane >> 4)) * 2);
}
__device__ __forceinline__ bf16x8 frag_t(const LAS unsigned char* base, int pitch, int k0, int n0, int lane) {
    const int i = lane & 15, gq = lane >> 4, q = i >> 2, p = i & 3;
    const unsigned a0 = (unsigned)(uintptr_t)(base + (k0 + 8 * gq + q) * pitch + (n0 + 4 * p) * 2), a1 = a0 + 4u * (unsigned)pitch;
    s16x4 lo, hi;
    asm volatile("ds_read_b64_tr_b16 %0, %2\n\tds_read_b64_tr_b16 %1, %3\n\ts_waitcnt lgkmcnt(0)" : "=&v"(lo), "=&v"(hi) : "v"(a0), "v"(a1) : "memory");
    return (bf16x8){lo[0], lo[1], lo[2], lo[3], hi[0], hi[1], hi[2], hi[3]};
}
#define MFMA16(a, b, c) __builtin_amdgcn_mfma_f32_16x16x32_bf16(a, b, c, 0, 0, 0)
__device__ __forceinline__ float log_sigmoid(float z) { return fminf(z, 0.f) - log1pf(expf(-fabsf(z))); }

__device__ __forceinline__ void gla_a_item(Frame& F, const Args& A, int b, int c) {
    unsigned char* ws = F.ws;
    LAS unsigned char* L = F.lds;
    LAS float* l_alr = (LAS float*)L;
    LAS unsigned char* l_kd = L + 4096;  constexpr int PK = 528;
    LAS unsigned char* l_v = L + 4096 + 64 * PK; constexpr int PV = 1040;
    LAS float* l_tot = (LAS float*)(L + 4096 + 64 * PK + 64 * PV);
    const int tid = F.tid, lane = F.lane, wid = F.wave;
    const size_t tok0 = (size_t)b * SEQ + (size_t)c * 64;
    const float* alr = (const float*)(ws + WS_ALR) + tok0 * 16;
    for (int i = tid; i < 1024; i += NTHR) l_alr[i] = alr[i];
    { const bf16* vg = (const bf16*)(ws + WS_VG) + tok0 * 512;
      for (int i = tid; i < 64 * 64; i += NTHR) { const int s = i >> 6, ch = i & 63; *(LAS u32x4*)(l_v + s * PV + ch * 16) = *(const u32x4*)(vg + (size_t)s * 512 + ch * 8); } }
    __syncthreads();
    const int col = tid & 255, half = tid >> 8;
    float w2c[16];
#pragma unroll
    for (int j = 0; j < 16; ++j) w2c[j] = INP(5)[j * 256 + col];
    const float b2 = INP(6)[col];
    float run = 0.f;
#pragma unroll 2
    for (int i = 0; i < 32; ++i) { const int t = half * 32 + i; float z = b2;
#pragma unroll
        for (int j = 0; j < 16; ++j) z = fmaf(l_alr[t * 16 + j], w2c[j], z);
        run += log_sigmoid(z) * (1.f / 16.f); }
    l_tot[half * 256 + col] = run;
    __syncthreads();
    const float t0 = l_tot[col], t1 = l_tot[256 + col], blast = t0 + t1;
    { const bf16* kg = (const bf16*)(ws + WS_KG) + tok0 * 256; float bcur = half ? t0 : 0.f;
#pragma unroll 2
      for (int i = 0; i < 32; ++i) { const int t = half * 32 + i; float z = b2;
#pragma unroll
          for (int j = 0; j < 16; ++j) z = fmaf(l_alr[t * 16 + j], w2c[j], z);
          bcur += log_sigmoid(z) * (1.f / 16.f);
          const float kv = bf2f(kg[(size_t)t * 256 + col]);
          *(LAS bf16*)(l_kd + t * PK + col * 2) = (bf16)f2bf(kv * __expf(blast - bcur)); } }
    if (half == 0) ((float*)(ws + WS_DECAY))[((size_t)(b * 4 + (col >> 6)) * 128 + c) * 64 + (col & 63)] = __expf(blast);
    __syncthreads();
    const int h = wid >> 1, j = wid & 1;
    f32x4 acc[4][4];
#pragma unroll
    for (int mt = 0; mt < 4; ++mt)
#pragma unroll
        for (int nt = 0; nt < 4; ++nt) acc[mt][nt] = (f32x4){0.f, 0.f, 0.f, 0.f};
#pragma unroll
    for (int ks = 0; ks < 2; ++ks) { bf16x8 a[4], bb[4];
#pragma unroll
        for (int mt = 0; mt < 4; ++mt) a[mt] = frag_t(l_kd, PK, 32 * ks, h * 64 + 16 * mt, lane);
#pragma unroll
        for (int nt = 0; nt < 4; ++nt) bb[nt] = frag_t(l_v, PV, 32 * ks, h * 128 + j * 64 + 16 * nt, lane);
        __builtin_amdgcn_sched_barrier(0);
#pragma unroll
        for (int mt = 0; mt < 4; ++mt)
#pragma unroll
            for (int nt = 0; nt < 4; ++nt) acc[mt][nt] = MFMA16(a[mt], bb[nt], acc[mt][nt]); }
    bf16* st = (bf16*)(F.dout + DO_ST) + ((size_t)(b * 4 + h) * 128 + c) * 8192;
#pragma unroll
    for (int mt = 0; mt < 4; ++mt)
#pragma unroll
        for (int nt = 0; nt < 4; ++nt)
#pragma unroll
            for (int r = 0; r < 4; ++r) st[(16 * mt + 4 * (lane >> 4) + r) * 128 + j * 64 + 16 * nt + (lane & 15)] = (bf16)f2bf(acc[mt][nt][r]);
    __syncthreads();
}

__device__ __forceinline__ void gla_scan(Frame& F) {
    unsigned* st = (unsigned*)(F.dout + DO_ST); const float* dec = (const float*)(F.ws + WS_DECAY);
    for (int idx = F.bid * NTHR + F.tid; idx < 32 * 4096; idx += F.G * NTHR) {
        const int bh = idx >> 12, e2 = idx & 4095, dk = e2 >> 6;
        unsigned* p = st + (size_t)bh * 128 * 4096 + e2; const float* dp = dec + (size_t)bh * 128 * 64 + dk;
        float s0 = 0.f, s1 = 0.f;
#pragma unroll 8
        for (int c = 0; c < 128; ++c) { const unsigned kv = p[(size_t)c * 4096]; const float d = dp[c * 64];
            p[(size_t)c * 4096] = cvt_pk_bf16(s0, s1);
            s0 = fmaf(d, s0, bflo(kv)); s1 = fmaf(d, s1, bfhi(kv)); }
    }
}

__device__ __forceinline__ void gla_c_item(Frame& F, const Args& A, int b, int c, int hp) {
    unsigned char* ws = F.ws;
    LAS unsigned char* L = F.lds;
    LAS float* l_alr = (LAS float*)L;
    constexpr int PQ = 272, PV = 528, PP = 144;
    LAS unsigned char* l_qh = L + 4096;
    LAS unsigned char* l_kt = L + 21504;
    LAS unsigned char* l_v = L + 38912;
    LAS unsigned char* l_s = L + 72704;
    LAS unsigned char* l_p = L + 107520;
    LAS float* l_tot = (LAS float*)(L + 125952);
    LAS float* l_ss = (LAS float*)(L + 128000);
    const int tid = F.tid, lane = F.lane, wid = F.wave;
    const size_t tok0 = (size_t)b * SEQ + (size_t)c * 64;
    { const float* alr = (const float*)(ws + WS_ALR) + tok0 * 16; for (int i = tid; i < 1024; i += NTHR) l_alr[i] = alr[i]; }
    { const bf16* vg = (const bf16*)(ws + WS_VG) + tok0 * 512 + hp * 256;
      for (int i = tid; i < 64 * 32; i += NTHR) { const int s = i >> 5, ch = i & 31; *(LAS u32x4*)(l_v + s * PV + ch * 16) = *(const u32x4*)(vg + (size_t)s * 512 + ch * 8); } }
    { for (int i = tid; i < 2 * 64 * 16; i += NTHR) { const int hh = i >> 10, r = (i >> 4) & 63, ch = i & 15;
          const bf16* sp = (const bf16*)(F.dout + DO_ST) + ((size_t)(b * 4 + hp * 2 + hh) * 128 + c) * 8192 + r * 128 + ch * 8;
          *(LAS u32x4*)(l_s + hh * (64 * PQ) + r * PQ + ch * 16) = *(const u32x4*)sp; } }
    __syncthreads();
    {
        const int col = tid & 127, qt = tid >> 7, gc = hp * 128 + col;
        float w2c[16];
#pragma unroll
        for (int j = 0; j < 16; ++j) w2c[j] = INP(5)[j * 256 + gc];
        const float b2 = INP(6)[gc];
        float bc[16]; float run = 0.f;
#pragma unroll
        for (int i = 0; i < 16; ++i) { const int t = qt * 16 + i; float z = b2;
#pragma unroll
            for (int j = 0; j < 16; ++j) z = fmaf(l_alr[t * 16 + j], w2c[j], z);
            run += log_sigmoid(z) * (1.f / 16.f); bc[i] = run; }
        l_tot[qt * 128 + col] = run;
        __syncthreads();
        float pre = 0.f;
#pragma unroll
        for (int q = 0; q < 3; ++q) pre += (q < qt) ? l_tot[q * 128 + col] : 0.f;
        const bf16* qg = (const bf16*)(ws + WS_QG) + tok0 * 256 + gc; const bf16* kg = (const bf16*)(ws + WS_KG) + tok0 * 256 + gc;
#pragma unroll
        for (int i = 0; i < 16; ++i) { const int t = qt * 16 + i; const float bb = pre + bc[i];
            *(LAS bf16*)(l_qh + t * PQ + col * 2) = (bf16)f2bf(bf2f(qg[(size_t)t * 256]) * __expf(bb));
            *(LAS bf16*)(l_kt + t * PQ + col * 2) = (bf16)f2bf(bf2f(kg[(size_t)t * 256]) * __expf(-bb)); }
    }
    __syncthreads();
    const int hh = wid >> 2, j = wid & 3;
    {
        f32x4 sc4[4];
#pragma unroll
        for (int nt = 0; nt < 4; ++nt) sc4[nt] = (f32x4){0.f, 0.f, 0.f, 0.f};
#pragma unroll
        for (int ks = 0; ks < 2; ++ks) { const bf16x8 a = frag_n(l_qh, PQ, 16 * j, hh * 64 + 32 * ks, lane);
#pragma unroll
            for (int nt = 0; nt < 4; ++nt) sc4[nt] = MFMA16(a, frag_n(l_kt, PQ, 16 * nt, hh * 64 + 32 * ks, lane), sc4[nt]); }
#pragma unroll
        for (int nt = 0; nt < 4; ++nt)
#pragma unroll
            for (int r = 0; r < 4; ++r) { const int t = 16 * j + 4 * (lane >> 4) + r, s = 16 * nt + (lane & 15);
                *(LAS bf16*)(l_p + hh * (64 * PP) + t * PP + s * 2) = (bf16)f2bf(s <= t ? sc4[nt][r] : 0.f); }
    }
    __syncthreads();
    f32x4 acc[4][2];
#pragma unroll
    for (int mt = 0; mt < 4; ++mt)
#pragma unroll
        for (int nt = 0; nt < 2; ++nt) acc[mt][nt] = (f32x4){0.f, 0.f, 0.f, 0.f};
#pragma unroll
    for (int ks = 0; ks < 2; ++ks) {
        bf16x8 bb[2];
#pragma unroll
        for (int nt = 0; nt < 2; ++nt) bb[nt] = frag_t(l_s + hh * (64 * PQ), PQ, 32 * ks, 32 * j + 16 * nt, lane);
        __builtin_amdgcn_sched_barrier(0);
#pragma unroll
        for (int mt = 0; mt < 4; ++mt) { const bf16x8 a = frag_n(l_qh, PQ, 16 * mt, hh * 64 + 32 * ks, lane);
#pragma unroll
            for (int nt = 0; nt < 2; ++nt) acc[mt][nt] = MFMA16(a, bb[nt], acc[mt][nt]); } }
#pragma unroll
    for (int ks = 0; ks < 2; ++ks) {
        bf16x8 bb[2];
#pragma unroll
        for (int nt = 0; nt < 2; ++nt) bb[nt] = frag_t(l_v, PV, 32 * ks, hh * 128 + 32 * j + 16 * nt, lane);
        __builtin_amdgcn_sched_barrier(0);
#pragma unroll
        for (int mt = 0; mt < 4; ++mt) { const bf16x8 a = frag_n(l_p + hh * (64 * PP), PP, 16 * mt, 32 * ks, lane);
#pragma unroll
            for (int nt = 0; nt < 2; ++nt) acc[mt][nt] = MFMA16(a, bb[nt], acc[mt][nt]); } }
#pragma unroll
    for (int mt = 0; mt < 4; ++mt)
#pragma unroll
        for (int r = 0; r < 4; ++r) { float q = acc[mt][0][r] * acc[mt][0][r] + acc[mt][1][r] * acc[mt][1][r];
            q += __shfl_xor(q, 1); q += __shfl_xor(q, 2); q += __shfl_xor(q, 4); q += __shfl_xor(q, 8);
            if ((lane & 15) == 0) l_ss[(hh * 64 + 16 * mt + 4 * (lane >> 4) + r) * 4 + j] = q; }
    __syncthreads();
    const int head = hp * 2 + hh;
    const float* gng = INP(7); const bf16* rg = (const bf16*)(ws + WS_RG) + tok0 * 512; bf16* og = (bf16*)(F.dout + DO_OG) + tok0 * 512;
#pragma unroll
    for (int mt = 0; mt < 4; ++mt)
#pragma unroll
        for (int r = 0; r < 4; ++r) { const int t = 16 * mt + 4 * (lane >> 4) + r; const LAS float* sp = l_ss + (hh * 64 + t) * 4;
            const float rstd = 1.f / sqrtf(((sp[0] + sp[1]) + (sp[2] + sp[3])) * (1.f / 128.f) + EPS);
#pragma unroll
            for (int nt = 0; nt < 2; ++nt) { const int ch = head * 128 + 32 * j + 16 * nt + (lane & 15);
                const float rv = bf2f(rg[(size_t)t * 512 + ch]); const float sl = rv * __builtin_amdgcn_rcpf(1.f + __expf(-rv));
                og[(size_t)t * 512 + ch] = (bf16)f2bf(acc[mt][nt][r] * rstd * gng[ch] * sl); } }
    __syncthreads();
}

__device__ __forceinline__ void dil_combine(Frame& F) {
    const bf16* qd = (const bf16*)(F.ws + WS_QD); const float* lse = (const float*)(F.ws + WS_LSE); bf16* od = (bf16*)(F.dout + DO_OD);
    for (int idx = F.bid * NTHR + F.tid; idx < M * 64; idx += F.G * NTHR) {
        const int tok = idx >> 6, rem = idx & 63, h = rem >> 4, ch = rem & 15;
        const float l0 = lse[(size_t)tok * 12 + h], l1 = lse[(size_t)tok * 12 + 4 + h], l2 = lse[(size_t)tok * 12 + 8 + h];
        const float mx = fmaxf(l0, fmaxf(l1, l2)); float w0 = __expf(l0 - mx), w1 = __expf(l1 - mx), w2 = __expf(l2 - mx); const float inv = 1.f / (w0 + w1 + w2); w0 *= inv; w1 *= inv; w2 *= inv;
        const bf16* p = qd + (size_t)tok * 1536 + h * 128 + ch * 8;
        f32x4 a0, a1, b0, b1, c0, c1; unpack8f(*(const u32x4*)p, a0, a1); unpack8f(*(const u32x4*)(p + 512), b0, b1); unpack8f(*(const u32x4*)(p + 1024), c0, c1);
        *(u32x4*)(od + (size_t)tok * 512 + h * 128 + ch * 8) = pack8f(a0 * w0 + b0 * w1 + c0 * w2, a1 * w0 + b1 * w1 + c1 * w2);
    }
}

__device__ __forceinline__ att::BlockRef dil_ref(Frame& F, int I) {
    const int g = I >> 10, r = I & 1023, d = 1 << (2 * g), nqb = 32 >> (2 * g), qb = r % nqb, s = r / nqb, p = s % d, bh = s / d, h = bh & 3, b = bh >> 2;
    const size_t tb = (size_t)b * SEQ + p;
    att::BlockRef R;
    R.qs = d * 1536; R.ks = d * 1536; R.ls = d * 12; R.skv = SEQ / d; R.P0 = qb * 256;
    bf16* q = (bf16*)(F.ws + WS_QD) + tb * 1536 + g * 512 + h * 128;
    R.Q = q + (size_t)qb * 256 * R.qs;
    R.K = (const bf16*)(F.ws + WS_KD) + tb * 1536 + g * 512 + h * 128;
    R.L = (float*)(F.ws + WS_LSE) + tb * 12 + g * 4 + h + (size_t)qb * 256 * R.ls;
    return R;
}
__device__ __forceinline__ att::BlockRef xat_ref(Frame& F, int I) {
    const int qb = I & 31, h = (I >> 5) & 3, b = I >> 7;
    att::BlockRef R; R.qs = 512; R.ks = 1024; R.ls = 0; R.skv = 256; R.P0 = 256; R.L = nullptr;
    bf16* q = (bf16*)(F.ws + WS_QX) + ((size_t)b * SEQ + (size_t)qb * 256) * 512 + h * 128;
    R.Q = q; R.K = (const bf16*)(F.ws + WS_KVM) + (size_t)b * 256 * 1024 + h * 128;
    return R;
}
template <bool DIL>
__device__ __forceinline__ void attn_phase(Frame& F) {
    constexpr int TOTAL = DIL ? 3072 : 1024; constexpr int W = DIL ? 129 : (1 << 20); constexpr long VOFF = DIL ? (long)((WS_VD - WS_KD) / 2) : 512;
    int I = F.bid; if (I >= TOTAL) return;
    att::BlockRef cur = DIL ? dil_ref(F, I) : xat_ref(F, I);
    att::Seam S;
    att::prime<VOFF>(cur, W, F.ldsg, S);
    for (;;) {
        const bool more = I + F.G < TOTAL; const int In = more ? I + F.G : I;
        const att::BlockRef nxt = DIL ? dil_ref(F, In) : xat_ref(F, In);
        att::block<true, VOFF>(cur, nxt, W, F.ldsg, S);
        if (!more) break;
        cur = nxt; I = In;
    }
}

__device__ __forceinline__ void router_phase(Frame& F, const Args& A) {
    unsigned char* ws = F.ws;
    LAS unsigned char* l_w = F.lds;
    LAS float* l_lg = (LAS float*)(F.lds + 65536) + F.wave * (16 * 33 + 16);
    LAS unsigned* l_hist = (LAS unsigned*)(F.lds + 65536 + 8 * (16 * 33 + 16) * 4);
    const int tid = F.tid, lane = F.lane;
    { const u32x4* wsrc = (const u32x4*)(ws + WS_WR);
      for (int i = tid; i < 32 * 128; i += NTHR) { const int e = i >> 7, ch = i & 127; *(LAS u32x4*)(l_w + e * 2048 + ((ch ^ (e & 15)) << 4)) = wsrc[i]; } }
    if (tid < 64) l_hist[tid] = 0u;
    { int* rt = (int*)(ws + WS_RTOK); float* rg = (float*)(ws + WS_RGATE);
      for (int i = F.bid * NTHR + tid; i < 2 * RT_CAP; i += F.G * NTHR) { rt[i] = 0; rg[i] = 0.f; } }
    __syncthreads();
    const float* h2 = (const float*)F.dout; const float* g3 = INP(18); const float* br = INP(20);
    bf16* fo = (bf16*)(ws + WS_A);
    const int fr = lane & 15, fq = lane >> 4;
    for (int rb = F.bid * NWAVES + F.wave; rb < M / 16; rb += F.G * NWAVES) {
        const size_t row0 = (size_t)rb * 16;
        const float* xr = h2 + (row0 + fr) * DM + 8 * fq;
        f32x4 c0 = {0.f, 0.f, 0.f, 0.f}, c1 = {0.f, 0.f, 0.f, 0.f}; float ss = 0.f;
#pragma unroll 4
        for (int kk = 0; kk < 32; ++kk) {
            const f32x4 x0 = *(const f32x4*)(xr + 32 * kk), x1 = *(const f32x4*)(xr + 32 * kk + 4);
            ss += (x0[0] * x0[0] + x0[1] * x0[1]) + (x0[2] * x0[2] + x0[3] * x0[3]) + (x1[0] * x1[0] + x1[1] * x1[1]) + (x1[2] * x1[2] + x1[3] * x1[3]);
            const u32x4 hi = pack8f(x0, x1); f32x4 y0, y1; unpack8f(hi, y0, y1);
            const u32x4 lo = pack8f(x0 - y0, x1 - y1);
            const bf16x8 ah = *reinterpret_cast<const bf16x8*>(&hi), al = *reinterpret_cast<const bf16x8*>(&lo);
            const int ch = 4 * kk + fq;
            const bf16x8 b0 = *(const LAS bf16x8*)(l_w + fr * 2048 + ((ch ^ fr) << 4)), b1 = *(const LAS bf16x8*)(l_w + (16 + fr) * 2048 + ((ch ^ fr) << 4));
            c0 = MFMA16(ah, b0, c0); c0 = MFMA16(al, b0, c0); c1 = MFMA16(ah, b1, c1); c1 = MFMA16(al, b1, c1);
        }
        ss += __shfl_xor(ss, 16); ss += __shfl_xor(ss, 32);
        const float rstd = 1.f / sqrtf(ss * (1.f / DM) + EPS);
        if (fq == 0) l_lg[16 * 33 + fr] = rstd;
#pragma unroll
        for (int r = 0; r < 4; ++r) { l_lg[(4 * fq + r) * 33 + fr] = c0[r]; l_lg[(4 * fq + r) * 33 + 16 + fr] = c1[r]; }
        LDS_WAIT(); asm volatile("" ::: "memory");
        if (lane < 16) {
            const float rs = l_lg[16 * 33 + lane]; float v[32];
#pragma unroll
            for (int e = 0; e < 32; ++e) v[e] = l_lg[lane * 33 + e] * rs + br[e];
            int ci[4]; float cv[4];
#pragma unroll
            for (int k = 0; k < 4; ++k) { float best = -__builtin_inff(); int bi = 0;
#pragma unroll
                for (int e = 0; e < 32; ++e) { bool free_ = true;
#pragma unroll
                    for (int kk2 = 0; kk2 < k; ++kk2) free_ = free_ && (ci[kk2] != e);
                    if (free_ && v[e] > best) { best = v[e]; bi = e; } }
                ci[k] = bi; cv[k] = best; }
            float ex[4], sum = 0.f;
#pragma unroll
            for (int k = 0; k < 4; ++k) { ex[k] = __expf(cv[k] - cv[0]); sum += ex[k]; }
            const float inv = 1.f / sum; const size_t tok = row0 + lane; const int hf = tok >= HALF_TOK ? 1 : 0;
            int* te = (int*)(ws + WS_TOPE) + tok * 4; float* tg = (float*)(ws + WS_TGATE) + tok * 4;
#pragma unroll
            for (int k = 0; k < 4; ++k) { te[k] = ci[k]; tg[k] = ex[k] * inv; atomicAdd((unsigned*)&l_hist[hf * 32 + ci[k]], 1u); }
        }
#pragma unroll 2
        for (int r = 0; r < 16; ++r) { const float rs = l_lg[16 * 33 + r];
            const f32x4* xp = (const f32x4*)(h2 + (row0 + r) * DM) + lane; const f32x4* gp = (const f32x4*)g3 + lane; u32x2* op = (u32x2*)(fo + (row0 + r) * DM) + lane;
#pragma unroll
            for (int jj = 0; jj < 4; ++jj) { const f32x4 x = xp[64 * jj], gg = gp[64 * jj]; u32x2 w; w.x = cvt_pk_bf16(x.x * rs * gg.x, x.y * rs * gg.y); w.y = cvt_pk_bf16(x.z * rs * gg.z, x.w * rs * gg.w); op[64 * jj] = w; } }
        LDS_WAIT(); asm volatile("" ::: "memory");
    }
    __syncthreads();
    if (tid < 64 && l_hist[tid] != 0u) atomicAdd(F.ctl + CW_CNT + tid, l_hist[tid]);
}

struct MoeTab { LAS int* pstart; LAS int* blk_e; LAS int* nblk; };
__device__ __forceinline__ MoeTab moe_tables(Frame& F, int half) {
    MoeTab T; T.pstart = (LAS int*)(F.lds + TAB_OFF); T.blk_e = T.pstart + 32; T.nblk = T.blk_e + MAXBLK;
    __syncthreads();
    if (F.tid == 0) { int pos = 0;
        for (int e = 0; e < NEXP; ++e) { const int cnt = (int)__hip_atomic_load(F.ctl + CW_CNT + half * 32 + e, __ATOMIC_RELAXED, __HIP_MEMORY_SCOPE_AGENT); const int nb = (cnt + 255) >> 8;
            T.pstart[e] = pos * 256; for (int jx = 0; jx < nb && pos < MAXBLK; ++jx) T.blk_e[pos++] = e; }
        T.nblk[0] = pos; }
    __syncthreads();
    return T;
}
__device__ __forceinline__ void place_phase(Frame& F) {
    unsigned char* ws = F.ws;
    LAS int* l_cnt = (LAS int*)(F.lds + 4096); LAS int* l_base = l_cnt + 32;
    const int* te = (const int*)(ws + WS_TOPE); const float* tg = (const float*)(ws + WS_TGATE);
    int* tslot = (int*)(ws + WS_TSLOT);
    for (int half = 0; half < 2; ++half) {
        const MoeTab T = moe_tables(F, half);
        int* rtok = (int*)(ws + WS_RTOK) + half * RT_CAP; float* rgate = (float*)(ws + WS_RGATE) + half * RT_CAP;
        for (int bt = F.bid; bt < HALF_TOK / 128; bt += F.G) {
            if (F.tid < 32) l_cnt[F.tid] = 0;
            __syncthreads();
            const int tok = half * HALF_TOK + bt * 128 + (F.tid >> 2), k = F.tid & 3;
            const int e = te[(size_t)tok * 4 + k];
            const int rank = atomicAdd((int*)&l_cnt[e], 1);
            __syncthreads();
            if (F.tid < 32) l_base[F.tid] = (int)atomicAdd(F.ctl + CW_CUR + half * 32 + F.tid, (unsigned)l_cnt[F.tid]);
            __syncthreads();
            const int dest = T.pstart[e] + l_base[e] + rank;
            if (dest < RT_CAP) { rtok[dest] = tok; rgate[dest] = tg[(size_t)tok * 4 + k]; }
            tslot[(size_t)tok * 4 + k] = dest < RT_CAP ? dest : 0;
            __syncthreads();
        }
    }
}
__device__ __forceinline__ void combine_phase(Frame& F, const Args& A, int half) {
    float* h2 = (float*)F.dout; const bf16* Y = (const bf16*)(F.ws + WS_Y); const int* tslot = (const int*)(F.ws + WS_TSLOT); const float* gf = INP(27);
    for (int m = half * HALF_TOK + F.bid * NWAVES + F.wave; m < (half + 1) * HALF_TOK; m += F.G * NWAVES) {
        f32x4* xr = (f32x4*)(h2 + (size_t)m * DM) + F.lane;
        f32x4 v[4];
#pragma unroll
        for (int j = 0; j < 4; ++j) v[j] = xr[64 * j];
#pragma unroll
        for (int k = 0; k < 4; ++k) { const int sl = tslot[(size_t)m * 4 + k]; const u32x2* yp = (const u32x2*)(Y + (size_t)sl * 1024) + F.lane;
#pragma unroll
            for (int j = 0; j < 4; ++j) { const u32x2 w = yp[64 * j]; v[j] += (f32x4){bflo(w.x), bfhi(w.x), bflo(w.y), bfhi(w.y)}; } }
        float s = 0.f;
#pragma unroll
        for (int j = 0; j < 4; ++j) s += (v[j].x * v[j].x + v[j].y * v[j].y) + (v[j].z * v[j].z + v[j].w * v[j].w);
        const float rstd = 1.f / sqrtf(wave_sum(s) * (1.f / DM) + EPS);
        const f32x4* gr = (const f32x4*)gf + F.lane;
#pragma unroll
        for (int j = 0; j < 4; ++j) xr[64 * j] = v[j] * rstd * gr[64 * j];
    }
}

__global__ void __launch_bounds__(NTHR, 2) mk_fwd(Args A) {
    extern __shared__ __attribute__((aligned(16))) unsigned char lds[];
    Frame F;
    F.lds = (LAS unsigned char*)lds; F.ldsg = (char*)lds;
    F.tid = threadIdx.x; F.lane = F.tid & 63; F.wave = __builtin_amdgcn_readfirstlane(F.tid >> 6);
    F.G = gridDim.x; F.bid = blockIdx.x;
    F.ws = A.ws; F.ctl = (unsigned*)(A.ws + WS_CTL); F.dout = (unsigned char*)A.out;
    volatile LAS unsigned* MISC = (volatile LAS unsigned*)(F.lds + MISC_OFF);
    if (F.tid < 16) MISC[F.tid] = 0u;
    __syncthreads();
    XcdBarrier bar; bar.bar = F.ctl + CW_BAR; bar.x = 0; bar.st = nullptr;
    if (!MK_PER_PHASE) bar = xcd_barrier_post(F.ctl + CW_BAR, MISC + 8);
    const int lo = A.ph_lo, hi = A.ph_hi;
#ifndef PHMASK
#define PHMASK 0x7ffff
#endif
#define IN(k) (((PHMASK >> (k)) & 1) && lo <= (k) && (k) < hi)
#define SEAM(k) do { if (IN(k) && IN((k) + 1)) xcd_barrier(bar); } while (0)
    unsigned char* ws = F.ws;
    const int* positions = (const int*)A.in[2];

    if (IN(0)) { p0_prologue(F, A); } SEAM(0);
    if (IN(1)) {
        { pg8::Gemm g{(const bf16*)(ws + WS_A), (const bf16*)(ws + WS_WIN), 1024, nullptr}; pg8::StaticOrder S; S.init(M / 256, N1 / 256, F.G, F.bid);
          EpiProj E{ws, positions}; pg8::gemm_phase<EpiProj, pg8::StaticOrder, false>(F.lds, g, S, E); }
        { pg8::Gemm g{(const bf16*)(ws + WS_MEMN), (const bf16*)(ws + WS_WXKV), 1024, nullptr}; pg8::StaticOrder S; S.init(8, 4, F.G, F.bid);
          EpiBf16<0> E{(bf16*)(ws + WS_KVM), 1024, nullptr, 1.f}; pg8::gemm_phase<EpiBf16<0>, pg8::StaticOrder, false>(F.lds, g, S, E); }
    } SEAM(1);
    if (IN(2)) {
#ifndef NO_GLAA
        for (int it = F.bid; it < NBATCH * 128; it += F.G) gla_a_item(F, A, it >> 7, it & 127);
#endif
#ifndef NO_DIL
        attn_phase<true>(F);
#endif
    } SEAM(2);
    if (IN(3)) { gla_scan(F); } SEAM(3);
    if (IN(4)) {
        for (int it = F.bid; it < NBATCH * 128 * 2; it += F.G) gla_c_item(F, A, it >> 8, (it >> 1) & 127, it & 1);
        dil_combine(F);
    } SEAM(4);
    if (IN(5)) { pg8::Gemm g{(const bf16*)(ws + WS_A), (const bf16*)(ws + WS_WGATE), 1024, nullptr}; pg8::StaticOrder S; S.init(M / 256, 8, F.G, F.bid);
        EpiBf16<1> E{(bf16*)(ws + WS_GATES), 2048, INP(11), 1.f}; pg8::gemm_phase<EpiBf16<1>, pg8::StaticOrder, false>(F.lds, g, S, E); } SEAM(5);
    if (IN(6)) {
        { pg8::Gemm g{(const bf16*)(F.dout + DO_OG), (const bf16*)(ws + WS_WBG), 512, nullptr}; pg8::StaticOrder S; S.init(M / 256, 4, F.G, F.bid);
          EpiBranch<0> E{(bf16*)(ws + WS_MERGED), (const bf16*)(ws + WS_GATES), 0}; pg8::gemm_phase<EpiBranch<0>, pg8::StaticOrder, false>(F.lds, g, S, E); }
        { pg8::Gemm g{(const bf16*)(F.dout + DO_OD), (const bf16*)(ws + WS_WBD), 512, nullptr}; pg8::StaticOrder S; S.init(M / 256, 4, F.G, F.bid);
          EpiBranch<1> E{(bf16*)(ws + WS_MERGED), (const bf16*)(ws + WS_GATES), 1024}; pg8::gemm_phase<EpiBranch<1>, pg8::StaticOrder, false>(F.lds, g, S, E); }
    } SEAM(6);
    if (IN(7)) { pg8::Gemm g{(const bf16*)(ws + WS_MERGED), (const bf16*)(ws + WS_WMIX), 1024, nullptr}; pg8::StaticOrder S; S.init(M / 256, 4, F.G, F.bid);
        EpiResF32 E{INP(0), (float*)F.dout}; pg8::gemm_phase<EpiResF32, pg8::StaticOrder, false>(F.lds, g, S, E); } SEAM(7);
    if (IN(8)) {
        const int gw = F.bid * NWAVES + F.wave, NGW = F.G * NWAVES;
        for (int m = gw; m < M; m += NGW) rms_row_to_bf16((const float*)F.dout + (size_t)m * DM, INP(13), (bf16*)(ws + WS_A) + (size_t)m * DM, F.lane);
        LAS float* scr = (LAS float*)(F.lds + F.wave * 16384);
        constexpr int IPM = 16 * 32;
        for (int it = gw; it < 3 * NEXP * IPM; it += NGW) { const int mat = it / IPM, r = it % IPM, kind = mat / NEXP, e = mat % NEXP;
            if (kind == 0) transpose_item(INP(21) + (size_t)e * 1048576, 1024, 1024, (bf16*)(ws + WS_WGU), RmGU{e * 2048}, scr, r, F.lane);
            else if (kind == 1) transpose_item(INP(23) + (size_t)e * 1048576, 1024, 1024, (bf16*)(ws + WS_WGU), RmGU{e * 2048 + 128}, scr, r, F.lane);
            else transpose_item(INP(25) + (size_t)e * 1048576, 1024, 1024, (bf16*)(ws + WS_WDN), RmId{e * 1024}, scr, r, F.lane); }
    } SEAM(8);
    if (IN(9)) { pg8::Gemm g{(const bf16*)(ws + WS_A), (const bf16*)(ws + WS_WXQ), 1024, nullptr}; pg8::StaticOrder S; S.init(M / 256, 2, F.G, F.bid);
        EpiBf16<0> E{(bf16*)(ws + WS_QX), 512, nullptr, 1.f}; pg8::gemm_phase<EpiBf16<0>, pg8::StaticOrder, false>(F.lds, g, S, E); } SEAM(9);
    if (IN(10)) { attn_phase<false>(F); } SEAM(10);
    if (IN(11)) { pg8::Gemm g{(const bf16*)(ws + WS_QX), (const bf16*)(ws + WS_WXO), 512, nullptr}; pg8::StaticOrder S; S.init(M / 256, 4, F.G, F.bid);
        EpiResF32 E{(const float*)F.dout, (float*)F.dout}; pg8::gemm_phase<EpiResF32, pg8::StaticOrder, false>(F.lds, g, S, E); } SEAM(11);
    if (IN(12)) { router_phase(F, A); } SEAM(12);
    if (IN(13)) { place_phase(F); } SEAM(13);
#define MOE_GU(half) do { const MoeTab T = moe_tables(F, half); \
        pg8::Gemm g{(const bf16*)(ws + WS_A), (const bf16*)(ws + WS_WGU), 1024, (const int*)(ws + WS_RTOK) + (half) * RT_CAP}; \
        pg8::MoeOrder S; S.init(T.nblk[0], 8, F.G, F.bid); S.blk_e = T.blk_e; \
        EpiSwiglu E{(bf16*)(ws + WS_H), INP(22), INP(24), 8}; pg8::gemm_phase<EpiSwiglu, pg8::MoeOrder, true>(F.lds, g, S, E); } while (0)
#define MOE_DN(half) do { const MoeTab T = moe_tables(F, half); \
        pg8::Gemm g{(const bf16*)(ws + WS_H), (const bf16*)(ws + WS_WDN), 1024, nullptr}; \
        pg8::MoeOrder S; S.init(T.nblk[0], 4, F.G, F.bid); S.blk_e = T.blk_e; \
        EpiDown E{(bf16*)(ws + WS_Y), INP(26), (const float*)(ws + WS_RGATE) + (half) * RT_CAP, 4}; pg8::gemm_phase<EpiDown, pg8::MoeOrder, false>(F.lds, g, S, E); } while (0)
    if (IN(14)) { MOE_GU(0); } SEAM(14);
    if (IN(15)) { MOE_DN(0); } SEAM(15);
    if (IN(16)) { combine_phase(F, A, 0); MOE_GU(1); } SEAM(16);
    if (IN(17)) { MOE_DN(1); } SEAM(17);
    if (IN(18)) { combine_phase(F, A, 1); }
#undef IN
#undef SEAM
}


extern "C" void kernel_launch(void* const* d_in, const int* in_sizes, int n_in, void* d_out, int out_size, void* d_ws, size_t ws_size, hipStream_t stream) {
    static int grid = 0;
    if (grid == 0) {
        if (n_in != 28 || out_size != M * DM || ws_size < WS_END) { fprintf(stderr, "kernel_launch: unexpected shapes (n_in %d, out %d, ws %zu)\n", n_in, out_size, ws_size); grid = -1; return; }
        int dev = 0, cus = 0, per_cu = 0;
        if (hipGetDevice(&dev) != hipSuccess || hipDeviceGetAttribute(&cus, hipDeviceAttributeMultiprocessorCount, dev) != hipSuccess) { grid = -1; return; }
        if (hipFuncSetAttribute((const void*)mk_fwd, hipFuncAttributeMaxDynamicSharedMemorySize, LDS_BYTES) != hipSuccess) { fprintf(stderr, "kernel_launch: hipFuncSetAttribute failed\n"); grid = -1; return; }
        if (hipOccupancyMaxActiveBlocksPerMultiprocessor(&per_cu, (const void*)mk_fwd, NTHR, LDS_BYTES) != hipSuccess || per_cu < 1) { fprintf(stderr, "kernel_launch: occupancy query says %d\n", per_cu); (void)hipGetLastError(); grid = -1; return; }
        grid = cus;
    }
    if (grid < 0) return;
#if MK_DIAG
    unsigned long long* sums = (unsigned long long*)((char*)d_ws + WS_DIAG);
    (void)hipMemsetAsync(sums, 0, 4096, stream);
    for (int run = 0; run < 2; ++run) {
        (void)hipMemsetAsync((char*)d_ws + 1 * MiB, run ? 0x3C : 0x00, WS_END - 1 * MiB, stream);
        (void)hipMemsetAsync(d_out, run ? 0x3D : 0x00, (size_t)M * DM * 4, stream);
        (void)hipMemsetAsync((char*)d_ws + WS_CTL, 0, CTL_ZERO_BYTES, stream);
        Args a{};
        for (int i = 0; i < 28; ++i) a.in[i] = d_in[i];
        a.out = (float*)d_out; a.ws = (unsigned char*)d_ws;
        for (int p = 0; p < NPH; ++p) { a.ph_lo = p; a.ph_hi = p + 1; hipLaunchKernelGGL(mk_fwd, dim3(grid), dim3(NTHR), LDS_BYTES, stream, a);
            diag_sums(p, (unsigned char*)d_ws, (unsigned char*)d_out, sums + run * 32 + p, stream); }
    }
    hipLaunchKernelGGL(k_verdict, dim3(1024), dim3(256), 0, stream, (const unsigned long long*)sums, (float*)d_out, (size_t)M * DM);
#else
    (void)hipMemsetAsync((char*)d_ws + WS_CTL, 0, CTL_ZERO_BYTES, stream);
    Args a{};
    for (int i = 0; i < 28; ++i) a.in[i] = d_in[i];
    a.out = (float*)d_out; a.ws = (unsigned char*)d_ws;
#if MK_PER_PHASE
    for (int p = 0; p < NPH; ++p) { a.ph_lo = p; a.ph_hi = p + 1; hipLaunchKernelGGL(mk_fwd, dim3(grid), dim3(NTHR), LDS_BYTES, stream, a); }
#else
    a.ph_lo = 0; a.ph_hi = NPH; hipLaunchKernelGGL(mk_fwd, dim3(grid), dim3(NTHR), LDS_BYTES, stream, a);
#endif
#endif
}
```

```cpp
#include <hip/hip_runtime.h>
#include <cstdio>
#include <cstdint>

#define LAS __attribute__((address_space(3)))
#define GAS __attribute__((address_space(1)))
typedef unsigned short bf16;
typedef short bf16x8 __attribute__((ext_vector_type(8)));
typedef short s16x4 __attribute__((ext_vector_type(4)));
typedef float f32x4 __attribute__((ext_vector_type(4)));
typedef float f32x16 __attribute__((ext_vector_type(16)));
typedef unsigned u32x4 __attribute__((ext_vector_type(4)));
typedef unsigned u32x2 __attribute__((ext_vector_type(2)));

typedef float f32x2 __attribute__((ext_vector_type(2)));
typedef __bf16 b16x2 __attribute__((ext_vector_type(2)));
__device__ __forceinline__ unsigned cvt_pk_bf16(float lo, float hi) { const f32x2 v = {lo, hi}; const b16x2 r = __builtin_convertvector(v, b16x2); return __builtin_bit_cast(unsigned, r); }
__device__ __forceinline__ float bf2f(unsigned b) { return __uint_as_float(b << 16); }
__device__ __forceinline__ float bflo(unsigned w) { return __uint_as_float(w << 16); }
__device__ __forceinline__ float bfhi(unsigned w) { return __uint_as_float(w & 0xffff0000u); }
__device__ __forceinline__ unsigned f2bf(float f) { unsigned u = __float_as_uint(f); return (u + 0x7fffu + ((u >> 16) & 1u)) >> 16; }
__device__ __forceinline__ unsigned pk2(float lo, float hi) { return f2bf(lo) | (f2bf(hi) << 16); }

namespace pg8 {
constexpr int BM = 256, BK = 64, HALF = 128, HTB = HALF * BK * 2, STAGE_BYTES = 8 * HTB, NXCD = 8, WGM = 8;
__host__ __device__ __forceinline__ int lds_byte(int r, int c) { const int st = (r >> 4) * 2 + (c >> 5), rr = r & 15, cc = c & 31, ob = rr * 64 + cc * 2; return st * 1024 + (ob ^ (((ob >> 9) & 1) << 5)); }
__host__ __device__ __forceinline__ void stage_rc(int b, int& R, int& C) { const int st = b / 1024, sb = b % 1024, swz = sb ^ (((sb >> 9) & 1) << 5); R = (st >> 1) * 16 + swz / 64; C = (st & 1) * 32 + (swz % 64) / 2; }
__host__ __device__ __forceinline__ int perm32(int rho) { const int n = rho >> 4, i = rho & 15; return 8 * (i >> 2) + 4 * n + (i & 3); }

struct Unit { int pm, pn, pb; };
struct Gemm { const bf16* A; const bf16* Bt; int K; const int* rowmap; };

struct StaticOrder {
    int nM, nN, nwg, G, c;
    __device__ void init(int nM_, int nN_, int G_, int c_) { nM = nM_; nN = nN_; nwg = nM * nN; G = G_; c = c_; }
    __device__ bool next(int i, Unit& u) const {
        const long L = (long)i * G + c; if (L >= nwg) return false;
        int wgid = (int)L; { const int q = nwg / NXCD, r = nwg % NXCD, xcd = wgid % NXCD, off = wgid / NXCD; wgid = (xcd < r ? xcd * (q + 1) : r * (q + 1) + (xcd - r) * q) + off; }
        const int nig = WGM * nN, gid = wgid / nig, fm = gid * WGM, gsz = (nM - fm) < WGM ? (nM - fm) : WGM;
        u.pm = fm + ((wgid % nig) % gsz); u.pn = (wgid % nig) / gsz; u.pb = u.pn; return true;
    }
};
struct MoeOrder : StaticOrder {
    const LAS int* blk_e;
    __device__ bool next(int i, Unit& u) const { if (!StaticOrder::next(i, u)) return false; u.pb = blk_e[u.pm] * nN + u.pn; return true; }
};

template <class Epi, class Sched, bool GATHER>
__device__ __forceinline__ void gemm_phase(LAS unsigned char* lds, const Gemm g, const Sched& S, const Epi& E) {
    const int tid = threadIdx.x, wid = __builtin_amdgcn_readfirstlane(tid >> 6), lane = tid & 63, wr = wid >> 2, wc = wid & 3, fr = lane & 15, fq = lane >> 4;
    const int K = g.K, nt = K / BK;
    unsigned voffA[2], voffB[2]; int rA[2], cA2[2];
#pragma unroll
    for (int i = 0; i < 2; ++i) { int R, C; stage_rc(tid * 16 + i * 8192, R, C); const int Rb = Epi::PERM ? ((R & ~31) + perm32(R & 31)) : R;
        voffA[i] = (unsigned)(R * K + C) * 2u; voffB[i] = (unsigned)(Rb * K + C) * 2u; rA[i] = R; cA2[i] = C * 2; }
    const size_t kstep = (size_t)(BK * 2);
    const size_t hstep = (size_t)HALF * K * 2;
    const size_t tstep = 2 * hstep;
    const unsigned ldsw = (unsigned)wid * 1024u;
    const int aoff = lds_byte(wr * 64 + fr, fq * 8), boff = lds_byte(wc * 32 + fr, fq * 8);
#define PG8_SA(b, h) (((b) * 2 + (h)) * HTB)
#define PG8_SB(b, h) ((4 + (b) * 2 + (h)) * HTB)
#define PG8_STAGE(bufoff, gbase, voff) do { _Pragma("unroll") for (int _i = 0; _i < 2; ++_i) \
        __builtin_amdgcn_global_load_lds((const unsigned*)((const char*)(gbase) + (voff)[_i]), (LAS unsigned*)(lds + (bufoff) + ldsw + _i * 8192), 16, 0, 0); } while (0)
#define PG8_STAGE_G(bufoff, o0, o1, kb) do { \
        __builtin_amdgcn_global_load_lds((const unsigned*)((const char*)g.A + (size_t)(o0) + (kb)), (LAS unsigned*)(lds + (bufoff) + ldsw), 16, 0, 0); \
        __builtin_amdgcn_global_load_lds((const unsigned*)((const char*)g.A + (size_t)(o1) + (kb)), (LAS unsigned*)(lds + (bufoff) + ldsw + 8192), 16, 0, 0); } while (0)
#define PG8_LDA(dst, b, h) do { _Pragma("unroll") for (int m = 0; m < 4; ++m) _Pragma("unroll") for (int k = 0; k < 2; ++k) dst[m][k] = *(const LAS bf16x8*)(lds + PG8_SA(b, h) + aoff + m * 2048 + k * 1024); } while (0)
#define PG8_LDB(dst, b, h) do { _Pragma("unroll") for (int n = 0; n < 2; ++n) _Pragma("unroll") for (int k = 0; k < 2; ++k) dst[n][k] = *(const LAS bf16x8*)(lds + PG8_SB(b, h) + boff + n * 2048 + k * 1024); } while (0)
#define PG8_MMA(ai, bj, At, Bt) do { __builtin_amdgcn_s_setprio(1); _Pragma("unroll") for (int m = 0; m < 4; ++m) _Pragma("unroll") for (int n = 0; n < 2; ++n) _Pragma("unroll") for (int k = 0; k < 2; ++k) \
        acc[ai][bj][m][n] = __builtin_amdgcn_mfma_f32_16x16x32_bf16(Bt[n][k], At[m][k], acc[ai][bj][m][n], 0, 0, 0); __builtin_amdgcn_s_setprio(0); } while (0)
#define PG8_WAIT_V(n) asm volatile("s_waitcnt vmcnt(" #n ")" ::: "memory")
#define PG8_WAIT_L(n) asm volatile("s_waitcnt lgkmcnt(" #n ")" ::: "memory")
#define PG8_BAR __builtin_amdgcn_s_barrier()
#define PG8_SCHED __builtin_amdgcn_sched_barrier(0)
#define PG8_ROWOFF(dst, U) do { _Pragma("unroll") for (int _h = 0; _h < 2; ++_h) _Pragma("unroll") for (int _i = 0; _i < 2; ++_i) \
        dst[_h][_i] = (unsigned)g.rowmap[(U).pm * BM + _h * HALF + rA[_i]] * (unsigned)(K * 2) + (unsigned)cA2[_i]; } while (0)
    Unit cur, nxt; int ui = 0;
    if (!S.next(0, cur)) return;
    f32x4 acc[2][2][4][2];
#pragma unroll
    for (int a = 0; a < 2; ++a)
#pragma unroll
        for (int b = 0; b < 2; ++b)
#pragma unroll
            for (int m = 0; m < 4; ++m)
#pragma unroll
                for (int n = 0; n < 2; ++n) acc[a][b][m][n] = (f32x4){0.f, 0.f, 0.f, 0.f};
    bf16x8 At[4][2], B0[2][2], B1[2][2];
    const char* cA = (const char*)g.A + (size_t)cur.pm * tstep; const char* cB = (const char*)g.Bt + (size_t)cur.pb * tstep;
    unsigned cO[2][2] = {{0u, 0u}, {0u, 0u}}, nO[2][2] = {{0u, 0u}, {0u, 0u}};
    bool has_next = S.next(1, nxt);
    if constexpr (GATHER) { PG8_ROWOFF(cO, cur); if (has_next) { PG8_ROWOFF(nO, nxt); } else { _Pragma("unroll") for (int h = 0; h < 2; ++h) _Pragma("unroll") for (int i = 0; i < 2; ++i) nO[h][i] = cO[h][i]; } }
    if constexpr (GATHER) {
        PG8_STAGE(PG8_SB(0, 0), cB, voffB); PG8_STAGE_G(PG8_SA(0, 0), cO[0][0], cO[0][1], 0); PG8_STAGE(PG8_SB(0, 1), cB + hstep, voffB); PG8_STAGE_G(PG8_SA(0, 1), cO[1][0], cO[1][1], 0);
        if (wr == 1) PG8_BAR;
        PG8_WAIT_V(4); PG8_BAR;
        PG8_STAGE(PG8_SB(1, 0), cB + kstep, voffB); PG8_STAGE_G(PG8_SA(1, 0), cO[0][0], cO[0][1], kstep); PG8_STAGE(PG8_SB(1, 1), cB + hstep + kstep, voffB);
        PG8_WAIT_V(6); PG8_BAR;
    } else {
        PG8_STAGE(PG8_SB(0, 0), cB, voffB); PG8_STAGE(PG8_SA(0, 0), cA, voffA); PG8_STAGE(PG8_SB(0, 1), cB + hstep, voffB); PG8_STAGE(PG8_SA(0, 1), cA + hstep, voffA);
        if (wr == 1) PG8_BAR;
        PG8_WAIT_V(4); PG8_BAR;
        PG8_STAGE(PG8_SB(1, 0), cB + kstep, voffB); PG8_STAGE(PG8_SA(1, 0), cA + kstep, voffA); PG8_STAGE(PG8_SB(1, 1), cB + hstep + kstep, voffB);
        PG8_WAIT_V(6); PG8_BAR;
    }
    for (;;) {
        const char* nA = has_next ? (const char*)g.A + (size_t)nxt.pm * tstep : cA; const char* nB = has_next ? (const char*)g.Bt + (size_t)nxt.pb * tstep : cB;
        for (int t = 0; t < nt; t += 2) {
            const bool last = (t == nt - 2);
            const char* a1 = cA + (size_t)(t + 1) * kstep;
            const char* a2 = last ? nA : cA + (size_t)(t + 2) * kstep; const char* b2 = last ? nB : cB + (size_t)(t + 2) * kstep;
            const char* a3 = a2 + kstep; const char* b3 = b2 + kstep;
            const size_t k1 = (size_t)(t + 1) * kstep, k2 = last ? 0 : (size_t)(t + 2) * kstep, k3 = k2 + kstep;
            unsigned x00 = 0, x01 = 0, x10 = 0, x11 = 0;
            if constexpr (GATHER) { x00 = last ? nO[0][0] : cO[0][0]; x01 = last ? nO[0][1] : cO[0][1]; x10 = last ? nO[1][0] : cO[1][0]; x11 = last ? nO[1][1] : cO[1][1]; }
            PG8_LDB(B0, 0, 0); PG8_SCHED; PG8_LDA(At, 0, 0);
            if constexpr (GATHER) PG8_STAGE_G(PG8_SA(1, 1), cO[1][0], cO[1][1], k1); else PG8_STAGE(PG8_SA(1, 1), a1 + hstep, voffA);
            PG8_WAIT_L(8); PG8_BAR; PG8_WAIT_L(0); PG8_MMA(0, 0, At, B0); PG8_BAR; PG8_SCHED;
            PG8_LDB(B1, 0, 1); PG8_STAGE(PG8_SB(0, 0), b2, voffB);
            PG8_BAR; PG8_WAIT_L(0); PG8_MMA(0, 1, At, B1); PG8_BAR;
            PG8_LDA(At, 0, 1);
            if constexpr (GATHER) PG8_STAGE_G(PG8_SA(0, 0), x00, x01, k2); else PG8_STAGE(PG8_SA(0, 0), a2, voffA);
            PG8_BAR; PG8_WAIT_L(0); PG8_MMA(1, 0, At, B0); PG8_BAR; PG8_SCHED;
            PG8_STAGE(PG8_SB(0, 1), b2 + hstep, voffB);
            PG8_WAIT_V(6); PG8_BAR; PG8_MMA(1, 1, At, B1); PG8_BAR;
            PG8_LDB(B0, 1, 0); PG8_SCHED; PG8_LDA(At, 1, 0);
            if constexpr (GATHER) PG8_STAGE_G(PG8_SA(0, 1), x10, x11, k2); else PG8_STAGE(PG8_SA(0, 1), a2 + hstep, voffA);
            PG8_WAIT_L(8); PG8_BAR; PG8_WAIT_L(0); PG8_MMA(0, 0, At, B0); PG8_BAR; PG8_SCHED;
            PG8_LDB(B1, 1, 1); PG8_STAGE(PG8_SB(1, 0), b3, voffB);
            PG8_BAR; PG8_WAIT_L(0); PG8_MMA(0, 1, At, B1); PG8_BAR;
            PG8_LDA(At, 1, 1);
            if constexpr (GATHER) PG8_STAGE_G(PG8_SA(1, 0), x00, x01, k3); else PG8_STAGE(PG8_SA(1, 0), a3, voffA);
            PG8_BAR; PG8_WAIT_L(0); PG8_MMA(1, 0, At, B0); PG8_BAR; PG8_SCHED;
            PG8_STAGE(PG8_SB(1, 1), b3 + hstep, voffB);
            PG8_WAIT_V(6); PG8_BAR; PG8_MMA(1, 1, At, B1); PG8_BAR;
        }
        Unit nn = cur; const bool has_nn = has_next && S.next(ui + 2, nn);
        unsigned tO[2][2] = {{0u, 0u}, {0u, 0u}};
        if constexpr (GATHER) { if (has_nn) { PG8_ROWOFF(tO, nn); } }
        E(acc, cur, wr, wc, fr, fq);
        if (!has_next) break;
#pragma unroll
        for (int a = 0; a < 2; ++a)
#pragma unroll
            for (int b = 0; b < 2; ++b)
#pragma unroll
                for (int m = 0; m < 4; ++m)
#pragma unroll
                    for (int n = 0; n < 2; ++n) acc[a][b][m][n] = (f32x4){0.f, 0.f, 0.f, 0.f};
        if constexpr (GATHER) {
#pragma unroll
            for (int h = 0; h < 2; ++h)
#pragma unroll
                for (int i = 0; i < 2; ++i) { cO[h][i] = nO[h][i]; nO[h][i] = has_nn ? tO[h][i] : nO[h][i]; } }
        cur = nxt; cA = nA; cB = nB; ++ui; nxt = nn; has_next = has_nn;
    }
    PG8_WAIT_V(0);
    if (wr == 0) PG8_BAR;
    PG8_BAR;
#undef PG8_SA
#undef PG8_SB
#undef PG8_STAGE
#undef PG8_STAGE_G
#undef PG8_LDA
#undef PG8_LDB
#undef PG8_MMA
#undef PG8_WAIT_V
#undef PG8_WAIT_L
#undef PG8_BAR
#undef PG8_SCHED
#undef PG8_ROWOFF
}
}

namespace att {
constexpr float SCALE = 0.08838834764831845f;
constexpr int NW = 8, QBLK = 32, KVBLK = 64, QB = NW * QBLK, D = 128;
constexpr int SHM_V = KVBLK * D * 2, SHM_K = KVBLK * D * 2;
constexpr int LDS_BYTES = 2 * SHM_V + 2 * SHM_K + NW * 64 * 4;
constexpr float THR = 8.f;
#define KSWZ(row, colB) ((row) * 256 + ((colB) ^ (((row) & 7) << 4)))
#define SBAR() __builtin_amdgcn_sched_barrier(0)
__device__ __forceinline__ int v_st(int k, int c) { const int kk = (k & ~0xC) | ((k & 4) << 1) | ((k & 8) >> 1); return ((kk >> 3) * 4 + (c >> 5)) * 512 + ((kk & 7) * 32 + (c & 31)) * 2; }
__device__ __forceinline__ int v_rd_base(int lane) { return ((lane & 3) << 3) | (((lane >> 2) & 3) << 6) | (((lane >> 4) & 1) << 5) | (((lane >> 5) & 1) << 8); }
constexpr int v_rd_off(int d0, int ks, int half) { return d0 * 512 + ks * 4096 + half * 2048; }
__device__ __forceinline__ int crow(int r, int hi) { return (r & 3) + 8 * (r >> 2) + 4 * hi; }
__device__ __forceinline__ unsigned cvtpk(float lo, float hi) { return cvt_pk_bf16(lo, hi); }
__device__ __forceinline__ bf16x8 load8(const bf16* p) { return *reinterpret_cast<const bf16x8*>(p); }
__device__ __forceinline__ void mask_tile(f32x16& p0, f32x16& p1, int dq, unsigned W) {
    const float NEG = -__builtin_inff();
#pragma unroll
    for (int r = 0; r < 16; ++r) {
        const int c = (r & 3) + 8 * (r >> 2);
        if ((unsigned)(dq - c) >= W) p0[r] = NEG;
        if ((unsigned)(dq - c - 32) >= W) p1[r] = NEG;
    }
}
__device__ __forceinline__ void partialSM(f32x16& p0, f32x16& p1, float& m_reg, float& mn, float& alpha) {
    float pmax = p0[0]; for (int r = 1; r < 16; ++r) pmax = fmaxf(pmax, p0[r]); for (int r = 0; r < 16; ++r) pmax = fmaxf(pmax, p1[r]);
    { auto rr = __builtin_amdgcn_permlane32_swap(__float_as_uint(pmax), __float_as_uint(pmax), false, false);
      pmax = fmaxf(__uint_as_float(rr[0]), __uint_as_float(rr[1])); }
    constexpr float C2 = 1.4426950408889634f * SCALE;
    if (__builtin_expect(__all((pmax - m_reg) * SCALE <= THR), 1)) { mn = m_reg; alpha = 1.f; }
    else { mn = fmaxf(m_reg, pmax); alpha = __builtin_amdgcn_exp2f((m_reg - mn) * C2); m_reg = mn; }
    const float mnL = -mn * C2;
    for (int r = 0; r < 16; ++r) p0[r] = fmaf(p0[r], C2, mnL); for (int r = 0; r < 16; ++r) p1[r] = fmaf(p1[r], C2, mnL);
    for (int r = 0; r < 16; ++r) p0[r] = __builtin_amdgcn_exp2f(p0[r]);
}
__device__ __forceinline__ void finishSM(f32x16& p0, f32x16& p1, float alpha, float& l_reg, bf16x8& pa0, bf16x8& pa1, bf16x8& pa2, bf16x8& pa3) {
    for (int r = 0; r < 16; ++r) p1[r] = __builtin_amdgcn_exp2f(p1[r]);
    float ps = 0; for (int r = 0; r < 16; ++r) ps += p0[r]; for (int r = 0; r < 16; ++r) ps += p1[r];
    { auto rr = __builtin_amdgcn_permlane32_swap(__float_as_uint(ps), __float_as_uint(ps), false, false);
      ps = __uint_as_float(rr[0]) + __uint_as_float(rr[1]); }
    l_reg = l_reg * alpha + ps;
#define PK4(P, B_, OUT) do { unsigned a0 = cvtpk(P[B_+0], P[B_+1]), a1 = cvtpk(P[B_+2], P[B_+3]);                          \
        unsigned b0 = cvtpk(P[B_+4], P[B_+5]), b1 = cvtpk(P[B_+6], P[B_+7]);                                             \
        auto r0 = __builtin_amdgcn_permlane32_swap(a0, b0, false, false); auto r1 = __builtin_amdgcn_permlane32_swap(a1, b1, false, false); \
        u32x4 w = {r0[0], r1[0], r0[1], r1[1]}; OUT = *reinterpret_cast<bf16x8*>(&w); } while (0)
    PK4(p0, 0, pa0); PK4(p0, 8, pa1); PK4(p1, 0, pa2); PK4(p1, 8, pa3);
#undef PK4
}
template <int KB, bool SK>
__device__ __forceinline__ void qkt(f32x16& p0, f32x16& p1, const char* K_lds, int r32, int hi, const bf16x8* qr, bool act) {
    if (SK && !act) { const float NEG = -__builtin_inff();
#pragma unroll
        for (int r = 0; r < 16; ++r) { p0[r] = NEG; p1[r] = NEG; } return; }
    p0 = f32x16{}; p1 = f32x16{};
    const char* kb[4];
#pragma unroll
    for (int dd = 0; dd < 4; ++dd) kb[dd] = K_lds + KB * SHM_K + KSWZ(r32, (dd * 16 + hi * 8) * 2);
#pragma unroll
    for (int d0 = 0; d0 < 8; ++d0) { const char* a = kb[d0 & 3] + (d0 >> 2) * 128;
        bf16x8 b0 = *reinterpret_cast<const bf16x8*>(a);
        bf16x8 b1 = *reinterpret_cast<const bf16x8*>(a + 32 * 256);
        p0 = __builtin_amdgcn_mfma_f32_32x32x16_bf16(b0, qr[d0], p0, 0, 0, 0);
        p1 = __builtin_amdgcn_mfma_f32_32x32x16_bf16(b1, qr[d0], p1, 0, 0, 0); }
}
template <int VB, bool SK>
__device__ __forceinline__ void pv_tile(f32x16* o, int vb0, bf16x8 pa0, bf16x8 pa1, bf16x8 pa2, bf16x8 pa3, bool act) {
    if (SK && !act) return;
#define TRRD(dst, off) asm volatile("ds_read_b64_tr_b16 %0, %1 offset:%2" : "=&v"(dst) : "v"(vb0), "i"(off) : "memory")
#define PV_D0(d0) do { s16x4 l0, l1, l2, l3, h0, h1, h2, h3; constexpr int b_ = VB * SHM_V + v_rd_off(d0, 0, 0); \
        TRRD(l0, b_); TRRD(h0, b_ + 2048); TRRD(l1, b_ + 4096); TRRD(h1, b_ + 6144); TRRD(l2, b_ + 8192); TRRD(h2, b_ + 10240); TRRD(l3, b_ + 12288); TRRD(h3, b_ + 14336); \
        asm volatile("s_waitcnt lgkmcnt(0)" ::: "memory"); SBAR();   \
        o[d0] = __builtin_amdgcn_mfma_f32_32x32x16_bf16(pa0, (bf16x8){l0[0], l0[1], l0[2], l0[3], h0[0], h0[1], h0[2], h0[3]}, o[d0], 0, 0, 0);   \
        o[d0] = __builtin_amdgcn_mfma_f32_32x32x16_bf16(pa1, (bf16x8){l1[0], l1[1], l1[2], l1[3], h1[0], h1[1], h1[2], h1[3]}, o[d0], 0, 0, 0);   \
        o[d0] = __builtin_amdgcn_mfma_f32_32x32x16_bf16(pa2, (bf16x8){l2[0], l2[1], l2[2], l2[3], h2[0], h2[1], h2[2], h2[3]}, o[d0], 0, 0, 0);   \
        o[d0] = __builtin_amdgcn_mfma_f32_32x32x16_bf16(pa3, (bf16x8){l3[0], l3[1], l3[2], l3[3], h3[0], h3[1], h3[2], h3[3]}, o[d0], 0, 0, 0); } while (0)
    PV_D0(0); PV_D0(1); PV_D0(2); PV_D0(3);
#undef PV_D0
#undef TRRD
}
struct BlockRef { bf16* Q; const bf16* K; float* L; int P0, qs, ks, ls, skv; };
struct Seam { bf16x8 qr[8]; bf16x8 st_v0, st_v1, st_k0, st_k1; };
__device__ __forceinline__ int swa_jlo(int P0, int W) { const int lowk = P0 - W + 1; return lowk > 0 ? lowk / KVBLK : 0; }
#define ROW(p, KS_, k0, rr) ((p) + (size_t)((k0) + (rr)) * (KS_) + sc)
#define VMW() asm volatile("s_waitcnt vmcnt(0)" ::: "memory")
#define VMWN(n) asm volatile("s_waitcnt vmcnt(%0)" :: "i"(n) : "memory")
#define SLOAD_H(Kp, Vp, KS_, k0) do { S.st_v0 = load8(ROW(Vp, KS_, k0, sr)); S.st_v1 = load8(ROW(Vp, KS_, k0, 32 + sr));              \
                         S.st_k0 = load8(ROW(Kp, KS_, k0, sr)); S.st_k1 = load8(ROW(Kp, KS_, k0, 32 + sr)); } while (0)
#define SWRITE_HK(bf) do { *(bf16x8*)(K_lds + (bf) * SHM_K + kws) = S.st_k0; *(bf16x8*)(K_lds + (bf) * SHM_K + kws + 32 * 256) = S.st_k1; } while (0)
#define SWRITE_HV(bf) do { *(bf16x8*)(V_lds + (bf) * SHM_V + vst0) = S.st_v0; *(bf16x8*)(V_lds + (bf) * SHM_V + vst1) = S.st_v1; } while (0)
#define SWRITE_H(bf) do { SWRITE_HV(bf); SWRITE_HK(bf); } while (0)
template <long VOFF>
__device__ __forceinline__ void prime(const BlockRef& cur, int W, char* lds, Seam& S) {
    const int tid = threadIdx.x, wid = __builtin_amdgcn_readfirstlane(tid >> 6), lane = tid & 63, r32 = lane & 31, hi = lane >> 5;
    const int sr = tid >> 4, sc = (tid & 15) * 8, kws = KSWZ(sr, sc * 2); char* K_lds = lds + 2 * SHM_V;
    const int kb0 = swa_jlo(cur.P0, W) * KVBLK;
    for (int d0 = 0; d0 < 8; ++d0) S.qr[d0] = load8(cur.Q + (size_t)(wid * QBLK + r32) * cur.qs + d0 * 16 + hi * 8);
    SLOAD_H(cur.K, cur.K + VOFF, cur.ks, kb0); VMW(); SWRITE_HK(0);
    __syncthreads();
}
template <bool SK, long VOFF>
__device__ __forceinline__ void block(const BlockRef& cur, const BlockRef& nxt, int W, char* lds, Seam& S) {
    const int tid = threadIdx.x, wid = __builtin_amdgcn_readfirstlane(tid >> 6), lane = tid & 63, r32 = lane & 31, hi = lane >> 5;
    const int skv = cur.skv;
    const int j_lo = swa_jlo(cur.P0, W);
    int j_hi = (cur.P0 + QB - 1) / KVBLK + 1; if (j_hi > skv / KVBLK) j_hi = skv / KVBLK;
    const int NT = j_hi - j_lo;
    const int kbn = swa_jlo(nxt.P0, W) * KVBLK;
    const int qlo = cur.P0 + wid * QBLK, qm = qlo + r32 - 4 * hi;
    char* V_lds = lds; char* K_lds = lds + 2 * SHM_V;
    float* ws = (float*)(lds + 2 * SHM_V + 2 * SHM_K) + wid * 64; float* li_l = ws, * al_l = ws + 32;
    float m_reg = -1e30f, l_reg = 0; f32x16 o[4] = {};
    const int sr = tid >> 4, sc = (tid & 15) * 8, vst0 = v_st(sr, sc), vst1 = v_st(32 + sr, sc), kws = KSWZ(sr, sc * 2);
    const int vb0 = (int)(uintptr_t)V_lds + v_rd_base(lane);
    const bf16* Kh = cur.K; const bf16* Vh = cur.K + VOFF; const int KS = cur.ks;
#define RESC(a) do { if (__any((a) < 1.f)) { if (hi == 0) al_l[r32] = (a); asm volatile("s_waitcnt lgkmcnt(0)" ::: "memory");              \
                     for (int d_ = 0; d_ < 4; ++d_) for (int r = 0; r < 16; ++r) o[d_][r] *= al_l[crow(r, hi)]; } } while (0)
#define KBASE(t) ((j_lo + (t)) * KVBLK)
#define ACT(t) (KBASE(t) <= qlo + QBLK - 1 && KBASE(t) + KVBLK - 1 >= qlo - W + 1)
#define MASKT(P0_, P1_, t) do { const int kb_ = KBASE(t); if ((!SK || ACT(t)) && (kb_ + KVBLK - 1 > qlo || kb_ <= qlo + QBLK - 1 - W)) mask_tile(P0_, P1_, qm - kb_, (unsigned)W); } while (0)
    constexpr int NQL = 8;
#define SEAM_K0() do { VMWN(NQL); SWRITE_HK(0); SBAR(); } while (0)
    f32x16 pA0, pA1, pB0, pB1; float mnA, mnB, alA, alB; bf16x8 pa0, pa1, pa2, pa3;
    SWRITE_HV(0); SBAR();
    if (NT > 1) { SLOAD_H(Kh, Vh, KS, KBASE(1)); }
    SBAR(); qkt<0, SK>(pA0, pA1, K_lds, r32, hi, S.qr, ACT(0));
    MASKT(pA0, pA1, 0); partialSM(pA0, pA1, m_reg, mnA, alA);
    if (NT > 1) { VMW(); SWRITE_H(1); }
    __syncthreads();
#define HALF_STEP(PX0, PX1, mnX, alX, PY0, PY1, alY, t, KB, VB, SB) do {                                                      \
        SBAR(); qkt<KB, SK>(PX0, PX1, K_lds, r32, hi, S.qr, ACT(t));                                             \
        finishSM(PY0, PY1, alY, l_reg, pa0, pa1, pa2, pa3); SBAR();                                                           \
        if ((t) + 1 < NT) { SLOAD_H(Kh, Vh, KS, KBASE((t) + 1)); SBAR(); }                                               \
        pv_tile<VB, SK>(o, vb0, pa0, pa1, pa2, pa3, ACT((t) - 1)); MASKT(PX0, PX1, (t)); partialSM(PX0, PX1, m_reg, mnX, alX);                                        \
        __syncthreads();                                                                                                      \
        if ((t) + 1 < NT) { VMW(); SWRITE_H(SB); }                                                                          \
        RESC(alX); __syncthreads(); } while (0)
    for (int t = 1; t + 1 < NT; t += 2) {
        HALF_STEP(pB0, pB1, mnB, alB, pA0, pA1, alA, t, 1, 0, 0);
        HALF_STEP(pA0, pA1, mnA, alA, pB0, pB1, alB, t + 1, 0, 1, 1);
    }
    const bool even = (NT & 1) == 0;
    if (even) { SBAR(); qkt<1, SK>(pB0, pB1, K_lds, r32, hi, S.qr, ACT(NT - 1)); SBAR(); }
    { SLOAD_H(nxt.K, nxt.K + VOFF, nxt.ks, kbn); SBAR();
#pragma unroll
      for (int d0 = 0; d0 < 8; ++d0) S.qr[d0] = load8(nxt.Q + (size_t)(wid * QBLK + r32) * nxt.qs + d0 * 16 + hi * 8); }
    SBAR();
    finishSM(pA0, pA1, alA, l_reg, pa0, pa1, pa2, pa3); SBAR();
    pv_tile<0, SK>(o, vb0, pa0, pa1, pa2, pa3, ACT(even ? NT - 2 : NT - 1));
    if (even) { MASKT(pB0, pB1, NT - 1); partialSM(pB0, pB1, m_reg, mnB, alB); __syncthreads(); RESC(alB);
        finishSM(pB0, pB1, alB, l_reg, pa0, pa1, pa2, pa3); SBAR(); pv_tile<1, SK>(o, vb0, pa0, pa1, pa2, pa3, ACT(NT - 1)); }
    SBAR(); SEAM_K0();
    if (hi == 0) li_l[r32] = l_reg; asm volatile("s_waitcnt lgkmcnt(0)" ::: "memory");
    if (cur.L != nullptr && hi == 0) cur.L[(size_t)(wid * QBLK + r32) * cur.ls] = m_reg * SCALE + __logf(l_reg);
    float rli[16];
#pragma unroll
    for (int r = 0; r < 16; ++r) rli[r] = __builtin_amdgcn_rcpf(li_l[crow(r, hi)]);
    bf16* Op = cur.Q + (size_t)(wid * QBLK + 4 * hi) * cur.qs + r32; const size_t qstep = (size_t)cur.qs;
#pragma unroll
    for (int r = 0; r < 16; ++r) {
        asm volatile("" : "+v"(Op));
#pragma unroll
        for (int d0 = 0; d0 < 4; ++d0) { const float v = o[d0][r] * rli[r];
            const float vn = __shfl_xor(v, 1);
            if ((r32 & 1) == 0) *(unsigned*)(Op + d0 * 32) = cvtpk(v, vn); }
        Op += ((r & 3) == 3) ? 5 * qstep : qstep; }
    __syncthreads();
#undef RESC
#undef KBASE
#undef ACT
#undef MASKT
#undef SEAM_K0
#undef HALF_STEP
}
#undef ROW
#undef VMW
#undef VMWN
#undef SLOAD_H
#undef SWRITE_HK
#undef SWRITE_HV
#undef SWRITE_H
#undef KSWZ
}

constexpr int NWAVES = 8, NTHR = 512;
constexpr int M = 65536, DM = 1024, SEQ = 8192, NBATCH = 8;
constexpr int N1 = 6400;
constexpr int ROPE_POS = 9216;
constexpr float EPS = 1e-5f;
constexpr int NEXP = 32, HALF_TOK = 32768, RT_CAP = 139264;
constexpr int MAXBLK = 544;
constexpr int NPH = 19;
#ifndef MK_DIAG
#define MK_DIAG 0
#endif
#ifndef MK_PER_PHASE
#define MK_PER_PHASE 0
#endif

constexpr size_t MiB = 1u << 20;
constexpr size_t WS_CTL = 0, CTL_ZERO_BYTES = 1 * MiB;
constexpr size_t WS_WIN = 1 * MiB, WS_WGATE = 14 * MiB, WS_WBG = 18 * MiB, WS_WBD = 19 * MiB, WS_WMIX = 20 * MiB, WS_WXQ = 22 * MiB, WS_WXKV = 23 * MiB, WS_WXO = 25 * MiB, WS_WR = 26 * MiB;
constexpr size_t WS_ROPE = 27 * MiB, WS_MEMN = 32 * MiB, WS_KVM = 36 * MiB, WS_DECAY = 40 * MiB;
constexpr size_t WS_TOPE = 41 * MiB, WS_TGATE = 42 * MiB, WS_TSLOT = 43 * MiB, WS_RTOK = 44 * MiB, WS_RGATE = 46 * MiB;
constexpr size_t WS_A = 49 * MiB;
constexpr size_t WS_QG = 177 * MiB, WS_KG = 209 * MiB, WS_VG = 241 * MiB, WS_RG = 305 * MiB, WS_ALR = 369 * MiB, WS_LSE = 373 * MiB;
constexpr size_t WS_QD = 376 * MiB, WS_KD = 568 * MiB, WS_VD = 760 * MiB, WS_END = 952 * MiB;
constexpr size_t WS_GATES = WS_KD, WS_MERGED = 824 * MiB;
constexpr size_t WS_QX = WS_QD;
constexpr size_t WS_WGU = 177 * MiB, WS_WDN = 305 * MiB;
constexpr size_t WS_H = 376 * MiB, WS_Y = 648 * MiB;
static_assert(WS_Y + (size_t)RT_CAP * 2048 <= WS_END && WS_H + (size_t)RT_CAP * 2048 <= WS_Y && WS_RTOK + 2 * (size_t)RT_CAP * 4 <= WS_RGATE && WS_RGATE + 2 * (size_t)RT_CAP * 4 <= WS_A, "ws map");
constexpr size_t DO_OG = 0, DO_OD = 64 * MiB, DO_ST = 128 * MiB;
constexpr int CW_BAR = 4096, CW_CNT = 8192, CW_CUR = 8320;
constexpr int RING_BYTES = 131072, MISC_OFF = RING_BYTES, TAB_OFF = RING_BYTES + 1024, LDS_BYTES = 147456;

#define XB_TMO      128
#define XB_XCNT(j)  (256  + 64 * (j))
#define XB_XSUB(j)  (1280 + 64 * (j))
#define XB_XGEN(j)  (2304 + 64 * (j))
#define XB_TOP      3328
#define XB_TOPGEN   3392
#define XCD_BAR_WORDS 3456
#define XB_SPIN_CAP (1u << 18)
__device__ __forceinline__ unsigned xb_ld(unsigned* p)              { return __hip_atomic_load(p, __ATOMIC_RELAXED, __HIP_MEMORY_SCOPE_AGENT); }
__device__ __forceinline__ unsigned xb_add(unsigned* p, unsigned v) { return __hip_atomic_fetch_add(p, v, __ATOMIC_RELAXED, __HIP_MEMORY_SCOPE_AGENT); }
__device__ __forceinline__ unsigned xb_xcc_id() { return (unsigned)__builtin_amdgcn_s_getreg((3 << 11) | 20) & 0xFu; }
#define XB_SPIN(cond, bar) do { unsigned _sp = 0; while (cond) { __builtin_amdgcn_s_sleep(1); \
    if ((++_sp & 255u) == 0u) { if (xb_ld(&(bar)[XB_TMO])) break; if (_sp > XB_SPIN_CAP) { atomicAdd(&(bar)[XB_TMO], 1u); break; } } } } while (0)
struct XcdBarrier { unsigned* bar; unsigned x; volatile LAS unsigned* st; };
__device__ __forceinline__ XcdBarrier xcd_barrier_post(unsigned* bar, volatile LAS unsigned* st) {
    XcdBarrier b; b.bar = bar; b.x = xb_xcc_id(); b.st = st;
    if (threadIdx.x == 0) (void)xb_add(&bar[XB_XCNT(b.x)], 1u);
    return b;
}
__device__ __forceinline__ void xcd_barrier_complete(unsigned* bar, unsigned x, unsigned& nloc, unsigned& nx) {
    const unsigned G = gridDim.x * gridDim.y * gridDim.z;
    unsigned sum, cnt, mine, sp = 0u;
    for (;;) {
        sum = 0u; cnt = 0u; mine = 0u;
#pragma unroll
        for (unsigned j = 0; j < 16; ++j) { const unsigned c = xb_ld(&bar[XB_XCNT(j)]); sum += c; cnt += (c > 0u) ? 1u : 0u; mine = (j == x) ? c : mine; }
        if (sum == G) break;
        __builtin_amdgcn_s_sleep(1);
        if ((++sp & 255u) == 0u) { if (xb_ld(&bar[XB_TMO])) break; if (sp > XB_SPIN_CAP) { atomicAdd(&bar[XB_TMO], 1u); break; } }
    }
    nloc = mine > 0u ? mine : 1u; nx = cnt > 0u ? cnt : 1u;
}
__device__ __forceinline__ void xcd_barrier(const XcdBarrier& b) {
    asm volatile("s_waitcnt vmcnt(0)" ::: "memory");
    __syncthreads();
    if (threadIdx.x == 0) {
        unsigned* bar = b.bar;
        __builtin_amdgcn_s_waitcnt(0);
        unsigned nloc = b.st[0], nx = b.st[1];
        if (nloc == 0u) { xcd_barrier_complete(bar, b.x, nloc, nx); b.st[0] = nloc; b.st[1] = nx; }
        const unsigned old = xb_add(&bar[XB_XSUB(b.x)], 1u);
        const unsigned gen = old / nloc;
        if (old + 1u == (gen + 1u) * nloc) {
            __builtin_amdgcn_fence(__ATOMIC_RELEASE, "agent");
            asm volatile("s_waitcnt vmcnt(0)" ::: "memory");
            const unsigned og = xb_add(&bar[XB_TOP], 1u);
            const unsigned tg = og / nx;
            if (og + 1u == (tg + 1u) * nx) xb_add(&bar[XB_TOPGEN], 1u);
            else XB_SPIN(xb_ld(&bar[XB_TOPGEN]) == tg, bar);
            __builtin_amdgcn_fence(__ATOMIC_ACQUIRE, "agent");
            xb_add(&bar[XB_XGEN(b.x)], 1u);
            asm volatile("s_waitcnt vmcnt(0)" ::: "memory");
        } else {
            XB_SPIN(xb_ld(&bar[XB_XGEN(b.x)]) == gen, bar);
            __builtin_amdgcn_fence(__ATOMIC_ACQUIRE, "agent");
            asm volatile("s_waitcnt vmcnt(0)" ::: "memory");
        }
    }
    __syncthreads();
}

struct Frame {
    LAS unsigned char* lds; char* ldsg;
    unsigned* ctl; unsigned char* ws; unsigned char* dout;
    int tid, lane, wave, G, bid;
};
struct Args { const void* in[28]; float* out; unsigned char* ws; int ph_lo, ph_hi; };
#define INP(k) ((const float*)A.in[k])
#define LDS_WAIT() asm volatile("s_waitcnt lgkmcnt(0)" ::: "memory")
__device__ __forceinline__ float wave_sum(float v) {
#pragma unroll
    for (int o = 1; o < 64; o <<= 1) v += __shfl_xor(v, o);
    return v;
}
template <class RM>
__device__ __forceinline__ void transpose_item(const float* W, int K, int N, bf16* WT, const RM& rm, LAS float* scr, int item, int lane) {
    const int nblk = (N + 31) / 32, kb = item / nblk, nb = item % nblk, k0 = 64 * kb, n0 = 32 * nb;
    const int ncol = n0 + (lane & 31);
#pragma unroll 8
    for (int i = 0; i < 32; ++i) { const int kk = 2 * i + (lane >> 5); scr[kk * 33 + (lane & 31)] = ncol < N ? W[(size_t)(k0 + kk) * N + ncol] : 0.f; }
    LDS_WAIT(); asm volatile("" ::: "memory");
    const int c = lane & 7;
#pragma unroll
    for (int j = 0; j < 4; ++j) { const int n = (lane >> 3) + 8 * j; const LAS float* s = scr + (8 * c) * 33 + n;
        u32x4 o; o.x = pk2(s[0 * 33], s[1 * 33]); o.y = pk2(s[2 * 33], s[3 * 33]); o.z = pk2(s[4 * 33], s[5 * 33]); o.w = pk2(s[6 * 33], s[7 * 33]);
        const int dr = (n0 + n < N) ? rm(n0 + n) : -1;
        if (dr >= 0) *(u32x4*)(WT + (size_t)dr * K + k0 + 8 * c) = o; }
    LDS_WAIT(); asm volatile("" ::: "memory");
}
struct RmId { int off; __device__ int operator()(int n) const { return off + n; } };
struct RmWin { __device__ int operator()(int n) const {
    if (n < 1536) return n;
    if (n < 1552) return 6144 + (n - 1536);
    if (n < 4624) { const int j = n - 1552, seg = j / 1536, jj = j % 1536, hd = jj >> 7, i = jj & 127; return 1536 + seg * 1536 + hd * 128 + ((i < 64) ? 2 * i : 2 * (i - 64) + 1); }
    return 4608 + (n - 4624); } };
struct RmGU { int base; __device__ int operator()(int n) const { return base + (n >> 7) * 256 + (n & 127); } };

__device__ __forceinline__ void rms_row_to_bf16(const float* xrow, const float* g, bf16* orow, int lane) {
    const f32x4* xr = (const f32x4*)xrow + lane; const f32x4* gr = (const f32x4*)g + lane;
    f32x4 v[4]; float s = 0.f;
#pragma unroll
    for (int j = 0; j < 4; ++j) { v[j] = xr[64 * j]; s += (v[j].x * v[j].x + v[j].y * v[j].y) + (v[j].z * v[j].z + v[j].w * v[j].w); }
    const float rstd = 1.f / sqrtf(wave_sum(s) * (1.f / DM) + EPS);
    u32x2* o8 = (u32x2*)orow + lane;
#pragma unroll
    for (int j = 0; j < 4; ++j) { const f32x4 gg = gr[64 * j]; u32x2 w; w.x = cvt_pk_bf16(v[j].x * rstd * gg.x, v[j].y * rstd * gg.y); w.y = cvt_pk_bf16(v[j].z * rstd * gg.z, v[j].w * rstd * gg.w); o8[64 * j] = w; }
}

__device__ __forceinline__ void p0_prologue(Frame& F, const Args& A) {
    LAS float* scr = (LAS float*)(F.lds + F.wave * 16384);
    const int gw = F.bid * NWAVES + F.wave, NGW = F.G * NWAVES;
    unsigned char* ws = F.ws;
    constexpr int I_IN = 16 * 193, I_GATE = 16 * 64, I_BG = 8 * 32, I_MIX = 16 * 32, I_XQ = 16 * 16, I_XKV = 16 * 32, I_XO = 8 * 32;
    constexpr int NIT = I_IN + I_GATE + 2 * I_BG + I_MIX + I_XQ + I_XKV + I_XO;
    for (int it = gw; it < NIT; it += NGW) {
        int r = it;
        if (r < I_IN) { transpose_item(INP(4), 1024, 6160, (bf16*)(ws + WS_WIN), RmWin{}, scr, r, F.lane); continue; } r -= I_IN;
        if (r < I_GATE) { transpose_item(INP(10), 1024, 2048, (bf16*)(ws + WS_WGATE), RmId{0}, scr, r, F.lane); continue; } r -= I_GATE;
        if (r < I_BG) { transpose_item(INP(8), 512, 1024, (bf16*)(ws + WS_WBG), RmId{0}, scr, r, F.lane); continue; } r -= I_BG;
        if (r < I_BG) { transpose_item(INP(9), 512, 1024, (bf16*)(ws + WS_WBD), RmId{0}, scr, r, F.lane); continue; } r -= I_BG;
        if (r < I_MIX) { transpose_item(INP(12), 1024, 1024, (bf16*)(ws + WS_WMIX), RmId{0}, scr, r, F.lane); continue; } r -= I_MIX;
        if (r < I_XQ) { transpose_item(INP(15), 1024, 512, (bf16*)(ws + WS_WXQ), RmId{0}, scr, r, F.lane); continue; } r -= I_XQ;
        if (r < I_XKV) { transpose_item(INP(16), 1024, 1024, (bf16*)(ws + WS_WXKV), RmId{0}, scr, r, F.lane); continue; } r -= I_XKV;
        transpose_item(INP(17), 512, 1024, (bf16*)(ws + WS_WXO), RmId{0}, scr, r, F.lane);
    }
    const int gt = F.bid * NTHR + F.tid, NGT = F.G * NTHR;
    { u32x4* z = (u32x4*)((bf16*)(ws + WS_WIN) + (size_t)6160 * 1024); for (int i = gt; i < 240 * 1024 / 8; i += NGT) z[i] = (u32x4){0u, 0u, 0u, 0u}; }
    { bf16* wr = (bf16*)(ws + WS_WR); const float* w = INP(19); const float* g3 = INP(18);
      for (int i = gt; i < NEXP * 1024; i += NGT) { const int e = i >> 10, k = i & 1023; wr[i] = (bf16)f2bf(g3[k] * w[k * NEXP + e]); } }
    { float* tab = (float*)(ws + WS_ROPE);
      for (int i = gt; i < ROPE_POS * 64; i += NGT) { const int pos = i >> 6, fi = i & 63;
          const float inv = (float)exp2(-(double)fi * (13.287712379549449 / 64.0));
          const float ang = (float)pos * inv;
          const double a = (double)ang, n = rint(a * 0.15915494309189535), rr = a - n * 6.283185307179586;
          const float rf = (float)rr;
          tab[2 * i] = cosf(rf); tab[2 * i + 1] = sinf(rf); } }
    for (int m = gw; m < NBATCH * 256; m += NGW) rms_row_to_bf16(INP(1) + (size_t)m * DM, INP(14), (bf16*)(ws + WS_MEMN) + (size_t)m * DM, F.lane);
    for (int m = gw; m < M; m += NGW) rms_row_to_bf16(INP(0) + (size_t)m * DM, INP(3), (bf16*)(ws + WS_A) + (size_t)m * DM, F.lane);
}

#define EPI_ROWS(ai, m) (u.pm * 256 + wr * 64 + fr + (ai) * 128 + (m) * 16)
__device__ __forceinline__ u32x4 pack8f(const f32x4& a, const f32x4& b) { u32x4 w; w.x = cvt_pk_bf16(a[0], a[1]); w.y = cvt_pk_bf16(a[2], a[3]); w.z = cvt_pk_bf16(b[0], b[1]); w.w = cvt_pk_bf16(b[2], b[3]); return w; }
__device__ __forceinline__ void unpack8f(const u32x4& w, f32x4& a, f32x4& b) { a = (f32x4){bflo(w.x), bfhi(w.x), bflo(w.y), bfhi(w.y)}; b = (f32x4){bflo(w.z), bfhi(w.z), bflo(w.w), bfhi(w.w)}; }

struct EpiProj {
    static constexpr bool PERM = true;
    unsigned char* ws; const int* pos;
    __device__ __forceinline__ void operator()(const f32x4 (&acc)[2][2][4][2], const pg8::Unit& u, int wr, int wc, int fr, int fq) const {
        const int pn = u.pn, cw = wc * 32 + 8 * fq;
        if (pn == 24) {
            if (wc == 0 && fq < 2) { float* alr = (float*)(ws + WS_ALR);
#pragma unroll
                for (int ai = 0; ai < 2; ++ai)
#pragma unroll
                    for (int m = 0; m < 4; ++m) { float* p = alr + (size_t)EPI_ROWS(ai, m) * 16 + 8 * fq; *(f32x4*)p = acc[ai][0][m][0]; *(f32x4*)(p + 4) = acc[ai][0][m][1]; } }
            return;
        }
        bf16* base; int ldc, coff; float sc = 1.f; bool rope = false;
        if (pn == 0) { base = (bf16*)(ws + WS_QG); ldc = 256; coff = 0; sc = 0.125f; }
        else if (pn == 1) { base = (bf16*)(ws + WS_KG); ldc = 256; coff = 0; }
        else if (pn < 4) { base = (bf16*)(ws + WS_VG); ldc = 512; coff = (pn - 2) * 256; }
        else if (pn < 6) { base = (bf16*)(ws + WS_RG); ldc = 512; coff = (pn - 4) * 256; }
        else if (pn < 12) { base = (bf16*)(ws + WS_QD); ldc = 1536; coff = (pn - 6) * 256; rope = true; }
        else if (pn < 18) { base = (bf16*)(ws + WS_KD); ldc = 1536; coff = (pn - 12) * 256; rope = true; }
        else { base = (bf16*)(ws + WS_VD); ldc = 1536; coff = (pn - 18) * 256; }
        const float* tab = (const float*)(ws + WS_ROPE);
#pragma unroll
        for (int ai = 0; ai < 2; ++ai)
#pragma unroll
            for (int m = 0; m < 4; ++m) { const int row = EPI_ROWS(ai, m); bf16* rowp = base + (size_t)row * ldc + coff + cw;
                f32x4 cs0 = {1.f, 0.f, 1.f, 0.f}, cs1 = {1.f, 0.f, 1.f, 0.f};
                if (rope) { int p = pos[row]; p = p < 0 ? 0 : (p >= ROPE_POS ? ROPE_POS - 1 : p); const float* tp = tab + ((size_t)p * 64 + 16 * wc + 4 * fq) * 2; cs0 = *(const f32x4*)tp; cs1 = *(const f32x4*)(tp + 4); }
#pragma unroll
                for (int bj = 0; bj < 2; ++bj) { f32x4 v0 = acc[ai][bj][m][0] * sc, v1 = acc[ai][bj][m][1] * sc;
                    if (rope) {
                        v0 = (f32x4){v0[0] * cs0[0] - v0[1] * cs0[1], v0[1] * cs0[0] + v0[0] * cs0[1], v0[2] * cs0[2] - v0[3] * cs0[3], v0[3] * cs0[2] + v0[2] * cs0[3]};
                        v1 = (f32x4){v1[0] * cs1[0] - v1[1] * cs1[1], v1[1] * cs1[0] + v1[0] * cs1[1], v1[2] * cs1[2] - v1[3] * cs1[3], v1[3] * cs1[2] + v1[2] * cs1[3]}; }
                    *(u32x4*)(rowp + bj * 128) = pack8f(v0, v1); } }
    }
};
template <int ACT  > struct EpiBf16 {
    static constexpr bool PERM = true;
    bf16* O; int ldc; const float* bias; float scale;
    __device__ __forceinline__ void operator()(const f32x4 (&acc)[2][2][4][2], const pg8::Unit& u, int wr, int wc, int fr, int fq) const {
        const int col0 = u.pn * 256 + wc * 32 + 8 * fq;
        f32x4 bv[2][2];
#pragma unroll
        for (int bj = 0; bj < 2; ++bj)
#pragma unroll
            for (int n = 0; n < 2; ++n) bv[bj][n] = bias ? *(const f32x4*)(bias + col0 + bj * 128 + 4 * n) : (f32x4){0.f, 0.f, 0.f, 0.f};
#pragma unroll
        for (int ai = 0; ai < 2; ++ai)
#pragma unroll
            for (int m = 0; m < 4; ++m) { bf16* rowp = O + (size_t)EPI_ROWS(ai, m) * ldc + col0;
#pragma unroll
                for (int bj = 0; bj < 2; ++bj) { f32x4 v0 = acc[ai][bj][m][0] * scale + bv[bj][0], v1 = acc[ai][bj][m][1] * scale + bv[bj][1];
                    if (ACT == 1) {
#pragma unroll
                        for (int j = 0; j < 4; ++j) { v0[j] = __builtin_amdgcn_rcpf(1.f + __expf(-v0[j])); v1[j] = __builtin_amdgcn_rcpf(1.f + __expf(-v1[j])); } }
                    *(u32x4*)(rowp + bj * 128) = pack8f(v0, v1); } }
    }
};
template <int SECOND> struct EpiBranch {
    static constexpr bool PERM = true;
    bf16* mg; const bf16* gates; int goff;
    __device__ __forceinline__ void operator()(const f32x4 (&acc)[2][2][4][2], const pg8::Unit& u, int wr, int wc, int fr, int fq) const {
        const int col0 = u.pn * 256 + wc * 32 + 8 * fq;
#pragma unroll
        for (int ai = 0; ai < 2; ++ai)
#pragma unroll
            for (int m = 0; m < 4; ++m) { const size_t row = EPI_ROWS(ai, m);
#pragma unroll
                for (int bj = 0; bj < 2; ++bj) { const int col = col0 + bj * 128;
                    f32x4 g0, g1; unpack8f(*(const u32x4*)(gates + row * 2048 + goff + col), g0, g1);
                    f32x4 v0 = acc[ai][bj][m][0] * g0, v1 = acc[ai][bj][m][1] * g1;
                    if (SECOND) { f32x4 p0, p1; unpack8f(*(const u32x4*)(mg + row * 1024 + col), p0, p1); v0 += p0; v1 += p1; }
                    *(u32x4*)(mg + row * 1024 + col) = pack8f(v0, v1); } }
    }
};
struct EpiResF32 {
    static constexpr bool PERM = false;
    const float* res; float* out;
    __device__ __forceinline__ void operator()(const f32x4 (&acc)[2][2][4][2], const pg8::Unit& u, int wr, int wc, int fr, int fq) const {
        const int col0 = u.pn * 256 + wc * 32 + 4 * fq;
#pragma unroll
        for (int ai = 0; ai < 2; ++ai)
#pragma unroll
            for (int m = 0; m < 4; ++m) { const size_t off = (size_t)EPI_ROWS(ai, m) * DM + col0;
#pragma unroll
                for (int bj = 0; bj < 2; ++bj)
#pragma unroll
                    for (int n = 0; n < 2; ++n) { const f32x4 r = *(const f32x4*)(res + off + bj * 128 + n * 16); *(f32x4*)(out + off + bj * 128 + n * 16) = r + acc[ai][bj][m][n]; } }
    }
};
struct EpiSwiglu {
    static constexpr bool PERM = true;
    bf16* H; const float* bg; const float* bu; int nN;
    __device__ __forceinline__ void operator()(const f32x4 (&acc)[2][2][4][2], const pg8::Unit& u, int wr, int wc, int fr, int fq) const {
        const int e = u.pb / nN, c0 = u.pn * 128 + wc * 32 + 8 * fq;
        const f32x4 g0 = *(const f32x4*)(bg + e * 1024 + c0), g1 = *(const f32x4*)(bg + e * 1024 + c0 + 4), u0 = *(const f32x4*)(bu + e * 1024 + c0), u1 = *(const f32x4*)(bu + e * 1024 + c0 + 4);
#pragma unroll
        for (int ai = 0; ai < 2; ++ai)
#pragma unroll
            for (int m = 0; m < 4; ++m) { f32x4 a0 = acc[ai][0][m][0] + g0, a1 = acc[ai][0][m][1] + g1, b0 = acc[ai][1][m][0] + u0, b1 = acc[ai][1][m][1] + u1, r0, r1;
#pragma unroll
                for (int j = 0; j < 4; ++j) {
                    float gl = fminf(a0[j], 7.f), ln = fminf(fmaxf(b0[j], -7.f), 7.f); r0[j] = gl * __builtin_amdgcn_rcpf(1.f + __expf(-1.702f * gl)) * (ln + 1.f);
                    gl = fminf(a1[j], 7.f); ln = fminf(fmaxf(b1[j], -7.f), 7.f); r1[j] = gl * __builtin_amdgcn_rcpf(1.f + __expf(-1.702f * gl)) * (ln + 1.f); }
                *(u32x4*)(H + (size_t)EPI_ROWS(ai, m) * 1024 + c0) = pack8f(r0, r1); }
    }
};
struct EpiDown {
    static constexpr bool PERM = true;
    bf16* Y; const float* bd; const float* rgate; int nN;
    __device__ __forceinline__ void operator()(const f32x4 (&acc)[2][2][4][2], const pg8::Unit& u, int wr, int wc, int fr, int fq) const {
        const int e = u.pb / nN, col0 = u.pn * 256 + wc * 32 + 8 * fq;
        f32x4 bv[2][2];
#pragma unroll
        for (int bj = 0; bj < 2; ++bj)
#pragma unroll
            for (int n = 0; n < 2; ++n) bv[bj][n] = *(const f32x4*)(bd + e * 1024 + col0 + bj * 128 + 4 * n);
#pragma unroll
        for (int ai = 0; ai < 2; ++ai)
#pragma unroll
            for (int m = 0; m < 4; ++m) { const int row = EPI_ROWS(ai, m); const float gt = rgate[row];
#pragma unroll
                for (int bj = 0; bj < 2; ++bj) *(u32x4*)(Y + (size_t)row * 1024 + col0 + bj * 128) = pack8f((acc[ai][bj][m][0] + bv[bj][0]) * gt, (acc[ai][bj][m][1] + bv[bj][1]) * gt); }
    }
};

__device__ __forceinline__ bf16x8 frag_n(const LAS unsigned char* base, int pitch, int r0, int k0, int lane) {
    return *(const LAS bf16x8*)(base + (r0 + (lane & 15)) * pitch + (k0 + 8 * (lane >> 4)) * 2);
}
__device__ __forceinline__ bf16x8 frag_t(const LAS unsigned char* base, int pitch, int k0, int n0, int lane) {
    const int i = lane & 15, gq = lane >> 4, q = i >> 2, p = i & 3;
    const unsigned a0 = (unsigned)(uintptr_t)(base + (k0 + 8 * gq + q) * pitch + (n0 + 4 * p) * 2), a1 = a0 + 4u * (unsigned)pitch;
    s16x4 lo, hi;
    asm volatile("ds_read_b64_tr_b16 %0, %2\n\tds_read_b64_tr_b16 %1, %3\n\ts_waitcnt lgkmcnt(0)" : "=&v"(lo), "=&v"(hi) : "v"(a0), "v"(a1) : "memory");
    return (bf16x8){lo[0], lo[1], lo[2], lo[3], hi[0], hi[1], hi[2], hi[3]};
}
#define MFMA16(a, b, c) __builtin_amdgcn_mfma_f32_16x16x32_bf16(a, b, c, 0, 0, 0)
__device__ __forceinline__ float log_sigmoid(float z) { return fminf(z, 0.f) - log1pf(expf(-fabsf(z))); }

__device__ __forceinline__ void gla_a_item(Frame& F, const Args& A, int b, int c) {
    unsigned char* ws = F.ws;
    LAS unsigned char* L = F.lds;
    LAS float* l_alr = (LAS float*)L;
    LAS unsigned char* l_kd = L + 4096;  constexpr int PK = 528;
    LAS unsigned char* l_v = L + 4096 + 64 * PK; constexpr int PV = 1040;
    LAS float* l_tot = (LAS float*)(L + 4096 + 64 * PK + 64 * PV);
    const int tid = F.tid, lane = F.lane, wid = F.wave;
    const size_t tok0 = (size_t)b * SEQ + (size_t)c * 64;
    const float* alr = (const float*)(ws + WS_ALR) + tok0 * 16;
    for (int i = tid; i < 1024; i += NTHR) l_alr[i] = alr[i];
    { const bf16* vg = (const bf16*)(ws + WS_VG) + tok0 * 512;
      for (int i = tid; i < 64 * 64; i += NTHR) { const int s = i >> 6, ch = i & 63; *(LAS u32x4*)(l_v + s * PV + ch * 16) = *(const u32x4*)(vg + (size_t)s * 512 + ch * 8); } }
    __syncthreads();
    const int col = tid & 255, half = tid >> 8;
    float w2c[16];
#pragma unroll
    for (int j = 0; j < 16; ++j) w2c[j] = INP(5)[j * 256 + col];
    const float b2 = INP(6)[col];
    float run = 0.f;
#pragma unroll 2
    for (int i = 0; i < 32; ++i) { const int t = half * 32 + i; float z = b2;
#pragma unroll
        for (int j = 0; j < 16; ++j) z = fmaf(l_alr[t * 16 + j], w2c[j], z);
        run += log_sigmoid(z) * (1.f / 16.f); }
    l_tot[half * 256 + col] = run;
    __syncthreads();
    const float t0 = l_tot[col], t1 = l_tot[256 + col], blast = t0 + t1;
    { const bf16* kg = (const bf16*)(ws + WS_KG) + tok0 * 256; float bcur = half ? t0 : 0.f;
#pragma unroll 2
      for (int i = 0; i < 32; ++i) { const int t = half * 32 + i; float z = b2;
#pragma unroll
          for (int j = 0; j < 16; ++j) z = fmaf(l_alr[t * 16 + j], w2c[j], z);
          bcur += log_sigmoid(z) * (1.f / 16.f);
          const float kv = bf2f(kg[(size_t)t * 256 + col]);
          *(LAS bf16*)(l_kd + t * PK + col * 2) = (bf16)f2bf(kv * __expf(blast - bcur)); } }
    if (half == 0) ((float*)(ws + WS_DECAY))[((size_t)(b * 4 + (col >> 6)) * 128 + c) * 64 + (col & 63)] = __expf(blast);
    __syncthreads();
    const int h = wid >> 1, j = wid & 1;
    f32x4 acc[4][4];
#pragma unroll
    for (int mt = 0; mt < 4; ++mt)
#pragma unroll
        for (int nt = 0; nt < 4; ++nt) acc[mt][nt] = (f32x4){0.f, 0.f, 0.f, 0.f};
#pragma unroll
    for (int ks = 0; ks < 2; ++ks) { bf16x8 a[4], bb[4];
#pragma unroll
        for (int mt = 0; mt < 4; ++mt) a[mt] = frag_t(l_kd, PK, 32 * ks, h * 64 + 16 * mt, lane);
#pragma unroll
        for (int nt = 0; nt < 4; ++nt) bb[nt] = frag_t(l_v, PV, 32 * ks, h * 128 + j * 64 + 16 * nt, lane);
        __builtin_amdgcn_sched_barrier(0);
#pragma unroll
        for (int mt = 0; mt < 4; ++mt)
#pragma unroll
            for (int nt = 0; nt < 4; ++nt) acc[mt][nt] = MFMA16(a[mt], bb[nt], acc[mt][nt]); }
    bf16* st = (bf16*)(F.dout + DO_ST) + ((size_t)(b * 4 + h) * 128 + c) * 8192;
#pragma unroll
    for (int mt = 0; mt < 4; ++mt)
#pragma unroll
        for (int nt = 0; nt < 4; ++nt)
#pragma unroll
            for (int r = 0; r < 4; ++r) st[(16 * mt + 4 * (lane >> 4) + r) * 128 + j * 64 + 16 * nt + (lane & 15)] = (bf16)f2bf(acc[mt][nt][r]);
    __syncthreads();
}

__device__ __forceinline__ void gla_scan(Frame& F) {
    unsigned* st = (unsigned*)(F.dout + DO_ST); const float* dec = (const float*)(F.ws + WS_DECAY);
    for (int idx = F.bid * NTHR + F.tid; idx < 32 * 4096; idx += F.G * NTHR) {
        const int bh = idx >> 12, e2 = idx & 4095, dk = e2 >> 6;
        unsigned* p = st + (size_t)bh * 128 * 4096 + e2; const float* dp = dec + (size_t)bh * 128 * 64 + dk;
        float s0 = 0.f, s1 = 0.f;
#pragma unroll 8
        for (int c = 0; c < 128; ++c) { const unsigned kv = p[(size_t)c * 4096]; const float d = dp[c * 64];
            p[(size_t)c * 4096] = cvt_pk_bf16(s0, s1);
            s0 = fmaf(d, s0, bflo(kv)); s1 = fmaf(d, s1, bfhi(kv)); }
    }
}

__device__ __forceinline__ void gla_c_item(Frame& F, const Args& A, int b, int c, int hp) {
    unsigned char* ws = F.ws;
    LAS unsigned char* L = F.lds;
    LAS float* l_alr = (LAS float*)L;
    constexpr int PQ = 272, PV = 528, PP = 144;
    LAS unsigned char* l_qh = L + 4096;
    LAS unsigned char* l_kt = L + 21504;
    LAS unsigned char* l_v = L + 38912;
    LAS unsigned char* l_s = L + 72704;
    LAS unsigned char* l_p = L + 107520;
    LAS float* l_tot = (LAS float*)(L + 125952);
    LAS float* l_ss = (LAS float*)(L + 128000);
    const int tid = F.tid, lane = F.lane, wid = F.wave;
    const size_t tok0 = (size_t)b * SEQ + (size_t)c * 64;
    { const float* alr = (const float*)(ws + WS_ALR) + tok0 * 16; for (int i = tid; i < 1024; i += NTHR) l_alr[i] = alr[i]; }
    { const bf16* vg = (const bf16*)(ws + WS_VG) + tok0 * 512 + hp * 256;
      for (int i = tid; i < 64 * 32; i += NTHR) { const int s = i >> 5, ch = i & 31; *(LAS u32x4*)(l_v + s * PV + ch * 16) = *(const u32x4*)(vg + (size_t)s * 512 + ch * 8); } }
    { for (int i = tid; i < 2 * 64 * 16; i += NTHR) { const int hh = i >> 10, r = (i >> 4) & 63, ch = i & 15;
          const bf16* sp = (const bf16*)(F.dout + DO_ST) + ((size_t)(b * 4 + hp * 2 + hh) * 128 + c) * 8192 + r * 128 + ch * 8;
          *(LAS u32x4*)(l_s + hh * (64 * PQ) + r * PQ + ch * 16) = *(const u32x4*)sp; } }
    __syncthreads();
    {
        const int col = tid & 127, qt = tid >> 7, gc = hp * 128 + col;
        float w2c[16];
#pragma unroll
        for (int j = 0; j < 16; ++j) w2c[j] = INP(5)[j * 256 + gc];
        const float b2 = INP(6)[gc];
        float bc[16]; float run = 0.f;
#pragma unroll
        for (int i = 0; i < 16; ++i) { const int t = qt * 16 + i; float z = b2;
#pragma unroll
            for (int j = 0; j < 16; ++j) z = fmaf(l_alr[t * 16 + j], w2c[j], z);
            run += log_sigmoid(z) * (1.f / 16.f); bc[i] = run; }
        l_tot[qt * 128 + col] = run;
        __syncthreads();
        float pre = 0.f;
#pragma unroll
        for (int q = 0; q < 3; ++q) pre += (q < qt) ? l_tot[q * 128 + col] : 0.f;
        const bf16* qg = (const bf16*)(ws + WS_QG) + tok0 * 256 + gc; const bf16* kg = (const bf16*)(ws + WS_KG) + tok0 * 256 + gc;
#pragma unroll
        for (int i = 0; i < 16; ++i) { const int t = qt * 16 + i; const float bb = pre + bc[i];
            *(LAS bf16*)(l_qh + t * PQ + col * 2) = (bf16)f2bf(bf2f(qg[(size_t)t * 256]) * __expf(bb));
            *(LAS bf16*)(l_kt + t * PQ + col * 2) = (bf16)f2bf(bf2f(kg[(size_t)t * 256]) * __expf(-bb)); }
    }
    __syncthreads();
    const int hh = wid >> 2, j = wid & 3;
    {
        f32x4 sc4[4];
#pragma unroll
        for (int nt = 0; nt < 4; ++nt) sc4[nt] = (f32x4){0.f, 0.f, 0.f, 0.f};
#pragma unroll
        for (int ks = 0; ks < 2; ++ks) { const bf16x8 a = frag_n(l_qh, PQ, 16 * j, hh * 64 + 32 * ks, lane);
#pragma unroll
            for (int nt = 0; nt < 4; ++nt) sc4[nt] = MFMA16(a, frag_n(l_kt, PQ, 16 * nt, hh * 64 + 32 * ks, lane), sc4[nt]); }
#pragma unroll
        for (int nt = 0; nt < 4; ++nt)
#pragma unroll
            for (int r = 0; r < 4; ++r) { const int t = 16 * j + 4 * (lane >> 4) + r, s = 16 * nt + (lane & 15);
                *(LAS bf16*)(l_p + hh * (64 * PP) + t * PP + s * 2) = (bf16)f2bf(s <= t ? sc4[nt][r] : 0.f); }
    }
    __syncthreads();
    f32x4 acc[4][2];
#pragma unroll
    for (int mt = 0; mt < 4; ++mt)
#pragma unroll
        for (int nt = 0; nt < 2; ++nt) acc[mt][nt] = (f32x4){0.f, 0.f, 0.f, 0.f};
#pragma unroll
    for (int ks = 0; ks < 2; ++ks) {
        bf16x8 bb[2];
#pragma unroll
        for (int nt = 0; nt < 2; ++nt) bb[nt] = frag_t(l_s + hh * (64 * PQ), PQ, 32 * ks, 32 * j + 16 * nt, lane);
        __builtin_amdgcn_sched_barrier(0);
#pragma unroll
        for (int mt = 0; mt < 4; ++mt) { const bf16x8 a = frag_n(l_qh, PQ, 16 * mt, hh * 64 + 32 * ks, lane);
#pragma unroll
            for (int nt = 0; nt < 2; ++nt) acc[mt][nt] = MFMA16(a, bb[nt], acc[mt][nt]); } }
#pragma unroll
    for (int ks = 0; ks < 2; ++ks) {
        bf16x8 bb[2];
#pragma unroll
        for (int nt = 0; nt < 2; ++nt) bb[nt] = frag_t(l_v, PV, 32 * ks, hh * 128 + 32 * j + 16 * nt, lane);
        __builtin_amdgcn_sched_barrier(0);
#pragma unroll
        for (int mt = 0; mt < 4; ++mt) { const bf16x8 a = frag_n(l_p + hh * (64 * PP), PP, 16 * mt, 32 * ks, lane);
#pragma unroll
            for (int nt = 0; nt < 2; ++nt) acc[mt][nt] = MFMA16(a, bb[nt], acc[mt][nt]); } }
#pragma unroll
    for (int mt = 0; mt < 4; ++mt)
#pragma unroll
        for (int r = 0; r < 4; ++r) { float q = acc[mt][0][r] * acc[mt][0][r] + acc[mt][1][r] * acc[mt][1][r];
            q += __shfl_xor(q, 1); q += __shfl_xor(q, 2); q += __shfl_xor(q, 4); q += __shfl_xor(q, 8);
            if ((lane & 15) == 0) l_ss[(hh * 64 + 16 * mt + 4 * (lane >> 4) + r) * 4 + j] = q; }
    __syncthreads();
    const int head = hp * 2 + hh;
    const float* gng = INP(7); const bf16* rg = (const bf16*)(ws + WS_RG) + tok0 * 512; bf16* og = (bf16*)(F.dout + DO_OG) + tok0 * 512;
#pragma unroll
    for (int mt = 0; mt < 4; ++mt)
#pragma unroll
        for (int r = 0; r < 4; ++r) { const int t = 16 * mt + 4 * (lane >> 4) + r; const LAS float* sp = l_ss + (hh * 64 + t) * 4;
            const float rstd = 1.f / sqrtf(((sp[0] + sp[1]) + (sp[2] + sp[3])) * (1.f / 128.f) + EPS);
#pragma unroll
            for (int nt = 0; nt < 2; ++nt) { const int ch = head * 128 + 32 * j + 16 * nt + (lane & 15);
                const float rv = bf2f(rg[(size_t)t * 512 + ch]); const float sl = rv * __builtin_amdgcn_rcpf(1.f + __expf(-rv));
                og[(size_t)t * 512 + ch] = (bf16)f2bf(acc[mt][nt][r] * rstd * gng[ch] * sl); } }
    __syncthreads();
}

__device__ __forceinline__ void dil_combine(Frame& F) {
    const bf16* qd = (const bf16*)(F.ws + WS_QD); const float* lse = (const float*)(F.ws + WS_LSE); bf16* od = (bf16*)(F.dout + DO_OD);
    for (int idx = F.bid * NTHR + F.tid; idx < M * 64; idx += F.G * NTHR) {
        const int tok = idx >> 6, rem = idx & 63, h = rem >> 4, ch = rem & 15;
        const float l0 = lse[(size_t)tok * 12 + h], l1 = lse[(size_t)tok * 12 + 4 + h], l2 = lse[(size_t)tok * 12 + 8 + h];
        const float mx = fmaxf(l0, fmaxf(l1, l2)); float w0 = __expf(l0 - mx), w1 = __expf(l1 - mx), w2 = __expf(l2 - mx); const float inv = 1.f / (w0 + w1 + w2); w0 *= inv; w1 *= inv; w2 *= inv;
        const bf16* p = qd + (size_t)tok * 1536 + h * 128 + ch * 8;
        f32x4 a0, a1, b0, b1, c0, c1; unpack8f(*(const u32x4*)p, a0, a1); unpack8f(*(const u32x4*)(p + 512), b0, b1); unpack8f(*(const u32x4*)(p + 1024), c0, c1);
        *(u32x4*)(od + (size_t)tok * 512 + h * 128 + ch * 8) = pack8f(a0 * w0 + b0 * w1 + c0 * w2, a1 * w0 + b1 * w1 + c1 * w2);
    }
}

__device__ __forceinline__ att::BlockRef dil_ref(Frame& F, int I) {
    const int g = I >> 10, r = I & 1023, d = 1 << (2 * g), nqb = 32 >> (2 * g), qb = r % nqb, s = r / nqb, p = s % d, bh = s / d, h = bh & 3, b = bh >> 2;
    const size_t tb = (size_t)b * SEQ + p;
    att::BlockRef R;
    R.qs = d * 1536; R.ks = d * 1536; R.ls = d * 12; R.skv = SEQ / d; R.P0 = qb * 256;
    bf16* q = (bf16*)(F.ws + WS_QD) + tb * 1536 + g * 512 + h * 128;
    R.Q = q + (size_t)qb * 256 * R.qs;
    R.K = (const bf16*)(F.ws + WS_KD) + tb * 1536 + g * 512 + h * 128;
    R.L = (float*)(F.ws + WS_LSE) + tb * 12 + g * 4 + h + (size_t)qb * 256 * R.ls;
    return R;
}
__device__ __forceinline__ att::BlockRef xat_ref(Frame& F, int I) {
    const int qb = I & 31, h = (I >> 5) & 3, b = I >> 7;
    att::BlockRef R; R.qs = 512; R.ks = 1024; R.ls = 0; R.skv = 256; R.P0 = 256; R.L = nullptr;
    bf16* q = (bf16*)(F.ws + WS_QX) + ((size_t)b * SEQ + (size_t)qb * 256) * 512 + h * 128;
    R.Q = q; R.K = (const bf16*)(F.ws + WS_KVM) + (size_t)b * 256 * 1024 + h * 128;
    return R;
}
template <bool DIL>
__device__ __forceinline__ void attn_phase(Frame& F) {
    constexpr int TOTAL = DIL ? 3072 : 1024; constexpr int W = DIL ? 129 : (1 << 20); constexpr long VOFF = DIL ? (long)((WS_VD - WS_KD) / 2) : 512;
    int I = F.bid; if (I >= TOTAL) return;
    att::BlockRef cur = DIL ? dil_ref(F, I) : xat_ref(F, I);
    att::Seam S;
    att::prime<VOFF>(cur, W, F.ldsg, S);
    for (;;) {
        const bool more = I + F.G < TOTAL; const int In = more ? I + F.G : I;
        const att::BlockRef nxt = DIL ? dil_ref(F, In) : xat_ref(F, In);
        att::block<true, VOFF>(cur, nxt, W, F.ldsg, S);
        if (!more) break;
        cur = nxt; I = In;
    }
}

__device__ __forceinline__ void router_phase(Frame& F, const Args& A) {
    unsigned char* ws = F.ws;
    LAS unsigned char* l_w = F.lds;
    LAS float* l_lg = (LAS float*)(F.lds + 65536) + F.wave * (16 * 33 + 16);
    LAS unsigned* l_hist = (LAS unsigned*)(F.lds + 65536 + 8 * (16 * 33 + 16) * 4);
    const int tid = F.tid, lane = F.lane;
    { const u32x4* wsrc = (const u32x4*)(ws + WS_WR);
      for (int i = tid; i < 32 * 128; i += NTHR) { const int e = i >> 7, ch = i & 127; *(LAS u32x4*)(l_w + e * 2048 + ((ch ^ (e & 15)) << 4)) = wsrc[i]; } }
    if (tid < 64) l_hist[tid] = 0u;
    { int* rt = (int*)(ws + WS_RTOK); float* rg = (float*)(ws + WS_RGATE);
      for (int i = F.bid * NTHR + tid; i < 2 * RT_CAP; i += F.G * NTHR) { rt[i] = 0; rg[i] = 0.f; } }
    __syncthreads();
    const float* h2 = (const float*)F.dout; const float* g3 = INP(18); const float* br = INP(20);
    bf16* fo = (bf16*)(ws + WS_A);
    const int fr = lane & 15, fq = lane >> 4;
    for (int rb = F.bid * NWAVES + F.wave; rb < M / 16; rb += F.G * NWAVES) {
        const size_t row0 = (size_t)rb * 16;
        const float* xr = h2 + (row0 + fr) * DM + 8 * fq;
        f32x4 c0 = {0.f, 0.f, 0.f, 0.f}, c1 = {0.f, 0.f, 0.f, 0.f}; float ss = 0.f;
#pragma unroll 4
        for (int kk = 0; kk < 32; ++kk) {
            const f32x4 x0 = *(const f32x4*)(xr + 32 * kk), x1 = *(const f32x4*)(xr + 32 * kk + 4);
            ss += (x0[0] * x0[0] + x0[1] * x0[1]) + (x0[2] * x0[2] + x0[3] * x0[3]) + (x1[0] * x1[0] + x1[1] * x1[1]) + (x1[2] * x1[2] + x1[3] * x1[3]);
            const u32x4 hi = pack8f(x0, x1); f32x4 y0, y1; unpack8f(hi, y0, y1);
            const u32x4 lo = pack8f(x0 - y0, x1 - y1);
            const bf16x8 ah = *reinterpret_cast<const bf16x8*>(&hi), al = *reinterpret_cast<const bf16x8*>(&lo);
            const int ch = 4 * kk + fq;
            const bf16x8 b0 = *(const LAS bf16x8*)(l_w + fr * 2048 + ((ch ^ fr) << 4)), b1 = *(const LAS bf16x8*)(l_w + (16 + fr) * 2048 + ((ch ^ fr) << 4));
            c0 = MFMA16(ah, b0, c0); c0 = MFMA16(al, b0, c0); c1 = MFMA16(ah, b1, c1); c1 = MFMA16(al, b1, c1);
        }
        ss += __shfl_xor(ss, 16); ss += __shfl_xor(ss, 32);
        const float rstd = 1.f / sqrtf(ss * (1.f / DM) + EPS);
        if (fq == 0) l_lg[16 * 33 + fr] = rstd;
#pragma unroll
        for (int r = 0; r < 4; ++r) { l_lg[(4 * fq + r) * 33 + fr] = c0[r]; l_lg[(4 * fq + r) * 33 + 16 + fr] = c1[r]; }
        LDS_WAIT(); asm volatile("" ::: "memory");
        if (lane < 16) {
            const float rs = l_lg[16 * 33 + lane]; float v[32];
#pragma unroll
            for (int e = 0; e < 32; ++e) v[e] = l_lg[lane * 33 + e] * rs + br[e];
            int ci[4]; float cv[4];
#pragma unroll
            for (int k = 0; k < 4; ++k) { float best = -__builtin_inff(); int bi = 0;
#pragma unroll
                for (int e = 0; e < 32; ++e) { bool free_ = true;
#pragma unroll
                    for (int kk2 = 0; kk2 < k; ++kk2) free_ = free_ && (ci[kk2] != e);
                    if (free_ && v[e] > best) { best = v[e]; bi = e; } }
                ci[k] = bi; cv[k] = best; }
            float ex[4], sum = 0.f;
#pragma unroll
            for (int k = 0; k < 4; ++k) { ex[k] = __expf(cv[k] - cv[0]); sum += ex[k]; }
            const float inv = 1.f / sum; const size_t tok = row0 + lane; const int hf = tok >= HALF_TOK ? 1 : 0;
            int* te = (int*)(ws + WS_TOPE) + tok * 4; float* tg = (float*)(ws + WS_TGATE) + tok * 4;
#pragma unroll
            for (int k = 0; k < 4; ++k) { te[k] = ci[k]; tg[k] = ex[k] * inv; atomicAdd((unsigned*)&l_hist[hf * 32 + ci[k]], 1u); }
        }
#pragma unroll 2
        for (int r = 0; r < 16; ++r) { const float rs = l_lg[16 * 33 + r];
            const f32x4* xp = (const f32x4*)(h2 + (row0 + r) * DM) + lane; const f32x4* gp = (const f32x4*)g3 + lane; u32x2* op = (u32x2*)(fo + (row0 + r) * DM) + lane;
#pragma unroll
            for (int jj = 0; jj < 4; ++jj) { const f32x4 x = xp[64 * jj], gg = gp[64 * jj]; u32x2 w; w.x = cvt_pk_bf16(x.x * rs * gg.x, x.y * rs * gg.y); w.y = cvt_pk_bf16(x.z * rs * gg.z, x.w * rs * gg.w); op[64 * jj] = w; } }
        LDS_WAIT(); asm volatile("" ::: "memory");
    }
    __syncthreads();
    if (tid < 64 && l_hist[tid] != 0u) atomicAdd(F.ctl + CW_CNT + tid, l_hist[tid]);
}

struct MoeTab { LAS int* pstart; LAS int* blk_e; LAS int* nblk; };
__device__ __forceinline__ MoeTab moe_tables(Frame& F, int half) {
    MoeTab T; T.pstart = (LAS int*)(F.lds + TAB_OFF); T.blk_e = T.pstart + 32; T.nblk = T.blk_e + MAXBLK;
    __syncthreads();
    if (F.tid == 0) { int pos = 0;
        for (int e = 0; e < NEXP; ++e) { const int cnt = (int)__hip_atomic_load(F.ctl + CW_CNT + half * 32 + e, __ATOMIC_RELAXED, __HIP_MEMORY_SCOPE_AGENT); const int nb = (cnt + 255) >> 8;
            T.pstart[e] = pos * 256; for (int jx = 0; jx < nb && pos < MAXBLK; ++jx) T.blk_e[pos++] = e; }
        T.nblk[0] = pos; }
    __syncthreads();
    return T;
}
__device__ __forceinline__ void place_phase(Frame& F) {
    unsigned char* ws = F.ws;
    LAS int* l_cnt = (LAS int*)(F.lds + 4096); LAS int* l_base = l_cnt + 32;
    const int* te = (const int*)(ws + WS_TOPE); const float* tg = (const float*)(ws + WS_TGATE);
    int* tslot = (int*)(ws + WS_TSLOT);
    for (int half = 0; half < 2; ++half) {
        const MoeTab T = moe_tables(F, half);
        int* rtok = (int*)(ws + WS_RTOK) + half * RT_CAP; float* rgate = (float*)(ws + WS_RGATE) + half * RT_CAP;
        for (int bt = F.bid; bt < HALF_TOK / 128; bt += F.G) {
            if (F.tid < 32) l_cnt[F.tid] = 0;
            __syncthreads();
            const int tok = half * HALF_TOK + bt * 128 + (F.tid >> 2), k = F.tid & 3;
            const int e = te[(size_t)tok * 4 + k];
            const int rank = atomicAdd((int*)&l_cnt[e], 1);
            __syncthreads();
            if (F.tid < 32) l_base[F.tid] = (int)atomicAdd(F.ctl + CW_CUR + half * 32 + F.tid, (unsigned)l_cnt[F.tid]);
            __syncthreads();
            const int dest = T.pstart[e] + l_base[e] + rank;
            if (dest < RT_CAP) { rtok[dest] = tok; rgate[dest] = tg[(size_t)tok * 4 + k]; }
            tslot[(size_t)tok * 4 + k] = dest < RT_CAP ? dest : 0;
            __syncthreads();
        }
    }
}
__device__ __forceinline__ void combine_phase(Frame& F, const Args& A, int half) {
    float* h2 = (float*)F.dout; const bf16* Y = (const bf16*)(F.ws + WS_Y); const int* tslot = (const int*)(F.ws + WS_TSLOT); const float* gf = INP(27);
    for (int m = half * HALF_TOK + F.bid * NWAVES + F.wave; m < (half + 1) * HALF_TOK; m += F.G * NWAVES) {
        f32x4* xr = (f32x4*)(h2 + (size_t)m * DM) + F.lane;
        f32x4 v[4];
#pragma unroll
        for (int j = 0; j < 4; ++j) v[j] = xr[64 * j];
#pragma unroll
        for (int k = 0; k < 4; ++k) { const int sl = tslot[(size_t)m * 4 + k]; const u32x2* yp = (const u32x2*)(Y + (size_t)sl * 1024) + F.lane;
#pragma unroll
            for (int j = 0; j < 4; ++j) { const u32x2 w = yp[64 * j]; v[j] += (f32x4){bflo(w.x), bfhi(w.x), bflo(w.y), bfhi(w.y)}; } }
        float s = 0.f;
#pragma unroll
        for (int j = 0; j < 4; ++j) s += (v[j].x * v[j].x + v[j].y * v[j].y) + (v[j].z * v[j].z + v[j].w * v[j].w);
        const float rstd = 1.f / sqrtf(wave_sum(s) * (1.f / DM) + EPS);
        const f32x4* gr = (const f32x4*)gf + F.lane;
#pragma unroll
        for (int j = 0; j < 4; ++j) xr[64 * j] = v[j] * rstd * gr[64 * j];
    }
}

__global__ void __launch_bounds__(NTHR, 2) mk_fwd(Args A) {
    extern __shared__ __attribute__((aligned(16))) unsigned char lds[];
    Frame F;
    F.lds = (LAS unsigned char*)lds; F.ldsg = (char*)lds;
    F.tid = threadIdx.x; F.lane = F.tid & 63; F.wave = __builtin_amdgcn_readfirstlane(F.tid >> 6);
    F.G = gridDim.x; F.bid = blockIdx.x;
    F.ws = A.ws; F.ctl = (unsigned*)(A.ws + WS_CTL); F.dout = (unsigned char*)A.out;
    volatile LAS unsigned* MISC = (volatile LAS unsigned*)(F.lds + MISC_OFF);
    if (F.tid < 16) MISC[F.tid] = 0u;
    __syncthreads();
    XcdBarrier bar; bar.bar = F.ctl + CW_BAR; bar.x = 0; bar.st = nullptr;
    if (!MK_PER_PHASE) bar = xcd_barrier_post(F.ctl + CW_BAR, MISC + 8);
    const int lo = A.ph_lo, hi = A.ph_hi;
#ifndef PHMASK
#define PHMASK 0x7ffff
#endif
#define IN(k) (((PHMASK >> (k)) & 1) && lo <= (k) && (k) < hi)
#define SEAM(k) do { if (IN(k) && IN((k) + 1)) xcd_barrier(bar); } while (0)
    unsigned char* ws = F.ws;
    const int* positions = (const int*)A.in[2];

    if (IN(0)) { p0_prologue(F, A); } SEAM(0);
    if (IN(1)) {
        { pg8::Gemm g{(const bf16*)(ws + WS_A), (const bf16*)(ws + WS_WIN), 1024, nullptr}; pg8::StaticOrder S; S.init(M / 256, N1 / 256, F.G, F.bid);
          EpiProj E{ws, positions}; pg8::gemm_phase<EpiProj, pg8::StaticOrder, false>(F.lds, g, S, E); }
        { pg8::Gemm g{(const bf16*)(ws + WS_MEMN), (const bf16*)(ws + WS_WXKV), 1024, nullptr}; pg8::StaticOrder S; S.init(8, 4, F.G, F.bid);
          EpiBf16<0> E{(bf16*)(ws + WS_KVM), 1024, nullptr, 1.f}; pg8::gemm_phase<EpiBf16<0>, pg8::StaticOrder, false>(F.lds, g, S, E); }
    } SEAM(1);
    if (IN(2)) {
#ifndef NO_GLAA
        for (int it = F.bid; it < NBATCH * 128; it += F.G) gla_a_item(F, A, it >> 7, it & 127);
#endif
#ifndef NO_DIL
        attn_phase<true>(F);
#endif
    } SEAM(2);
    if (IN(3)) { gla_scan(F); } SEAM(3);
    if (IN(4)) {
        for (int it = F.bid; it < NBATCH * 128 * 2; it += F.G) gla_c_item(F, A, it >> 8, (it >> 1) & 127, it & 1);
        dil_combine(F);
    } SEAM(4);
    if (IN(5)) { pg8::Gemm g{(const bf16*)(ws + WS_A), (const bf16*)(ws + WS_WGATE), 1024, nullptr}; pg8::StaticOrder S; S.init(M / 256, 8, F.G, F.bid);
        EpiBf16<1> E{(bf16*)(ws + WS_GATES), 2048, INP(11), 1.f}; pg8::gemm_phase<EpiBf16<1>, pg8::StaticOrder, false>(F.lds, g, S, E); } SEAM(5);
    if (IN(6)) {
        { pg8::Gemm g{(const bf16*)(F.dout + DO_OG), (const bf16*)(ws + WS_WBG), 512, nullptr}; pg8::StaticOrder S; S.init(M / 256, 4, F.G, F.bid);
          EpiBranch<0> E{(bf16*)(ws + WS_MERGED), (const bf16*)(ws + WS_GATES), 0}; pg8::gemm_phase<EpiBranch<0>, pg8::StaticOrder, false>(F.lds, g, S, E); }
        { pg8::Gemm g{(const bf16*)(F.dout + DO_OD), (const bf16*)(ws + WS_WBD), 512, nullptr}; pg8::StaticOrder S; S.init(M / 256, 4, F.G, F.bid);
          EpiBranch<1> E{(bf16*)(ws + WS_MERGED), (const bf16*)(ws + WS_GATES), 1024}; pg8::gemm_phase<EpiBranch<1>, pg8::StaticOrder, false>(F.lds, g, S, E); }
    } SEAM(6);
    if (IN(7)) { pg8::Gemm g{(const bf16*)(ws + WS_MERGED), (const bf16*)(ws + WS_WMIX), 1024, nullptr}; pg8::StaticOrder S; S.init(M / 256, 4, F.G, F.bid);
        EpiResF32 E{INP(0), (float*)F.dout}; pg8::gemm_phase<EpiResF32, pg8::StaticOrder, false>(F.lds, g, S, E); } SEAM(7);
    if (IN(8)) {
        const int gw = F.bid * NWAVES + F.wave, NGW = F.G * NWAVES;
        for (int m = gw; m < M; m += NGW) rms_row_to_bf16((const float*)F.dout + (size_t)m * DM, INP(13), (bf16*)(ws + WS_A) + (size_t)m * DM, F.lane);
        LAS float* scr = (LAS float*)(F.lds + F.wave * 16384);
        constexpr int IPM = 16 * 32;
        for (int it = gw; it < 3 * NEXP * IPM; it += NGW) { const int mat = it / IPM, r = it % IPM, kind = mat / NEXP, e = mat % NEXP;
            if (kind == 0) transpose_item(INP(21) + (size_t)e * 1048576, 1024, 1024, (bf16*)(ws + WS_WGU), RmGU{e * 2048}, scr, r, F.lane);
            else if (kind == 1) transpose_item(INP(23) + (size_t)e * 1048576, 1024, 1024, (bf16*)(ws + WS_WGU), RmGU{e * 2048 + 128}, scr, r, F.lane);
            else transpose_item(INP(25) + (size_t)e * 1048576, 1024, 1024, (bf16*)(ws + WS_WDN), RmId{e * 1024}, scr, r, F.lane); }
    } SEAM(8);
    if (IN(9)) { pg8::Gemm g{(const bf16*)(ws + WS_A), (const bf16*)(ws + WS_WXQ), 1024, nullptr}; pg8::StaticOrder S; S.init(M / 256, 2, F.G, F.bid);
        EpiBf16<0> E{(bf16*)(ws + WS_QX), 512, nullptr, 1.f}; pg8::gemm_phase<EpiBf16<0>, pg8::StaticOrder, false>(F.lds, g, S, E); } SEAM(9);
    if (IN(10)) { attn_phase<false>(F); } SEAM(10);
    if (IN(11)) { pg8::Gemm g{(const bf16*)(ws + WS_QX), (const bf16*)(ws + WS_WXO), 512, nullptr}; pg8::StaticOrder S; S.init(M / 256, 4, F.G, F.bid);
        EpiResF32 E{(const float*)F.dout, (float*)F.dout}; pg8::gemm_phase<EpiResF32, pg8::StaticOrder, false>(F.lds, g, S, E); } SEAM(11);
    if (IN(12)) { router_phase(F, A); } SEAM(12);
    if (IN(13)) { place_phase(F); } SEAM(13);
#define MOE_GU(half) do { const MoeTab T = moe_tables(F, half); \
        pg8::Gemm g{(const bf16*)(ws + WS_A), (const bf16*)(ws + WS_WGU), 1024, (const int*)(ws + WS_RTOK) + (half) * RT_CAP}; \
        pg8::MoeOrder S; S.init(T.nblk[0], 8, F.G, F.bid); S.blk_e = T.blk_e; \
        EpiSwiglu E{(bf16*)(ws + WS_H), INP(22), INP(24), 8}; pg8::gemm_phase<EpiSwiglu, pg8::MoeOrder, true>(F.lds, g, S, E); } while (0)
#define MOE_DN(half) do { const MoeTab T = moe_tables(F, half); \
        pg8::Gemm g{(const bf16*)(ws + WS_H), (const bf16*)(ws + WS_WDN), 1024, nullptr}; \
        pg8::MoeOrder S; S.init(T.nblk[0], 4, F.G, F.bid); S.blk_e = T.blk_e; \
        EpiDown E{(bf16*)(ws + WS_Y), INP(26), (const float*)(ws + WS_RGATE) + (half) * RT_CAP, 4}; pg8::gemm_phase<EpiDown, pg8::MoeOrder, false>(F.lds, g, S, E); } while (0)
    if (IN(14)) { MOE_GU(0); } SEAM(14);
    if (IN(15)) { MOE_DN(0); } SEAM(15);
    if (IN(16)) { combine_phase(F, A, 0); MOE_GU(1); } SEAM(16);
    if (IN(17)) { MOE_DN(1); } SEAM(17);
    if (IN(18)) { combine_phase(F, A, 1); }
#undef IN
#undef SEAM
}


extern "C" void kernel_launch(void* const* d_in, const int* in_sizes, int n_in, void* d_out, int out_size, void* d_ws, size_t ws_size, hipStream_t stream) {
    static int grid = 0;
    if (grid == 0) {
        if (n_in != 28 || out_size != M * DM || ws_size < WS_END) { fprintf(stderr, "kernel_launch: unexpected shapes (n_in %d, out %d, ws %zu)\n", n_in, out_size, ws_size); grid = -1; return; }
        int dev = 0, cus = 0, per_cu = 0;
        if (hipGetDevice(&dev) != hipSuccess || hipDeviceGetAttribute(&cus, hipDeviceAttributeMultiprocessorCount, dev) != hipSuccess) { grid = -1; return; }
        if (hipFuncSetAttribute((const void*)mk_fwd, hipFuncAttributeMaxDynamicSharedMemorySize, LDS_BYTES) != hipSuccess) { fprintf(stderr, "kernel_launch: hipFuncSetAttribute failed\n"); grid = -1; return; }
        if (hipOccupancyMaxActiveBlocksPerMultiprocessor(&per_cu, (const void*)mk_fwd, NTHR, LDS_BYTES) != hipSuccess || per_cu < 1) { fprintf(stderr, "kernel_launch: occupancy query says %d\n", per_cu); (void)hipGetLastError(); grid = -1; return; }
        grid = cus;
    }
    if (grid < 0) return;
#if MK_DIAG
    unsigned long long* sums = (unsigned long long*)((char*)d_ws + WS_DIAG);
    (void)hipMemsetAsync(sums, 0, 4096, stream);
    for (int run = 0; run < 2; ++run) {
        (void)hipMemsetAsync((char*)d_ws + 1 * MiB, run ? 0x3C : 0x00, WS_END - 1 * MiB, stream);
        (void)hipMemsetAsync(d_out, run ? 0x3D : 0x00, (size_t)M * DM * 4, stream);
        (void)hipMemsetAsync((char*)d_ws + WS_CTL, 0, CTL_ZERO_BYTES, stream);
        Args a{};
        for (int i = 0; i < 28; ++i) a.in[i] = d_in[i];
        a.out = (float*)d_out; a.ws = (unsigned char*)d_ws;
        for (int p = 0; p < NPH; ++p) { a.ph_lo = p; a.ph_hi = p + 1; hipLaunchKernelGGL(mk_fwd, dim3(grid), dim3(NTHR), LDS_BYTES, stream, a);
            diag_sums(p, (unsigned char*)d_ws, (unsigned char*)d_out, sums + run * 32 + p, stream); }
    }
    hipLaunchKernelGGL(k_verdict, dim3(1024), dim3(256), 0, stream, (const unsigned long long*)sums, (float*)d_out, (size_t)M * DM);
#else
    (void)hipMemsetAsync((char*)d_ws + WS_CTL, 0, CTL_ZERO_BYTES, stream);
    Args a{};
    for (int i = 0; i < 28; ++i) a.in[i] = d_in[i];
    a.out = (float*)d_out; a.ws = (unsigned char*)d_ws;
#if MK_PER_PHASE
    for (int p = 0; p < NPH; ++p) { a.ph_lo = p; a.ph_hi = p + 1; hipLaunchKernelGGL(mk_fwd, dim3(grid), dim3(NTHR), LDS_BYTES, stream, a); }
#else
    a.ph_lo = 0; a.ph_hi = NPH; hipLaunchKernelGGL(mk_fwd, dim3(grid), dim3(NTHR), LDS_BYTES, stream, a);
#endif
#endif
}
```

```cpp
#include <hip/hip_runtime.h>
#include <cstdio>
#include <cstdint>

#define LAS __attribute__((address_space(3)))
#define GAS __attribute__((address_space(1)))
typedef unsigned short bf16;
typedef short bf16x8 __attribute__((ext_vector_type(8)));
typedef short s16x4 __attribute__((ext_vector_type(4)));
typedef float f32x4 __attribute__((ext_vector_type(4)));
typedef float f32x16 __attribute__((ext_vector_type(16)));
typedef unsigned u32x4 __attribute__((ext_vector_type(4)));
typedef unsigned u32x2 __attribute__((ext_vector_type(2)));
typedef int i32x4 __attribute__((ext_vector_type(4)));
typedef int i32x8 __attribute__((ext_vector_type(8)));

typedef float f32x2 __attribute__((ext_vector_type(2)));
typedef __bf16 b16x2 __attribute__((ext_vector_type(2)));
__device__ __forceinline__ unsigned cvt_pk_bf16(float lo, float hi) { const f32x2 v = {lo, hi}; const b16x2 r = __builtin_convertvector(v, b16x2); return __builtin_bit_cast(unsigned, r); }
__device__ __forceinline__ u32x2 pack8_fp8(const f32x4& a, const f32x4& b) {
    unsigned lo = 0, hi = 0; lo = __builtin_amdgcn_cvt_pk_fp8_f32(a[0], a[1], lo, false); lo = __builtin_amdgcn_cvt_pk_fp8_f32(a[2], a[3], lo, true); hi = __builtin_amdgcn_cvt_pk_fp8_f32(b[0], b[1], hi, false); hi = __builtin_amdgcn_cvt_pk_fp8_f32(b[2], b[3], hi, true);
    u32x2 w; w.x = lo; w.y = hi; return w; }
__device__ __forceinline__ float bf2f(unsigned b) { return __uint_as_float(b << 16); }
__device__ __forceinline__ float bflo(unsigned w) { return __uint_as_float(w << 16); }
__device__ __forceinline__ float bfhi(unsigned w) { return __uint_as_float(w & 0xffff0000u); }
__device__ __forceinline__ unsigned f2bf(float f) { unsigned u = __float_as_uint(f); return (u + 0x7fffu + ((u >> 16) & 1u)) >> 16; }
__device__ __forceinline__ unsigned pk2(float lo, float hi) { return f2bf(lo) | (f2bf(hi) << 16); }

namespace pg8 {
constexpr int BM = 256, BK = 64, HALF = 128, HTB = HALF * BK * 2, STAGE_BYTES = 8 * HTB, NXCD = 8, WGM = 4;
__host__ __device__ __forceinline__ int lds_byte(int r, int c) { const int st = (r >> 4) * 2 + (c >> 5), rr = r & 15, cc = c & 31, ob = rr * 64 + cc * 2; return st * 1024 + (ob ^ (((ob >> 9) & 1) << 5)); }
__host__ __device__ __forceinline__ void stage_rc(int b, int& R, int& C) { const int st = b / 1024, sb = b % 1024, swz = sb ^ (((sb >> 9) & 1) << 5); R = (st >> 1) * 16 + swz / 64; C = (st & 1) * 32 + (swz % 64) / 2; }
__host__ __device__ __forceinline__ int perm32(int rho) { const int n = rho >> 4, i = rho & 15; return 8 * (i >> 2) + 4 * n + (i & 3); }

struct Unit { int pm, pn, pb, ord; };
struct Gemm { const bf16* A; const bf16* Bt; int K; const int* rowmap; };

struct StaticOrder {
    int nM, nN, nwg, G, c, pn0, pbd;
    __device__ __forceinline__ void init(int nM_, int nN_, int G_, int c_, int pn0_ = 0, int pbd_ = 0) { nM = nM_; nN = nN_; nwg = nM * nN; G = G_; c = c_; pn0 = pn0_; pbd = pbd_; }
    __device__ __forceinline__ bool next(int i, Unit& u) const {
        const long L = (long)i * G + c; if (L >= nwg) return false;
        int wgid = (int)L; { const int q = nwg / NXCD, r = nwg % NXCD, xcd = wgid % NXCD, off = wgid / NXCD; wgid = (xcd < r ? xcd * (q + 1) : r * (q + 1) + (xcd - r) * q) + off; }
        const int nig = WGM * nN, gid = wgid / nig, fm = gid * WGM, gsz = (nM - fm) < WGM ? (nM - fm) : WGM;
        u.pm = fm + ((wgid % nig) % gsz); u.pn = pn0 + (wgid % nig) / gsz; u.pb = u.pn + pbd; u.ord = i; return true;
    }
};
struct MoeOrder : StaticOrder {
    const LAS int* blk_e;
    __device__ __forceinline__ bool next(int i, Unit& u) const { if (!StaticOrder::next(i, u)) return false; u.pb = blk_e[u.pm] * nN + u.pn; return true; }
};

template <class Epi, class Sched, bool GATHER, int ES = 2>
__device__ __forceinline__ void gemm_phase(LAS unsigned char* lds, const Gemm g, const Sched& S, const Epi& E) {
    const int tid = threadIdx.x, wid = __builtin_amdgcn_readfirstlane(tid >> 6), lane = tid & 63, wr = wid >> 2, wc = wid & 3, fr = lane & 15, fq = lane >> 4;
    const int K = g.K, KB = K * ES  , nt = KB / (BK * 2);
    unsigned voffA[2], voffB[2]; int rA[2], cA2[2];
#pragma unroll
    for (int i = 0; i < 2; ++i) { int R, C; stage_rc(tid * 16 + i * 8192, R, C); const int Rb = Epi::PERM ? ((R & ~31) + perm32(R & 31)) : R;
        voffA[i] = (unsigned)(R * KB + C * 2); voffB[i] = (unsigned)(Rb * KB + C * 2); rA[i] = R; cA2[i] = C * 2; }
    const size_t kstep = (size_t)(BK * 2);
    const size_t hstep = (size_t)HALF * KB;
    const size_t tstep = 2 * hstep;
    const unsigned ldsw = (unsigned)wid * 1024u;
    const int aoff = lds_byte(wr * 64 + fr, fq * 8), boff = lds_byte(wc * 32 + fr, fq * 8);
#define PG8_SA(b, h) (((b) * 2 + (h)) * HTB)
#define PG8_SB(b, h) ((4 + (b) * 2 + (h)) * HTB)
#define PG8_STAGE(bufoff, gbase, voff) do { _Pragma("unroll") for (int _i = 0; _i < 2; ++_i) \
        __builtin_amdgcn_global_load_lds((const unsigned*)((const char*)(gbase) + (voff)[_i]), (LAS unsigned*)(lds + (bufoff) + ldsw + _i * 8192), 16, 0, 0); } while (0)
#define PG8_STAGE_G(bufoff, o0, o1, kb) do { \
        __builtin_amdgcn_global_load_lds((const unsigned*)((const char*)g.A + (size_t)(o0) + (kb)), (LAS unsigned*)(lds + (bufoff) + ldsw), 16, 0, 0); \
        __builtin_amdgcn_global_load_lds((const unsigned*)((const char*)g.A + (size_t)(o1) + (kb)), (LAS unsigned*)(lds + (bufoff) + ldsw + 8192), 16, 0, 0); } while (0)
#define PG8_CAT8(x0, x1) __builtin_shufflevector(__builtin_bit_cast(i32x4, x0), __builtin_bit_cast(i32x4, x1), 0, 1, 2, 3, 4, 5, 6, 7)
#define PG8_LDA(dst, b, h) do { if constexpr (ES == 2) { _Pragma("unroll") for (int m = 0; m < 4; ++m) _Pragma("unroll") for (int k = 0; k < 2; ++k) dst[m][k] = *(const LAS bf16x8*)(lds + PG8_SA(b, h) + aoff + m * 2048 + k * 1024); } \
        else { _Pragma("unroll") for (int m = 0; m < 4; ++m) dst##8[m] = PG8_CAT8(*(const LAS bf16x8*)(lds + PG8_SA(b, h) + aoff + m * 2048), *(const LAS bf16x8*)(lds + PG8_SA(b, h) + aoff + m * 2048 + 1024)); } } while (0)
#define PG8_LDB(dst, b, h) do { if constexpr (ES == 2) { _Pragma("unroll") for (int n = 0; n < 2; ++n) _Pragma("unroll") for (int k = 0; k < 2; ++k) dst[n][k] = *(const LAS bf16x8*)(lds + PG8_SB(b, h) + boff + n * 2048 + k * 1024); } \
        else { _Pragma("unroll") for (int n = 0; n < 2; ++n) dst##8[n] = PG8_CAT8(*(const LAS bf16x8*)(lds + PG8_SB(b, h) + boff + n * 2048), *(const LAS bf16x8*)(lds + PG8_SB(b, h) + boff + n * 2048 + 1024)); } } while (0)
#define PG8_MMA(ai, bj, At, Bt) do { __builtin_amdgcn_s_setprio(1); if constexpr (ES == 2) { _Pragma("unroll") for (int m = 0; m < 4; ++m) _Pragma("unroll") for (int n = 0; n < 2; ++n) _Pragma("unroll") for (int k = 0; k < 2; ++k) \
        acc[ai][bj][m][n] = __builtin_amdgcn_mfma_f32_16x16x32_bf16(Bt[n][k], At[m][k], acc[ai][bj][m][n], 0, 0, 0); } else { _Pragma("unroll") for (int m = 0; m < 4; ++m) _Pragma("unroll") for (int n = 0; n < 2; ++n) \
        asm volatile("v_mfma_scale_f32_16x16x128_f8f6f4 %0, %1, %2, %0, %3, %3 op_sel_hi:[0,0,0]" : "+v"(acc[ai][bj][m][n]) : "v"(Bt##8[n]), "v"(At##8[m]), "v"(sc1)); } \
        __builtin_amdgcn_s_setprio(0); } while (0)
#define PG8_WAIT_V(n) asm volatile("s_waitcnt vmcnt(" #n ")" ::: "memory")
#define PG8_WAIT_L(n) asm volatile("s_waitcnt lgkmcnt(" #n ")" ::: "memory")
#define PG8_BAR __builtin_amdgcn_s_barrier()
#define PG8_SCHED __builtin_amdgcn_sched_barrier(0)
#define PG8_ROWOFF(dst, U) do { _Pragma("unroll") for (int _h = 0; _h < 2; ++_h) _Pragma("unroll") for (int _i = 0; _i < 2; ++_i) \
        dst[_h][_i] = (unsigned)g.rowmap[(U).pm * BM + _h * HALF + rA[_i]] * (unsigned)KB + (unsigned)cA2[_i]; } while (0)
    Unit cur, nxt; int ui = 0;
    if (!S.next(0, cur)) return;
    f32x4 acc[2][2][4][2];
#pragma unroll
    for (int a = 0; a < 2; ++a)
#pragma unroll
        for (int b = 0; b < 2; ++b)
#pragma unroll
            for (int m = 0; m < 4; ++m)
#pragma unroll
                for (int n = 0; n < 2; ++n) acc[a][b][m][n] = (f32x4){0.f, 0.f, 0.f, 0.f};
    const int sc1 = 0x7f7f7f7f;
    bf16x8 At[4][2], B0[2][2], B1[2][2]; i32x8 At8[4], B08[2], B18[2];
    const char* cA = (const char*)g.A + (size_t)cur.pm * tstep; const char* cB = (const char*)g.Bt + (size_t)cur.pb * tstep;
    unsigned cO[2][2] = {{0u, 0u}, {0u, 0u}}, nO[2][2] = {{0u, 0u}, {0u, 0u}};
    bool has_next = S.next(1, nxt);
    if constexpr (GATHER) { PG8_ROWOFF(cO, cur); if (has_next) { PG8_ROWOFF(nO, nxt); } else { _Pragma("unroll") for (int h = 0; h < 2; ++h) _Pragma("unroll") for (int i = 0; i < 2; ++i) nO[h][i] = cO[h][i]; } }
    if constexpr (GATHER) {
        PG8_STAGE(PG8_SB(0, 0), cB, voffB); PG8_STAGE(PG8_SB(0, 1), cB + hstep, voffB); PG8_STAGE_G(PG8_SA(0, 0), cO[0][0], cO[0][1], 0); PG8_STAGE_G(PG8_SA(0, 1), cO[1][0], cO[1][1], 0);
        if (wr == 1) PG8_BAR;
        PG8_WAIT_V(2); PG8_BAR;
        PG8_STAGE(PG8_SB(1, 0), cB + kstep, voffB); PG8_STAGE_G(PG8_SA(1, 0), cO[0][0], cO[0][1], kstep); PG8_STAGE(PG8_SB(1, 1), cB + hstep + kstep, voffB);
        PG8_WAIT_V(6); PG8_BAR;
    } else {
        PG8_STAGE(PG8_SB(0, 0), cB, voffB); PG8_STAGE(PG8_SB(0, 1), cB + hstep, voffB); PG8_STAGE(PG8_SA(0, 0), cA, voffA); PG8_STAGE(PG8_SA(0, 1), cA + hstep, voffA);
        if (wr == 1) PG8_BAR;
        PG8_WAIT_V(2); PG8_BAR;
        PG8_STAGE(PG8_SB(1, 0), cB + kstep, voffB); PG8_STAGE(PG8_SA(1, 0), cA + kstep, voffA); PG8_STAGE(PG8_SB(1, 1), cB + hstep + kstep, voffB);
        PG8_WAIT_V(6); PG8_BAR;
    }
    for (;;) {
        const char* nA = has_next ? (const char*)g.A + (size_t)nxt.pm * tstep : cA; const char* nB = has_next ? (const char*)g.Bt + (size_t)nxt.pb * tstep : cB;
#pragma nounroll
        for (int t = 0; t < nt; t += 2) {
            const bool last = (t == nt - 2);
            const char* a1 = cA + (size_t)(t + 1) * kstep;
            const char* a2 = last ? nA : cA + (size_t)(t + 2) * kstep; const char* b2 = last ? nB : cB + (size_t)(t + 2) * kstep;
            const char* a3 = a2 + kstep; const char* b3 = b2 + kstep;
            const size_t k1 = (size_t)(t + 1) * kstep, k2 = last ? 0 : (size_t)(t + 2) * kstep, k3 = k2 + kstep;
            unsigned x00 = 0, x01 = 0, x10 = 0, x11 = 0;
            if constexpr (GATHER) { x00 = last ? nO[0][0] : cO[0][0]; x01 = last ? nO[0][1] : cO[0][1]; x10 = last ? nO[1][0] : cO[1][0]; x11 = last ? nO[1][1] : cO[1][1]; }
            if constexpr (Epi::HAS_MID) { if (t == nt / 2) E.mid(acc, cur, wr, wc, fr, fq); }
            PG8_LDB(B0, 0, 0); PG8_LDB(B1, 0, 1); PG8_SCHED; PG8_LDA(At, 0, 0);
            if constexpr (GATHER) PG8_STAGE_G(PG8_SA(1, 1), cO[1][0], cO[1][1], k1); else PG8_STAGE(PG8_SA(1, 1), a1 + hstep, voffA);
            PG8_WAIT_V(8); PG8_WAIT_L(0); PG8_BAR; PG8_MMA(0, 0, At, B0); PG8_MMA(0, 1, At, B1); PG8_BAR; PG8_SCHED;
            PG8_LDA(At, 0, 1); PG8_STAGE(PG8_SB(0, 0), b2, voffB); PG8_STAGE(PG8_SB(0, 1), b2 + hstep, voffB);
            if constexpr (GATHER) PG8_STAGE_G(PG8_SA(0, 0), x00, x01, k2); else PG8_STAGE(PG8_SA(0, 0), a2, voffA);
            PG8_WAIT_V(8); PG8_WAIT_L(0); PG8_BAR; PG8_MMA(1, 0, At, B0); PG8_MMA(1, 1, At, B1); PG8_BAR; PG8_SCHED;
            PG8_LDB(B0, 1, 0); PG8_LDB(B1, 1, 1); PG8_SCHED; PG8_LDA(At, 1, 0);
            if constexpr (GATHER) PG8_STAGE_G(PG8_SA(0, 1), x10, x11, k2); else PG8_STAGE(PG8_SA(0, 1), a2 + hstep, voffA);
            PG8_WAIT_V(8); PG8_WAIT_L(0); PG8_BAR; PG8_MMA(0, 0, At, B0); PG8_MMA(0, 1, At, B1); PG8_BAR; PG8_SCHED;
            PG8_LDA(At, 1, 1); PG8_STAGE(PG8_SB(1, 0), b3, voffB); PG8_STAGE(PG8_SB(1, 1), b3 + hstep, voffB);
            if constexpr (GATHER) PG8_STAGE_G(PG8_SA(1, 0), x00, x01, k3); else PG8_STAGE(PG8_SA(1, 0), a3, voffA);
            PG8_WAIT_V(8); PG8_WAIT_L(0); PG8_BAR; PG8_MMA(1, 0, At, B0); PG8_MMA(1, 1, At, B1); PG8_BAR; PG8_SCHED;
        }
        if constexpr (ES == 1) asm volatile("s_nop 15\n\ts_nop 15" ::: "memory");
        asm volatile("" : "+s"(cur.pm), "+s"(cur.pn), "+s"(cur.pb));
        if (wr == 0) PG8_BAR;
        Unit nn = cur; const bool has_nn = has_next && S.next(ui + 2, nn);
        unsigned tO[2][2] = {{0u, 0u}, {0u, 0u}};
        if constexpr (GATHER) { if (has_nn) { PG8_ROWOFF(tO, nn); } }
        E(acc, cur, wr, wc, fr, fq);
        if (!has_next) break;
#pragma unroll
        for (int a = 0; a < 2; ++a)
#pragma unroll
            for (int b = 0; b < 2; ++b)
#pragma unroll
                for (int m = 0; m < 4; ++m)
#pragma unroll
                    for (int n = 0; n < 2; ++n) acc[a][b][m][n] = (f32x4){0.f, 0.f, 0.f, 0.f};
        if constexpr (GATHER) {
#pragma unroll
            for (int h = 0; h < 2; ++h)
#pragma unroll
                for (int i = 0; i < 2; ++i) { cO[h][i] = nO[h][i]; nO[h][i] = has_nn ? tO[h][i] : nO[h][i]; } }
        cur = nxt; cA = nA; cB = nB; ++ui; nxt = nn; has_next = has_nn;
        if (wr == 1) PG8_BAR;
    }
    PG8_WAIT_V(0);
    PG8_BAR;
#undef PG8_SA
#undef PG8_SB
#undef PG8_STAGE
#undef PG8_STAGE_G
#undef PG8_LDA
#undef PG8_LDB
#undef PG8_MMA
#undef PG8_CAT8
#undef PG8_WAIT_V
#undef PG8_WAIT_L
#undef PG8_BAR
#undef PG8_SCHED
#undef PG8_ROWOFF
}
}

namespace att {
constexpr float SCALE = 0.08838834764831845f;
constexpr int NW = 8, QBLK = 32, KVBLK = 64, QB = NW * QBLK, D = 128;
constexpr int SHM_V = KVBLK * D * 2, SHM_K = KVBLK * D * 2;
constexpr int LDS_BYTES = 2 * SHM_V + 2 * SHM_K + NW * 64 * 4;
constexpr float THR = 8.f;
#define KSWZ(row, colB) ((row) * 256 + ((colB) ^ (((row) & 7) << 4)))
#define SBAR() __builtin_amdgcn_sched_barrier(0)
__device__ __forceinline__ int v_st(int k, int c) { const int kk = (k & ~0xC) | ((k & 4) << 1) | ((k & 8) >> 1); return ((kk >> 3) * 4 + (c >> 5)) * 512 + ((kk & 7) * 32 + (c & 31)) * 2; }
__device__ __forceinline__ int v_rd_base(int lane) { return ((lane & 3) << 3) | (((lane >> 2) & 3) << 6) | (((lane >> 4) & 1) << 5) | (((lane >> 5) & 1) << 8); }
constexpr int v_rd_off(int d0, int ks, int half) { return d0 * 512 + ks * 4096 + half * 2048; }
__device__ __forceinline__ int crow(int r, int hi) { return (r & 3) + 8 * (r >> 2) + 4 * hi; }
__device__ __forceinline__ unsigned cvtpk(float lo, float hi) { return cvt_pk_bf16(lo, hi); }
__device__ __forceinline__ bf16x8 load8(const bf16* p) { return *reinterpret_cast<const bf16x8*>(p); }
__device__ __forceinline__ void mask_tile(f32x16& p0, f32x16& p1, int dq, unsigned W) {
    const float NEG = -__builtin_inff();
#pragma unroll
    for (int r = 0; r < 16; ++r) {
        const int c = (r & 3) + 8 * (r >> 2);
        if ((unsigned)(dq - c) >= W) p0[r] = NEG;
        if ((unsigned)(dq - c - 32) >= W) p1[r] = NEG;
    }
}
__device__ __forceinline__ void partialSM(f32x16& p0, f32x16& p1, float& m_reg, float& mn, float& alpha) {
    float pmax = p0[0]; for (int r = 1; r < 16; ++r) pmax = fmaxf(pmax, p0[r]); for (int r = 0; r < 16; ++r) pmax = fmaxf(pmax, p1[r]);
    { auto rr = __builtin_amdgcn_permlane32_swap(__float_as_uint(pmax), __float_as_uint(pmax), false, false);
      pmax = fmaxf(__uint_as_float(rr[0]), __uint_as_float(rr[1])); }
    constexpr float C2 = 1.4426950408889634f * SCALE;
    if (__builtin_expect(__all((pmax - m_reg) * SCALE <= THR), 1)) { mn = m_reg; alpha = 1.f; }
    else { mn = fmaxf(m_reg, pmax); alpha = __builtin_amdgcn_exp2f((m_reg - mn) * C2); m_reg = mn; }
    const float mnL = -mn * C2;
    for (int r = 0; r < 16; ++r) p0[r] = fmaf(p0[r], C2, mnL); for (int r = 0; r < 16; ++r) p1[r] = fmaf(p1[r], C2, mnL);
    for (int r = 0; r < 16; ++r) p0[r] = __builtin_amdgcn_exp2f(p0[r]);
}
__device__ __forceinline__ void finishSM(f32x16& p0, f32x16& p1, float alpha, float& l_reg, bf16x8& pa0, bf16x8& pa1, bf16x8& pa2, bf16x8& pa3) {
    for (int r = 0; r < 16; ++r) p1[r] = __builtin_amdgcn_exp2f(p1[r]);
    float ps = 0; for (int r = 0; r < 16; ++r) ps += p0[r]; for (int r = 0; r < 16; ++r) ps += p1[r];
    { auto rr = __builtin_amdgcn_permlane32_swap(__float_as_uint(ps), __float_as_uint(ps), false, false);
      ps = __uint_as_float(rr[0]) + __uint_as_float(rr[1]); }
    l_reg = l_reg * alpha + ps;
#define PK4(P, B_, OUT) do { unsigned a0 = cvtpk(P[B_+0], P[B_+1]), a1 = cvtpk(P[B_+2], P[B_+3]);                          \
        unsigned b0 = cvtpk(P[B_+4], P[B_+5]), b1 = cvtpk(P[B_+6], P[B_+7]);                                             \
        auto r0 = __builtin_amdgcn_permlane32_swap(a0, b0, false, false); auto r1 = __builtin_amdgcn_permlane32_swap(a1, b1, false, false); \
        u32x4 w = {r0[0], r1[0], r0[1], r1[1]}; OUT = *reinterpret_cast<bf16x8*>(&w); } while (0)
    PK4(p0, 0, pa0); PK4(p0, 8, pa1); PK4(p1, 0, pa2); PK4(p1, 8, pa3);
#undef PK4
}
template <int KB, bool SK>
__device__ __forceinline__ void qkt(f32x16& p0, f32x16& p1, const char* K_lds, int r32, int hi, const bf16x8* qr, bool act) {
    if (SK && !act) { const float NEG = -__builtin_inff();
#pragma unroll
        for (int r = 0; r < 16; ++r) { p0[r] = NEG; p1[r] = NEG; } return; }
    p0 = f32x16{}; p1 = f32x16{};
    const char* kb[4];
#pragma unroll
    for (int dd = 0; dd < 4; ++dd) kb[dd] = K_lds + KB * SHM_K + KSWZ(r32, (dd * 16 + hi * 8) * 2);
#pragma unroll
    for (int d0 = 0; d0 < 8; ++d0) { const char* a = kb[d0 & 3] + (d0 >> 2) * 128;
        bf16x8 b0 = *reinterpret_cast<const bf16x8*>(a);
        bf16x8 b1 = *reinterpret_cast<const bf16x8*>(a + 32 * 256);
        p0 = __builtin_amdgcn_mfma_f32_32x32x16_bf16(b0, qr[d0], p0, 0, 0, 0);
        p1 = __builtin_amdgcn_mfma_f32_32x32x16_bf16(b1, qr[d0], p1, 0, 0, 0); }
}
template <int VB, bool SK>
__device__ __forceinline__ void pv_tile(f32x16* o, int vb0, bf16x8 pa0, bf16x8 pa1, bf16x8 pa2, bf16x8 pa3, bool act) {
    if (SK && !act) return;
#define TRRD(dst, off) asm volatile("ds_read_b64_tr_b16 %0, %1 offset:%2" : "=&v"(dst) : "v"(vb0), "i"(off) : "memory")
#define PV_D0(d0) do { s16x4 l0, l1, l2, l3, h0, h1, h2, h3; constexpr int b_ = VB * SHM_V + v_rd_off(d0, 0, 0); \
        TRRD(l0, b_); TRRD(h0, b_ + 2048); TRRD(l1, b_ + 4096); TRRD(h1, b_ + 6144); TRRD(l2, b_ + 8192); TRRD(h2, b_ + 10240); TRRD(l3, b_ + 12288); TRRD(h3, b_ + 14336); \
        asm volatile("s_waitcnt lgkmcnt(0)" ::: "memory"); SBAR();   \
        o[d0] = __builtin_amdgcn_mfma_f32_32x32x16_bf16(pa0, (bf16x8){l0[0], l0[1], l0[2], l0[3], h0[0], h0[1], h0[2], h0[3]}, o[d0], 0, 0, 0);   \
        o[d0] = __builtin_amdgcn_mfma_f32_32x32x16_bf16(pa1, (bf16x8){l1[0], l1[1], l1[2], l1[3], h1[0], h1[1], h1[2], h1[3]}, o[d0], 0, 0, 0);   \
        o[d0] = __builtin_amdgcn_mfma_f32_32x32x16_bf16(pa2, (bf16x8){l2[0], l2[1], l2[2], l2[3], h2[0], h2[1], h2[2], h2[3]}, o[d0], 0, 0, 0);   \
        o[d0] = __builtin_amdgcn_mfma_f32_32x32x16_bf16(pa3, (bf16x8){l3[0], l3[1], l3[2], l3[3], h3[0], h3[1], h3[2], h3[3]}, o[d0], 0, 0, 0); } while (0)
    PV_D0(0); PV_D0(1); PV_D0(2); PV_D0(3);
#undef PV_D0
#undef TRRD
}
struct BlockRef { bf16* Q; const bf16* K; float* L; int P0, qs, ks, ls, skv; };
struct Seam { bf16x8 qr[8]; bf16x8 st_v0, st_v1, st_k0, st_k1; };
__device__ __forceinline__ int swa_jlo(int P0, int W) { const int lowk = P0 - W + 1; return lowk > 0 ? lowk / KVBLK : 0; }
#define ROW(p, KS_, k0, rr) ((p) + (size_t)((k0) + (rr)) * (KS_) + sc)
#define VMW() asm volatile("s_waitcnt vmcnt(0)" ::: "memory")
#define VMWN(n) asm volatile("s_waitcnt vmcnt(%0)" :: "i"(n) : "memory")
#define SLOAD_H(Kp, Vp, KS_, k0) do { S.st_v0 = load8(ROW(Vp, KS_, k0, sr)); S.st_v1 = load8(ROW(Vp, KS_, k0, 32 + sr));              \
                         S.st_k0 = load8(ROW(Kp, KS_, k0, sr)); S.st_k1 = load8(ROW(Kp, KS_, k0, 32 + sr)); } while (0)
#define SWRITE_HK(bf) do { *(bf16x8*)(K_lds + (bf) * SHM_K + kws) = S.st_k0; *(bf16x8*)(K_lds + (bf) * SHM_K + kws + 32 * 256) = S.st_k1; } while (0)
#define SWRITE_HV(bf) do { *(bf16x8*)(V_lds + (bf) * SHM_V + vst0) = S.st_v0; *(bf16x8*)(V_lds + (bf) * SHM_V + vst1) = S.st_v1; } while (0)
#define SWRITE_H(bf) do { SWRITE_HV(bf); SWRITE_HK(bf); } while (0)
template <long VOFF>
__device__ __forceinline__ void prime(const BlockRef& cur, int W, char* lds, Seam& S) {
    const int tid = threadIdx.x, wid = __builtin_amdgcn_readfirstlane(tid >> 6), lane = tid & 63, r32 = lane & 31, hi = lane >> 5;
    const int sr = tid >> 4, sc = (tid & 15) * 8, kws = KSWZ(sr, sc * 2); char* K_lds = lds + 2 * SHM_V;
    const int kb0 = swa_jlo(cur.P0, W) * KVBLK;
    for (int d0 = 0; d0 < 8; ++d0) S.qr[d0] = load8(cur.Q + (size_t)(wid * QBLK + r32) * cur.qs + d0 * 16 + hi * 8);
    SLOAD_H(cur.K, cur.K + VOFF, cur.ks, kb0); VMW(); SWRITE_HK(0);
    __syncthreads();
}
template <bool SK, long VOFF>
__device__ __forceinline__ void block(const BlockRef& cur, const BlockRef& nxt, int W, char* lds, Seam& S) {
    const int tid = threadIdx.x, wid = __builtin_amdgcn_readfirstlane(tid >> 6), lane = tid & 63, r32 = lane & 31, hi = lane >> 5;
    const int skv = cur.skv;
    const int j_lo = swa_jlo(cur.P0, W);
    int j_hi = (cur.P0 + QB - 1) / KVBLK + 1; if (j_hi > skv / KVBLK) j_hi = skv / KVBLK;
    const int NT = j_hi - j_lo;
    const int kbn = swa_jlo(nxt.P0, W) * KVBLK;
    const int qlo = cur.P0 + wid * QBLK, qm = qlo + r32 - 4 * hi;
    char* V_lds = lds; char* K_lds = lds + 2 * SHM_V;
    float* ws = (float*)(lds + 2 * SHM_V + 2 * SHM_K) + wid * 64; float* li_l = ws, * al_l = ws + 32;
    float m_reg = -1e30f, l_reg = 0; f32x16 o[4] = {};
    const int sr = tid >> 4, sc = (tid & 15) * 8, vst0 = v_st(sr, sc), vst1 = v_st(32 + sr, sc), kws = KSWZ(sr, sc * 2);
    const int vb0 = (int)(uintptr_t)V_lds + v_rd_base(lane);
    const bf16* Kh = cur.K; const bf16* Vh = cur.K + VOFF; const int KS = cur.ks;
#define RESC(a) do { if (__any((a) < 1.f)) { if (hi == 0) al_l[r32] = (a); asm volatile("s_waitcnt lgkmcnt(0)" ::: "memory");              \
                     for (int d_ = 0; d_ < 4; ++d_) for (int r = 0; r < 16; ++r) o[d_][r] *= al_l[crow(r, hi)]; } } while (0)
#define KBASE(t) ((j_lo + (t)) * KVBLK)
#define ACT(t) (KBASE(t) <= qlo + QBLK - 1 && KBASE(t) + KVBLK - 1 >= qlo - W + 1)
#define MASKT(P0_, P1_, t) do { const int kb_ = KBASE(t); if ((!SK || ACT(t)) && (kb_ + KVBLK - 1 > qlo || kb_ <= qlo + QBLK - 1 - W)) mask_tile(P0_, P1_, qm - kb_, (unsigned)W); } while (0)
    constexpr int NQL = 8;
#define SEAM_K0() do { VMWN(NQL); SWRITE_HK(0); SBAR(); } while (0)
    f32x16 pA0, pA1, pB0, pB1; float mnA, mnB, alA, alB; bf16x8 pa0, pa1, pa2, pa3;
    SWRITE_HV(0); SBAR();
    if (NT > 1) { SLOAD_H(Kh, Vh, KS, KBASE(1)); }
    SBAR(); qkt<0, SK>(pA0, pA1, K_lds, r32, hi, S.qr, ACT(0));
    MASKT(pA0, pA1, 0); partialSM(pA0, pA1, m_reg, mnA, alA);
    if (NT > 1) { VMW(); SWRITE_H(1); }
    __syncthreads();
#define HALF_STEP(PX0, PX1, mnX, alX, PY0, PY1, alY, t, KB, VB, SB) do {                                                      \
        SBAR(); qkt<KB, SK>(PX0, PX1, K_lds, r32, hi, S.qr, ACT(t));                                             \
        finishSM(PY0, PY1, alY, l_reg, pa0, pa1, pa2, pa3); SBAR();                                                           \
        if ((t) + 1 < NT) { SLOAD_H(Kh, Vh, KS, KBASE((t) + 1)); SBAR(); }                                               \
        pv_tile<VB, SK>(o, vb0, pa0, pa1, pa2, pa3, ACT((t) - 1)); MASKT(PX0, PX1, (t)); partialSM(PX0, PX1, m_reg, mnX, alX);                                        \
        __syncthreads();                                                                                                      \
        if ((t) + 1 < NT) { VMW(); SWRITE_H(SB); }                                                                          \
        RESC(alX); __syncthreads(); } while (0)
    for (int t = 1; t + 1 < NT; t += 2) {
        HALF_STEP(pB0, pB1, mnB, alB, pA0, pA1, alA, t, 1, 0, 0);
        HALF_STEP(pA0, pA1, mnA, alA, pB0, pB1, alB, t + 1, 0, 1, 1);
    }
    const bool even = (NT & 1) == 0;
    if (even) { SBAR(); qkt<1, SK>(pB0, pB1, K_lds, r32, hi, S.qr, ACT(NT - 1)); SBAR(); }
    { SLOAD_H(nxt.K, nxt.K + VOFF, nxt.ks, kbn); SBAR();
#pragma unroll
      for (int d0 = 0; d0 < 8; ++d0) S.qr[d0] = load8(nxt.Q + (size_t)(wid * QBLK + r32) * nxt.qs + d0 * 16 + hi * 8); }
    SBAR();
    finishSM(pA0, pA1, alA, l_reg, pa0, pa1, pa2, pa3); SBAR();
    pv_tile<0, SK>(o, vb0, pa0, pa1, pa2, pa3, ACT(even ? NT - 2 : NT - 1));
    if (even) { MASKT(pB0, pB1, NT - 1); partialSM(pB0, pB1, m_reg, mnB, alB); __syncthreads(); RESC(alB);
        finishSM(pB0, pB1, alB, l_reg, pa0, pa1, pa2, pa3); SBAR(); pv_tile<1, SK>(o, vb0, pa0, pa1, pa2, pa3, ACT(NT - 1)); }
    SBAR(); SEAM_K0();
    if (hi == 0) li_l[r32] = l_reg; asm volatile("s_waitcnt lgkmcnt(0)" ::: "memory");
    if (cur.L != nullptr && hi == 0) cur.L[(size_t)(wid * QBLK + r32) * cur.ls] = m_reg * SCALE + __logf(l_reg);
    float rli[16];
#pragma unroll
    for (int r = 0; r < 16; ++r) rli[r] = __builtin_amdgcn_rcpf(li_l[crow(r, hi)]);
    bf16* Op = cur.Q + (size_t)(wid * QBLK + 4 * hi) * cur.qs + r32; const size_t qstep = (size_t)cur.qs;
#pragma unroll
    for (int r = 0; r < 16; ++r) {
        asm volatile("" : "+v"(Op));
#pragma unroll
        for (int d0 = 0; d0 < 4; ++d0) { const float v = o[d0][r] * rli[r];
            const float vn = __shfl_xor(v, 1);
            if ((r32 & 1) == 0) *(unsigned*)(Op + d0 * 32) = cvtpk(v, vn); }
        Op += ((r & 3) == 3) ? 5 * qstep : qstep; }
    __syncthreads();
#undef RESC
#undef KBASE
#undef ACT
#undef MASKT
#undef SEAM_K0
#undef HALF_STEP
}
#undef ROW
#undef VMW
#undef VMWN
#undef SLOAD_H
#undef SWRITE_HK
#undef SWRITE_HV
#undef SWRITE_H
#undef KSWZ
}

constexpr int NWAVES = 8, NTHR = 512;
constexpr int M = 65536, DM = 1024, SEQ = 8192, NBATCH = 8;
constexpr int N1 = 6144;
constexpr int ROPE_POS = 9216;
constexpr float EPS = 1e-5f;
constexpr int NEXP = 32, HALF_TOK = 32768, RT_CAP = 139264;
constexpr int MAXBLK = 544;
constexpr int NPH = 19;
#ifndef MK_REPS
#define MK_REPS 1
#endif
#ifndef MK_PROBE
#define MK_PROBE 0
#define PROBE_A 0
#define PROBE_K 1
#endif
#ifndef MK_DIAG
#define MK_DIAG 0
#endif
#ifndef MK_PER_PHASE
#define MK_PER_PHASE 0
#endif

constexpr size_t MiB = 1u << 20;
constexpr size_t WS_CTL = 0, CTL_ZERO_BYTES = 1 * MiB;
constexpr size_t WS_WIN = 1 * MiB, WS_WGATE = 14 * MiB, WS_WBG = 18 * MiB, WS_WBD = 19 * MiB, WS_WMIX = 20 * MiB, WS_WXQ = 22 * MiB, WS_WXKV = 23 * MiB, WS_WXO = 25 * MiB, WS_WR = 26 * MiB;
constexpr size_t WS_ROPE = 27 * MiB, WS_MEMN = 32 * MiB, WS_KVM = 36 * MiB, WS_DECAY = 40 * MiB;
constexpr size_t WS_TOPE = 41 * MiB, WS_TGATE = 42 * MiB, WS_TSLOT = 43 * MiB, WS_RTOK = 44 * MiB, WS_RGATE = 46 * MiB;
constexpr size_t WS_RRS = 47 * MiB + 512 * 1024, WS_RSTD3 = 48 * MiB + 768 * 1024;
constexpr size_t WS_A = 49 * MiB;
constexpr size_t WS_QG = 177 * MiB, WS_KG = 209 * MiB, WS_VG = 241 * MiB, WS_RG = 305 * MiB, WS_ALR = 369 * MiB, WS_LSE = 373 * MiB;
constexpr size_t WS_QD = 376 * MiB, WS_KD = 568 * MiB, WS_VD = 760 * MiB, WS_A8 = 952 * MiB, WS_WIN8 = 1016 * MiB, WS_END = 1021 * MiB;
constexpr size_t WS_GATES = WS_KD, WS_MERGED = 824 * MiB;
constexpr size_t WS_QX = WS_QD;
constexpr size_t WS_WGU = 177 * MiB, WS_WDN = 241 * MiB, WS_H2F8 = 273 * MiB;
constexpr float W8_SCALE = 64.f, W8_INV = 1.f / 64.f;
constexpr size_t WS_H = 376 * MiB, WS_Y = 648 * MiB;
static_assert(WS_RGATE + 2 * (size_t)RT_CAP * 4 <= WS_RRS && WS_RRS + 2 * (size_t)RT_CAP * 4 <= WS_RSTD3 && WS_RSTD3 + (size_t)M * 4 <= WS_A, "ws map (row tables)");
static_assert(WS_Y + (size_t)RT_CAP * 2048 <= WS_END && WS_H + (size_t)RT_CAP * 2048 <= WS_Y && WS_RTOK + 2 * (size_t)RT_CAP * 4 <= WS_RGATE && WS_RGATE + 2 * (size_t)RT_CAP * 4 <= WS_A, "ws map");
constexpr size_t DO_OGD = 0, DO_ST = 128 * MiB;
constexpr int CW_BAR = 4096, CW_CNT = 8192, CW_CUR = 8320;
constexpr int RING_BYTES = 131072, MISC_OFF = RING_BYTES, TAB_OFF = RING_BYTES + 1024, LDS_BYTES = 147456;

#define XB_TMO      128
#define XB_XCNT(j)  (256  + 64 * (j))
#define XB_XSUB(j)  (1280 + 64 * (j))
#define XB_XGEN(j)  (2304 + 64 * (j))
#define XB_TOP      3328
#define XB_TOPGEN   3392
#define XCD_BAR_WORDS 3456
#define XB_SPIN_CAP (1u << 18)
__device__ __forceinline__ unsigned xb_ld(unsigned* p)              { return __hip_atomic_load(p, __ATOMIC_RELAXED, __HIP_MEMORY_SCOPE_AGENT); }
__device__ __forceinline__ unsigned xb_add(unsigned* p, unsigned v) { return __hip_atomic_fetch_add(p, v, __ATOMIC_RELAXED, __HIP_MEMORY_SCOPE_AGENT); }
__device__ __forceinline__ unsigned xb_xcc_id() { return (unsigned)__builtin_amdgcn_s_getreg((3 << 11) | 20) & 0xFu; }
#define XB_SPIN(cond, bar) do { unsigned _sp = 0; while (cond) { __builtin_amdgcn_s_sleep(1); \
    if ((++_sp & 255u) == 0u) { if (xb_ld(&(bar)[XB_TMO])) break; if (_sp > XB_SPIN_CAP) { atomicAdd(&(bar)[XB_TMO], 1u); break; } } } } while (0)
struct XcdBarrier { unsigned* bar; unsigned x; volatile LAS unsigned* st; };
__device__ __forceinline__ XcdBarrier xcd_barrier_post(unsigned* bar, volatile LAS unsigned* st) {
    XcdBarrier b; b.bar = bar; b.x = xb_xcc_id(); b.st = st;
    if (threadIdx.x == 0) (void)xb_add(&bar[XB_XCNT(b.x)], 1u);
    return b;
}
__device__ __forceinline__ void xcd_barrier_complete(unsigned* bar, unsigned x, unsigned& nloc, unsigned& nx) {
    const unsigned G = gridDim.x * gridDim.y * gridDim.z;
    unsigned sum, cnt, mine, sp = 0u;
    for (;;) {
        sum = 0u; cnt = 0u; mine = 0u;
#pragma unroll
        for (unsigned j = 0; j < 16; ++j) { const unsigned c = xb_ld(&bar[XB_XCNT(j)]); sum += c; cnt += (c > 0u) ? 1u : 0u; mine = (j == x) ? c : mine; }
        if (sum == G) break;
        __builtin_amdgcn_s_sleep(1);
        if ((++sp & 255u) == 0u) { if (xb_ld(&bar[XB_TMO])) break; if (sp > XB_SPIN_CAP) { atomicAdd(&bar[XB_TMO], 1u); break; } }
    }
    nloc = mine > 0u ? mine : 1u; nx = cnt > 0u ? cnt : 1u;
}
__device__ __forceinline__ void xcd_barrier(const XcdBarrier& b) {
    asm volatile("s_waitcnt vmcnt(0)" ::: "memory");
    __syncthreads();
    if (threadIdx.x == 0) {
        unsigned* bar = b.bar;
        __builtin_amdgcn_s_waitcnt(0);
        unsigned nloc = b.st[0], nx = b.st[1];
        if (nloc == 0u) { xcd_barrier_complete(bar, b.x, nloc, nx); b.st[0] = nloc; b.st[1] = nx; }
        const unsigned old = xb_add(&bar[XB_XSUB(b.x)], 1u);
        const unsigned gen = old / nloc;
        if (old + 1u == (gen + 1u) * nloc) {
            __builtin_amdgcn_fence(__ATOMIC_RELEASE, "agent");
            asm volatile("s_waitcnt vmcnt(0)" ::: "memory");
            const unsigned og = xb_add(&bar[XB_TOP], 1u);
            const unsigned tg = og / nx;
            if (og + 1u == (tg + 1u) * nx) xb_add(&bar[XB_TOPGEN], 1u);
            else XB_SPIN(xb_ld(&bar[XB_TOPGEN]) == tg, bar);
            __builtin_amdgcn_fence(__ATOMIC_ACQUIRE, "agent");
            xb_add(&bar[XB_XGEN(b.x)], 1u);
            asm volatile("s_waitcnt vmcnt(0)" ::: "memory");
        } else {
            XB_SPIN(xb_ld(&bar[XB_XGEN(b.x)]) == gen, bar);
            __builtin_amdgcn_fence(__ATOMIC_ACQUIRE, "agent");
            asm volatile("s_waitcnt vmcnt(0)" ::: "memory");
        }
    }
    __syncthreads();
}

struct Frame {
    LAS unsigned char* lds; char* ldsg;
    unsigned* ctl; unsigned char* ws; unsigned char* dout;
    int tid, lane, wave, G, bid;
};
struct Args { const void* in[28]; float* out; unsigned char* ws; int ph_lo, ph_hi; };
#define INP(k) ((const float*)A.in[k])
#define LDS_WAIT() asm volatile("s_waitcnt lgkmcnt(0)" ::: "memory")
__device__ __forceinline__ float wave_sum(float v) {
#pragma unroll
    for (int o = 1; o < 64; o <<= 1) v += __shfl_xor(v, o);
    return v;
}
template <class RM, bool F8 = false>
__device__ __forceinline__ void transpose_item(const float* W, int K, int N, bf16* WT, const RM& rm, LAS float* scr, int item, int lane, const float* kgain = nullptr, int dpitch = 0, int doff = 0, int ncount = 0) {
    const int NC = ncount ? ncount : N;
    const int nblk = (NC + 31) / 32, kb = item / nblk, nb = item % nblk, k0 = 64 * kb, n0 = 32 * nb;
    const int ncol = n0 + (lane & 31);
    float tv[32];
    { const float* wp = W + (size_t)(k0 + (lane >> 5)) * N + (ncol < NC ? ncol : 0);
#pragma unroll
      for (int i = 0; i < 32; ++i) tv[i] = wp[(size_t)(2 * i) * N]; }
#pragma unroll
    for (int i = 0; i < 32; ++i) { const int kk = 2 * i + (lane >> 5); scr[kk * 33 + (lane & 31)] = ncol < NC ? (kgain ? tv[i] * kgain[k0 + kk] : tv[i]) : 0.f; }
    LDS_WAIT(); asm volatile("" ::: "memory");
    const int c = lane & 7;
#pragma unroll
    for (int j = 0; j < 4; ++j) { const int n = (lane >> 3) + 8 * j; const LAS float* s = scr + (8 * c) * 33 + n;
        const int dr = (n0 + n < NC) ? rm(n0 + n) : -1;
        if constexpr (F8) { const f32x4 a = {s[0 * 33] * W8_SCALE, s[1 * 33] * W8_SCALE, s[2 * 33] * W8_SCALE, s[3 * 33] * W8_SCALE}, b = {s[4 * 33] * W8_SCALE, s[5 * 33] * W8_SCALE, s[6 * 33] * W8_SCALE, s[7 * 33] * W8_SCALE};
            if (dr >= 0) *(u32x2*)((unsigned char*)WT + (size_t)dr * (dpitch ? dpitch : K) + doff + k0 + 8 * c) = pack8_fp8(a, b); }
        else { u32x4 o; o.x = cvt_pk_bf16(s[0 * 33], s[1 * 33]); o.y = cvt_pk_bf16(s[2 * 33], s[3 * 33]); o.z = cvt_pk_bf16(s[4 * 33], s[5 * 33]); o.w = cvt_pk_bf16(s[6 * 33], s[7 * 33]);
            if (dr >= 0) *(u32x4*)(WT + (size_t)dr * (dpitch ? dpitch : K) + doff + k0 + 8 * c) = o; } }
    LDS_WAIT(); asm volatile("" ::: "memory");
}
struct RmId { int off; __device__ int operator()(int n) const { return off + n; } };
struct RmWin { __device__ int operator()(int n) const {
    if (n < 1536) return n;
    if (n < 1552) return -1;
    if (n < 4624) { const int j = n - 1552, seg = j / 1536, jj = j % 1536, hd = jj >> 7, i = jj & 127; return 1536 + seg * 1536 + hd * 128 + ((i < 64) ? 2 * i : 2 * (i - 64) + 1); }
    return 4608 + (n - 4624); } };
struct RmWin8 { __device__ int operator()(int j) const { if (j >= 3072) return j; const int seg = j / 1536, jj = j % 1536, hd = jj >> 7, i = jj & 127; return seg * 1536 + hd * 128 + ((i < 64) ? 2 * i : 2 * (i - 64) + 1); } };
struct RmGate { __device__ int operator()(int n) const { return ((n & 1023) >> 7) * 256 + (n >> 10) * 128 + (n & 127); } };
struct RmGU { int base; __device__ int operator()(int n) const { return base + (n >> 7) * 256 + (n & 127); } };

template <int NR>
__device__ __forceinline__ void rms_rows_to_bf16(const float* xrow, const float* g, bf16* orow, int lane, unsigned char* orow8 = nullptr) {
    f32x4 v[NR][4];
#pragma unroll
    for (int r = 0; r < NR; ++r) { const f32x4* xr = (const f32x4*)(xrow + (size_t)r * DM) + lane;
#pragma unroll
        for (int j = 0; j < 4; ++j) v[r][j] = xr[64 * j]; }
    const f32x4* gr = (const f32x4*)g + lane; f32x4 gg[4];
#pragma unroll
    for (int j = 0; j < 4; ++j) gg[j] = gr[64 * j];
#pragma unroll
    for (int r = 0; r < NR; ++r) { float s = 0.f;
#pragma unroll
        for (int j = 0; j < 4; ++j) s += (v[r][j].x * v[r][j].x + v[r][j].y * v[r][j].y) + (v[r][j].z * v[r][j].z + v[r][j].w * v[r][j].w);
        const float rstd = 1.f / sqrtf(wave_sum(s) * (1.f / DM) + EPS);
        u32x2* o8 = (u32x2*)(orow + (size_t)r * DM) + lane;
#pragma unroll
        for (int j = 0; j < 4; ++j) { const float y0 = v[r][j].x * rstd * gg[j].x, y1 = v[r][j].y * rstd * gg[j].y, y2 = v[r][j].z * rstd * gg[j].z, y3 = v[r][j].w * rstd * gg[j].w;
            u32x2 w; w.x = cvt_pk_bf16(y0, y1); w.y = cvt_pk_bf16(y2, y3); o8[64 * j] = w;
            if (orow8) { unsigned q = 0; q = __builtin_amdgcn_cvt_pk_fp8_f32(y0, y1, q, false); q = __builtin_amdgcn_cvt_pk_fp8_f32(y2, y3, q, true); ((unsigned*)(orow8 + (size_t)r * DM))[lane + 64 * j] = q; } } }
}

__device__ __forceinline__ void p0_prologue(Frame& F, const Args& A) {
    LAS float* scr = (LAS float*)(F.lds + F.wave * 8448);
    LAS unsigned char* l_wa = F.lds + 69632;
    const int gw = F.bid * NWAVES + F.wave, NGW = F.G * NWAVES;
    unsigned char* ws = F.ws;
    { const float* win = INP(4);
      for (int i = F.tid; i < 16 * 1024; i += NTHR) { const int k = i >> 4, j = i & 15; *(LAS bf16*)(l_wa + j * 2048 + ((((k >> 3) ^ j) << 4) | ((k & 7) << 1))) = (bf16)f2bf(win[(size_t)k * 6160 + 1536 + j]); } }
    __syncthreads();
    constexpr int I_IN = 16 * 48, I_IN8 = 16 * 144, I_GATE = 16 * 64, I_BG = 8 * 32, I_MIX = 16 * 32, I_XQ = 16 * 16, I_XKV = 16 * 32, I_XO = 8 * 32;
    constexpr int NIT = I_IN + I_IN8 + I_GATE + 2 * I_BG + I_MIX + I_XQ + I_XKV + I_XO;
    for (int it = gw; it < NIT; it += NGW) {
        int r = it;
        if (r < I_IN) { transpose_item(INP(4), 1024, 6160, (bf16*)(ws + WS_WIN), RmId{0}, scr, r, F.lane, nullptr, 0, 0, 1536); continue; } r -= I_IN;
        if (r < I_IN8) { transpose_item<RmWin8, true>(INP(4) + 1552, 1024, 6160, (bf16*)(ws + WS_WIN8), RmWin8{}, scr, r, F.lane, nullptr, 0, 0, 4608); continue; } r -= I_IN8;
        if (r < I_GATE) { transpose_item<RmGate, true>(INP(10), 1024, 2048, (bf16*)(ws + WS_WGATE), RmGate{}, scr, r, F.lane); continue; } r -= I_GATE;
        if (r < I_BG) { transpose_item(INP(8), 512, 1024, (bf16*)(ws + WS_WBG), RmId{0}, scr, r, F.lane, nullptr, 1024, 0); continue; } r -= I_BG;
        if (r < I_BG) { transpose_item(INP(9), 512, 1024, (bf16*)(ws + WS_WBG), RmId{0}, scr, r, F.lane, nullptr, 1024, 512); continue; } r -= I_BG;
        if (r < I_MIX) { transpose_item(INP(12), 1024, 1024, (bf16*)(ws + WS_WMIX), RmId{0}, scr, r, F.lane); continue; } r -= I_MIX;
        if (r < I_XQ) { transpose_item<RmId, true>(INP(15), 1024, 512, (bf16*)(ws + WS_WXQ), RmId{0}, scr, r, F.lane, INP(13)); continue; } r -= I_XQ;
        if (r < I_XKV) { transpose_item(INP(16), 1024, 1024, (bf16*)(ws + WS_WXKV), RmId{0}, scr, r, F.lane); continue; } r -= I_XKV;
        transpose_item(INP(17), 512, 1024, (bf16*)(ws + WS_WXO), RmId{0}, scr, r, F.lane);
    }
    const int gt = F.bid * NTHR + F.tid, NGT = F.G * NTHR;
    { bf16* wr = (bf16*)(ws + WS_WR); const float* w = INP(19); const float* g3 = INP(18);
      for (int i = gt; i < NEXP * 1024; i += NGT) { const int e = i >> 10, k = i & 1023; wr[i] = (bf16)f2bf(g3[k] * w[k * NEXP + e]); } }
    { float* tab = (float*)(ws + WS_ROPE);
      for (int i = gt; i < ROPE_POS * 64; i += NGT) { const int pos = i >> 6, fi = i & 63;
          const float inv = (float)exp2(-(double)fi * (13.287712379549449 / 64.0));
          const float ang = (float)pos * inv;
          const double xr = (double)ang * 0.15915494309189535, fr_ = xr - rint(xr);
          const float xf = (float)fr_;
          tab[2 * i] = __builtin_amdgcn_cosf(xf); tab[2 * i + 1] = __builtin_amdgcn_sinf(xf); } }
    for (int m = gw; m < NBATCH * 256; m += NGW) rms_rows_to_bf16<1>(INP(1) + (size_t)m * DM, INP(14), (bf16*)(ws + WS_MEMN) + (size_t)m * DM, F.lane);
    { const int fr = F.lane & 15, fq = F.lane >> 4; float* alr = (float*)(ws + WS_ALR);
      for (int gidx = gw; gidx < M / 16; gidx += NGW) { const size_t row0 = (size_t)gidx * 16; bf16* arow = (bf16*)(ws + WS_A) + row0 * DM;
#pragma unroll
          for (int q = 0; q < 4; ++q) rms_rows_to_bf16<4>(INP(0) + (row0 + 4 * q) * DM, INP(3), arow + (size_t)(4 * q) * DM, F.lane, ws + WS_A8 + (row0 + 4 * q) * DM);
          asm volatile("s_waitcnt vmcnt(0)" ::: "memory");
          f32x4 c = {0.f, 0.f, 0.f, 0.f}; const bf16* ap = arow + (size_t)fr * DM + 8 * fq;
#pragma unroll 8
          for (int kk = 0; kk < 32; ++kk) { const bf16x8 af = *(const bf16x8*)(ap + 32 * kk); const int ch = 4 * kk + fq;
              const bf16x8 bfr = *(const LAS bf16x8*)(l_wa + fr * 2048 + ((ch ^ fr) << 4)); c = __builtin_amdgcn_mfma_f32_16x16x32_bf16(af, bfr, c, 0, 0, 0); }
#pragma unroll
          for (int r = 0; r < 4; ++r) alr[(row0 + 4 * fq + r) * 16 + fr] = c[r]; } }
}

#define EPI_ROWS(ai, m) (u.pm * 256 + wr * 64 + fr + (ai) * 128 + (m) * 16)
__device__ __forceinline__ u32x4 pack8f(const f32x4& a, const f32x4& b) { u32x4 w; w.x = cvt_pk_bf16(a[0], a[1]); w.y = cvt_pk_bf16(a[2], a[3]); w.z = cvt_pk_bf16(b[0], b[1]); w.w = cvt_pk_bf16(b[2], b[3]); return w; }
__device__ __forceinline__ void unpack8f(const u32x4& w, f32x4& a, f32x4& b) { a = (f32x4){bflo(w.x), bfhi(w.x), bflo(w.y), bfhi(w.y)}; b = (f32x4){bflo(w.z), bfhi(w.z), bflo(w.w), bfhi(w.w)}; }

struct EpiProj {
    static constexpr bool PERM = true, HAS_MID = false;
    unsigned char* ws; const int* pos; float asc;
    __device__ __forceinline__ void operator()(const f32x4 (&acc)[2][2][4][2], const pg8::Unit& u, int wr, int wc, int fr, int fq) const {
        const int pn = u.pn, cw = wc * 32 + 8 * fq;
        bf16* base; int ldc, coff; float sc = 1.f; bool rope = false;
        if (pn == 0) { base = (bf16*)(ws + WS_QG); ldc = 256; coff = 0; sc = 0.125f; }
        else if (pn == 1) { base = (bf16*)(ws + WS_KG); ldc = 256; coff = 0; }
        else if (pn < 4) { base = (bf16*)(ws + WS_VG); ldc = 512; coff = (pn - 2) * 256; }
        else if (pn < 6) { base = (bf16*)(ws + WS_RG); ldc = 512; coff = (pn - 4) * 256; }
        else if (pn < 12) { base = (bf16*)(ws + WS_QD); ldc = 1536; coff = (pn - 6) * 256; rope = true; }
        else if (pn < 18) { base = (bf16*)(ws + WS_KD); ldc = 1536; coff = (pn - 12) * 256; rope = true; }
        else { base = (bf16*)(ws + WS_VD); ldc = 1536; coff = (pn - 18) * 256; }
        sc *= asc;
        const float* tab = (const float*)(ws + WS_ROPE);
        if (rope) {
#pragma unroll
            for (int ai = 0; ai < 2; ++ai) { int pp[4]; f32x4 cs[4][2];
#pragma unroll
                for (int m = 0; m < 4; ++m) pp[m] = pos[EPI_ROWS(ai, m)];
#pragma unroll
                for (int m = 0; m < 4; ++m) { int p = pp[m]; p = p < 0 ? 0 : (p >= ROPE_POS ? ROPE_POS - 1 : p); const float* tp = tab + ((size_t)p * 64 + 16 * wc + 4 * fq) * 2; cs[m][0] = *(const f32x4*)tp; cs[m][1] = *(const f32x4*)(tp + 4); }
#pragma unroll
                for (int m = 0; m < 4; ++m) { bf16* rowp = base + (size_t)EPI_ROWS(ai, m) * ldc + coff + cw; const f32x4 cs0 = cs[m][0], cs1 = cs[m][1];
#pragma unroll
                    for (int bj = 0; bj < 2; ++bj) { f32x4 v0 = acc[ai][bj][m][0] * asc, v1 = acc[ai][bj][m][1] * asc;
                        v0 = (f32x4){v0[0] * cs0[0] - v0[1] * cs0[1], v0[1] * cs0[0] + v0[0] * cs0[1], v0[2] * cs0[2] - v0[3] * cs0[3], v0[3] * cs0[2] + v0[2] * cs0[3]};
                        v1 = (f32x4){v1[0] * cs1[0] - v1[1] * cs1[1], v1[1] * cs1[0] + v1[0] * cs1[1], v1[2] * cs1[2] - v1[3] * cs1[3], v1[3] * cs1[2] + v1[2] * cs1[3]};
                        *(u32x4*)(rowp + bj * 128) = pack8f(v0, v1); } }
                asm volatile("" ::: "memory"); }
            return;
        }
#pragma unroll
        for (int ai = 0; ai < 2; ++ai)
#pragma unroll
            for (int m = 0; m < 4; ++m) { bf16* rowp = base + (size_t)EPI_ROWS(ai, m) * ldc + coff + cw;
#pragma unroll
                for (int bj = 0; bj < 2; ++bj) *(u32x4*)(rowp + bj * 128) = pack8f(acc[ai][bj][m][0] * sc, acc[ai][bj][m][1] * sc); }
    }
};
template <int ACT  > struct EpiBf16 {
    static constexpr bool PERM = true, HAS_MID = false;
    bf16* O; int ldc; const float* bias; float scale;
    __device__ __forceinline__ void operator()(const f32x4 (&acc)[2][2][4][2], const pg8::Unit& u, int wr, int wc, int fr, int fq) const {
        const int col0 = u.pn * 256 + wc * 32 + 8 * fq;
        f32x4 bv[2][2];
#pragma unroll
        for (int bj = 0; bj < 2; ++bj)
#pragma unroll
            for (int n = 0; n < 2; ++n) bv[bj][n] = bias ? *(const f32x4*)(bias + col0 + bj * 128 + 4 * n) : (f32x4){0.f, 0.f, 0.f, 0.f};
#pragma unroll
        for (int ai = 0; ai < 2; ++ai)
#pragma unroll
            for (int m = 0; m < 4; ++m) { bf16* rowp = O + (size_t)EPI_ROWS(ai, m) * ldc + col0;
#pragma unroll
                for (int bj = 0; bj < 2; ++bj) { f32x4 v0 = acc[ai][bj][m][0] * scale + bv[bj][0], v1 = acc[ai][bj][m][1] * scale + bv[bj][1];
                    if (ACT == 1) {
#pragma unroll
                        for (int j = 0; j < 4; ++j) { v0[j] = __builtin_amdgcn_rcpf(1.f + __expf(-v0[j])); v1[j] = __builtin_amdgcn_rcpf(1.f + __expf(-v1[j])); } }
                    *(u32x4*)(rowp + bj * 128) = pack8f(v0, v1); } }
    }
};
struct EpiGates {
    static constexpr bool PERM = true, HAS_MID = false;
    bf16* O; const float* bias; float scale;
    __device__ __forceinline__ void operator()(const f32x4 (&acc)[2][2][4][2], const pg8::Unit& u, int wr, int wc, int fr, int fq) const {
        const int c0 = u.pn * 128 + wc * 32 + 8 * fq;
        f32x4 bv[2][2];
#pragma unroll
        for (int bj = 0; bj < 2; ++bj)
#pragma unroll
            for (int n = 0; n < 2; ++n) bv[bj][n] = *(const f32x4*)(bias + bj * 1024 + c0 + 4 * n);
#pragma unroll
        for (int ai = 0; ai < 2; ++ai)
#pragma unroll
            for (int m = 0; m < 4; ++m) { bf16* rowp = O + (size_t)EPI_ROWS(ai, m) * 2048 + c0; f32x4 rt[2], gd[2];
#pragma unroll
                for (int n = 0; n < 2; ++n)
#pragma unroll
                    for (int h = 0; h < 2; ++h) {
                        const f32x2 y1 = (f32x2){acc[ai][0][m][n][2 * h], acc[ai][0][m][n][2 * h + 1]} * scale + (f32x2){bv[0][n][2 * h], bv[0][n][2 * h + 1]}, y2 = (f32x2){acc[ai][1][m][n][2 * h], acc[ai][1][m][n][2 * h + 1]} * scale + (f32x2){bv[1][n][2 * h], bv[1][n][2 * h + 1]};
                        const f32x2 z1 = {fminf(fmaxf(y1.x, -30.f), 30.f), fminf(fmaxf(y1.y, -30.f), 30.f)}, z2 = {fminf(fmaxf(y2.x, -30.f), 30.f), fminf(fmaxf(y2.y, -30.f), 30.f)};
                        const f32x2 t1 = z1 * -1.4426950408889634f, t2 = z2 * -1.4426950408889634f;
                        const f32x2 d1 = (f32x2){__builtin_amdgcn_exp2f(t1.x), __builtin_amdgcn_exp2f(t1.y)} + 1.f, d2 = (f32x2){__builtin_amdgcn_exp2f(t2.x), __builtin_amdgcn_exp2f(t2.y)} + 1.f;
                        const f32x2 dd = d1 * d2, q = {__builtin_amdgcn_rcpf(dd.x), __builtin_amdgcn_rcpf(dd.y)};
                        const f32x2 g2 = q * d1, r = (d2 * d2) * q;
                        rt[n][2 * h] = r.x; rt[n][2 * h + 1] = r.y; gd[n][2 * h] = g2.x; gd[n][2 * h + 1] = g2.y; }
                *(u32x4*)rowp = pack8f(rt[0], rt[1]); *(u32x4*)(rowp + 1024) = pack8f(gd[0], gd[1]); }
    }
};
struct EpiBranchFused {
    static constexpr bool PERM = true, HAS_MID = true;
    bf16* mg; const bf16* gates;
    __device__ __forceinline__ void mid(f32x4 (&acc)[2][2][4][2], const pg8::Unit& u, int wr, int wc, int fr, int fq) const {
        const int col0 = u.pn * 256 + wc * 32 + 8 * fq;
#pragma unroll
        for (int ai = 0; ai < 2; ++ai) { u32x4 rt[4][2];
#pragma unroll
            for (int m = 0; m < 4; ++m) { const size_t row = EPI_ROWS(ai, m);
#pragma unroll
                for (int bj = 0; bj < 2; ++bj) rt[m][bj] = *(const u32x4*)(gates + row * 2048 + col0 + bj * 128); }
#pragma unroll
            for (int m = 0; m < 4; ++m)
#pragma unroll
                for (int bj = 0; bj < 2; ++bj) { f32x4 a0, a1; unpack8f(rt[m][bj], a0, a1); acc[ai][bj][m][0] *= a0; acc[ai][bj][m][1] *= a1; }
            asm volatile("" ::: "memory"); }
    }
    __device__ __forceinline__ void operator()(const f32x4 (&acc)[2][2][4][2], const pg8::Unit& u, int wr, int wc, int fr, int fq) const {
        const int col0 = u.pn * 256 + wc * 32 + 8 * fq;
#pragma unroll
        for (int ai = 0; ai < 2; ++ai) { u32x4 g2[4][2];
#pragma unroll
            for (int m = 0; m < 4; ++m) { const size_t row = EPI_ROWS(ai, m);
#pragma unroll
                for (int bj = 0; bj < 2; ++bj) g2[m][bj] = *(const u32x4*)(gates + row * 2048 + 1024 + col0 + bj * 128); }
#pragma unroll
            for (int m = 0; m < 4; ++m) { const size_t row = EPI_ROWS(ai, m);
#pragma unroll
                for (int bj = 0; bj < 2; ++bj) { f32x4 b0, b1; unpack8f(g2[m][bj], b0, b1); *(u32x4*)(mg + row * 1024 + col0 + bj * 128) = pack8f(acc[ai][bj][m][0] * b0, acc[ai][bj][m][1] * b1); } }
            asm volatile("" ::: "memory"); }
    }
};
struct EpiResBf16 {
    static constexpr bool PERM = true, HAS_MID = false;
    const float* resf; const bf16* resb; bf16* out; unsigned char* out8;
    __device__ __forceinline__ void operator()(const f32x4 (&acc)[2][2][4][2], const pg8::Unit& u, int wr, int wc, int fr, int fq) const {
        const int col0 = u.pn * 256 + wc * 32 + 8 * fq;
        if (!resf) {
            u32x4 w[2][4][2];
#pragma unroll
            for (int ai = 0; ai < 2; ++ai)
#pragma unroll
                for (int m = 0; m < 4; ++m) { const size_t off = (size_t)EPI_ROWS(ai, m) * DM + col0;
#pragma unroll
                    for (int bj = 0; bj < 2; ++bj) w[ai][m][bj] = *(const u32x4*)(resb + off + bj * 128); }
#pragma unroll
            for (int ai = 0; ai < 2; ++ai)
#pragma unroll
                for (int m = 0; m < 4; ++m) { const size_t off = (size_t)EPI_ROWS(ai, m) * DM + col0;
#pragma unroll
                    for (int bj = 0; bj < 2; ++bj) { f32x4 r0, r1; unpack8f(w[ai][m][bj], r0, r1); const f32x4 v0 = r0 + acc[ai][bj][m][0], v1 = r1 + acc[ai][bj][m][1]; *(u32x4*)(out + off + bj * 128) = pack8f(v0, v1);
                        if (out8) *(u32x2*)(out8 + off + bj * 128) = pack8_fp8(v0, v1); } }
            return;
        }
#pragma unroll
        for (int ai = 0; ai < 2; ++ai) { f32x4 rv[4][2][2];
#pragma unroll
            for (int m = 0; m < 4; ++m) { const size_t off = (size_t)EPI_ROWS(ai, m) * DM + col0;
#pragma unroll
                for (int bj = 0; bj < 2; ++bj) {
                    if (resf) { rv[m][bj][0] = *(const f32x4*)(resf + off + bj * 128); rv[m][bj][1] = *(const f32x4*)(resf + off + bj * 128 + 4); }
                    else { const u32x4 w = *(const u32x4*)(resb + off + bj * 128); unpack8f(w, rv[m][bj][0], rv[m][bj][1]); } } }
#pragma unroll
            for (int m = 0; m < 4; ++m) { const size_t off = (size_t)EPI_ROWS(ai, m) * DM + col0;
#pragma unroll
                for (int bj = 0; bj < 2; ++bj) { const f32x4 v0 = rv[m][bj][0] + acc[ai][bj][m][0], v1 = rv[m][bj][1] + acc[ai][bj][m][1]; *(u32x4*)(out + off + bj * 128) = pack8f(v0, v1);
                    if (out8) *(u32x2*)(out8 + off + bj * 128) = pack8_fp8(v0, v1); } }
            asm volatile("" ::: "memory"); }
    }
};
struct EpiRowScaleBf16 {
    static constexpr bool PERM = true, HAS_MID = false;
    bf16* O; int ldc; const LAS float* rs;
    __device__ __forceinline__ void operator()(const f32x4 (&acc)[2][2][4][2], const pg8::Unit& u, int wr, int wc, int fr, int fq) const {
        const int col0 = u.pn * 256 + wc * 32 + 8 * fq;
#pragma unroll
        for (int ai = 0; ai < 2; ++ai)
#pragma unroll
            for (int m = 0; m < 4; ++m) { const float r = rs[u.ord * 256 + wr * 64 + fr + ai * 128 + m * 16]; bf16* rowp = O + (size_t)EPI_ROWS(ai, m) * ldc + col0;
#pragma unroll
                for (int bj = 0; bj < 2; ++bj) *(u32x4*)(rowp + bj * 128) = pack8f(acc[ai][bj][m][0] * r, acc[ai][bj][m][1] * r); }
    }
};
__device__ __forceinline__ f32x2 swiglu2(const f32x2 a, const f32x2 b) {
    const f32x2 gl = {fminf(a.x, 7.f), fminf(a.y, 7.f)}, ln = {fminf(fmaxf(b.x, -7.f), 7.f), fminf(fmaxf(b.y, -7.f), 7.f)};
    const f32x2 t = gl * (-1.702f * 1.4426950408889634f);
    const f32x2 d = (f32x2){__builtin_amdgcn_exp2f(t.x), __builtin_amdgcn_exp2f(t.y)} + 1.f;
    const f32x2 r = {__builtin_amdgcn_rcpf(d.x), __builtin_amdgcn_rcpf(d.y)};
    return (gl * r) * (ln + 1.f);
}
struct EpiSwiglu {
    static constexpr bool PERM = true, HAS_MID = false;
    unsigned char* H; const float* bg; const float* bu; int nN; const float* rs;
    __device__ __forceinline__ void operator()(const f32x4 (&acc)[2][2][4][2], const pg8::Unit& u, int wr, int wc, int fr, int fq) const {
        const int e = u.pb / nN, c0 = u.pn * 128 + wc * 32 + 8 * fq;
        const f32x4 g0 = *(const f32x4*)(bg + e * 1024 + c0), g1 = *(const f32x4*)(bg + e * 1024 + c0 + 4), u0 = *(const f32x4*)(bu + e * 1024 + c0), u1 = *(const f32x4*)(bu + e * 1024 + c0 + 4);
        float rr[2][4];
#pragma unroll
        for (int ai = 0; ai < 2; ++ai)
#pragma unroll
            for (int m = 0; m < 4; ++m) rr[ai][m] = rs[EPI_ROWS(ai, m)];
#pragma unroll
        for (int ai = 0; ai < 2; ++ai)
#pragma unroll
            for (int m = 0; m < 4; ++m) { const float rq = rr[ai][m] * W8_INV; const f32x4 a0 = acc[ai][0][m][0] * rq + g0, a1 = acc[ai][0][m][1] * rq + g1, b0 = acc[ai][1][m][0] * rq + u0, b1 = acc[ai][1][m][1] * rq + u1;
                const f32x2 p0 = swiglu2((f32x2){a0[0], a0[1]}, (f32x2){b0[0], b0[1]}), p1 = swiglu2((f32x2){a0[2], a0[3]}, (f32x2){b0[2], b0[3]}), p2 = swiglu2((f32x2){a1[0], a1[1]}, (f32x2){b1[0], b1[1]}), p3 = swiglu2((f32x2){a1[2], a1[3]}, (f32x2){b1[2], b1[3]});
                const f32x4 r0 = {p0.x, p0.y, p1.x, p1.y}, r1 = {p2.x, p2.y, p3.x, p3.y};
                *(u32x2*)(H + (size_t)EPI_ROWS(ai, m) * 1024 + c0) = pack8_fp8(r0, r1); }
    }
};
struct EpiDown {
    static constexpr bool PERM = true, HAS_MID = false;
    bf16* Y; const float* bd; const float* rgate; int nN;
    __device__ __forceinline__ void operator()(const f32x4 (&acc)[2][2][4][2], const pg8::Unit& u, int wr, int wc, int fr, int fq) const {
        const int e = u.pb / nN, col0 = u.pn * 256 + wc * 32 + 8 * fq;
        f32x4 bv[2][2];
#pragma unroll
        for (int bj = 0; bj < 2; ++bj)
#pragma unroll
            for (int n = 0; n < 2; ++n) bv[bj][n] = *(const f32x4*)(bd + e * 1024 + col0 + bj * 128 + 4 * n);
        float gt[2][4];
#pragma unroll
        for (int ai = 0; ai < 2; ++ai)
#pragma unroll
            for (int m = 0; m < 4; ++m) gt[ai][m] = rgate[EPI_ROWS(ai, m)];
#pragma unroll
        for (int ai = 0; ai < 2; ++ai)
#pragma unroll
            for (int m = 0; m < 4; ++m) { const int row = EPI_ROWS(ai, m);
#pragma unroll
                for (int bj = 0; bj < 2; ++bj) *(u32x4*)(Y + (size_t)row * 1024 + col0 + bj * 128) = pack8f((acc[ai][bj][m][0] * W8_INV + bv[bj][0]) * gt[ai][m], (acc[ai][bj][m][1] * W8_INV + bv[bj][1]) * gt[ai][m]); }
    }
};

__device__ __forceinline__ bf16x8 frag_n(const LAS unsigned char* base, int pitch, int r0, int k0, int lane) {
    return *(const LAS bf16x8*)(base + (r0 + (lane & 15)) * pitch + (k0 + 8 * (lane >> 4)) * 2);
}
__device__ __forceinline__ bf16x8 frag_t(const LAS unsigned char* base, int pitch, int k0, int n0, int lane) {
    const int i = lane & 15, gq = lane >> 4, q = i >> 2, p = i & 3;
    const unsigned a0 = (unsigned)(uintptr_t)(base + (k0 + 8 * gq + q) * pitch + (n0 + 4 * p) * 2), a1 = a0 + 4u * (unsigned)pitch;
    s16x4 lo, hi;
    asm volatile("ds_read_b64_tr_b16 %0, %2\n\tds_read_b64_tr_b16 %1, %3\n\ts_waitcnt lgkmcnt(0)" : "=&v"(lo), "=&v"(hi) : "v"(a0), "v"(a1) : "memory");
    return (bf16x8){lo[0], lo[1], lo[2], lo[3], hi[0], hi[1], hi[2], hi[3]};
}
#define MFMA16(a, b, c) __builtin_amdgcn_mfma_f32_16x16x32_bf16(a, b, c, 0, 0, 0)

__device__ __forceinline__ float log_sigmoid_fast(float z) { return fminf(z, 0.f) - __logf(1.f + __expf(-fabsf(z))); }
__device__ __forceinline__ void gla_a_phase(Frame& F, const Args& A) {
    unsigned char* ws = F.ws;
    LAS unsigned char* L = F.lds;
    LAS float* l_alr = (LAS float*)L;
    constexpr int PK = 272, PV = 528;
    LAS unsigned char* l_kd = L + 4096;
    LAS unsigned char* l_v = L + 4096 + 64 * PK;
    LAS float* l_tot = (LAS float*)(L + 4096 + 64 * PK + 64 * PV);
    const int tid = F.tid, lane = F.lane, wid = F.wave;
    const int col = tid & 127, qt = tid >> 7;
    float pf_alr[2]; u32x4 pf_v[4], pf_k[2];
#define GLA_A_PREFETCH(it_) do { const int b_ = (it_) >> 8, c_ = ((it_) >> 1) & 127, hp_ = (it_) & 1; const size_t tk0 = (size_t)b_ * SEQ + (size_t)c_ * 64; \
        const float* alr_ = (const float*)(ws + WS_ALR) + tk0 * 16; pf_alr[0] = alr_[tid]; pf_alr[1] = alr_[tid + 512]; \
        const bf16* vg_ = (const bf16*)(ws + WS_VG) + tk0 * 512 + hp_ * 256; const bf16* kg_ = (const bf16*)(ws + WS_KG) + tk0 * 256 + hp_ * 128; \
        _Pragma("unroll") for (int q_ = 0; q_ < 4; ++q_) { const int i_ = tid + q_ * 512; pf_v[q_] = *(const u32x4*)(vg_ + (size_t)(i_ >> 5) * 512 + (i_ & 31) * 8); } \
        _Pragma("unroll") for (int q_ = 0; q_ < 2; ++q_) { const int i_ = tid + q_ * 512; pf_k[q_] = *(const u32x4*)(kg_ + (size_t)(i_ >> 4) * 256 + (i_ & 15) * 8); } } while (0)
    int it = F.bid; if (it >= NBATCH * 256) return;
    GLA_A_PREFETCH(it);
    int hp_loaded = -1; float w2c[16]; float b2 = 0.f;
#pragma unroll
    for (int j = 0; j < 16; ++j) w2c[j] = 0.f;
    for (; it < NBATCH * 256; it += F.G) {
        const int b = it >> 8, c = (it >> 1) & 127, hp = it & 1;
        l_alr[tid] = pf_alr[0]; l_alr[tid + 512] = pf_alr[1];
#pragma unroll
        for (int q = 0; q < 4; ++q) { const int i = tid + q * 512; *(LAS u32x4*)(l_v + (i >> 5) * PV + (i & 31) * 16) = pf_v[q]; }
#pragma unroll
        for (int q = 0; q < 2; ++q) { const int i = tid + q * 512; *(LAS u32x4*)(l_kd + (i >> 4) * PK + (i & 15) * 16) = pf_k[q]; }
        __syncthreads();
        if (it + F.G < NBATCH * 256) GLA_A_PREFETCH(it + F.G);
        {   const int gc = hp * 128 + col;
            if (hp != hp_loaded) { hp_loaded = hp; b2 = INP(6)[gc];
#pragma unroll
                for (int jj = 0; jj < 16; ++jj) w2c[jj] = INP(5)[jj * 256 + gc]; }
            float bc[16]; float run = 0.f;
#pragma unroll
            for (int i = 0; i < 16; ++i) { const int t = qt * 16 + i; float z = b2;
#pragma unroll
                for (int jj = 0; jj < 16; ++jj) z = fmaf(l_alr[t * 16 + jj], w2c[jj], z);
                run += log_sigmoid_fast(z) * (1.f / 16.f); bc[i] = run; }
            l_tot[qt * 128 + col] = run;
            __syncthreads();
            const float q0 = l_tot[col], q1 = l_tot[128 + col], q2 = l_tot[256 + col], q3 = l_tot[384 + col];
            const float blast = (q0 + q1) + (q2 + q3), pre = (qt > 0 ? q0 : 0.f) + (qt > 1 ? q1 : 0.f) + (qt > 2 ? q2 : 0.f);
#pragma unroll
            for (int i = 0; i < 16; ++i) { const int t = qt * 16 + i; LAS bf16* kp = (LAS bf16*)(l_kd + t * PK + col * 2);
                *kp = (bf16)f2bf(bf2f(*kp) * __expf(blast - (pre + bc[i]))); }
            if (qt == 0) ((float*)(ws + WS_DECAY))[((size_t)(b * 4 + hp * 2 + (col >> 6)) * 128 + c) * 64 + (col & 63)] = __expf(blast);
        }
        __syncthreads();
        const int hh = wid >> 2, j = wid & 3;
        f32x4 acc[4][2];
#pragma unroll
        for (int mt = 0; mt < 4; ++mt)
#pragma unroll
            for (int nt = 0; nt < 2; ++nt) acc[mt][nt] = (f32x4){0.f, 0.f, 0.f, 0.f};
#pragma unroll
        for (int ks = 0; ks < 2; ++ks) { bf16x8 a[4], bb[2];
#pragma unroll
            for (int mt = 0; mt < 4; ++mt) a[mt] = frag_t(l_kd, PK, 32 * ks, hh * 64 + 16 * mt, lane);
#pragma unroll
            for (int nt = 0; nt < 2; ++nt) bb[nt] = frag_t(l_v, PV, 32 * ks, hh * 128 + 32 * j + 16 * nt, lane);
            __builtin_amdgcn_sched_barrier(0);
#pragma unroll
            for (int mt = 0; mt < 4; ++mt)
#pragma unroll
                for (int nt = 0; nt < 2; ++nt) acc[mt][nt] = MFMA16(a[mt], bb[nt], acc[mt][nt]); }
        __syncthreads();
        { LAS unsigned char* l_st = l_kd + hh * (64 * 272) + (4 * (lane >> 4)) * 272 + (32 * j + (lane & 15)) * 2;
#pragma unroll
          for (int mt = 0; mt < 4; ++mt)
#pragma unroll
              for (int nt = 0; nt < 2; ++nt)
#pragma unroll
                  for (int r = 0; r < 4; ++r) *(LAS bf16*)(l_st + (16 * mt + r) * 272 + 32 * nt) = (bf16)f2bf(acc[mt][nt][r]); }
        __syncthreads();
        { bf16* st = (bf16*)(F.dout + DO_ST) + ((size_t)(b * 4 + hp * 2) * 128 + c) * 8192;
#pragma unroll
          for (int q = 0; q < 4; ++q) { const int i = tid + q * 512, h2 = i >> 10, dk = (i >> 4) & 63, c16 = i & 15;
              const u32x4 w = *(const LAS u32x4*)(l_kd + h2 * (64 * 272) + dk * 272 + c16 * 16);
              *(u32x4*)(st + (size_t)h2 * 128 * 8192 + dk * 128 + c16 * 8) = w; } }
        __syncthreads();
    }
#undef GLA_A_PREFETCH
}

__device__ __forceinline__ void gla_scan(Frame& F) {
    unsigned* st = (unsigned*)(F.dout + DO_ST); const float* dec = (const float*)(F.ws + WS_DECAY);
    for (int idx = F.bid * NTHR + F.tid; idx < 32 * 4096; idx += F.G * NTHR) {
        const int bh = idx >> 12, e2 = idx & 4095, dk = e2 >> 6;
        unsigned* p = st + (size_t)bh * 128 * 4096 + e2; const float* dp = dec + (size_t)bh * 128 * 64 + dk;
        float s0 = 0.f, s1 = 0.f;
#pragma unroll 32
        for (int c = 0; c < 128; ++c) { const unsigned kv = p[(size_t)c * 4096]; const float d = dp[c * 64];
            p[(size_t)c * 4096] = cvt_pk_bf16(s0, s1);
            s0 = fmaf(d, s0, bflo(kv)); s1 = fmaf(d, s1, bfhi(kv)); }
    }
}

__device__ __forceinline__ void gla_c_phase(Frame& F, const Args& A) {
    unsigned char* ws = F.ws;
    LAS unsigned char* L = F.lds;
    LAS float* l_alr = (LAS float*)L;
    constexpr int PQ = 272, PV = 528, PP = 144;
    LAS unsigned char* l_qh = L + 4096;
    LAS unsigned char* l_kt = L + 21504;
    LAS unsigned char* l_v = L + 38912;
    LAS unsigned char* l_s = L + 72704;
    LAS unsigned char* l_p = L + 107520;
    LAS float* l_tot = (LAS float*)(L + 125952);
    LAS float* l_ss = (LAS float*)(L + 128000);
    const int tid = F.tid, lane = F.lane, wid = F.wave;
    const int col = tid & 127, qt = tid >> 7;
    float pf_alr[2]; u32x4 pf_v[4], pf_s[4], pf_q[2], pf_k[2], pf_r[4];
#define GLA_C_PREFETCH(it_) do { const int b_ = (it_) >> 8, c_ = ((it_) >> 1) & 127, hp_ = (it_) & 1; const size_t tk0 = (size_t)b_ * SEQ + (size_t)c_ * 64; \
        const float* alr_ = (const float*)(ws + WS_ALR) + tk0 * 16; pf_alr[0] = alr_[tid]; pf_alr[1] = alr_[tid + 512]; \
        const bf16* vg_ = (const bf16*)(ws + WS_VG) + tk0 * 512 + hp_ * 256; const bf16* rg_ = (const bf16*)(ws + WS_RG) + tk0 * 512 + hp_ * 256; \
        _Pragma("unroll") for (int q_ = 0; q_ < 4; ++q_) { const int i_ = tid + q_ * 512; pf_v[q_] = *(const u32x4*)(vg_ + (size_t)(i_ >> 5) * 512 + (i_ & 31) * 8); pf_r[q_] = *(const u32x4*)(rg_ + (size_t)(i_ >> 5) * 512 + (i_ & 31) * 8); } \
        _Pragma("unroll") for (int q_ = 0; q_ < 4; ++q_) { const int i_ = tid + q_ * 512, hh_ = i_ >> 10, r_ = (i_ >> 4) & 63, ch_ = i_ & 15; \
            pf_s[q_] = *(const u32x4*)((const bf16*)(F.dout + DO_ST) + ((size_t)(b_ * 4 + hp_ * 2 + hh_) * 128 + c_) * 8192 + r_ * 128 + ch_ * 8); } \
        const bf16* qg_ = (const bf16*)(ws + WS_QG) + tk0 * 256 + hp_ * 128; const bf16* kg_ = (const bf16*)(ws + WS_KG) + tk0 * 256 + hp_ * 128; \
        _Pragma("unroll") for (int q_ = 0; q_ < 2; ++q_) { const int i_ = tid + q_ * 512; pf_q[q_] = *(const u32x4*)(qg_ + (size_t)(i_ >> 4) * 256 + (i_ & 15) * 8); pf_k[q_] = *(const u32x4*)(kg_ + (size_t)(i_ >> 4) * 256 + (i_ & 15) * 8); } } while (0)
    int it = F.bid; if (it >= NBATCH * 256) return;
    GLA_C_PREFETCH(it);
    int hp_loaded = -1; float w2c[16]; float b2 = 0.f;
#pragma unroll
    for (int j = 0; j < 16; ++j) w2c[j] = 0.f;
    for (; it < NBATCH * 256; it += F.G) {
        const int b = it >> 8, c = (it >> 1) & 127, hp = it & 1;
        const size_t tok0 = (size_t)b * SEQ + (size_t)c * 64;
        l_alr[tid] = pf_alr[0]; l_alr[tid + 512] = pf_alr[1];
#pragma unroll
        for (int q = 0; q < 4; ++q) { const int i = tid + q * 512; *(LAS u32x4*)(l_v + (i >> 5) * PV + (i & 31) * 16) = pf_v[q]; }
#pragma unroll
        for (int q = 0; q < 4; ++q) { const int i = tid + q * 512, hh = i >> 10, r = (i >> 4) & 63, ch = i & 15; *(LAS u32x4*)(l_s + hh * (64 * PQ) + r * PQ + ch * 16) = pf_s[q]; }
#pragma unroll
        for (int q = 0; q < 2; ++q) { const int i = tid + q * 512; *(LAS u32x4*)(l_qh + (i >> 4) * PQ + (i & 15) * 16) = pf_q[q]; *(LAS u32x4*)(l_kt + (i >> 4) * PQ + (i & 15) * 16) = pf_k[q]; }
        u32x4 cur_r[4];
#pragma unroll
        for (int q = 0; q < 4; ++q) cur_r[q] = pf_r[q];
        __syncthreads();
        if (it + F.G < NBATCH * 256) GLA_C_PREFETCH(it + F.G);
        const int hh = wid >> 2, j = wid & 3, head = hp * 2 + hh;
        {
            const int gc = hp * 128 + col;
            if (hp != hp_loaded) { hp_loaded = hp; b2 = INP(6)[gc];
#pragma unroll
                for (int jj = 0; jj < 16; ++jj) w2c[jj] = INP(5)[jj * 256 + gc]; }
            float bc[16]; float run = 0.f;
#pragma unroll
            for (int i = 0; i < 16; ++i) { const int t = qt * 16 + i; float z = b2;
#pragma unroll
                for (int jj = 0; jj < 16; ++jj) z = fmaf(l_alr[t * 16 + jj], w2c[jj], z);
                run += log_sigmoid_fast(z) * (1.f / 16.f); bc[i] = run; }
            l_tot[qt * 128 + col] = run;
            __syncthreads();
            float pre = 0.f;
#pragma unroll
            for (int q = 0; q < 3; ++q) pre += (q < qt) ? l_tot[q * 128 + col] : 0.f;
#pragma unroll
            for (int i = 0; i < 16; ++i) { const int t = qt * 16 + i; const float bb = pre + bc[i];
                LAS bf16* qp = (LAS bf16*)(l_qh + t * PQ + col * 2); LAS bf16* kp = (LAS bf16*)(l_kt + t * PQ + col * 2);
                *qp = (bf16)f2bf(bf2f(*qp) * __expf(bb)); *kp = (bf16)f2bf(bf2f(*kp) * __expf(-bb)); }
        }
        __syncthreads();
        {
            f32x4 sc4[4];
#pragma unroll
            for (int nt = 0; nt < 4; ++nt) sc4[nt] = (f32x4){0.f, 0.f, 0.f, 0.f};
#pragma unroll
            for (int ks = 0; ks < 2; ++ks) { const bf16x8 a = frag_n(l_qh, PQ, 16 * j, hh * 64 + 32 * ks, lane);
#pragma unroll
                for (int nt = 0; nt < 4; ++nt) sc4[nt] = MFMA16(a, frag_n(l_kt, PQ, 16 * nt, hh * 64 + 32 * ks, lane), sc4[nt]); }
#pragma unroll
            for (int nt = 0; nt < 4; ++nt)
#pragma unroll
                for (int r = 0; r < 4; ++r) { const int t = 16 * j + 4 * (lane >> 4) + r, s2 = 16 * nt + (lane & 15);
                    *(LAS bf16*)(l_p + hh * (64 * PP) + t * PP + s2 * 2) = (bf16)f2bf(s2 <= t ? sc4[nt][r] : 0.f); }
        }
        __syncthreads();
        f32x4 acc[4][2];
#pragma unroll
        for (int mt = 0; mt < 4; ++mt)
#pragma unroll
            for (int nt = 0; nt < 2; ++nt) acc[mt][nt] = (f32x4){0.f, 0.f, 0.f, 0.f};
#pragma unroll
        for (int ks = 0; ks < 2; ++ks) {
            bf16x8 bb[2];
#pragma unroll
            for (int nt = 0; nt < 2; ++nt) bb[nt] = frag_t(l_s + hh * (64 * PQ), PQ, 32 * ks, 32 * j + 16 * nt, lane);
            __builtin_amdgcn_sched_barrier(0);
#pragma unroll
            for (int mt = 0; mt < 4; ++mt) { const bf16x8 a = frag_n(l_qh, PQ, 16 * mt, hh * 64 + 32 * ks, lane);
#pragma unroll
                for (int nt = 0; nt < 2; ++nt) acc[mt][nt] = MFMA16(a, bb[nt], acc[mt][nt]); } }
#pragma unroll
        for (int ks = 0; ks < 2; ++ks) {
            bf16x8 bb[2];
#pragma unroll
            for (int nt = 0; nt < 2; ++nt) bb[nt] = frag_t(l_v, PV, 32 * ks, hh * 128 + 32 * j + 16 * nt, lane);
            __builtin_amdgcn_sched_barrier(0);
#pragma unroll
            for (int mt = 0; mt < 4; ++mt) { const bf16x8 a = frag_n(l_p + hh * (64 * PP), PP, 16 * mt, 32 * ks, lane);
#pragma unroll
                for (int nt = 0; nt < 2; ++nt) acc[mt][nt] = MFMA16(a, bb[nt], acc[mt][nt]); } }
#pragma unroll
        for (int mt = 0; mt < 4; ++mt)
#pragma unroll
            for (int r = 0; r < 4; ++r) { float q = acc[mt][0][r] * acc[mt][0][r] + acc[mt][1][r] * acc[mt][1][r];
                q += __shfl_xor(q, 1); q += __shfl_xor(q, 2); q += __shfl_xor(q, 4); q += __shfl_xor(q, 8);
                if ((lane & 15) == 0) l_ss[(hh * 64 + 16 * mt + 4 * (lane >> 4) + r) * 4 + j] = q; }
        __syncthreads();
        {
            const float* gng = INP(7); const float g0 = gng[head * 128 + 32 * j + (lane & 15)], g1 = gng[head * 128 + 32 * j + 16 + (lane & 15)];
            LAS unsigned char* l_o = l_v + (4 * (lane >> 4)) * PV + (hh * 128 + 32 * j + (lane & 15)) * 2;
#pragma unroll
            for (int mt = 0; mt < 4; ++mt)
#pragma unroll
                for (int r = 0; r < 4; ++r) { const int t = 16 * mt + 4 * (lane >> 4) + r; const LAS float* sp = l_ss + (hh * 64 + t) * 4;
                    const float rstd = 1.f / sqrtf(((sp[0] + sp[1]) + (sp[2] + sp[3])) * (1.f / 128.f) + EPS);
                    *(LAS bf16*)(l_o + (16 * mt + r) * PV) = (bf16)f2bf(acc[mt][0][r] * rstd * g0); *(LAS bf16*)(l_o + (16 * mt + r) * PV + 32) = (bf16)f2bf(acc[mt][1][r] * rstd * g1); } }
        __syncthreads();
        { bf16* og = (bf16*)(F.dout + DO_OGD) + tok0 * 1024 + hp * 256;
#pragma unroll
          for (int q = 0; q < 4; ++q) { const int i = tid + q * 512; f32x4 o0, o1, r0, r1; const u32x4 ow = *(const LAS u32x4*)(l_v + (i >> 5) * PV + (i & 31) * 16); unpack8f(ow, o0, o1); unpack8f(cur_r[q], r0, r1);
#pragma unroll
              for (int e = 0; e < 4; ++e) { o0[e] *= r0[e] * __builtin_amdgcn_rcpf(1.f + __expf(-r0[e])); o1[e] *= r1[e] * __builtin_amdgcn_rcpf(1.f + __expf(-r1[e])); }
              *(u32x4*)(og + (size_t)(i >> 5) * 1024 + (i & 31) * 8) = pack8f(o0, o1); } }
        __syncthreads();
    }
#undef GLA_C_PREFETCH
}

__device__ __forceinline__ void dil_combine(Frame& F) {
    const bf16* qd = (const bf16*)(F.ws + WS_QD); const float* lse = (const float*)(F.ws + WS_LSE); bf16* od = (bf16*)(F.dout + DO_OGD) + 512;
    constexpr int U = 4; const int NT = F.G * NTHR;
    for (int idx0 = F.bid * NTHR + F.tid; idx0 < M * 64; idx0 += U * NT) {
        float l0[U], l1[U], l2[U]; u32x4 a[U], bq[U], c[U];
#pragma unroll
        for (int u = 0; u < U; ++u) { const int idx = idx0 + u * NT; if (idx < M * 64) { const int tok = idx >> 6, rem = idx & 63, h = rem >> 4, ch = rem & 15;
            l0[u] = lse[(size_t)tok * 12 + h]; l1[u] = lse[(size_t)tok * 12 + 4 + h]; l2[u] = lse[(size_t)tok * 12 + 8 + h];
            const bf16* p = qd + (size_t)tok * 1536 + h * 128 + ch * 8; a[u] = *(const u32x4*)p; bq[u] = *(const u32x4*)(p + 512); c[u] = *(const u32x4*)(p + 1024); } }
#pragma unroll
        for (int u = 0; u < U; ++u) { const int idx = idx0 + u * NT; if (idx < M * 64) { const int tok = idx >> 6, rem = idx & 63, h = rem >> 4, ch = rem & 15;
            const float mx = fmaxf(l0[u], fmaxf(l1[u], l2[u])); float w0 = __expf(l0[u] - mx), w1 = __expf(l1[u] - mx), w2 = __expf(l2[u] - mx); const float inv = 1.f / (w0 + w1 + w2); w0 *= inv; w1 *= inv; w2 *= inv;
            f32x4 a0, a1, b0, b1, c0, c1; unpack8f(a[u], a0, a1); unpack8f(bq[u], b0, b1); unpack8f(c[u], c0, c1);
            *(u32x4*)(od + (size_t)tok * 1024 + h * 128 + ch * 8) = pack8f(a0 * w0 + b0 * w1 + c0 * w2, a1 * w0 + b1 * w1 + c1 * w2); } }
    }
}

__device__ __forceinline__ void kv_small(Frame& F) {
    const bf16* memn = (const bf16*)(F.ws + WS_MEMN); const bf16* wt = (const bf16*)(F.ws + WS_WXKV); bf16* kvm = (bf16*)(F.ws + WS_KVM);
    const int fr = F.lane & 15, fq = F.lane >> 4;
    for (int t = F.bid; t < 256; t += F.G) { const int rt = t >> 3, ct = t & 7;
        f32x4 acc[4];
#pragma unroll
        for (int mt = 0; mt < 4; ++mt) acc[mt] = (f32x4){0.f, 0.f, 0.f, 0.f};
        const bf16* ap = memn + (size_t)(rt * 64 + fr) * DM + 8 * fq; const bf16* bp = wt + (size_t)(ct * 128 + 16 * F.wave + fr) * DM + 8 * fq;
#pragma unroll 4
        for (int kk = 0; kk < 32; ++kk) { const bf16x8 b = *(const bf16x8*)(bp + 32 * kk);
#pragma unroll
            for (int mt = 0; mt < 4; ++mt) acc[mt] = MFMA16(*(const bf16x8*)(ap + (size_t)(16 * mt) * DM + 32 * kk), b, acc[mt]); }
#pragma unroll
        for (int mt = 0; mt < 4; ++mt)
#pragma unroll
            for (int r = 0; r < 4; ++r) kvm[(size_t)(rt * 64 + 16 * mt + 4 * fq + r) * DM + ct * 128 + 16 * F.wave + fr] = (bf16)f2bf(acc[mt][r]);
    }
}

__device__ __forceinline__ att::BlockRef dil_ref(Frame& F, int I) {
    const int g = I >> 10, r = I & 1023, d = 1 << (2 * g), nqb = 32 >> (2 * g), qb = r % nqb, s = r / nqb, p = s % d, bh = s / d, h = bh & 3, b = bh >> 2;
    const size_t tb = (size_t)b * SEQ + p;
    att::BlockRef R;
    R.qs = d * 1536; R.ks = d * 1536; R.ls = d * 12; R.skv = SEQ / d; R.P0 = qb * 256;
    bf16* q = (bf16*)(F.ws + WS_QD) + tb * 1536 + g * 512 + h * 128;
    R.Q = q + (size_t)qb * 256 * R.qs;
    R.K = (const bf16*)(F.ws + WS_KD) + tb * 1536 + g * 512 + h * 128;
    R.L = (float*)(F.ws + WS_LSE) + tb * 12 + g * 4 + h + (size_t)qb * 256 * R.ls;
    return R;
}
__device__ __forceinline__ att::BlockRef xat_ref(Frame& F, int I) {
    const int qb = I & 31, h = (I >> 5) & 3, b = I >> 7;
    att::BlockRef R; R.qs = 512; R.ks = 1024; R.ls = 0; R.skv = 256; R.P0 = 256; R.L = nullptr;
    bf16* q = (bf16*)(F.ws + WS_QX) + ((size_t)b * SEQ + (size_t)qb * 256) * 512 + h * 128;
    R.Q = q; R.K = (const bf16*)(F.ws + WS_KVM) + (size_t)b * 256 * 1024 + h * 128;
    return R;
}
template <bool DIL>
__device__ __forceinline__ void attn_phase(Frame& F) {
    constexpr int TOTAL = DIL ? 3072 : 1024; constexpr int W = DIL ? 129 : (1 << 20); constexpr long VOFF = DIL ? (long)((WS_VD - WS_KD) / 2) : 512;
    const int G8 = F.G & ~255;
    auto remap = [&](int I_) { if (I_ >= (TOTAL / 256) * 256 || (I_ % F.G) >= G8 || F.G != 256) return I_; const int r_ = I_ >> 8, w_ = I_ & 255; return (r_ << 8) + ((w_ & 7) << 5) + (w_ >> 3); };
    int I = F.bid; if (I >= TOTAL) return;
    att::BlockRef cur = DIL ? dil_ref(F, remap(I)) : xat_ref(F, remap(I));
    att::Seam S;
    att::prime<VOFF>(cur, W, F.ldsg, S);
    for (;;) {
        const bool more = I + F.G < TOTAL; const int In = more ? I + F.G : I;
        const att::BlockRef nxt = DIL ? dil_ref(F, remap(In)) : xat_ref(F, remap(In));
        att::block<true, VOFF>(cur, nxt, W, F.ldsg, S);
        if (!more) break;
        cur = nxt; I = In;
    }
}

__device__ __forceinline__ void router_phase(Frame& F, const Args& A) {
    unsigned char* ws = F.ws;
    LAS unsigned char* l_w = F.lds;
    LAS float* l_lg = (LAS float*)(F.lds + 65536) + F.wave * (16 * 33 + 16);
    LAS unsigned* l_hist = (LAS unsigned*)(F.lds + 65536 + 8 * (16 * 33 + 16) * 4);
    const int tid = F.tid, lane = F.lane;
    { const u32x4* wsrc = (const u32x4*)(ws + WS_WR);
      for (int i = tid; i < 32 * 128; i += NTHR) { const int e = i >> 7, ch = i & 127; *(LAS u32x4*)(l_w + e * 2048 + ((ch ^ (e & 15)) << 4)) = wsrc[i]; } }
    if (tid < 64) l_hist[tid] = 0u;
    LAS float* l_br = (LAS float*)(l_hist + 64);
    if (tid < 32) l_br[tid] = INP(20)[tid];
    { int* rt = (int*)(ws + WS_RTOK); float* rg = (float*)(ws + WS_RGATE); float* rr = (float*)(ws + WS_RRS);
      for (int i = F.bid * NTHR + tid; i < 2 * RT_CAP; i += F.G * NTHR) { rt[i] = 0; rg[i] = 0.f; rr[i] = 0.f; } }
    __syncthreads();
    const bf16* h2b = (const bf16*)(ws + WS_A); float* rstd3 = (float*)(ws + WS_RSTD3);
    const int fr = lane & 15, fq = lane >> 4;
    for (int rb = F.bid * NWAVES + F.wave; rb < M / 16; rb += F.G * NWAVES) {
        const size_t row0 = (size_t)rb * 16;
        const bf16* xr = h2b + (row0 + fr) * DM + 8 * fq;
        f32x4 c0 = {0.f, 0.f, 0.f, 0.f}, c1 = {0.f, 0.f, 0.f, 0.f}; float ss = 0.f;
#pragma unroll
        for (int kk = 0; kk < 32; ++kk) {
            const u32x4 xw = *(const u32x4*)(xr + 32 * kk); f32x4 x0, x1; unpack8f(xw, x0, x1);
            ss += (x0[0] * x0[0] + x0[1] * x0[1]) + (x0[2] * x0[2] + x0[3] * x0[3]) + (x1[0] * x1[0] + x1[1] * x1[1]) + (x1[2] * x1[2] + x1[3] * x1[3]);
            const bf16x8 ah = *reinterpret_cast<const bf16x8*>(&xw);
            const int ch = 4 * kk + fq;
            const bf16x8 b0 = *(const LAS bf16x8*)(l_w + fr * 2048 + ((ch ^ fr) << 4)), b1 = *(const LAS bf16x8*)(l_w + (16 + fr) * 2048 + ((ch ^ fr) << 4));
            c0 = MFMA16(ah, b0, c0); c1 = MFMA16(ah, b1, c1);
        }
        ss += __shfl_xor(ss, 16); ss += __shfl_xor(ss, 32);
        const float rstd = 1.f / sqrtf(ss * (1.f / DM) + EPS);
        if (fq == 0) { l_lg[16 * 33 + fr] = rstd; rstd3[row0 + fr] = rstd; }
#pragma unroll
        for (int r = 0; r < 4; ++r) { l_lg[(4 * fq + r) * 33 + fr] = c0[r]; l_lg[(4 * fq + r) * 33 + 16 + fr] = c1[r]; }
        LDS_WAIT(); asm volatile("" ::: "memory");
        if (lane < 16) {
            const float rs = l_lg[16 * 33 + lane]; float v[32];
#pragma unroll
            for (int e = 0; e < 32; ++e) v[e] = l_lg[lane * 33 + e] * rs + l_br[e];
            int ci[4]; float cv[4];
#pragma unroll
            for (int k = 0; k < 4; ++k) { float best = -__builtin_inff(); int bi = 0;
#pragma unroll
                for (int e = 0; e < 32; ++e) { bool free_ = true;
#pragma unroll
                    for (int kk2 = 0; kk2 < k; ++kk2) free_ = free_ && (ci[kk2] != e);
                    if (free_ && v[e] > best) { best = v[e]; bi = e; } }
                ci[k] = bi; cv[k] = best; }
            float ex[4], sum = 0.f;
#pragma unroll
            for (int k = 0; k < 4; ++k) { ex[k] = __expf(cv[k] - cv[0]); sum += ex[k]; }
            const float inv = 1.f / sum; const size_t tok = row0 + lane; const int hf = tok >= HALF_TOK ? 1 : 0;
            int* te = (int*)(ws + WS_TOPE) + tok * 4; float* tg = (float*)(ws + WS_TGATE) + tok * 4;
#pragma unroll
            for (int k = 0; k < 4; ++k) { te[k] = ci[k]; tg[k] = ex[k] * inv; atomicAdd((unsigned*)&l_hist[hf * 32 + ci[k]], 1u); }
        }
        LDS_WAIT(); asm volatile("" ::: "memory");
    }
    __syncthreads();
    if (tid < 64 && l_hist[tid] != 0u) atomicAdd(F.ctl + CW_CNT + tid, l_hist[tid]);
}

struct MoeTab { LAS int* pstart; LAS int* blk_e; LAS int* nblk; };
__device__ __forceinline__ MoeTab moe_tables(Frame& F, int half) {
    MoeTab T; T.pstart = (LAS int*)(F.lds + TAB_OFF); T.blk_e = T.pstart + 32; T.nblk = T.blk_e + MAXBLK;
    __syncthreads();
    if (F.tid < 64) {
        const int lane = F.tid; int cnt = 0;
        if (lane < NEXP) cnt = (int)__hip_atomic_load(F.ctl + CW_CNT + half * 32 + lane, __ATOMIC_RELAXED, __HIP_MEMORY_SCOPE_AGENT);
        const int nb = (cnt + 255) >> 8; int incl = nb;
#pragma unroll
        for (int d = 1; d < 32; d <<= 1) { const int t = __shfl_up(incl, d); if (lane >= d) incl += t; }
        int pos = incl - nb; if (pos > MAXBLK) pos = MAXBLK;
        if (lane < NEXP) { T.pstart[lane] = pos * 256; for (int jx = 0; jx < nb && pos + jx < MAXBLK; ++jx) T.blk_e[pos + jx] = lane; }
        if (lane == NEXP - 1) T.nblk[0] = incl < MAXBLK ? incl : MAXBLK;
    }
    __syncthreads();
    return T;
}
__device__ __forceinline__ void place_phase(Frame& F) {
    unsigned char* ws = F.ws;
    LAS int* l_cnt = (LAS int*)(F.lds + 4096); LAS int* l_base = l_cnt + 32;
    const int* te = (const int*)(ws + WS_TOPE); const float* tg = (const float*)(ws + WS_TGATE);
    int* tslot = (int*)(ws + WS_TSLOT);
    for (int half = 0; half < 2; ++half) {
        const MoeTab T = moe_tables(F, half);
        int* rtok = (int*)(ws + WS_RTOK) + half * RT_CAP; float* rgate = (float*)(ws + WS_RGATE) + half * RT_CAP; float* rrs = (float*)(ws + WS_RRS) + half * RT_CAP; const float* rstd3 = (const float*)(ws + WS_RSTD3);
        for (int bt = F.bid; bt < HALF_TOK / 128; bt += F.G) {
            if (F.tid < 32) l_cnt[F.tid] = 0;
            __syncthreads();
            const int tok = half * HALF_TOK + bt * 128 + (F.tid >> 2), k = F.tid & 3;
            const int e = te[(size_t)tok * 4 + k];
            const int rank = atomicAdd((int*)&l_cnt[e], 1);
            __syncthreads();
            if (F.tid < 32) l_base[F.tid] = (int)atomicAdd(F.ctl + CW_CUR + half * 32 + F.tid, (unsigned)l_cnt[F.tid]);
            __syncthreads();
            const int dest = T.pstart[e] + l_base[e] + rank;
            if (dest < RT_CAP) { rtok[dest] = tok; rgate[dest] = tg[(size_t)tok * 4 + k]; rrs[dest] = rstd3[tok]; }
            tslot[(size_t)tok * 4 + k] = dest < RT_CAP ? dest : 0;
            __syncthreads();
        }
    }
}
__device__ __forceinline__ void combine_phase(Frame& F, const Args& A, int half) {
    float* outp = (float*)F.dout; const bf16* h2b = (const bf16*)(F.ws + WS_A); const bf16* Y = (const bf16*)(F.ws + WS_Y); const int* tslot = (const int*)(F.ws + WS_TSLOT); const float* gf = INP(27);
    f32x4 gg[2][2];
#pragma unroll
    for (int c = 0; c < 2; ++c) { gg[c][0] = *(const f32x4*)(gf + c * 512 + 8 * F.lane); gg[c][1] = *(const f32x4*)(gf + c * 512 + 8 * F.lane + 4); }
    for (int m0 = half * HALF_TOK + 2 * (F.bid * NWAVES + F.wave); m0 < (half + 1) * HALF_TOK; m0 += 2 * F.G * NWAVES) {
        u32x4 hw[2][2], yw[2][4][2]; int sl[2][4];
#pragma unroll
        for (int r = 0; r < 2; ++r)
#pragma unroll
            for (int k = 0; k < 4; ++k) sl[r][k] = tslot[(size_t)(m0 + r) * 4 + k];
#pragma unroll
        for (int r = 0; r < 2; ++r) {
#pragma unroll
            for (int c = 0; c < 2; ++c) hw[r][c] = *(const u32x4*)(h2b + (size_t)(m0 + r) * DM + c * 512 + 8 * F.lane);
#pragma unroll
            for (int k = 0; k < 4; ++k)
#pragma unroll
                for (int c = 0; c < 2; ++c) yw[r][k][c] = *(const u32x4*)(Y + (size_t)sl[r][k] * 1024 + c * 512 + 8 * F.lane); }
#pragma unroll
        for (int r = 0; r < 2; ++r) { f32x4 v[2][2]; float s = 0.f;
#pragma unroll
            for (int c = 0; c < 2; ++c) { unpack8f(hw[r][c], v[c][0], v[c][1]);
#pragma unroll
                for (int k = 0; k < 4; ++k) { f32x4 y0, y1; unpack8f(yw[r][k][c], y0, y1); v[c][0] += y0; v[c][1] += y1; }
#pragma unroll
                for (int e = 0; e < 2; ++e) s += (v[c][e].x * v[c][e].x + v[c][e].y * v[c][e].y) + (v[c][e].z * v[c][e].z + v[c][e].w * v[c][e].w); }
            const float rstd = 1.f / sqrtf(wave_sum(s) * (1.f / DM) + EPS);
            float* op = outp + (size_t)(m0 + r) * DM + 8 * F.lane;
#pragma unroll
            for (int c = 0; c < 2; ++c) { *(f32x4*)(op + c * 512) = v[c][0] * rstd * gg[c][0]; *(f32x4*)(op + c * 512 + 4) = v[c][1] * rstd * gg[c][1]; } }
    }
}

__global__ void __launch_bounds__(NTHR, 2) mk_fwd(Args A) {
    extern __shared__ __attribute__((aligned(16))) unsigned char lds[];
    Frame F;
    F.lds = (LAS unsigned char*)lds; F.ldsg = (char*)lds;
    F.tid = threadIdx.x; F.lane = F.tid & 63; F.wave = __builtin_amdgcn_readfirstlane(F.tid >> 6);
    F.G = gridDim.x; F.bid = blockIdx.x;
    F.ws = A.ws; F.ctl = (unsigned*)(A.ws + WS_CTL); F.dout = (unsigned char*)A.out;
    volatile LAS unsigned* MISC = (volatile LAS unsigned*)(F.lds + MISC_OFF);
    if (F.tid < 16) MISC[F.tid] = 0u;
    __syncthreads();
    XcdBarrier bar; bar.bar = F.ctl + CW_BAR; bar.x = 0; bar.st = nullptr;
    if (!MK_PER_PHASE) bar = xcd_barrier_post(F.ctl + CW_BAR, MISC + 8);
    const int lo = A.ph_lo, hi = A.ph_hi;
#ifndef PHMASK
#define PHMASK 0x7ffff
#endif
#define IN(k) (((PHMASK >> (k)) & 1) && lo <= (k) && (k) < hi)
#if MK_PROBE
#define SEAM(k) do { if (IN(k) && IN((k) + 1)) xcd_barrier(bar); if ((k) == PROBE_A) t_mark = __builtin_amdgcn_s_memrealtime(); } while (0)
#else
#define SEAM(k) do { if (IN(k) && IN((k) + 1)) xcd_barrier(bar); } while (0)
#endif
    unsigned char* ws = F.ws;
    const int* positions = (const int*)A.in[2];

#if MK_PROBE
    const unsigned long long t_k0 = __builtin_amdgcn_s_memrealtime(); unsigned long long t_mark = t_k0;
#endif
#if MK_REPS > 1
    for (int rep_ = 0; rep_ < MK_REPS; ++rep_) {
    if (rep_ > 0) { if (F.bid == 0 && F.tid < 128) { __hip_atomic_store(F.ctl + CW_CNT + F.tid, 0u, __ATOMIC_RELAXED, __HIP_MEMORY_SCOPE_AGENT); __hip_atomic_store(F.ctl + CW_CUR + F.tid, 0u, __ATOMIC_RELAXED, __HIP_MEMORY_SCOPE_AGENT); } xcd_barrier(bar); }
#endif
    if (IN(0)) { p0_prologue(F, A); } SEAM(0);
    if (IN(1)) {
        { pg8::Gemm g{(const bf16*)(ws + WS_A), (const bf16*)(ws + WS_WIN), 1024, nullptr}; pg8::StaticOrder S; S.init(M / 256, 6, F.G, F.bid, 0);
          EpiProj E{ws, positions, 1.f}; pg8::gemm_phase<EpiProj, pg8::StaticOrder, false>(F.lds, g, S, E); }
        { pg8::Gemm g{(const bf16*)(ws + WS_A8), (const bf16*)(ws + WS_WIN8), 1024, nullptr}; pg8::StaticOrder S; S.init(M / 256, 18, F.G, F.bid, 6, -6);
          EpiProj E{ws, positions, W8_INV}; pg8::gemm_phase<EpiProj, pg8::StaticOrder, false, 1>(F.lds, g, S, E); }
        kv_small(F);
    } SEAM(1);
    if (IN(2)) {
#ifndef NO_GLAA
        gla_a_phase(F, A);
#endif
#ifndef NO_DIL
        attn_phase<true>(F);
#endif
    } SEAM(2);
    if (IN(3)) { gla_scan(F);
        { pg8::Gemm g{(const bf16*)(ws + WS_A8), (const bf16*)(ws + WS_WGATE), 1024, nullptr}; pg8::StaticOrder S; S.init(M / 256, 8, F.G, F.bid);
        EpiGates E{(bf16*)(ws + WS_GATES), INP(11), W8_INV}; pg8::gemm_phase<EpiGates, pg8::StaticOrder, false, 1>(F.lds, g, S, E); } } SEAM(3);
    if (IN(4)) {
        gla_c_phase(F, A);
        dil_combine(F);
    } SEAM(4);
    if (IN(6)) { pg8::Gemm g{(const bf16*)(F.dout + DO_OGD), (const bf16*)(ws + WS_WBG), 1024, nullptr}; pg8::StaticOrder S; S.init(M / 256, 4, F.G, F.bid);
        EpiBranchFused E{(bf16*)(ws + WS_MERGED), (const bf16*)(ws + WS_GATES)}; pg8::gemm_phase<EpiBranchFused, pg8::StaticOrder, false>(F.lds, g, S, E); } SEAM(6);
    if (IN(7)) { pg8::Gemm g{(const bf16*)(ws + WS_MERGED), (const bf16*)(ws + WS_WMIX), 1024, nullptr}; pg8::StaticOrder S; S.init(M / 256, 4, F.G, F.bid);
        EpiResBf16 E{INP(0), nullptr, (bf16*)(ws + WS_A), ws + WS_H2F8}; pg8::gemm_phase<EpiResBf16, pg8::StaticOrder, false>(F.lds, g, S, E); } SEAM(7);
    if (IN(8)) {
        const int gw = F.bid * NWAVES + F.wave, NGW = F.G * NWAVES;
        LAS float* scr = (LAS float*)(F.lds + F.wave * 16384);
        constexpr int IPM = 16 * 32;
        for (int it = gw; it < 3 * NEXP * IPM; it += NGW) { const int mat = it / IPM, r = it % IPM, kind = mat / NEXP, e = mat % NEXP;
            if (kind == 0) transpose_item<RmGU, true>(INP(21) + (size_t)e * 1048576, 1024, 1024, (bf16*)(ws + WS_WGU), RmGU{e * 2048}, scr, r, F.lane, INP(18));
            else if (kind == 1) transpose_item<RmGU, true>(INP(23) + (size_t)e * 1048576, 1024, 1024, (bf16*)(ws + WS_WGU), RmGU{e * 2048 + 128}, scr, r, F.lane, INP(18));
            else transpose_item<RmId, true>(INP(25) + (size_t)e * 1048576, 1024, 1024, (bf16*)(ws + WS_WDN), RmId{e * 1024}, scr, r, F.lane); }
    }
    if (IN(9)) { pg8::Gemm g{(const bf16*)(ws + WS_H2F8), (const bf16*)(ws + WS_WXQ), 1024, nullptr};     pg8::StaticOrder S; S.init(M / 256, 2, F.G, F.bid);
        LAS float* rs = (LAS float*)(F.lds + TAB_OFF);
        { pg8::Unit u; for (int i = 0; i < 8 && S.next(i, u); ++i) {
              for (int r0 = F.wave * 32; r0 < F.wave * 32 + 32; r0 += 8) {
                  u32x4 w[8][2];
#pragma unroll
                  for (int q = 0; q < 8; ++q) { const bf16* xr = (const bf16*)(ws + WS_A) + ((size_t)u.pm * 256 + r0 + q) * DM + F.lane * 8; w[q][0] = *(const u32x4*)xr; w[q][1] = *(const u32x4*)(xr + 512); }
#pragma unroll
                  for (int q = 0; q < 8; ++q) { f32x4 a0, a1, b0, b1; unpack8f(w[q][0], a0, a1); unpack8f(w[q][1], b0, b1);
                      float ss = (a0[0] * a0[0] + a0[1] * a0[1]) + (a0[2] * a0[2] + a0[3] * a0[3]) + (a1[0] * a1[0] + a1[1] * a1[1]) + (a1[2] * a1[2] + a1[3] * a1[3])
                               + (b0[0] * b0[0] + b0[1] * b0[1]) + (b0[2] * b0[2] + b0[3] * b0[3]) + (b1[0] * b1[0] + b1[1] * b1[1]) + (b1[2] * b1[2] + b1[3] * b1[3]);
                      ss = wave_sum(ss); if (F.lane == 0) rs[i * 256 + r0 + q] = W8_INV / sqrtf(ss * (1.f / DM) + EPS); } } } }
        __syncthreads();
        EpiRowScaleBf16 E{(bf16*)(ws + WS_QX), 512, rs}; pg8::gemm_phase<EpiRowScaleBf16, pg8::StaticOrder, false, 1>(F.lds, g, S, E); } SEAM(9);
    if (IN(10)) { attn_phase<false>(F); } SEAM(10);
    if (IN(11)) { pg8::Gemm g{(const bf16*)(ws + WS_QX), (const bf16*)(ws + WS_WXO), 512, nullptr}; pg8::StaticOrder S; S.init(M / 256, 4, F.G, F.bid);
        EpiResBf16 E{nullptr, (const bf16*)(ws + WS_A), (bf16*)(ws + WS_A), ws + WS_H2F8}; pg8::gemm_phase<EpiResBf16, pg8::StaticOrder, false>(F.lds, g, S, E); } SEAM(11);
    if (IN(12)) { router_phase(F, A); } SEAM(12);
    if (IN(13)) { place_phase(F); } SEAM(13);
#define MOE_GU(half) do { const MoeTab T = moe_tables(F, half); \
        pg8::Gemm g{(const bf16*)(ws + WS_H2F8), (const bf16*)(ws + WS_WGU), 1024, (const int*)(ws + WS_RTOK) + (half) * RT_CAP}; \
        pg8::MoeOrder S; S.init(T.nblk[0], 8, F.G, F.bid); S.blk_e = T.blk_e; \
        EpiSwiglu E{ws + WS_H, INP(22), INP(24), 8, (const float*)(ws + WS_RRS) + (half) * RT_CAP}; pg8::gemm_phase<EpiSwiglu, pg8::MoeOrder, true, 1>(F.lds, g, S, E); } while (0)
#define MOE_DN(half) do { const MoeTab T = moe_tables(F, half); \
        pg8::Gemm g{(const bf16*)(ws + WS_H), (const bf16*)(ws + WS_WDN), 1024, nullptr}; \
        pg8::MoeOrder S; S.init(T.nblk[0], 4, F.G, F.bid); S.blk_e = T.blk_e; \
        EpiDown E{(bf16*)(ws + WS_Y), INP(26), (const float*)(ws + WS_RGATE) + (half) * RT_CAP, 4}; pg8::gemm_phase<EpiDown, pg8::MoeOrder, false, 1>(F.lds, g, S, E); } while (0)
    if (IN(14)) { MOE_GU(0); } SEAM(14);
    if (IN(15)) { MOE_DN(0); } SEAM(15);
    if (IN(16)) { combine_phase(F, A, 0); MOE_GU(1); } SEAM(16);
    if (IN(17)) { MOE_DN(1); } SEAM(17);
    if (IN(18)) { combine_phase(F, A, 1); }
#if MK_PROBE
    { xcd_barrier(bar); if (F.tid == 0) { const unsigned long long t1 = __builtin_amdgcn_s_memrealtime(), w = ((PROBE_A == 100 ? t1 : t_mark) - t_k0) * PROBE_K; while (__builtin_amdgcn_s_memrealtime() - t1 < w) __builtin_amdgcn_s_sleep(8); } __syncthreads(); }
#endif
#if MK_REPS > 1
    xcd_barrier(bar); }
#endif
#undef IN
#undef SEAM
}


extern "C" void kernel_launch(void* const* d_in, const int* in_sizes, int n_in, void* d_out, int out_size, void* d_ws, size_t ws_size, hipStream_t stream) {
    static int grid = 0;
    if (grid == 0) {
        if (n_in != 28 || out_size != M * DM || ws_size < WS_END) { fprintf(stderr, "kernel_launch: unexpected shapes (n_in %d, out %d, ws %zu)\n", n_in, out_size, ws_size); grid = -1; return; }
        int dev = 0, cus = 0, per_cu = 0;
        if (hipGetDevice(&dev) != hipSuccess || hipDeviceGetAttribute(&cus, hipDeviceAttributeMultiprocessorCount, dev) != hipSuccess) { grid = -1; return; }
        if (hipFuncSetAttribute((const void*)mk_fwd, hipFuncAttributeMaxDynamicSharedMemorySize, LDS_BYTES) != hipSuccess) { fprintf(stderr, "kernel_launch: hipFuncSetAttribute failed\n"); grid = -1; return; }
        if (hipOccupancyMaxActiveBlocksPerMultiprocessor(&per_cu, (const void*)mk_fwd, NTHR, LDS_BYTES) != hipSuccess || per_cu < 1) { fprintf(stderr, "kernel_launch: occupancy query says %d\n", per_cu); (void)hipGetLastError(); grid = -1; return; }
        grid = cus;
    }
    if (grid < 0) return;
#if MK_DIAG
    unsigned long long* sums = (unsigned long long*)((char*)d_ws + WS_DIAG);
    (void)hipMemsetAsync(sums, 0, 4096, stream);
    for (int run = 0; run < 2; ++run) {
        (void)hipMemsetAsync((char*)d_ws + 1 * MiB, run ? 0x3C : 0x00, WS_END - 1 * MiB, stream);
        (void)hipMemsetAsync(d_out, run ? 0x3D : 0x00, (size_t)M * DM * 4, stream);
        (void)hipMemsetAsync((char*)d_ws + WS_CTL, 0, CTL_ZERO_BYTES, stream);
        Args a{};
        for (int i = 0; i < 28; ++i) a.in[i] = d_in[i];
        a.out = (float*)d_out; a.ws = (unsigned char*)d_ws;
        for (int p = 0; p < NPH; ++p) { a.ph_lo = p; a.ph_hi = p + 1; hipLaunchKernelGGL(mk_fwd, dim3(grid), dim3(NTHR), LDS_BYTES, stream, a);
            diag_sums(p, (unsigned char*)d_ws, (unsigned char*)d_out, sums + run * 32 + p, stream); }
    }
    hipLaunchKernelGGL(k_verdict, dim3(1024), dim3(256), 0, stream, (const unsigned long long*)sums, (float*)d_out, (size_t)M * DM);
#else
    (void)hipMemsetAsync((char*)d_ws + WS_CTL, 0, CTL_ZERO_BYTES, stream);
    Args a{};
    for (int i = 0; i < 28; ++i) a.in[i] = d_in[i];
    a.out = (float*)d_out; a.ws = (unsigned char*)d_ws;
#if MK_PER_PHASE
    for (int p = 0; p < NPH; ++p) { a.ph_lo = p; a.ph_hi = p + 1; hipLaunchKernelGGL(mk_fwd, dim3(grid), dim3(NTHR), LDS_BYTES, stream, a); }
#else
    a.ph_lo = 0; a.ph_hi = NPH; hipLaunchKernelGGL(mk_fwd, dim3(grid), dim3(NTHR), LDS_BYTES, stream, a);
#endif
#endif
}
```

```cpp
#include <hip/hip_runtime.h>
#include <cstdio>
#include <cstdint>

#define LAS __attribute__((address_space(3)))
#define GAS __attribute__((address_space(1)))
typedef unsigned short bf16;
typedef short bf16x8 __attribute__((ext_vector_type(8)));
typedef short s16x4 __attribute__((ext_vector_type(4)));
typedef float f32x4 __attribute__((ext_vector_type(4)));
typedef float f32x16 __attribute__((ext_vector_type(16)));
typedef unsigned u32x4 __attribute__((ext_vector_type(4)));
typedef unsigned u32x2 __attribute__((ext_vector_type(2)));
typedef int i32x4 __attribute__((ext_vector_type(4)));
typedef int i32x8 __attribute__((ext_vector_type(8)));

typedef float f32x2 __attribute__((ext_vector_type(2)));
typedef __bf16 b16x2 __attribute__((ext_vector_type(2)));
__device__ __forceinline__ unsigned cvt_pk_bf16(float lo, float hi) { const f32x2 v = {lo, hi}; const b16x2 r = __builtin_convertvector(v, b16x2); return __builtin_bit_cast(unsigned, r); }
__device__ __forceinline__ u32x2 pack8_fp8(const f32x4& a, const f32x4& b) {
    unsigned lo = 0, hi = 0; lo = __builtin_amdgcn_cvt_pk_fp8_f32(a[0], a[1], lo, false); lo = __builtin_amdgcn_cvt_pk_fp8_f32(a[2], a[3], lo, true); hi = __builtin_amdgcn_cvt_pk_fp8_f32(b[0], b[1], hi, false); hi = __builtin_amdgcn_cvt_pk_fp8_f32(b[2], b[3], hi, true);
    u32x2 w; w.x = lo; w.y = hi; return w; }
__device__ __forceinline__ float bf2f(unsigned b) { return __uint_as_float(b << 16); }
__device__ __forceinline__ float bflo(unsigned w) { return __uint_as_float(w << 16); }
__device__ __forceinline__ float bfhi(unsigned w) { return __uint_as_float(w & 0xffff0000u); }
__device__ __forceinline__ unsigned f2bf(float f) { unsigned u = __float_as_uint(f); return (u + 0x7fffu + ((u >> 16) & 1u)) >> 16; }
__device__ __forceinline__ unsigned pk2(float lo, float hi) { return f2bf(lo) | (f2bf(hi) << 16); }

namespace pg8 {
constexpr int BM = 256, BK = 64, HALF = 128, HTB = HALF * BK * 2, STAGE_BYTES = 8 * HTB, NXCD = 8, WGM = 4;
__host__ __device__ __forceinline__ int lds_byte(int r, int c) { const int st = (r >> 4) * 2 + (c >> 5), rr = r & 15, cc = c & 31, ob = rr * 64 + cc * 2; return st * 1024 + (ob ^ (((ob >> 9) & 1) << 5)); }
__host__ __device__ __forceinline__ void stage_rc(int b, int& R, int& C) { const int st = b / 1024, sb = b % 1024, swz = sb ^ (((sb >> 9) & 1) << 5); R = (st >> 1) * 16 + swz / 64; C = (st & 1) * 32 + (swz % 64) / 2; }
__host__ __device__ __forceinline__ int perm32(int rho) { const int n = rho >> 4, i = rho & 15; return 8 * (i >> 2) + 4 * n + (i & 3); }

struct Unit { int pm, pn, pb, ord; };
struct Gemm { const bf16* A; const bf16* Bt; int K; const int* rowmap; };

struct StaticOrder {
    int nM, nN, nwg, G, c, pn0, pbd;
    __device__ __forceinline__ void init(int nM_, int nN_, int G_, int c_, int pn0_ = 0, int pbd_ = 0) { nM = nM_; nN = nN_; nwg = nM * nN; G = G_; c = c_; pn0 = pn0_; pbd = pbd_; }
    __device__ __forceinline__ bool next(int i, Unit& u) const {
        const long L = (long)i * G + c; if (L >= nwg) return false;
        int wgid = (int)L; { const int q = nwg / NXCD, r = nwg % NXCD, xcd = wgid % NXCD, off = wgid / NXCD; wgid = (xcd < r ? xcd * (q + 1) : r * (q + 1) + (xcd - r) * q) + off; }
        const int nig = WGM * nN, gid = wgid / nig, fm = gid * WGM, gsz = (nM - fm) < WGM ? (nM - fm) : WGM;
        u.pm = fm + ((wgid % nig) % gsz); u.pn = pn0 + (wgid % nig) / gsz; u.pb = u.pn + pbd; u.ord = i; return true;
    }
};
struct MoeOrder : StaticOrder {
    const LAS int* blk_e;
    __device__ __forceinline__ bool next(int i, Unit& u) const { if (!StaticOrder::next(i, u)) return false; u.pb = blk_e[u.pm] * nN + u.pn; return true; }
};

template <class Epi, class Sched, bool GATHER, int ES = 2>
__device__ __forceinline__ void gemm_phase(LAS unsigned char* lds, const Gemm g, const Sched& S, const Epi& E) {
    const int tid = threadIdx.x, wid = __builtin_amdgcn_readfirstlane(tid >> 6), lane = tid & 63, wr = wid >> 2, wc = wid & 3, fr = lane & 15, fq = lane >> 4;
    const int K = g.K, KB = K * ES  , nt = KB / (BK * 2);
    unsigned voffA[2], voffB[2]; int rA[2], cA2[2];
#pragma unroll
    for (int i = 0; i < 2; ++i) { int R, C; stage_rc(tid * 16 + i * 8192, R, C); const int Rb = Epi::PERM ? ((R & ~31) + perm32(R & 31)) : R;
        voffA[i] = (unsigned)(R * KB + C * 2); voffB[i] = (unsigned)(Rb * KB + C * 2); rA[i] = R; cA2[i] = C * 2; }
    const size_t kstep = (size_t)(BK * 2);
    const size_t hstep = (size_t)HALF * KB;
    const size_t tstep = 2 * hstep;
    const unsigned ldsw = (unsigned)wid * 1024u;
    const int aoff = lds_byte(wr * 64 + fr, fq * 8), boff = lds_byte(wc * 32 + fr, fq * 8);
#define PG8_SA(b, h) (((b) * 2 + (h)) * HTB)
#define PG8_SB(b, h) ((4 + (b) * 2 + (h)) * HTB)
#define PG8_STAGE(bufoff, gbase, voff) do { _Pragma("unroll") for (int _i = 0; _i < 2; ++_i) \
        __builtin_amdgcn_global_load_lds((const unsigned*)((const char*)(gbase) + (voff)[_i]), (LAS unsigned*)(lds + (bufoff) + ldsw + _i * 8192), 16, 0, 0); } while (0)
#define PG8_STAGE_G(bufoff, o0, o1, kb) do { \
        __builtin_amdgcn_global_load_lds((const unsigned*)((const char*)g.A + (size_t)(o0) + (kb)), (LAS unsigned*)(lds + (bufoff) + ldsw), 16, 0, 0); \
        __builtin_amdgcn_global_load_lds((const unsigned*)((const char*)g.A + (size_t)(o1) + (kb)), (LAS unsigned*)(lds + (bufoff) + ldsw + 8192), 16, 0, 0); } while (0)
#define PG8_CAT8(x0, x1) __builtin_shufflevector(__builtin_bit_cast(i32x4, x0), __builtin_bit_cast(i32x4, x1), 0, 1, 2, 3, 4, 5, 6, 7)
#define PG8_LDA(dst, b, h) do { if constexpr (ES == 2) { _Pragma("unroll") for (int m = 0; m < 4; ++m) _Pragma("unroll") for (int k = 0; k < 2; ++k) dst[m][k] = *(const LAS bf16x8*)(lds + PG8_SA(b, h) + aoff + m * 2048 + k * 1024); } \
        else { _Pragma("unroll") for (int m = 0; m < 4; ++m) dst##8[m] = PG8_CAT8(*(const LAS bf16x8*)(lds + PG8_SA(b, h) + aoff + m * 2048), *(const LAS bf16x8*)(lds + PG8_SA(b, h) + aoff + m * 2048 + 1024)); } } while (0)
#define PG8_LDB(dst, b, h) do { if constexpr (ES == 2) { _Pragma("unroll") for (int n = 0; n < 2; ++n) _Pragma("unroll") for (int k = 0; k < 2; ++k) dst[n][k] = *(const LAS bf16x8*)(lds + PG8_SB(b, h) + boff + n * 2048 + k * 1024); } \
        else { _Pragma("unroll") for (int n = 0; n < 2; ++n) dst##8[n] = PG8_CAT8(*(const LAS bf16x8*)(lds + PG8_SB(b, h) + boff + n * 2048), *(const LAS bf16x8*)(lds + PG8_SB(b, h) + boff + n * 2048 + 1024)); } } while (0)
#define PG8_MMA(ai, bj, At, Bt) do { __builtin_amdgcn_s_setprio(1); if constexpr (ES == 2) { _Pragma("unroll") for (int m = 0; m < 4; ++m) _Pragma("unroll") for (int n = 0; n < 2; ++n) _Pragma("unroll") for (int k = 0; k < 2; ++k) \
        acc[ai][bj][m][n] = __builtin_amdgcn_mfma_f32_16x16x32_bf16(Bt[n][k], At[m][k], acc[ai][bj][m][n], 0, 0, 0); } else { _Pragma("unroll") for (int m = 0; m < 4; ++m) _Pragma("unroll") for (int n = 0; n < 2; ++n) \
        asm volatile("v_mfma_scale_f32_16x16x128_f8f6f4 %0, %1, %2, %0, %3, %3 op_sel_hi:[0,0,0]" : "+v"(acc[ai][bj][m][n]) : "v"(Bt##8[n]), "v"(At##8[m]), "v"(sc1)); } \
        __builtin_amdgcn_s_setprio(0); } while (0)
#define PG8_WAIT_V(n) asm volatile("s_waitcnt vmcnt(" #n ")" ::: "memory")
#define PG8_WAIT_L(n) asm volatile("s_waitcnt lgkmcnt(" #n ")" ::: "memory")
#define PG8_BAR __builtin_amdgcn_s_barrier()
#define PG8_SCHED __builtin_amdgcn_sched_barrier(0)
#define PG8_ROWOFF(dst, U) do { _Pragma("unroll") for (int _h = 0; _h < 2; ++_h) _Pragma("unroll") for (int _i = 0; _i < 2; ++_i) \
        dst[_h][_i] = (unsigned)g.rowmap[(U).pm * BM + _h * HALF + rA[_i]] * (unsigned)KB + (unsigned)cA2[_i]; } while (0)
    Unit cur, nxt; int ui = 0;
    if (!S.next(0, cur)) return;
    f32x4 acc[2][2][4][2];
#pragma unroll
    for (int a = 0; a < 2; ++a)
#pragma unroll
        for (int b = 0; b < 2; ++b)
#pragma unroll
            for (int m = 0; m < 4; ++m)
#pragma unroll
                for (int n = 0; n < 2; ++n) acc[a][b][m][n] = (f32x4){0.f, 0.f, 0.f, 0.f};
    const int sc1 = 0x7f7f7f7f;
    bf16x8 At[4][2], B0[2][2], B1[2][2]; i32x8 At8[4], B08[2], B18[2];
    const char* cA = (const char*)g.A + (size_t)cur.pm * tstep; const char* cB = (const char*)g.Bt + (size_t)cur.pb * tstep;
    unsigned cO[2][2] = {{0u, 0u}, {0u, 0u}}, nO[2][2] = {{0u, 0u}, {0u, 0u}};
    bool has_next = S.next(1, nxt);
    if constexpr (GATHER) { PG8_ROWOFF(cO, cur); if (has_next) { PG8_ROWOFF(nO, nxt); } else { _Pragma("unroll") for (int h = 0; h < 2; ++h) _Pragma("unroll") for (int i = 0; i < 2; ++i) nO[h][i] = cO[h][i]; } }
    if constexpr (GATHER) {
        PG8_STAGE(PG8_SB(0, 0), cB, voffB); PG8_STAGE(PG8_SB(0, 1), cB + hstep, voffB); PG8_STAGE_G(PG8_SA(0, 0), cO[0][0], cO[0][1], 0); PG8_STAGE_G(PG8_SA(0, 1), cO[1][0], cO[1][1], 0);
        if (wr == 1) PG8_BAR;
        PG8_WAIT_V(2); PG8_BAR;
        PG8_STAGE(PG8_SB(1, 0), cB + kstep, voffB); PG8_STAGE_G(PG8_SA(1, 0), cO[0][0], cO[0][1], kstep); PG8_STAGE(PG8_SB(1, 1), cB + hstep + kstep, voffB);
        PG8_WAIT_V(6); PG8_BAR;
    } else {
        PG8_STAGE(PG8_SB(0, 0), cB, voffB); PG8_STAGE(PG8_SB(0, 1), cB + hstep, voffB); PG8_STAGE(PG8_SA(0, 0), cA, voffA); PG8_STAGE(PG8_SA(0, 1), cA + hstep, voffA);
        if (wr == 1) PG8_BAR;
        PG8_WAIT_V(2); PG8_BAR;
        PG8_STAGE(PG8_SB(1, 0), cB + kstep, voffB); PG8_STAGE(PG8_SA(1, 0), cA + kstep, voffA); PG8_STAGE(PG8_SB(1, 1), cB + hstep + kstep, voffB);
        PG8_WAIT_V(6); PG8_BAR;
    }
    for (;;) {
        const char* nA = has_next ? (const char*)g.A + (size_t)nxt.pm * tstep : cA; const char* nB = has_next ? (const char*)g.Bt + (size_t)nxt.pb * tstep : cB;
#pragma nounroll
        for (int t = 0; t < nt; t += 2) {
            const bool last = (t == nt - 2);
            const char* a1 = cA + (size_t)(t + 1) * kstep;
            const char* a2 = last ? nA : cA + (size_t)(t + 2) * kstep; const char* b2 = last ? nB : cB + (size_t)(t + 2) * kstep;
            const char* a3 = a2 + kstep; const char* b3 = b2 + kstep;
            const size_t k1 = (size_t)(t + 1) * kstep, k2 = last ? 0 : (size_t)(t + 2) * kstep, k3 = k2 + kstep;
            unsigned x00 = 0, x01 = 0, x10 = 0, x11 = 0;
            if constexpr (GATHER) { x00 = last ? nO[0][0] : cO[0][0]; x01 = last ? nO[0][1] : cO[0][1]; x10 = last ? nO[1][0] : cO[1][0]; x11 = last ? nO[1][1] : cO[1][1]; }
            if constexpr (Epi::HAS_MID) { if (t == nt / 2) E.mid(acc, cur, wr, wc, fr, fq); }
            PG8_LDB(B0, 0, 0); PG8_LDB(B1, 0, 1); PG8_SCHED; PG8_LDA(At, 0, 0);
            if constexpr (GATHER) PG8_STAGE_G(PG8_SA(1, 1), cO[1][0], cO[1][1], k1); else PG8_STAGE(PG8_SA(1, 1), a1 + hstep, voffA);
            PG8_WAIT_V(8); PG8_WAIT_L(0); PG8_BAR; PG8_MMA(0, 0, At, B0); PG8_MMA(0, 1, At, B1); PG8_BAR; PG8_SCHED;
            PG8_LDA(At, 0, 1); PG8_STAGE(PG8_SB(0, 0), b2, voffB); PG8_STAGE(PG8_SB(0, 1), b2 + hstep, voffB);
            if constexpr (GATHER) PG8_STAGE_G(PG8_SA(0, 0), x00, x01, k2); else PG8_STAGE(PG8_SA(0, 0), a2, voffA);
            PG8_WAIT_V(8); PG8_WAIT_L(0); PG8_BAR; PG8_MMA(1, 0, At, B0); PG8_MMA(1, 1, At, B1); PG8_BAR; PG8_SCHED;
            PG8_LDB(B0, 1, 0); PG8_LDB(B1, 1, 1); PG8_SCHED; PG8_LDA(At, 1, 0);
            if constexpr (GATHER) PG8_STAGE_G(PG8_SA(0, 1), x10, x11, k2); else PG8_STAGE(PG8_SA(0, 1), a2 + hstep, voffA);
            PG8_WAIT_V(8); PG8_WAIT_L(0); PG8_BAR; PG8_MMA(0, 0, At, B0); PG8_MMA(0, 1, At, B1); PG8_BAR; PG8_SCHED;
            PG8_LDA(At, 1, 1); PG8_STAGE(PG8_SB(1, 0), b3, voffB); PG8_STAGE(PG8_SB(1, 1), b3 + hstep, voffB);
            if constexpr (GATHER) PG8_STAGE_G(PG8_SA(1, 0), x00, x01, k3); else PG8_STAGE(PG8_SA(1, 0), a3, voffA);
            PG8_WAIT_V(8); PG8_WAIT_L(0); PG8_BAR; PG8_MMA(1, 0, At, B0); PG8_MMA(1, 1, At, B1); PG8_BAR; PG8_SCHED;
        }
        if constexpr (ES == 1) asm volatile("s_nop 15\n\ts_nop 15" ::: "memory");
        asm volatile("" : "+s"(cur.pm), "+s"(cur.pn), "+s"(cur.pb));
        if (wr == 0) PG8_BAR;
        Unit nn = cur; const bool has_nn = has_next && S.next(ui + 2, nn);
        unsigned tO[2][2] = {{0u, 0u}, {0u, 0u}};
        if constexpr (GATHER) { if (has_nn) { PG8_ROWOFF(tO, nn); } }
        E(acc, cur, wr, wc, fr, fq);
        if (!has_next) break;
#pragma unroll
        for (int a = 0; a < 2; ++a)
#pragma unroll
            for (int b = 0; b < 2; ++b)
#pragma unroll
                for (int m = 0; m < 4; ++m)
#pragma unroll
                    for (int n = 0; n < 2; ++n) acc[a][b][m][n] = (f32x4){0.f, 0.f, 0.f, 0.f};
        if constexpr (GATHER) {
#pragma unroll
            for (int h = 0; h < 2; ++h)
#pragma unroll
                for (int i = 0; i < 2; ++i) { cO[h][i] = nO[h][i]; nO[h][i] = has_nn ? tO[h][i] : nO[h][i]; } }
        cur = nxt; cA = nA; cB = nB; ++ui; nxt = nn; has_next = has_nn;
        if (wr == 1) PG8_BAR;
    }
    PG8_WAIT_V(0);
    PG8_BAR;
#undef PG8_SA
#undef PG8_SB
#undef PG8_STAGE
#undef PG8_STAGE_G
#undef PG8_LDA
#undef PG8_LDB
#undef PG8_MMA
#undef PG8_CAT8
#undef PG8_WAIT_V
#undef PG8_WAIT_L
#undef PG8_BAR
#undef PG8_SCHED
#undef PG8_ROWOFF
}
}

namespace att {
constexpr float SCALE = 0.08838834764831845f;
constexpr int NW = 8, QBLK = 32, KVBLK = 64, QB = NW * QBLK, D = 128;
constexpr int SHM_V = KVBLK * D * 2, SHM_K = KVBLK * D * 2;
constexpr int LDS_BYTES = 2 * SHM_V + 2 * SHM_K + NW * 64 * 4;
constexpr float THR = 8.f;
#define KSWZ(row, colB) ((row) * 256 + ((colB) ^ (((row) & 7) << 4)))
#define SBAR() __builtin_amdgcn_sched_barrier(0)
__device__ __forceinline__ int v_st(int k, int c) { const int kk = (k & ~0xC) | ((k & 4) << 1) | ((k & 8) >> 1); return ((kk >> 3) * 4 + (c >> 5)) * 512 + ((kk & 7) * 32 + (c & 31)) * 2; }
__device__ __forceinline__ int v_rd_base(int lane) { return ((lane & 3) << 3) | (((lane >> 2) & 3) << 6) | (((lane >> 4) & 1) << 5) | (((lane >> 5) & 1) << 8); }
constexpr int v_rd_off(int d0, int ks, int half) { return d0 * 512 + ks * 4096 + half * 2048; }
__device__ __forceinline__ int crow(int r, int hi) { return (r & 3) + 8 * (r >> 2) + 4 * hi; }
__device__ __forceinline__ unsigned cvtpk(float lo, float hi) { return cvt_pk_bf16(lo, hi); }
__device__ __forceinline__ bf16x8 load8(const bf16* p) { return *reinterpret_cast<const bf16x8*>(p); }
__device__ __forceinline__ void mask_tile(f32x16& p0, f32x16& p1, int dq, unsigned W) {
    const float NEG = -__builtin_inff();
#pragma unroll
    for (int r = 0; r < 16; ++r) {
        const int c = (r & 3) + 8 * (r >> 2);
        if ((unsigned)(dq - c) >= W) p0[r] = NEG;
        if ((unsigned)(dq - c - 32) >= W) p1[r] = NEG;
    }
}
__device__ __forceinline__ void partialSM(f32x16& p0, f32x16& p1, float& m_reg, float& mn, float& alpha) {
    float pmax = p0[0]; for (int r = 1; r < 16; ++r) pmax = fmaxf(pmax, p0[r]); for (int r = 0; r < 16; ++r) pmax = fmaxf(pmax, p1[r]);
    { auto rr = __builtin_amdgcn_permlane32_swap(__float_as_uint(pmax), __float_as_uint(pmax), false, false);
      pmax = fmaxf(__uint_as_float(rr[0]), __uint_as_float(rr[1])); }
    constexpr float C2 = 1.4426950408889634f * SCALE;
    if (__builtin_expect(__all((pmax - m_reg) * SCALE <= THR), 1)) { mn = m_reg; alpha = 1.f; }
    else { mn = fmaxf(m_reg, pmax); alpha = __builtin_amdgcn_exp2f((m_reg - mn) * C2); m_reg = mn; }
    const float mnL = -mn * C2;
    for (int r = 0; r < 16; ++r) p0[r] = fmaf(p0[r], C2, mnL); for (int r = 0; r < 16; ++r) p1[r] = fmaf(p1[r], C2, mnL);
    for (int r = 0; r < 16; ++r) p0[r] = __builtin_amdgcn_exp2f(p0[r]);
}
__device__ __forceinline__ void finishSM(f32x16& p0, f32x16& p1, float alpha, float& l_reg, bf16x8& pa0, bf16x8& pa1, bf16x8& pa2, bf16x8& pa3) {
    for (int r = 0; r < 16; ++r) p1[r] = __builtin_amdgcn_exp2f(p1[r]);
    float ps = 0; for (int r = 0; r < 16; ++r) ps += p0[r]; for (int r = 0; r < 16; ++r) ps += p1[r];
    { auto rr = __builtin_amdgcn_permlane32_swap(__float_as_uint(ps), __float_as_uint(ps), false, false);
      ps = __uint_as_float(rr[0]) + __uint_as_float(rr[1]); }
    l_reg = l_reg * alpha + ps;
#define PK4(P, B_, OUT) do { unsigned a0 = cvtpk(P[B_+0], P[B_+1]), a1 = cvtpk(P[B_+2], P[B_+3]);                          \
        unsigned b0 = cvtpk(P[B_+4], P[B_+5]), b1 = cvtpk(P[B_+6], P[B_+7]);                                             \
        auto r0 = __builtin_amdgcn_permlane32_swap(a0, b0, false, false); auto r1 = __builtin_amdgcn_permlane32_swap(a1, b1, false, false); \
        u32x4 w = {r0[0], r1[0], r0[1], r1[1]}; OUT = *reinterpret_cast<bf16x8*>(&w); } while (0)
    PK4(p0, 0, pa0); PK4(p0, 8, pa1); PK4(p1, 0, pa2); PK4(p1, 8, pa3);
#undef PK4
}
template <int KB, bool SK>
__device__ __forceinline__ void qkt(f32x16& p0, f32x16& p1, const char* K_lds, int r32, int hi, const bf16x8* qr, bool act) {
    if (SK && !act) { const float NEG = -__builtin_inff();
#pragma unroll
        for (int r = 0; r < 16; ++r) { p0[r] = NEG; p1[r] = NEG; } return; }
    p0 = f32x16{}; p1 = f32x16{};
    const char* kb[4];
#pragma unroll
    for (int dd = 0; dd < 4; ++dd) kb[dd] = K_lds + KB * SHM_K + KSWZ(r32, (dd * 16 + hi * 8) * 2);
#pragma unroll
    for (int d0 = 0; d0 < 8; ++d0) { const char* a = kb[d0 & 3] + (d0 >> 2) * 128;
        bf16x8 b0 = *reinterpret_cast<const bf16x8*>(a);
        bf16x8 b1 = *reinterpret_cast<const bf16x8*>(a + 32 * 256);
        p0 = __builtin_amdgcn_mfma_f32_32x32x16_bf16(b0, qr[d0], p0, 0, 0, 0);
        p1 = __builtin_amdgcn_mfma_f32_32x32x16_bf16(b1, qr[d0], p1, 0, 0, 0); }
}
template <int VB, bool SK>
__device__ __forceinline__ void pv_tile(f32x16* o, int vb0, bf16x8 pa0, bf16x8 pa1, bf16x8 pa2, bf16x8 pa3, bool act) {
    if (SK && !act) return;
#define TRRD(dst, off) asm volatile("ds_read_b64_tr_b16 %0, %1 offset:%2" : "=&v"(dst) : "v"(vb0), "i"(off) : "memory")
#define PV_D0(d0) do { s16x4 l0, l1, l2, l3, h0, h1, h2, h3; constexpr int b_ = VB * SHM_V + v_rd_off(d0, 0, 0); \
        TRRD(l0, b_); TRRD(h0, b_ + 2048); TRRD(l1, b_ + 4096); TRRD(h1, b_ + 6144); TRRD(l2, b_ + 8192); TRRD(h2, b_ + 10240); TRRD(l3, b_ + 12288); TRRD(h3, b_ + 14336); \
        asm volatile("s_waitcnt lgkmcnt(0)" ::: "memory"); SBAR();   \
        o[d0] = __builtin_amdgcn_mfma_f32_32x32x16_bf16(pa0, (bf16x8){l0[0], l0[1], l0[2], l0[3], h0[0], h0[1], h0[2], h0[3]}, o[d0], 0, 0, 0);   \
        o[d0] = __builtin_amdgcn_mfma_f32_32x32x16_bf16(pa1, (bf16x8){l1[0], l1[1], l1[2], l1[3], h1[0], h1[1], h1[2], h1[3]}, o[d0], 0, 0, 0);   \
        o[d0] = __builtin_amdgcn_mfma_f32_32x32x16_bf16(pa2, (bf16x8){l2[0], l2[1], l2[2], l2[3], h2[0], h2[1], h2[2], h2[3]}, o[d0], 0, 0, 0);   \
        o[d0] = __builtin_amdgcn_mfma_f32_32x32x16_bf16(pa3, (bf16x8){l3[0], l3[1], l3[2], l3[3], h3[0], h3[1], h3[2], h3[3]}, o[d0], 0, 0, 0); } while (0)
    PV_D0(0); PV_D0(1); PV_D0(2); PV_D0(3);
#undef PV_D0
#undef TRRD
}
struct BlockRef { bf16* Q; const bf16* K; float* L; int P0, qs, ks, ls, skv; };
struct Seam { bf16x8 qr[8]; bf16x8 st_v0, st_v1, st_k0, st_k1; };
__device__ __forceinline__ int swa_jlo(int P0, int W) { const int lowk = P0 - W + 1; return lowk > 0 ? lowk / KVBLK : 0; }
#define ROW(p, KS_, k0, rr) ((p) + (size_t)((k0) + (rr)) * (KS_) + sc)
#define VMW() asm volatile("s_waitcnt vmcnt(0)" ::: "memory")
#define VMWN(n) asm volatile("s_waitcnt vmcnt(%0)" :: "i"(n) : "memory")
#define SLOAD_H(Kp, Vp, KS_, k0) do { S.st_v0 = load8(ROW(Vp, KS_, k0, sr)); S.st_v1 = load8(ROW(Vp, KS_, k0, 32 + sr));              \
                         S.st_k0 = load8(ROW(Kp, KS_, k0, sr)); S.st_k1 = load8(ROW(Kp, KS_, k0, 32 + sr)); } while (0)
#define SWRITE_HK(bf) do { *(bf16x8*)(K_lds + (bf) * SHM_K + kws) = S.st_k0; *(bf16x8*)(K_lds + (bf) * SHM_K + kws + 32 * 256) = S.st_k1; } while (0)
#define SWRITE_HV(bf) do { *(bf16x8*)(V_lds + (bf) * SHM_V + vst0) = S.st_v0; *(bf16x8*)(V_lds + (bf) * SHM_V + vst1) = S.st_v1; } while (0)
#define SWRITE_H(bf) do { SWRITE_HV(bf); SWRITE_HK(bf); } while (0)
template <long VOFF>
__device__ __forceinline__ void prime(const BlockRef& cur, int W, char* lds, Seam& S) {
    const int tid = threadIdx.x, wid = __builtin_amdgcn_readfirstlane(tid >> 6), lane = tid & 63, r32 = lane & 31, hi = lane >> 5;
    const int sr = tid >> 4, sc = (tid & 15) * 8, kws = KSWZ(sr, sc * 2); char* K_lds = lds + 2 * SHM_V;
    const int kb0 = swa_jlo(cur.P0, W) * KVBLK;
    for (int d0 = 0; d0 < 8; ++d0) S.qr[d0] = load8(cur.Q + (size_t)(wid * QBLK + r32) * cur.qs + d0 * 16 + hi * 8);
    SLOAD_H(cur.K, cur.K + VOFF, cur.ks, kb0); VMW(); SWRITE_HK(0);
    __syncthreads();
}
template <bool SK, long VOFF>
__device__ __forceinline__ void block(const BlockRef& cur, const BlockRef& nxt, int W, char* lds, Seam& S) {
    const int tid = threadIdx.x, wid = __builtin_amdgcn_readfirstlane(tid >> 6), lane = tid & 63, r32 = lane & 31, hi = lane >> 5;
    const int skv = cur.skv;
    const int j_lo = swa_jlo(cur.P0, W);
    int j_hi = (cur.P0 + QB - 1) / KVBLK + 1; if (j_hi > skv / KVBLK) j_hi = skv / KVBLK;
    const int NT = j_hi - j_lo;
    const int kbn = swa_jlo(nxt.P0, W) * KVBLK;
    const int qlo = cur.P0 + wid * QBLK, qm = qlo + r32 - 4 * hi;
    char* V_lds = lds; char* K_lds = lds + 2 * SHM_V;
    float* ws = (float*)(lds + 2 * SHM_V + 2 * SHM_K) + wid * 64; float* li_l = ws, * al_l = ws + 32;
    float m_reg = -1e30f, l_reg = 0; f32x16 o[4] = {};
    const int sr = tid >> 4, sc = (tid & 15) * 8, vst0 = v_st(sr, sc), vst1 = v_st(32 + sr, sc), kws = KSWZ(sr, sc * 2);
    const int vb0 = (int)(uintptr_t)V_lds + v_rd_base(lane);
    const bf16* Kh = cur.K; const bf16* Vh = cur.K + VOFF; const int KS = cur.ks;
#define RESC(a) do { if (__any((a) < 1.f)) { if (hi == 0) al_l[r32] = (a); asm volatile("s_waitcnt lgkmcnt(0)" ::: "memory");              \
                     for (int d_ = 0; d_ < 4; ++d_) for (int r = 0; r < 16; ++r) o[d_][r] *= al_l[crow(r, hi)]; } } while (0)
#define KBASE(t) ((j_lo + (t)) * KVBLK)
#define ACT(t) (KBASE(t) <= qlo + QBLK - 1 && KBASE(t) + KVBLK - 1 >= qlo - W + 1)
#define MASKT(P0_, P1_, t) do { const int kb_ = KBASE(t); if ((!SK || ACT(t)) && (kb_ + KVBLK - 1 > qlo || kb_ <= qlo + QBLK - 1 - W)) mask_tile(P0_, P1_, qm - kb_, (unsigned)W); } while (0)
    constexpr int NQL = 8;
#define SEAM_K0() do { VMWN(NQL); SWRITE_HK(0); SBAR(); } while (0)
    f32x16 pA0, pA1, pB0, pB1; float mnA, mnB, alA, alB; bf16x8 pa0, pa1, pa2, pa3;
    SWRITE_HV(0); SBAR();
    if (NT > 1) { SLOAD_H(Kh, Vh, KS, KBASE(1)); }
    SBAR(); qkt<0, SK>(pA0, pA1, K_lds, r32, hi, S.qr, ACT(0));
    MASKT(pA0, pA1, 0); partialSM(pA0, pA1, m_reg, mnA, alA);
    if (NT > 1) { VMW(); SWRITE_H(1); }
    __syncthreads();
#define HALF_STEP(PX0, PX1, mnX, alX, PY0, PY1, alY, t, KB, VB, SB) do {                                                      \
        SBAR(); qkt<KB, SK>(PX0, PX1, K_lds, r32, hi, S.qr, ACT(t));                                             \
        finishSM(PY0, PY1, alY, l_reg, pa0, pa1, pa2, pa3); SBAR();                                                           \
        if ((t) + 1 < NT) { SLOAD_H(Kh, Vh, KS, KBASE((t) + 1)); SBAR(); }                                               \
        pv_tile<VB, SK>(o, vb0, pa0, pa1, pa2, pa3, ACT((t) - 1)); MASKT(PX0, PX1, (t)); partialSM(PX0, PX1, m_reg, mnX, alX);                                        \
        __syncthreads();                                                                                                      \
        if ((t) + 1 < NT) { VMW(); SWRITE_H(SB); }                                                                          \
        RESC(alX); __syncthreads(); } while (0)
    for (int t = 1; t + 1 < NT; t += 2) {
        HALF_STEP(pB0, pB1, mnB, alB, pA0, pA1, alA, t, 1, 0, 0);
        HALF_STEP(pA0, pA1, mnA, alA, pB0, pB1, alB, t + 1, 0, 1, 1);
    }
    const bool even = (NT & 1) == 0;
    if (even) { SBAR(); qkt<1, SK>(pB0, pB1, K_lds, r32, hi, S.qr, ACT(NT - 1)); SBAR(); }
    { SLOAD_H(nxt.K, nxt.K + VOFF, nxt.ks, kbn); SBAR();
#pragma unroll
      for (int d0 = 0; d0 < 8; ++d0) S.qr[d0] = load8(nxt.Q + (size_t)(wid * QBLK + r32) * nxt.qs + d0 * 16 + hi * 8); }
    SBAR();
    finishSM(pA0, pA1, alA, l_reg, pa0, pa1, pa2, pa3); SBAR();
    pv_tile<0, SK>(o, vb0, pa0, pa1, pa2, pa3, ACT(even ? NT - 2 : NT - 1));
    if (even) { MASKT(pB0, pB1, NT - 1); partialSM(pB0, pB1, m_reg, mnB, alB); __syncthreads(); RESC(alB);
        finishSM(pB0, pB1, alB, l_reg, pa0, pa1, pa2, pa3); SBAR(); pv_tile<1, SK>(o, vb0, pa0, pa1, pa2, pa3, ACT(NT - 1)); }
    SBAR(); SEAM_K0();
    if (hi == 0) li_l[r32] = l_reg; asm volatile("s_waitcnt lgkmcnt(0)" ::: "memory");
    if (cur.L != nullptr && hi == 0) cur.L[(size_t)(wid * QBLK + r32) * cur.ls] = m_reg * SCALE + __logf(l_reg);
    float rli[16];
#pragma unroll
    for (int r = 0; r < 16; ++r) rli[r] = __builtin_amdgcn_rcpf(li_l[crow(r, hi)]);
    bf16* Op = cur.Q + (size_t)(wid * QBLK + 4 * hi) * cur.qs + r32; const size_t qstep = (size_t)cur.qs;
#pragma unroll
    for (int r = 0; r < 16; ++r) {
        asm volatile("" : "+v"(Op));
#pragma unroll
        for (int d0 = 0; d0 < 4; ++d0) { const float v = o[d0][r] * rli[r];
            const float vn = __shfl_xor(v, 1);
            if ((r32 & 1) == 0) *(unsigned*)(Op + d0 * 32) = cvtpk(v, vn); }
        Op += ((r & 3) == 3) ? 5 * qstep : qstep; }
    __syncthreads();
#undef RESC
#undef KBASE
#undef ACT
#undef MASKT
#undef SEAM_K0
#undef HALF_STEP
}
#undef ROW
#undef VMW
#undef VMWN
#undef SLOAD_H
#undef SWRITE_HK
#undef SWRITE_HV
#undef SWRITE_H
#undef KSWZ
}

constexpr int NWAVES = 8, NTHR = 512;
constexpr int M = 65536, DM = 1024, SEQ = 8192, NBATCH = 8;
constexpr int N1 = 6144;
constexpr int ROPE_POS = 9216;
constexpr float EPS = 1e-5f;
constexpr int NEXP = 32, HALF_TOK = 32768, RT_CAP = 139264;
constexpr int MAXBLK = 544;
constexpr int NPH = 19;
#ifndef MK_REPS
#define MK_REPS 1
#endif
#ifndef MK_PROBE
#define MK_PROBE 0
#define PROBE_A 0
#define PROBE_K 1
#endif
#ifndef MK_DIAG
#define MK_DIAG 0
#endif
#ifndef MK_PER_PHASE
#define MK_PER_PHASE 0
#endif

constexpr size_t MiB = 1u << 20;
constexpr size_t WS_CTL = 0, CTL_ZERO_BYTES = 1 * MiB;
constexpr size_t WS_WIN = 1 * MiB, WS_WGATE = 14 * MiB, WS_WBG = 18 * MiB, WS_WBD = 19 * MiB, WS_WMIX = 20 * MiB, WS_WXQ = 22 * MiB, WS_WXKV = 23 * MiB, WS_WXO = 25 * MiB, WS_WR = 26 * MiB;
constexpr size_t WS_ROPE = 27 * MiB, WS_MEMN = 32 * MiB, WS_KVM = 36 * MiB, WS_DECAY = 40 * MiB;
constexpr size_t WS_TOPE = 41 * MiB, WS_TGATE = 42 * MiB, WS_TSLOT = 43 * MiB, WS_RTOK = 44 * MiB, WS_RGATE = 46 * MiB;
constexpr size_t WS_RRS = 47 * MiB + 512 * 1024, WS_RSTD3 = 48 * MiB + 768 * 1024;
constexpr size_t WS_A = 49 * MiB;
constexpr size_t WS_QG = 177 * MiB, WS_KG = 209 * MiB, WS_VG = 241 * MiB, WS_RG = 305 * MiB, WS_ALR = 369 * MiB, WS_LSE = 373 * MiB;
constexpr size_t WS_QD = 376 * MiB, WS_KD = 568 * MiB, WS_VD = 760 * MiB, WS_A8 = 952 * MiB, WS_WIN8 = 1016 * MiB, WS_END = 1021 * MiB;
constexpr size_t WS_GATES = WS_KD, WS_MERGED = 824 * MiB;
constexpr size_t WS_QX = WS_QD;
constexpr size_t WS_WGU = 177 * MiB, WS_WDN = 920 * MiB, WS_H2F8 = 273 * MiB;
constexpr float W8_SCALE = 64.f, W8_INV = 1.f / 64.f;
constexpr size_t WS_H = 376 * MiB, WS_H1 = 512 * MiB, WS_Y = 648 * MiB, WS_Y1 = 177 * MiB;
static_assert(WS_RGATE + 2 * (size_t)RT_CAP * 4 <= WS_RRS && WS_RRS + 2 * (size_t)RT_CAP * 4 <= WS_RSTD3 && WS_RSTD3 + (size_t)M * 4 <= WS_A, "ws map (row tables)");
static_assert(WS_Y + (size_t)RT_CAP * 2048 <= WS_WDN && WS_WDN + 32 * MiB <= WS_A8 && WS_H + (size_t)RT_CAP * 1024 <= WS_H1 && WS_H1 + (size_t)RT_CAP * 1024 <= WS_Y && WS_Y1 + (size_t)RT_CAP * 2048 <= WS_H1 && WS_RTOK + 2 * (size_t)RT_CAP * 4 <= WS_RGATE && WS_RGATE + 2 * (size_t)RT_CAP * 4 <= WS_A, "ws map");
constexpr size_t DO_OGD = 0, DO_ST = 128 * MiB;
constexpr int CW_BAR = 4096, CW_CNT = 8192, CW_CUR = 8320;
constexpr int RING_BYTES = 131072, MISC_OFF = RING_BYTES, TAB_OFF = RING_BYTES + 1024, LDS_BYTES = 147456;

#define XB_TMO      128
#define XB_XCNT(j)  (256  + 64 * (j))
#define XB_XSUB(j)  (1280 + 64 * (j))
#define XB_XGEN(j)  (2304 + 64 * (j))
#define XB_TOP      3328
#define XB_TOPGEN   3392
#define XCD_BAR_WORDS 3456
#define XB_SPIN_CAP (1u << 18)
__device__ __forceinline__ unsigned xb_ld(unsigned* p)              { return __hip_atomic_load(p, __ATOMIC_RELAXED, __HIP_MEMORY_SCOPE_AGENT); }
__device__ __forceinline__ unsigned xb_add(unsigned* p, unsigned v) { return __hip_atomic_fetch_add(p, v, __ATOMIC_RELAXED, __HIP_MEMORY_SCOPE_AGENT); }
__device__ __forceinline__ unsigned xb_xcc_id() { return (unsigned)__builtin_amdgcn_s_getreg((3 << 11) | 20) & 0xFu; }
#define XB_SPIN(cond, bar) do { unsigned _sp = 0; while (cond) { __builtin_amdgcn_s_sleep(1); \
    if ((++_sp & 255u) == 0u) { if (xb_ld(&(bar)[XB_TMO])) break; if (_sp > XB_SPIN_CAP) { atomicAdd(&(bar)[XB_TMO], 1u); break; } } } } while (0)
struct XcdBarrier { unsigned* bar; unsigned x; volatile LAS unsigned* st; };
__device__ __forceinline__ XcdBarrier xcd_barrier_post(unsigned* bar, volatile LAS unsigned* st) {
    XcdBarrier b; b.bar = bar; b.x = xb_xcc_id(); b.st = st;
    if (threadIdx.x == 0) (void)xb_add(&bar[XB_XCNT(b.x)], 1u);
    return b;
}
__device__ __forceinline__ void xcd_barrier_complete(unsigned* bar, unsigned x, unsigned& nloc, unsigned& nx) {
    const unsigned G = gridDim.x * gridDim.y * gridDim.z;
    unsigned sum, cnt, mine, sp = 0u;
    for (;;) {
        sum = 0u; cnt = 0u; mine = 0u;
#pragma unroll
        for (unsigned j = 0; j < 16; ++j) { const unsigned c = xb_ld(&bar[XB_XCNT(j)]); sum += c; cnt += (c > 0u) ? 1u : 0u; mine = (j == x) ? c : mine; }
        if (sum == G) break;
        __builtin_amdgcn_s_sleep(1);
        if ((++sp & 255u) == 0u) { if (xb_ld(&bar[XB_TMO])) break; if (sp > XB_SPIN_CAP) { atomicAdd(&bar[XB_TMO], 1u); break; } }
    }
    nloc = mine > 0u ? mine : 1u; nx = cnt > 0u ? cnt : 1u;
}
__device__ __forceinline__ void xcd_barrier(const XcdBarrier& b) {
    asm volatile("s_waitcnt vmcnt(0)" ::: "memory");
    __syncthreads();
    if (threadIdx.x == 0) {
        unsigned* bar = b.bar;
        __builtin_amdgcn_s_waitcnt(0);
        unsigned nloc = b.st[0], nx = b.st[1];
        if (nloc == 0u) { xcd_barrier_complete(bar, b.x, nloc, nx); b.st[0] = nloc; b.st[1] = nx; }
        const unsigned old = xb_add(&bar[XB_XSUB(b.x)], 1u);
        const unsigned gen = old / nloc;
        if (old + 1u == (gen + 1u) * nloc) {
            __builtin_amdgcn_fence(__ATOMIC_RELEASE, "agent");
            asm volatile("s_waitcnt vmcnt(0)" ::: "memory");
            const unsigned og = xb_add(&bar[XB_TOP], 1u);
            const unsigned tg = og / nx;
            if (og + 1u == (tg + 1u) * nx) xb_add(&bar[XB_TOPGEN], 1u);
            else XB_SPIN(xb_ld(&bar[XB_TOPGEN]) == tg, bar);
            __builtin_amdgcn_fence(__ATOMIC_ACQUIRE, "agent");
            xb_add(&bar[XB_XGEN(b.x)], 1u);
            asm volatile("s_waitcnt vmcnt(0)" ::: "memory");
        } else {
            XB_SPIN(xb_ld(&bar[XB_XGEN(b.x)]) == gen, bar);
            __builtin_amdgcn_fence(__ATOMIC_ACQUIRE, "agent");
            asm volatile("s_waitcnt vmcnt(0)" ::: "memory");
        }
    }
    __syncthreads();
}

struct Frame {
    LAS unsigned char* lds; char* ldsg;
    unsigned* ctl; unsigned char* ws; unsigned char* dout;
    int tid, lane, wave, G, bid;
};
struct Args { const void* in[28]; float* out; unsigned char* ws; int ph_lo, ph_hi; };
#define INP(k) ((const float*)A.in[k])
#define LDS_WAIT() asm volatile("s_waitcnt lgkmcnt(0)" ::: "memory")
__device__ __forceinline__ float wave_sum(float v) {
#pragma unroll
    for (int o = 1; o < 64; o <<= 1) v += __shfl_xor(v, o);
    return v;
}
template <class RM, bool F8 = false>
__device__ __forceinline__ void transpose_item(const float* W, int K, int N, bf16* WT, const RM& rm, LAS float* scr, int item, int lane, const float* kgain = nullptr, int dpitch = 0, int doff = 0, int ncount = 0) {
    const int NC = ncount ? ncount : N;
    const int nblk = (NC + 31) / 32, kb = item / nblk, nb = item % nblk, k0 = 64 * kb, n0 = 32 * nb;
    const int ncol = n0 + (lane & 31);
    float tv[32];
    { const float* wp = W + (size_t)(k0 + (lane >> 5)) * N + (ncol < NC ? ncol : 0);
#pragma unroll
      for (int i = 0; i < 32; ++i) tv[i] = wp[(size_t)(2 * i) * N]; }
#pragma unroll
    for (int i = 0; i < 32; ++i) { const int kk = 2 * i + (lane >> 5); scr[kk * 33 + (lane & 31)] = ncol < NC ? (kgain ? tv[i] * kgain[k0 + kk] : tv[i]) : 0.f; }
    LDS_WAIT(); asm volatile("" ::: "memory");
    const int c = lane & 7;
#pragma unroll
    for (int j = 0; j < 4; ++j) { const int n = (lane >> 3) + 8 * j; const LAS float* s = scr + (8 * c) * 33 + n;
        const int dr = (n0 + n < NC) ? rm(n0 + n) : -1;
        if constexpr (F8) { const f32x4 a = {s[0 * 33] * W8_SCALE, s[1 * 33] * W8_SCALE, s[2 * 33] * W8_SCALE, s[3 * 33] * W8_SCALE}, b = {s[4 * 33] * W8_SCALE, s[5 * 33] * W8_SCALE, s[6 * 33] * W8_SCALE, s[7 * 33] * W8_SCALE};
            if (dr >= 0) *(u32x2*)((unsigned char*)WT + (size_t)dr * (dpitch ? dpitch : K) + doff + k0 + 8 * c) = pack8_fp8(a, b); }
        else { u32x4 o; o.x = cvt_pk_bf16(s[0 * 33], s[1 * 33]); o.y = cvt_pk_bf16(s[2 * 33], s[3 * 33]); o.z = cvt_pk_bf16(s[4 * 33], s[5 * 33]); o.w = cvt_pk_bf16(s[6 * 33], s[7 * 33]);
            if (dr >= 0) *(u32x4*)(WT + (size_t)dr * (dpitch ? dpitch : K) + doff + k0 + 8 * c) = o; } }
    LDS_WAIT(); asm volatile("" ::: "memory");
}
struct RmId { int off; __device__ int operator()(int n) const { return off + n; } };
struct RmWin { __device__ int operator()(int n) const {
    if (n < 1536) return n;
    if (n < 1552) return -1;
    if (n < 4624) { const int j = n - 1552, seg = j / 1536, jj = j % 1536, hd = jj >> 7, i = jj & 127; return 1536 + seg * 1536 + hd * 128 + ((i < 64) ? 2 * i : 2 * (i - 64) + 1); }
    return 4608 + (n - 4624); } };
struct RmWin8 { __device__ int operator()(int j) const { if (j >= 3072) return j; const int seg = j / 1536, jj = j % 1536, hd = jj >> 7, i = jj & 127; return seg * 1536 + hd * 128 + ((i < 64) ? 2 * i : 2 * (i - 64) + 1); } };
struct RmGate { __device__ int operator()(int n) const { return ((n & 1023) >> 7) * 256 + (n >> 10) * 128 + (n & 127); } };
struct RmGU { int base; __device__ int operator()(int n) const { return base + (n >> 7) * 256 + (n & 127); } };

template <int NR>
__device__ __forceinline__ void rms_rows_to_bf16(const float* xrow, const float* g, bf16* orow, int lane, unsigned char* orow8 = nullptr) {
    f32x4 v[NR][4];
#pragma unroll
    for (int r = 0; r < NR; ++r) { const f32x4* xr = (const f32x4*)(xrow + (size_t)r * DM) + lane;
#pragma unroll
        for (int j = 0; j < 4; ++j) v[r][j] = xr[64 * j]; }
    const f32x4* gr = (const f32x4*)g + lane; f32x4 gg[4];
#pragma unroll
    for (int j = 0; j < 4; ++j) gg[j] = gr[64 * j];
#pragma unroll
    for (int r = 0; r < NR; ++r) { float s = 0.f;
#pragma unroll
        for (int j = 0; j < 4; ++j) s += (v[r][j].x * v[r][j].x + v[r][j].y * v[r][j].y) + (v[r][j].z * v[r][j].z + v[r][j].w * v[r][j].w);
        const float rstd = 1.f / sqrtf(wave_sum(s) * (1.f / DM) + EPS);
        u32x2* o8 = (u32x2*)(orow + (size_t)r * DM) + lane;
#pragma unroll
        for (int j = 0; j < 4; ++j) { const float y0 = v[r][j].x * rstd * gg[j].x, y1 = v[r][j].y * rstd * gg[j].y, y2 = v[r][j].z * rstd * gg[j].z, y3 = v[r][j].w * rstd * gg[j].w;
            u32x2 w; w.x = cvt_pk_bf16(y0, y1); w.y = cvt_pk_bf16(y2, y3); o8[64 * j] = w;
            if (orow8) { unsigned q = 0; q = __builtin_amdgcn_cvt_pk_fp8_f32(y0, y1, q, false); q = __builtin_amdgcn_cvt_pk_fp8_f32(y2, y3, q, true); ((unsigned*)(orow8 + (size_t)r * DM))[lane + 64 * j] = q; } } }
}

__device__ __forceinline__ void p0_prologue(Frame& F, const Args& A) {
    LAS float* scr = (LAS float*)(F.lds + F.wave * 8448);
    LAS unsigned char* l_wa = F.lds + 69632;
    const int gw = F.bid * NWAVES + F.wave, NGW = F.G * NWAVES;
    unsigned char* ws = F.ws;
    { const float* win = INP(4);
      for (int i = F.tid; i < 16 * 1024; i += NTHR) { const int k = i >> 4, j = i & 15; *(LAS bf16*)(l_wa + j * 2048 + ((((k >> 3) ^ j) << 4) | ((k & 7) << 1))) = (bf16)f2bf(win[(size_t)k * 6160 + 1536 + j]); } }
    __syncthreads();
    constexpr int I_IN = 16 * 48, I_IN8 = 16 * 144, I_GATE = 16 * 64, I_BG = 8 * 32, I_MIX = 16 * 32, I_XQ = 16 * 16, I_XKV = 16 * 32, I_XO = 8 * 32;
    constexpr int NIT = I_IN + I_IN8 + I_GATE + 2 * I_BG + I_MIX + I_XQ + I_XKV + I_XO;
    for (int it = gw; it < NIT; it += NGW) {
        int r = it;
        if (r < I_IN) { transpose_item(INP(4), 1024, 6160, (bf16*)(ws + WS_WIN), RmId{0}, scr, r, F.lane, nullptr, 0, 0, 1536); continue; } r -= I_IN;
        if (r < I_IN8) { transpose_item<RmWin8, true>(INP(4) + 1552, 1024, 6160, (bf16*)(ws + WS_WIN8), RmWin8{}, scr, r, F.lane, nullptr, 0, 0, 4608); continue; } r -= I_IN8;
        if (r < I_GATE) { transpose_item<RmGate, true>(INP(10), 1024, 2048, (bf16*)(ws + WS_WGATE), RmGate{}, scr, r, F.lane); continue; } r -= I_GATE;
        if (r < I_BG) { transpose_item(INP(8), 512, 1024, (bf16*)(ws + WS_WBG), RmId{0}, scr, r, F.lane, nullptr, 1024, 0); continue; } r -= I_BG;
        if (r < I_BG) { transpose_item(INP(9), 512, 1024, (bf16*)(ws + WS_WBG), RmId{0}, scr, r, F.lane, nullptr, 1024, 512); continue; } r -= I_BG;
        if (r < I_MIX) { transpose_item(INP(12), 1024, 1024, (bf16*)(ws + WS_WMIX), RmId{0}, scr, r, F.lane); continue; } r -= I_MIX;
        if (r < I_XQ) { transpose_item<RmId, true>(INP(15), 1024, 512, (bf16*)(ws + WS_WXQ), RmId{0}, scr, r, F.lane, INP(13)); continue; } r -= I_XQ;
        if (r < I_XKV) { transpose_item(INP(16), 1024, 1024, (bf16*)(ws + WS_WXKV), RmId{0}, scr, r, F.lane); continue; } r -= I_XKV;
        transpose_item(INP(17), 512, 1024, (bf16*)(ws + WS_WXO), RmId{0}, scr, r, F.lane);
    }
    const int gt = F.bid * NTHR + F.tid, NGT = F.G * NTHR;
    { bf16* wr = (bf16*)(ws + WS_WR); const float* w = INP(19); const float* g3 = INP(18);
      for (int i = gt; i < NEXP * 1024; i += NGT) { const int e = i >> 10, k = i & 1023; wr[i] = (bf16)f2bf(g3[k] * w[k * NEXP + e]); } }
    { float* tab = (float*)(ws + WS_ROPE);
      for (int i = gt; i < ROPE_POS * 64; i += NGT) { const int pos = i >> 6, fi = i & 63;
          const float inv = (float)exp2(-(double)fi * (13.287712379549449 / 64.0));
          const float ang = (float)pos * inv;
          const double xr = (double)ang * 0.15915494309189535, fr_ = xr - rint(xr);
          const float xf = (float)fr_;
          tab[2 * i] = __builtin_amdgcn_cosf(xf); tab[2 * i + 1] = __builtin_amdgcn_sinf(xf); } }
    for (int m = gw; m < NBATCH * 256; m += NGW) rms_rows_to_bf16<1>(INP(1) + (size_t)m * DM, INP(14), (bf16*)(ws + WS_MEMN) + (size_t)m * DM, F.lane);
    { const int fr = F.lane & 15, fq = F.lane >> 4; float* alr = (float*)(ws + WS_ALR);
      for (int gidx = gw; gidx < M / 16; gidx += NGW) { const size_t row0 = (size_t)gidx * 16; bf16* arow = (bf16*)(ws + WS_A) + row0 * DM;
#pragma unroll
          for (int q = 0; q < 4; ++q) rms_rows_to_bf16<4>(INP(0) + (row0 + 4 * q) * DM, INP(3), arow + (size_t)(4 * q) * DM, F.lane, ws + WS_A8 + (row0 + 4 * q) * DM);
          asm volatile("s_waitcnt vmcnt(0)" ::: "memory");
          f32x4 c = {0.f, 0.f, 0.f, 0.f}; const bf16* ap = arow + (size_t)fr * DM + 8 * fq;
#pragma unroll 8
          for (int kk = 0; kk < 32; ++kk) { const bf16x8 af = *(const bf16x8*)(ap + 32 * kk); const int ch = 4 * kk + fq;
              const bf16x8 bfr = *(const LAS bf16x8*)(l_wa + fr * 2048 + ((ch ^ fr) << 4)); c = __builtin_amdgcn_mfma_f32_16x16x32_bf16(af, bfr, c, 0, 0, 0); }
#pragma unroll
          for (int r = 0; r < 4; ++r) alr[(row0 + 4 * fq + r) * 16 + fr] = c[r]; } }
}

#define EPI_ROWS(ai, m) (u.pm * 256 + wr * 64 + fr + (ai) * 128 + (m) * 16)
__device__ __forceinline__ u32x4 pack8f(const f32x4& a, const f32x4& b) { u32x4 w; w.x = cvt_pk_bf16(a[0], a[1]); w.y = cvt_pk_bf16(a[2], a[3]); w.z = cvt_pk_bf16(b[0], b[1]); w.w = cvt_pk_bf16(b[2], b[3]); return w; }
__device__ __forceinline__ void unpack8f(const u32x4& w, f32x4& a, f32x4& b) { a = (f32x4){bflo(w.x), bfhi(w.x), bflo(w.y), bfhi(w.y)}; b = (f32x4){bflo(w.z), bfhi(w.z), bflo(w.w), bfhi(w.w)}; }

struct EpiProj {
    static constexpr bool PERM = true, HAS_MID = false;
    unsigned char* ws; const int* pos; float asc;
    __device__ __forceinline__ void operator()(const f32x4 (&acc)[2][2][4][2], const pg8::Unit& u, int wr, int wc, int fr, int fq) const {
        const int pn = u.pn, cw = wc * 32 + 8 * fq;
        bf16* base; int ldc, coff; float sc = 1.f; bool rope = false;
        if (pn == 0) { base = (bf16*)(ws + WS_QG); ldc = 256; coff = 0; sc = 0.125f; }
        else if (pn == 1) { base = (bf16*)(ws + WS_KG); ldc = 256; coff = 0; }
        else if (pn < 4) { base = (bf16*)(ws + WS_VG); ldc = 512; coff = (pn - 2) * 256; }
        else if (pn < 6) { base = (bf16*)(ws + WS_RG); ldc = 512; coff = (pn - 4) * 256; }
        else if (pn < 12) { base = (bf16*)(ws + WS_QD); ldc = 1536; coff = (pn - 6) * 256; rope = true; }
        else if (pn < 18) { base = (bf16*)(ws + WS_KD); ldc = 1536; coff = (pn - 12) * 256; rope = true; }
        else { base = (bf16*)(ws + WS_VD); ldc = 1536; coff = (pn - 18) * 256; }
        sc *= asc;
        const float* tab = (const float*)(ws + WS_ROPE);
        if (rope) {
#pragma unroll
            for (int ai = 0; ai < 2; ++ai) { int pp[4]; f32x4 cs[4][2];
#pragma unroll
                for (int m = 0; m < 4; ++m) pp[m] = pos[EPI_ROWS(ai, m)];
#pragma unroll
                for (int m = 0; m < 4; ++m) { int p = pp[m]; p = p < 0 ? 0 : (p >= ROPE_POS ? ROPE_POS - 1 : p); const float* tp = tab + ((size_t)p * 64 + 16 * wc + 4 * fq) * 2; cs[m][0] = *(const f32x4*)tp; cs[m][1] = *(const f32x4*)(tp + 4); }
#pragma unroll
                for (int m = 0; m < 4; ++m) { bf16* rowp = base + (size_t)EPI_ROWS(ai, m) * ldc + coff + cw; const f32x4 cs0 = cs[m][0], cs1 = cs[m][1];
#pragma unroll
                    for (int bj = 0; bj < 2; ++bj) { f32x4 v0 = acc[ai][bj][m][0] * asc, v1 = acc[ai][bj][m][1] * asc;
                        v0 = (f32x4){v0[0] * cs0[0] - v0[1] * cs0[1], v0[1] * cs0[0] + v0[0] * cs0[1], v0[2] * cs0[2] - v0[3] * cs0[3], v0[3] * cs0[2] + v0[2] * cs0[3]};
                        v1 = (f32x4){v1[0] * cs1[0] - v1[1] * cs1[1], v1[1] * cs1[0] + v1[0] * cs1[1], v1[2] * cs1[2] - v1[3] * cs1[3], v1[3] * cs1[2] + v1[2] * cs1[3]};
                        *(u32x4*)(rowp + bj * 128) = pack8f(v0, v1); } }
                asm volatile("" ::: "memory"); }
            return;
        }
#pragma unroll
        for (int ai = 0; ai < 2; ++ai)
#pragma unroll
            for (int m = 0; m < 4; ++m) { bf16* rowp = base + (size_t)EPI_ROWS(ai, m) * ldc + coff + cw;
#pragma unroll
                for (int bj = 0; bj < 2; ++bj) *(u32x4*)(rowp + bj * 128) = pack8f(acc[ai][bj][m][0] * sc, acc[ai][bj][m][1] * sc); }
    }
};
template <int ACT  > struct EpiBf16 {
    static constexpr bool PERM = true, HAS_MID = false;
    bf16* O; int ldc; const float* bias; float scale;
    __device__ __forceinline__ void operator()(const f32x4 (&acc)[2][2][4][2], const pg8::Unit& u, int wr, int wc, int fr, int fq) const {
        const int col0 = u.pn * 256 + wc * 32 + 8 * fq;
        f32x4 bv[2][2];
#pragma unroll
        for (int bj = 0; bj < 2; ++bj)
#pragma unroll
            for (int n = 0; n < 2; ++n) bv[bj][n] = bias ? *(const f32x4*)(bias + col0 + bj * 128 + 4 * n) : (f32x4){0.f, 0.f, 0.f, 0.f};
#pragma unroll
        for (int ai = 0; ai < 2; ++ai)
#pragma unroll
            for (int m = 0; m < 4; ++m) { bf16* rowp = O + (size_t)EPI_ROWS(ai, m) * ldc + col0;
#pragma unroll
                for (int bj = 0; bj < 2; ++bj) { f32x4 v0 = acc[ai][bj][m][0] * scale + bv[bj][0], v1 = acc[ai][bj][m][1] * scale + bv[bj][1];
                    if (ACT == 1) {
#pragma unroll
                        for (int j = 0; j < 4; ++j) { v0[j] = __builtin_amdgcn_rcpf(1.f + __expf(-v0[j])); v1[j] = __builtin_amdgcn_rcpf(1.f + __expf(-v1[j])); } }
                    *(u32x4*)(rowp + bj * 128) = pack8f(v0, v1); } }
    }
};
struct EpiGates {
    static constexpr bool PERM = true, HAS_MID = false;
    bf16* O; const float* bias; float scale;
    __device__ __forceinline__ void operator()(const f32x4 (&acc)[2][2][4][2], const pg8::Unit& u, int wr, int wc, int fr, int fq) const {
        const int c0 = u.pn * 128 + wc * 32 + 8 * fq;
        f32x4 bv[2][2];
#pragma unroll
        for (int bj = 0; bj < 2; ++bj)
#pragma unroll
            for (int n = 0; n < 2; ++n) bv[bj][n] = *(const f32x4*)(bias + bj * 1024 + c0 + 4 * n);
#pragma unroll
        for (int ai = 0; ai < 2; ++ai)
#pragma unroll
            for (int m = 0; m < 4; ++m) { bf16* rowp = O + (size_t)EPI_ROWS(ai, m) * 2048 + c0; f32x4 rt[2], gd[2];
#pragma unroll
                for (int n = 0; n < 2; ++n)
#pragma unroll
                    for (int h = 0; h < 2; ++h) {
                        const f32x2 y1 = (f32x2){acc[ai][0][m][n][2 * h], acc[ai][0][m][n][2 * h + 1]} * scale + (f32x2){bv[0][n][2 * h], bv[0][n][2 * h + 1]}, y2 = (f32x2){acc[ai][1][m][n][2 * h], acc[ai][1][m][n][2 * h + 1]} * scale + (f32x2){bv[1][n][2 * h], bv[1][n][2 * h + 1]};
                        const f32x2 z1 = {fminf(fmaxf(y1.x, -30.f), 30.f), fminf(fmaxf(y1.y, -30.f), 30.f)}, z2 = {fminf(fmaxf(y2.x, -30.f), 30.f), fminf(fmaxf(y2.y, -30.f), 30.f)};
                        const f32x2 t1 = z1 * -1.4426950408889634f, t2 = z2 * -1.4426950408889634f;
                        const f32x2 d1 = (f32x2){__builtin_amdgcn_exp2f(t1.x), __builtin_amdgcn_exp2f(t1.y)} + 1.f, d2 = (f32x2){__builtin_amdgcn_exp2f(t2.x), __builtin_amdgcn_exp2f(t2.y)} + 1.f;
                        const f32x2 dd = d1 * d2, q = {__builtin_amdgcn_rcpf(dd.x), __builtin_amdgcn_rcpf(dd.y)};
                        const f32x2 g2 = q * d1, r = (d2 * d2) * q;
                        rt[n][2 * h] = r.x; rt[n][2 * h + 1] = r.y; gd[n][2 * h] = g2.x; gd[n][2 * h + 1] = g2.y; }
                *(u32x4*)rowp = pack8f(rt[0], rt[1]); *(u32x4*)(rowp + 1024) = pack8f(gd[0], gd[1]); }
    }
};
struct EpiBranchFused {
    static constexpr bool PERM = true, HAS_MID = true;
    bf16* mg; const bf16* gates;
    __device__ __forceinline__ void mid(f32x4 (&acc)[2][2][4][2], const pg8::Unit& u, int wr, int wc, int fr, int fq) const {
        const int col0 = u.pn * 256 + wc * 32 + 8 * fq;
#pragma unroll
        for (int ai = 0; ai < 2; ++ai) { u32x4 rt[4][2];
#pragma unroll
            for (int m = 0; m < 4; ++m) { const size_t row = EPI_ROWS(ai, m);
#pragma unroll
                for (int bj = 0; bj < 2; ++bj) rt[m][bj] = *(const u32x4*)(gates + row * 2048 + col0 + bj * 128); }
#pragma unroll
            for (int m = 0; m < 4; ++m)
#pragma unroll
                for (int bj = 0; bj < 2; ++bj) { f32x4 a0, a1; unpack8f(rt[m][bj], a0, a1); acc[ai][bj][m][0] *= a0; acc[ai][bj][m][1] *= a1; }
            asm volatile("" ::: "memory"); }
    }
    __device__ __forceinline__ void operator()(const f32x4 (&acc)[2][2][4][2], const pg8::Unit& u, int wr, int wc, int fr, int fq) const {
        const int col0 = u.pn * 256 + wc * 32 + 8 * fq;
#pragma unroll
        for (int ai = 0; ai < 2; ++ai) { u32x4 g2[4][2];
#pragma unroll
            for (int m = 0; m < 4; ++m) { const size_t row = EPI_ROWS(ai, m);
#pragma unroll
                for (int bj = 0; bj < 2; ++bj) g2[m][bj] = *(const u32x4*)(gates + row * 2048 + 1024 + col0 + bj * 128); }
#pragma unroll
            for (int m = 0; m < 4; ++m) { const size_t row = EPI_ROWS(ai, m);
#pragma unroll
                for (int bj = 0; bj < 2; ++bj) { f32x4 b0, b1; unpack8f(g2[m][bj], b0, b1); *(u32x4*)(mg + row * 1024 + col0 + bj * 128) = pack8f(acc[ai][bj][m][0] * b0, acc[ai][bj][m][1] * b1); } }
            asm volatile("" ::: "memory"); }
    }
};
struct EpiResBf16 {
    static constexpr bool PERM = true, HAS_MID = false;
    const float* resf; const bf16* resb; bf16* out; unsigned char* out8;
    __device__ __forceinline__ void operator()(const f32x4 (&acc)[2][2][4][2], const pg8::Unit& u, int wr, int wc, int fr, int fq) const {
        const int col0 = u.pn * 256 + wc * 32 + 8 * fq;
        if (!resf) {
            u32x4 w[2][4][2];
#pragma unroll
            for (int ai = 0; ai < 2; ++ai)
#pragma unroll
                for (int m = 0; m < 4; ++m) { const size_t off = (size_t)EPI_ROWS(ai, m) * DM + col0;
#pragma unroll
                    for (int bj = 0; bj < 2; ++bj) w[ai][m][bj] = *(const u32x4*)(resb + off + bj * 128); }
#pragma unroll
            for (int ai = 0; ai < 2; ++ai)
#pragma unroll
                for (int m = 0; m < 4; ++m) { const size_t off = (size_t)EPI_ROWS(ai, m) * DM + col0;
#pragma unroll
                    for (int bj = 0; bj < 2; ++bj) { f32x4 r0, r1; unpack8f(w[ai][m][bj], r0, r1); const f32x4 v0 = r0 + acc[ai][bj][m][0], v1 = r1 + acc[ai][bj][m][1]; *(u32x4*)(out + off + bj * 128) = pack8f(v0, v1);
                        if (out8) *(u32x2*)(out8 + off + bj * 128) = pack8_fp8(v0, v1); } }
            return;
        }
#pragma unroll
        for (int ai = 0; ai < 2; ++ai) { f32x4 rv[4][2][2];
#pragma unroll
            for (int m = 0; m < 4; ++m) { const size_t off = (size_t)EPI_ROWS(ai, m) * DM + col0;
#pragma unroll
                for (int bj = 0; bj < 2; ++bj) {
                    if (resf) { rv[m][bj][0] = *(const f32x4*)(resf + off + bj * 128); rv[m][bj][1] = *(const f32x4*)(resf + off + bj * 128 + 4); }
                    else { const u32x4 w = *(const u32x4*)(resb + off + bj * 128); unpack8f(w, rv[m][bj][0], rv[m][bj][1]); } } }
#pragma unroll
            for (int m = 0; m < 4; ++m) { const size_t off = (size_t)EPI_ROWS(ai, m) * DM + col0;
#pragma unroll
                for (int bj = 0; bj < 2; ++bj) { const f32x4 v0 = rv[m][bj][0] + acc[ai][bj][m][0], v1 = rv[m][bj][1] + acc[ai][bj][m][1]; *(u32x4*)(out + off + bj * 128) = pack8f(v0, v1);
                    if (out8) *(u32x2*)(out8 + off + bj * 128) = pack8_fp8(v0, v1); } }
            asm volatile("" ::: "memory"); }
    }
};
struct EpiRowScaleBf16 {
    static constexpr bool PERM = true, HAS_MID = false;
    bf16* O; int ldc; const LAS float* rs;
    __device__ __forceinline__ void operator()(const f32x4 (&acc)[2][2][4][2], const pg8::Unit& u, int wr, int wc, int fr, int fq) const {
        const int col0 = u.pn * 256 + wc * 32 + 8 * fq;
#pragma unroll
        for (int ai = 0; ai < 2; ++ai)
#pragma unroll
            for (int m = 0; m < 4; ++m) { const float r = rs[u.ord * 256 + wr * 64 + fr + ai * 128 + m * 16]; bf16* rowp = O + (size_t)EPI_ROWS(ai, m) * ldc + col0;
#pragma unroll
                for (int bj = 0; bj < 2; ++bj) *(u32x4*)(rowp + bj * 128) = pack8f(acc[ai][bj][m][0] * r, acc[ai][bj][m][1] * r); }
    }
};
__device__ __forceinline__ f32x2 swiglu2(const f32x2 a, const f32x2 b) {
    const f32x2 gl = {fminf(a.x, 7.f), fminf(a.y, 7.f)}, ln = {fminf(fmaxf(b.x, -7.f), 7.f), fminf(fmaxf(b.y, -7.f), 7.f)};
    const f32x2 t = gl * (-1.702f * 1.4426950408889634f);
    const f32x2 d = (f32x2){__builtin_amdgcn_exp2f(t.x), __builtin_amdgcn_exp2f(t.y)} + 1.f;
    const f32x2 r = {__builtin_amdgcn_rcpf(d.x), __builtin_amdgcn_rcpf(d.y)};
    return (gl * r) * (ln + 1.f);
}
struct EpiSwiglu {
    static constexpr bool PERM = true, HAS_MID = false;
    unsigned char* H; const float* bg; const float* bu; int nN; const float* rs;
    __device__ __forceinline__ void operator()(const f32x4 (&acc)[2][2][4][2], const pg8::Unit& u, int wr, int wc, int fr, int fq) const {
        const int e = u.pb / nN, c0 = u.pn * 128 + wc * 32 + 8 * fq;
        const f32x4 g0 = *(const f32x4*)(bg + e * 1024 + c0), g1 = *(const f32x4*)(bg + e * 1024 + c0 + 4), u0 = *(const f32x4*)(bu + e * 1024 + c0), u1 = *(const f32x4*)(bu + e * 1024 + c0 + 4);
        float rr[2][4];
#pragma unroll
        for (int ai = 0; ai < 2; ++ai)
#pragma unroll
            for (int m = 0; m < 4; ++m) rr[ai][m] = rs[EPI_ROWS(ai, m)];
#pragma unroll
        for (int ai = 0; ai < 2; ++ai)
#pragma unroll
            for (int m = 0; m < 4; ++m) { const float rq = rr[ai][m] * W8_INV; const f32x4 a0 = acc[ai][0][m][0] * rq + g0, a1 = acc[ai][0][m][1] * rq + g1, b0 = acc[ai][1][m][0] * rq + u0, b1 = acc[ai][1][m][1] * rq + u1;
                const f32x2 p0 = swiglu2((f32x2){a0[0], a0[1]}, (f32x2){b0[0], b0[1]}), p1 = swiglu2((f32x2){a0[2], a0[3]}, (f32x2){b0[2], b0[3]}), p2 = swiglu2((f32x2){a1[0], a1[1]}, (f32x2){b1[0], b1[1]}), p3 = swiglu2((f32x2){a1[2], a1[3]}, (f32x2){b1[2], b1[3]});
                const f32x4 r0 = {p0.x, p0.y, p1.x, p1.y}, r1 = {p2.x, p2.y, p3.x, p3.y};
                *(u32x2*)(H + (size_t)EPI_ROWS(ai, m) * 1024 + c0) = pack8_fp8(r0, r1); }
    }
};
struct EpiDown {
    static constexpr bool PERM = true, HAS_MID = false;
    bf16* Y; const float* bd; const float* rgate; int nN;
    __device__ __forceinline__ void operator()(const f32x4 (&acc)[2][2][4][2], const pg8::Unit& u, int wr, int wc, int fr, int fq) const {
        const int e = u.pb / nN, col0 = u.pn * 256 + wc * 32 + 8 * fq;
        f32x4 bv[2][2];
#pragma unroll
        for (int bj = 0; bj < 2; ++bj)
#pragma unroll
            for (int n = 0; n < 2; ++n) bv[bj][n] = *(const f32x4*)(bd + e * 1024 + col0 + bj * 128 + 4 * n);
        float gt[2][4];
#pragma unroll
        for (int ai = 0; ai < 2; ++ai)
#pragma unroll
            for (int m = 0; m < 4; ++m) gt[ai][m] = rgate[EPI_ROWS(ai, m)];
#pragma unroll
        for (int ai = 0; ai < 2; ++ai)
#pragma unroll
            for (int m = 0; m < 4; ++m) { const int row = EPI_ROWS(ai, m);
#pragma unroll
                for (int bj = 0; bj < 2; ++bj) *(u32x4*)(Y + (size_t)row * 1024 + col0 + bj * 128) = pack8f((acc[ai][bj][m][0] * W8_INV + bv[bj][0]) * gt[ai][m], (acc[ai][bj][m][1] * W8_INV + bv[bj][1]) * gt[ai][m]); }
    }
};

__device__ __forceinline__ bf16x8 frag_n(const LAS unsigned char* base, int pitch, int r0, int k0, int lane) {
    return *(const LAS bf16x8*)(base + (r0 + (lane & 15)) * pitch + (k0 + 8 * (lane >> 4)) * 2);
}
__device__ __forceinline__ bf16x8 frag_t(const LAS unsigned char* base, int pitch, int k0, int n0, int lane) {
    const int i = lane & 15, gq = lane >> 4, q = i >> 2, p = i & 3;
    const unsigned a0 = (unsigned)(uintptr_t)(base + (k0 + 8 * gq + q) * pitch + (n0 + 4 * p) * 2), a1 = a0 + 4u * (unsigned)pitch;
    s16x4 lo, hi;
    asm volatile("ds_read_b64_tr_b16 %0, %2\n\tds_read_b64_tr_b16 %1, %3\n\ts_waitcnt lgkmcnt(0)" : "=&v"(lo), "=&v"(hi) : "v"(a0), "v"(a1) : "memory");
    return (bf16x8){lo[0], lo[1], lo[2], lo[3], hi[0], hi[1], hi[2], hi[3]};
}
#define MFMA16(a, b, c) __builtin_amdgcn_mfma_f32_16x16x32_bf16(a, b, c, 0, 0, 0)

__device__ __forceinline__ float log_sigmoid_fast(float z) { return fminf(z, 0.f) - __logf(1.f + __expf(-fabsf(z))); }
__device__ __forceinline__ void gla_a_phase(Frame& F, const Args& A) {
    unsigned char* ws = F.ws;
    LAS unsigned char* L = F.lds;
    LAS float* l_alr = (LAS float*)L;
    constexpr int PK = 272, PV = 528;
    LAS unsigned char* l_kd = L + 4096;
    LAS unsigned char* l_v = L + 4096 + 64 * PK;
    LAS float* l_tot = (LAS float*)(L + 4096 + 64 * PK + 64 * PV);
    const int tid = F.tid, lane = F.lane, wid = F.wave;
    const int col = tid & 127, qt = tid >> 7;
    float pf_alr[2]; u32x4 pf_v[4], pf_k[2];
#define GLA_A_PREFETCH(it_) do { const int b_ = (it_) >> 8, c_ = ((it_) >> 1) & 127, hp_ = (it_) & 1; const size_t tk0 = (size_t)b_ * SEQ + (size_t)c_ * 64; \
        const float* alr_ = (const float*)(ws + WS_ALR) + tk0 * 16; pf_alr[0] = alr_[tid]; pf_alr[1] = alr_[tid + 512]; \
        const bf16* vg_ = (const bf16*)(ws + WS_VG) + tk0 * 512 + hp_ * 256; const bf16* kg_ = (const bf16*)(ws + WS_KG) + tk0 * 256 + hp_ * 128; \
        _Pragma("unroll") for (int q_ = 0; q_ < 4; ++q_) { const int i_ = tid + q_ * 512; pf_v[q_] = *(const u32x4*)(vg_ + (size_t)(i_ >> 5) * 512 + (i_ & 31) * 8); } \
        _Pragma("unroll") for (int q_ = 0; q_ < 2; ++q_) { const int i_ = tid + q_ * 512; pf_k[q_] = *(const u32x4*)(kg_ + (size_t)(i_ >> 4) * 256 + (i_ & 15) * 8); } } while (0)
    int it = F.bid; if (it >= NBATCH * 256) return;
    GLA_A_PREFETCH(it);
    int hp_loaded = -1; float w2c[16]; float b2 = 0.f;
#pragma unroll
    for (int j = 0; j < 16; ++j) w2c[j] = 0.f;
    for (; it < NBATCH * 256; it += F.G) {
        const int b = it >> 8, c = (it >> 1) & 127, hp = it & 1;
        l_alr[tid] = pf_alr[0]; l_alr[tid + 512] = pf_alr[1];
#pragma unroll
        for (int q = 0; q < 4; ++q) { const int i = tid + q * 512; *(LAS u32x4*)(l_v + (i >> 5) * PV + (i & 31) * 16) = pf_v[q]; }
#pragma unroll
        for (int q = 0; q < 2; ++q) { const int i = tid + q * 512; *(LAS u32x4*)(l_kd + (i >> 4) * PK + (i & 15) * 16) = pf_k[q]; }
        __syncthreads();
        if (it + F.G < NBATCH * 256) GLA_A_PREFETCH(it + F.G);
        {   const int gc = hp * 128 + col;
            if (hp != hp_loaded) { hp_loaded = hp; b2 = INP(6)[gc];
#pragma unroll
                for (int jj = 0; jj < 16; ++jj) w2c[jj] = INP(5)[jj * 256 + gc]; }
            float bc[16]; float run = 0.f;
#pragma unroll
            for (int i = 0; i < 16; ++i) { const int t = qt * 16 + i; float z = b2;
#pragma unroll
                for (int jj = 0; jj < 16; ++jj) z = fmaf(l_alr[t * 16 + jj], w2c[jj], z);
                run += log_sigmoid_fast(z) * (1.f / 16.f); bc[i] = run; }
            l_tot[qt * 128 + col] = run;
            __syncthreads();
            const float q0 = l_tot[col], q1 = l_tot[128 + col], q2 = l_tot[256 + col], q3 = l_tot[384 + col];
            const float blast = (q0 + q1) + (q2 + q3), pre = (qt > 0 ? q0 : 0.f) + (qt > 1 ? q1 : 0.f) + (qt > 2 ? q2 : 0.f);
#pragma unroll
            for (int i = 0; i < 16; ++i) { const int t = qt * 16 + i; LAS bf16* kp = (LAS bf16*)(l_kd + t * PK + col * 2);
                *kp = (bf16)f2bf(bf2f(*kp) * __expf(blast - (pre + bc[i]))); }
            if (qt == 0) ((float*)(ws + WS_DECAY))[((size_t)(b * 4 + hp * 2 + (col >> 6)) * 128 + c) * 64 + (col & 63)] = __expf(blast);
        }
        __syncthreads();
        const int hh = wid >> 2, j = wid & 3;
        f32x4 acc[4][2];
#pragma unroll
        for (int mt = 0; mt < 4; ++mt)
#pragma unroll
            for (int nt = 0; nt < 2; ++nt) acc[mt][nt] = (f32x4){0.f, 0.f, 0.f, 0.f};
#pragma unroll
        for (int ks = 0; ks < 2; ++ks) { bf16x8 a[4], bb[2];
#pragma unroll
            for (int mt = 0; mt < 4; ++mt) a[mt] = frag_t(l_kd, PK, 32 * ks, hh * 64 + 16 * mt, lane);
#pragma unroll
            for (int nt = 0; nt < 2; ++nt) bb[nt] = frag_t(l_v, PV, 32 * ks, hh * 128 + 32 * j + 16 * nt, lane);
            __builtin_amdgcn_sched_barrier(0);
#pragma unroll
            for (int mt = 0; mt < 4; ++mt)
#pragma unroll
                for (int nt = 0; nt < 2; ++nt) acc[mt][nt] = MFMA16(a[mt], bb[nt], acc[mt][nt]); }
        __syncthreads();
        { LAS unsigned char* l_st = l_kd + hh * (64 * 272) + (4 * (lane >> 4)) * 272 + (32 * j + (lane & 15)) * 2;
#pragma unroll
          for (int mt = 0; mt < 4; ++mt)
#pragma unroll
              for (int nt = 0; nt < 2; ++nt)
#pragma unroll
                  for (int r = 0; r < 4; ++r) *(LAS bf16*)(l_st + (16 * mt + r) * 272 + 32 * nt) = (bf16)f2bf(acc[mt][nt][r]); }
        __syncthreads();
        { bf16* st = (bf16*)(F.dout + DO_ST) + ((size_t)(b * 4 + hp * 2) * 128 + c) * 8192;
#pragma unroll
          for (int q = 0; q < 4; ++q) { const int i = tid + q * 512, h2 = i >> 10, dk = (i >> 4) & 63, c16 = i & 15;
              const u32x4 w = *(const LAS u32x4*)(l_kd + h2 * (64 * 272) + dk * 272 + c16 * 16);
              *(u32x4*)(st + (size_t)h2 * 128 * 8192 + dk * 128 + c16 * 8) = w; } }
        __syncthreads();
    }
#undef GLA_A_PREFETCH
}

__device__ __forceinline__ void gla_scan(Frame& F) {
    unsigned* st = (unsigned*)(F.dout + DO_ST); const float* dec = (const float*)(F.ws + WS_DECAY);
    for (int idx = F.bid * NTHR + F.tid; idx < 32 * 4096; idx += F.G * NTHR) {
        const int bh = idx >> 12, e2 = idx & 4095, dk = e2 >> 6;
        unsigned* p = st + (size_t)bh * 128 * 4096 + e2; const float* dp = dec + (size_t)bh * 128 * 64 + dk;
        float s0 = 0.f, s1 = 0.f;
#pragma unroll 32
        for (int c = 0; c < 128; ++c) { const unsigned kv = p[(size_t)c * 4096]; const float d = dp[c * 64];
            p[(size_t)c * 4096] = cvt_pk_bf16(s0, s1);
            s0 = fmaf(d, s0, bflo(kv)); s1 = fmaf(d, s1, bfhi(kv)); }
    }
}

__device__ __forceinline__ void gla_c_phase(Frame& F, const Args& A) {
    unsigned char* ws = F.ws;
    LAS unsigned char* L = F.lds;
    LAS float* l_alr = (LAS float*)L;
    constexpr int PQ = 272, PV = 528, PP = 144;
    LAS unsigned char* l_qh = L + 4096;
    LAS unsigned char* l_kt = L + 21504;
    LAS unsigned char* l_v = L + 38912;
    LAS unsigned char* l_s = L + 72704;
    LAS unsigned char* l_p = L + 107520;
    LAS float* l_tot = (LAS float*)(L + 125952);
    LAS float* l_ss = (LAS float*)(L + 128000);
    const int tid = F.tid, lane = F.lane, wid = F.wave;
    const int col = tid & 127, qt = tid >> 7;
    float pf_alr[2]; u32x4 pf_v[4], pf_s[4], pf_q[2], pf_k[2], pf_r[4];
#define GLA_C_PREFETCH(it_) do { const int b_ = (it_) >> 8, c_ = ((it_) >> 1) & 127, hp_ = (it_) & 1; const size_t tk0 = (size_t)b_ * SEQ + (size_t)c_ * 64; \
        const float* alr_ = (const float*)(ws + WS_ALR) + tk0 * 16; pf_alr[0] = alr_[tid]; pf_alr[1] = alr_[tid + 512]; \
        const bf16* vg_ = (const bf16*)(ws + WS_VG) + tk0 * 512 + hp_ * 256; const bf16* rg_ = (const bf16*)(ws + WS_RG) + tk0 * 512 + hp_ * 256; \
        _Pragma("unroll") for (int q_ = 0; q_ < 4; ++q_) { const int i_ = tid + q_ * 512; pf_v[q_] = *(const u32x4*)(vg_ + (size_t)(i_ >> 5) * 512 + (i_ & 31) * 8); pf_r[q_] = *(const u32x4*)(rg_ + (size_t)(i_ >> 5) * 512 + (i_ & 31) * 8); } \
        _Pragma("unroll") for (int q_ = 0; q_ < 4; ++q_) { const int i_ = tid + q_ * 512, hh_ = i_ >> 10, r_ = (i_ >> 4) & 63, ch_ = i_ & 15; \
            pf_s[q_] = *(const u32x4*)((const bf16*)(F.dout + DO_ST) + ((size_t)(b_ * 4 + hp_ * 2 + hh_) * 128 + c_) * 8192 + r_ * 128 + ch_ * 8); } \
        const bf16* qg_ = (const bf16*)(ws + WS_QG) + tk0 * 256 + hp_ * 128; const bf16* kg_ = (const bf16*)(ws + WS_KG) + tk0 * 256 + hp_ * 128; \
        _Pragma("unroll") for (int q_ = 0; q_ < 2; ++q_) { const int i_ = tid + q_ * 512; pf_q[q_] = *(const u32x4*)(qg_ + (size_t)(i_ >> 4) * 256 + (i_ & 15) * 8); pf_k[q_] = *(const u32x4*)(kg_ + (size_t)(i_ >> 4) * 256 + (i_ & 15) * 8); } } while (0)
    int it = F.bid; if (it >= NBATCH * 256) return;
    GLA_C_PREFETCH(it);
    int hp_loaded = -1; float w2c[16]; float b2 = 0.f;
#pragma unroll
    for (int j = 0; j < 16; ++j) w2c[j] = 0.f;
    for (; it < NBATCH * 256; it += F.G) {
        const int b = it >> 8, c = (it >> 1) & 127, hp = it & 1;
        const size_t tok0 = (size_t)b * SEQ + (size_t)c * 64;
        l_alr[tid] = pf_alr[0]; l_alr[tid + 512] = pf_alr[1];
#pragma unroll
        for (int q = 0; q < 4; ++q) { const int i = tid + q * 512; *(LAS u32x4*)(l_v + (i >> 5) * PV + (i & 31) * 16) = pf_v[q]; }
#pragma unroll
        for (int q = 0; q < 4; ++q) { const int i = tid + q * 512, hh = i >> 10, r = (i >> 4) & 63, ch = i & 15; *(LAS u32x4*)(l_s + hh * (64 * PQ) + r * PQ + ch * 16) = pf_s[q]; }
#pragma unroll
        for (int q = 0; q < 2; ++q) { const int i = tid + q * 512; *(LAS u32x4*)(l_qh + (i >> 4) * PQ + (i & 15) * 16) = pf_q[q]; *(LAS u32x4*)(l_kt + (i >> 4) * PQ + (i & 15) * 16) = pf_k[q]; }
        u32x4 cur_r[4];
#pragma unroll
        for (int q = 0; q < 4; ++q) cur_r[q] = pf_r[q];
        __syncthreads();
        if (it + F.G < NBATCH * 256) GLA_C_PREFETCH(it + F.G);
        const int hh = wid >> 2, j = wid & 3, head = hp * 2 + hh;
        {
            const int gc = hp * 128 + col;
            if (hp != hp_loaded) { hp_loaded = hp; b2 = INP(6)[gc];
#pragma unroll
                for (int jj = 0; jj < 16; ++jj) w2c[jj] = INP(5)[jj * 256 + gc]; }
            float bc[16]; float run = 0.f;
#pragma unroll
            for (int i = 0; i < 16; ++i) { const int t = qt * 16 + i; float z = b2;
#pragma unroll
                for (int jj = 0; jj < 16; ++jj) z = fmaf(l_alr[t * 16 + jj], w2c[jj], z);
                run += log_sigmoid_fast(z) * (1.f / 16.f); bc[i] = run; }
            l_tot[qt * 128 + col] = run;
            __syncthreads();
            float pre = 0.f;
#pragma unroll
            for (int q = 0; q < 3; ++q) pre += (q < qt) ? l_tot[q * 128 + col] : 0.f;
#pragma unroll
            for (int i = 0; i < 16; ++i) { const int t = qt * 16 + i; const float bb = pre + bc[i];
                LAS bf16* qp = (LAS bf16*)(l_qh + t * PQ + col * 2); LAS bf16* kp = (LAS bf16*)(l_kt + t * PQ + col * 2);
                *qp = (bf16)f2bf(bf2f(*qp) * __expf(bb)); *kp = (bf16)f2bf(bf2f(*kp) * __expf(-bb)); }
        }
        __syncthreads();
        {
            f32x4 sc4[4];
#pragma unroll
            for (int nt = 0; nt < 4; ++nt) sc4[nt] = (f32x4){0.f, 0.f, 0.f, 0.f};
#pragma unroll
            for (int ks = 0; ks < 2; ++ks) { const bf16x8 a = frag_n(l_qh, PQ, 16 * j, hh * 64 + 32 * ks, lane);
#pragma unroll
                for (int nt = 0; nt < 4; ++nt) sc4[nt] = MFMA16(a, frag_n(l_kt, PQ, 16 * nt, hh * 64 + 32 * ks, lane), sc4[nt]); }
#pragma unroll
            for (int nt = 0; nt < 4; ++nt)
#pragma unroll
                for (int r = 0; r < 4; ++r) { const int t = 16 * j + 4 * (lane >> 4) + r, s2 = 16 * nt + (lane & 15);
                    *(LAS bf16*)(l_p + hh * (64 * PP) + t * PP + s2 * 2) = (bf16)f2bf(s2 <= t ? sc4[nt][r] : 0.f); }
        }
        __syncthreads();
        f32x4 acc[4][2];
#pragma unroll
        for (int mt = 0; mt < 4; ++mt)
#pragma unroll
            for (int nt = 0; nt < 2; ++nt) acc[mt][nt] = (f32x4){0.f, 0.f, 0.f, 0.f};
#pragma unroll
        for (int ks = 0; ks < 2; ++ks) {
            bf16x8 bb[2];
#pragma unroll
            for (int nt = 0; nt < 2; ++nt) bb[nt] = frag_t(l_s + hh * (64 * PQ), PQ, 32 * ks, 32 * j + 16 * nt, lane);
            __builtin_amdgcn_sched_barrier(0);
#pragma unroll
            for (int mt = 0; mt < 4; ++mt) { const bf16x8 a = frag_n(l_qh, PQ, 16 * mt, hh * 64 + 32 * ks, lane);
#pragma unroll
                for (int nt = 0; nt < 2; ++nt) acc[mt][nt] = MFMA16(a, bb[nt], acc[mt][nt]); } }
#pragma unroll
        for (int ks = 0; ks < 2; ++ks) {
            bf16x8 bb[2];
#pragma unroll
            for (int nt = 0; nt < 2; ++nt) bb[nt] = frag_t(l_v, PV, 32 * ks, hh * 128 + 32 * j + 16 * nt, lane);
            __builtin_amdgcn_sched_barrier(0);
#pragma unroll
            for (int mt = 0; mt < 4; ++mt) { const bf16x8 a = frag_n(l_p + hh * (64 * PP), PP, 16 * mt, 32 * ks, lane);
#pragma unroll
                for (int nt = 0; nt < 2; ++nt) acc[mt][nt] = MFMA16(a, bb[nt], acc[mt][nt]); } }
#pragma unroll
        for (int mt = 0; mt < 4; ++mt)
#pragma unroll
            for (int r = 0; r < 4; ++r) { float q = acc[mt][0][r] * acc[mt][0][r] + acc[mt][1][r] * acc[mt][1][r];
                q += __shfl_xor(q, 1); q += __shfl_xor(q, 2); q += __shfl_xor(q, 4); q += __shfl_xor(q, 8);
                if ((lane & 15) == 0) l_ss[(hh * 64 + 16 * mt + 4 * (lane >> 4) + r) * 4 + j] = q; }
        __syncthreads();
        {
            const float* gng = INP(7); const float g0 = gng[head * 128 + 32 * j + (lane & 15)], g1 = gng[head * 128 + 32 * j + 16 + (lane & 15)];
            LAS unsigned char* l_o = l_v + (4 * (lane >> 4)) * PV + (hh * 128 + 32 * j + (lane & 15)) * 2;
#pragma unroll
            for (int mt = 0; mt < 4; ++mt)
#pragma unroll
                for (int r = 0; r < 4; ++r) { const int t = 16 * mt + 4 * (lane >> 4) + r; const LAS float* sp = l_ss + (hh * 64 + t) * 4;
                    const float rstd = 1.f / sqrtf(((sp[0] + sp[1]) + (sp[2] + sp[3])) * (1.f / 128.f) + EPS);
                    *(LAS bf16*)(l_o + (16 * mt + r) * PV) = (bf16)f2bf(acc[mt][0][r] * rstd * g0); *(LAS bf16*)(l_o + (16 * mt + r) * PV + 32) = (bf16)f2bf(acc[mt][1][r] * rstd * g1); } }
        __syncthreads();
        { bf16* og = (bf16*)(F.dout + DO_OGD) + tok0 * 1024 + hp * 256;
#pragma unroll
          for (int q = 0; q < 4; ++q) { const int i = tid + q * 512; f32x4 o0, o1, r0, r1; const u32x4 ow = *(const LAS u32x4*)(l_v + (i >> 5) * PV + (i & 31) * 16); unpack8f(ow, o0, o1); unpack8f(cur_r[q], r0, r1);
#pragma unroll
              for (int e = 0; e < 4; ++e) { o0[e] *= r0[e] * __builtin_amdgcn_rcpf(1.f + __expf(-r0[e])); o1[e] *= r1[e] * __builtin_amdgcn_rcpf(1.f + __expf(-r1[e])); }
              *(u32x4*)(og + (size_t)(i >> 5) * 1024 + (i & 31) * 8) = pack8f(o0, o1); } }
        __syncthreads();
    }
#undef GLA_C_PREFETCH
}

__device__ __forceinline__ void dil_combine(Frame& F) {
    const bf16* qd = (const bf16*)(F.ws + WS_QD); const float* lse = (const float*)(F.ws + WS_LSE); bf16* od = (bf16*)(F.dout + DO_OGD) + 512;
    constexpr int U = 4; const int NT = F.G * NTHR;
    for (int idx0 = F.bid * NTHR + F.tid; idx0 < M * 64; idx0 += U * NT) {
        float l0[U], l1[U], l2[U]; u32x4 a[U], bq[U], c[U];
#pragma unroll
        for (int u = 0; u < U; ++u) { const int idx = idx0 + u * NT; if (idx < M * 64) { const int tok = idx >> 6, rem = idx & 63, h = rem >> 4, ch = rem & 15;
            l0[u] = lse[(size_t)tok * 12 + h]; l1[u] = lse[(size_t)tok * 12 + 4 + h]; l2[u] = lse[(size_t)tok * 12 + 8 + h];
            const bf16* p = qd + (size_t)tok * 1536 + h * 128 + ch * 8; a[u] = *(const u32x4*)p; bq[u] = *(const u32x4*)(p + 512); c[u] = *(const u32x4*)(p + 1024); } }
#pragma unroll
        for (int u = 0; u < U; ++u) { const int idx = idx0 + u * NT; if (idx < M * 64) { const int tok = idx >> 6, rem = idx & 63, h = rem >> 4, ch = rem & 15;
            const float mx = fmaxf(l0[u], fmaxf(l1[u], l2[u])); float w0 = __expf(l0[u] - mx), w1 = __expf(l1[u] - mx), w2 = __expf(l2[u] - mx); const float inv = 1.f / (w0 + w1 + w2); w0 *= inv; w1 *= inv; w2 *= inv;
            f32x4 a0, a1, b0, b1, c0, c1; unpack8f(a[u], a0, a1); unpack8f(bq[u], b0, b1); unpack8f(c[u], c0, c1);
            *(u32x4*)(od + (size_t)tok * 1024 + h * 128 + ch * 8) = pack8f(a0 * w0 + b0 * w1 + c0 * w2, a1 * w0 + b1 * w1 + c1 * w2); } }
    }
}

__device__ __forceinline__ void kv_small(Frame& F) {
    const bf16* memn = (const bf16*)(F.ws + WS_MEMN); const bf16* wt = (const bf16*)(F.ws + WS_WXKV); bf16* kvm = (bf16*)(F.ws + WS_KVM);
    const int fr = F.lane & 15, fq = F.lane >> 4;
    for (int t = F.bid; t < 256; t += F.G) { const int rt = t >> 3, ct = t & 7;
        f32x4 acc[4];
#pragma unroll
        for (int mt = 0; mt < 4; ++mt) acc[mt] = (f32x4){0.f, 0.f, 0.f, 0.f};
        const bf16* ap = memn + (size_t)(rt * 64 + fr) * DM + 8 * fq; const bf16* bp = wt + (size_t)(ct * 128 + 16 * F.wave + fr) * DM + 8 * fq;
#pragma unroll 4
        for (int kk = 0; kk < 32; ++kk) { const bf16x8 b = *(const bf16x8*)(bp + 32 * kk);
#pragma unroll
            for (int mt = 0; mt < 4; ++mt) acc[mt] = MFMA16(*(const bf16x8*)(ap + (size_t)(16 * mt) * DM + 32 * kk), b, acc[mt]); }
#pragma unroll
        for (int mt = 0; mt < 4; ++mt)
#pragma unroll
            for (int r = 0; r < 4; ++r) kvm[(size_t)(rt * 64 + 16 * mt + 4 * fq + r) * DM + ct * 128 + 16 * F.wave + fr] = (bf16)f2bf(acc[mt][r]);
    }
}

__device__ __forceinline__ att::BlockRef dil_ref(Frame& F, int I) {
    const int g = I >> 10, r = I & 1023, d = 1 << (2 * g), nqb = 32 >> (2 * g), qb = r % nqb, s = r / nqb, p = s % d, bh = s / d, h = bh & 3, b = bh >> 2;
    const size_t tb = (size_t)b * SEQ + p;
    att::BlockRef R;
    R.qs = d * 1536; R.ks = d * 1536; R.ls = d * 12; R.skv = SEQ / d; R.P0 = qb * 256;
    bf16* q = (bf16*)(F.ws + WS_QD) + tb * 1536 + g * 512 + h * 128;
    R.Q = q + (size_t)qb * 256 * R.qs;
    R.K = (const bf16*)(F.ws + WS_KD) + tb * 1536 + g * 512 + h * 128;
    R.L = (float*)(F.ws + WS_LSE) + tb * 12 + g * 4 + h + (size_t)qb * 256 * R.ls;
    return R;
}
__device__ __forceinline__ att::BlockRef xat_ref(Frame& F, int I) {
    const int qb = I & 31, h = (I >> 5) & 3, b = I >> 7;
    att::BlockRef R; R.qs = 512; R.ks = 1024; R.ls = 0; R.skv = 256; R.P0 = 256; R.L = nullptr;
    bf16* q = (bf16*)(F.ws + WS_QX) + ((size_t)b * SEQ + (size_t)qb * 256) * 512 + h * 128;
    R.Q = q; R.K = (const bf16*)(F.ws + WS_KVM) + (size_t)b * 256 * 1024 + h * 128;
    return R;
}
template <bool DIL>
__device__ __forceinline__ void attn_phase(Frame& F) {
    constexpr int TOTAL = DIL ? 3072 : 1024; constexpr int W = DIL ? 129 : (1 << 20); constexpr long VOFF = DIL ? (long)((WS_VD - WS_KD) / 2) : 512;
    const int G8 = F.G & ~255;
    auto remap = [&](int I_) { if (I_ >= (TOTAL / 256) * 256 || (I_ % F.G) >= G8 || F.G != 256) return I_; const int r_ = I_ >> 8, w_ = I_ & 255; return (r_ << 8) + ((w_ & 7) << 5) + (w_ >> 3); };
    int I = F.bid; if (I >= TOTAL) return;
    att::BlockRef cur = DIL ? dil_ref(F, remap(I)) : xat_ref(F, remap(I));
    att::Seam S;
    att::prime<VOFF>(cur, W, F.ldsg, S);
    for (;;) {
        const bool more = I + F.G < TOTAL; const int In = more ? I + F.G : I;
        const att::BlockRef nxt = DIL ? dil_ref(F, remap(In)) : xat_ref(F, remap(In));
        att::block<true, VOFF>(cur, nxt, W, F.ldsg, S);
        if (!more) break;
        cur = nxt; I = In;
    }
}

__device__ __forceinline__ void router_phase(Frame& F, const Args& A) {
    unsigned char* ws = F.ws;
    LAS unsigned char* l_w = F.lds;
    LAS float* l_lg = (LAS float*)(F.lds + 65536) + F.wave * (16 * 33 + 16);
    LAS unsigned* l_hist = (LAS unsigned*)(F.lds + 65536 + 8 * (16 * 33 + 16) * 4);
    const int tid = F.tid, lane = F.lane;
    { const u32x4* wsrc = (const u32x4*)(ws + WS_WR);
      for (int i = tid; i < 32 * 128; i += NTHR) { const int e = i >> 7, ch = i & 127; *(LAS u32x4*)(l_w + e * 2048 + ((ch ^ (e & 15)) << 4)) = wsrc[i]; } }
    if (tid < 64) l_hist[tid] = 0u;
    LAS float* l_br = (LAS float*)(l_hist + 64);
    if (tid < 32) l_br[tid] = INP(20)[tid];
    { int* rt = (int*)(ws + WS_RTOK); float* rg = (float*)(ws + WS_RGATE); float* rr = (float*)(ws + WS_RRS);
      for (int i = F.bid * NTHR + tid; i < 2 * RT_CAP; i += F.G * NTHR) { rt[i] = 0; rg[i] = 0.f; rr[i] = 0.f; } }
    __syncthreads();
    const bf16* h2b = (const bf16*)(ws + WS_A); float* rstd3 = (float*)(ws + WS_RSTD3);
    const int fr = lane & 15, fq = lane >> 4;
    for (int rb = F.bid * NWAVES + F.wave; rb < M / 16; rb += F.G * NWAVES) {
        const size_t row0 = (size_t)rb * 16;
        const bf16* xr = h2b + (row0 + fr) * DM + 8 * fq;
        f32x4 c0 = {0.f, 0.f, 0.f, 0.f}, c1 = {0.f, 0.f, 0.f, 0.f}; float ss = 0.f;
#pragma unroll
        for (int kk = 0; kk < 32; ++kk) {
            const u32x4 xw = *(const u32x4*)(xr + 32 * kk); f32x4 x0, x1; unpack8f(xw, x0, x1);
            ss += (x0[0] * x0[0] + x0[1] * x0[1]) + (x0[2] * x0[2] + x0[3] * x0[3]) + (x1[0] * x1[0] + x1[1] * x1[1]) + (x1[2] * x1[2] + x1[3] * x1[3]);
            const bf16x8 ah = *reinterpret_cast<const bf16x8*>(&xw);
            const int ch = 4 * kk + fq;
            const bf16x8 b0 = *(const LAS bf16x8*)(l_w + fr * 2048 + ((ch ^ fr) << 4)), b1 = *(const LAS bf16x8*)(l_w + (16 + fr) * 2048 + ((ch ^ fr) << 4));
            c0 = MFMA16(ah, b0, c0); c1 = MFMA16(ah, b1, c1);
        }
        ss += __shfl_xor(ss, 16); ss += __shfl_xor(ss, 32);
        const float rstd = 1.f / sqrtf(ss * (1.f / DM) + EPS);
        if (fq == 0) { l_lg[16 * 33 + fr] = rstd; rstd3[row0 + fr] = rstd; }
#pragma unroll
        for (int r = 0; r < 4; ++r) { l_lg[(4 * fq + r) * 33 + fr] = c0[r]; l_lg[(4 * fq + r) * 33 + 16 + fr] = c1[r]; }
        LDS_WAIT(); asm volatile("" ::: "memory");
        if (lane < 16) {
            const float rs = l_lg[16 * 33 + lane]; float v[32];
#pragma unroll
            for (int e = 0; e < 32; ++e) v[e] = l_lg[lane * 33 + e] * rs + l_br[e];
            int ci[4]; float cv[4];
#pragma unroll
            for (int k = 0; k < 4; ++k) { float best = -__builtin_inff(); int bi = 0;
#pragma unroll
                for (int e = 0; e < 32; ++e) { bool free_ = true;
#pragma unroll
                    for (int kk2 = 0; kk2 < k; ++kk2) free_ = free_ && (ci[kk2] != e);
                    if (free_ && v[e] > best) { best = v[e]; bi = e; } }
                ci[k] = bi; cv[k] = best; }
            float ex[4], sum = 0.f;
#pragma unroll
            for (int k = 0; k < 4; ++k) { ex[k] = __expf(cv[k] - cv[0]); sum += ex[k]; }
            const float inv = 1.f / sum; const size_t tok = row0 + lane; const int hf = tok >= HALF_TOK ? 1 : 0;
            int* te = (int*)(ws + WS_TOPE) + tok * 4; float* tg = (float*)(ws + WS_TGATE) + tok * 4;
#pragma unroll
            for (int k = 0; k < 4; ++k) { te[k] = ci[k]; tg[k] = ex[k] * inv; atomicAdd((unsigned*)&l_hist[hf * 32 + ci[k]], 1u); }
        }
        LDS_WAIT(); asm volatile("" ::: "memory");
    }
    __syncthreads();
    if (tid < 64 && l_hist[tid] != 0u) atomicAdd(F.ctl + CW_CNT + tid, l_hist[tid]);
}

struct MoeTab { LAS int* pstart; LAS int* blk_e; LAS int* nblk; };
__device__ __forceinline__ MoeTab moe_tables(Frame& F, int half) {
    MoeTab T; T.pstart = (LAS int*)(F.lds + TAB_OFF); T.blk_e = T.pstart + 32; T.nblk = T.blk_e + MAXBLK;
    __syncthreads();
    if (F.tid < 64) {
        const int lane = F.tid; int cnt = 0;
        if (lane < NEXP) cnt = (int)__hip_atomic_load(F.ctl + CW_CNT + half * 32 + lane, __ATOMIC_RELAXED, __HIP_MEMORY_SCOPE_AGENT);
        const int nb = (cnt + 255) >> 8; int incl = nb;
#pragma unroll
        for (int d = 1; d < 32; d <<= 1) { const int t = __shfl_up(incl, d); if (lane >= d) incl += t; }
        int pos = incl - nb; if (pos > MAXBLK) pos = MAXBLK;
        if (lane < NEXP) { T.pstart[lane] = pos * 256; for (int jx = 0; jx < nb && pos + jx < MAXBLK; ++jx) T.blk_e[pos + jx] = lane; }
        if (lane == NEXP - 1) T.nblk[0] = incl < MAXBLK ? incl : MAXBLK;
    }
    __syncthreads();
    return T;
}
__device__ __forceinline__ void place_phase(Frame& F) {
    unsigned char* ws = F.ws;
    LAS int* l_cnt = (LAS int*)(F.lds + 4096); LAS int* l_base = l_cnt + 32;
    const int* te = (const int*)(ws + WS_TOPE); const float* tg = (const float*)(ws + WS_TGATE);
    int* tslot = (int*)(ws + WS_TSLOT);
    for (int half = 0; half < 2; ++half) {
        const MoeTab T = moe_tables(F, half);
        int* rtok = (int*)(ws + WS_RTOK) + half * RT_CAP; float* rgate = (float*)(ws + WS_RGATE) + half * RT_CAP; float* rrs = (float*)(ws + WS_RRS) + half * RT_CAP; const float* rstd3 = (const float*)(ws + WS_RSTD3);
        for (int bt = F.bid; bt < HALF_TOK / 128; bt += F.G) {
            if (F.tid < 32) l_cnt[F.tid] = 0;
            __syncthreads();
            const int tok = half * HALF_TOK + bt * 128 + (F.tid >> 2), k = F.tid & 3;
            const int e = te[(size_t)tok * 4 + k];
            const int rank = atomicAdd((int*)&l_cnt[e], 1);
            __syncthreads();
            if (F.tid < 32) l_base[F.tid] = (int)atomicAdd(F.ctl + CW_CUR + half * 32 + F.tid, (unsigned)l_cnt[F.tid]);
            __syncthreads();
            const int dest = T.pstart[e] + l_base[e] + rank;
            if (dest < RT_CAP) { rtok[dest] = tok; rgate[dest] = tg[(size_t)tok * 4 + k]; rrs[dest] = rstd3[tok]; }
            tslot[(size_t)tok * 4 + k] = dest < RT_CAP ? dest : 0;
            __syncthreads();
        }
    }
}
__device__ __forceinline__ void combine_phase(Frame& F, const Args& A, int half, size_t ws_y) {
    float* outp = (float*)F.dout; const bf16* h2b = (const bf16*)(F.ws + WS_A); const bf16* Y = (const bf16*)(F.ws + ws_y); const int* tslot = (const int*)(F.ws + WS_TSLOT); const float* gf = INP(27);
    f32x4 gg[2][2];
#pragma unroll
    for (int c = 0; c < 2; ++c) { gg[c][0] = *(const f32x4*)(gf + c * 512 + 8 * F.lane); gg[c][1] = *(const f32x4*)(gf + c * 512 + 8 * F.lane + 4); }
    for (int m0 = half * HALF_TOK + 2 * (F.bid * NWAVES + F.wave); m0 < (half + 1) * HALF_TOK; m0 += 2 * F.G * NWAVES) {
        u32x4 hw[2][2], yw[2][4][2]; int sl[2][4];
#pragma unroll
        for (int r = 0; r < 2; ++r)
#pragma unroll
            for (int k = 0; k < 4; ++k) sl[r][k] = tslot[(size_t)(m0 + r) * 4 + k];
#pragma unroll
        for (int r = 0; r < 2; ++r) {
#pragma unroll
            for (int c = 0; c < 2; ++c) hw[r][c] = *(const u32x4*)(h2b + (size_t)(m0 + r) * DM + c * 512 + 8 * F.lane);
#pragma unroll
            for (int k = 0; k < 4; ++k)
#pragma unroll
                for (int c = 0; c < 2; ++c) yw[r][k][c] = *(const u32x4*)(Y + (size_t)sl[r][k] * 1024 + c * 512 + 8 * F.lane); }
#pragma unroll
        for (int r = 0; r < 2; ++r) { f32x4 v[2][2]; float s = 0.f;
#pragma unroll
            for (int c = 0; c < 2; ++c) { unpack8f(hw[r][c], v[c][0], v[c][1]);
#pragma unroll
                for (int k = 0; k < 4; ++k) { f32x4 y0, y1; unpack8f(yw[r][k][c], y0, y1); v[c][0] += y0; v[c][1] += y1; }
#pragma unroll
                for (int e = 0; e < 2; ++e) s += (v[c][e].x * v[c][e].x + v[c][e].y * v[c][e].y) + (v[c][e].z * v[c][e].z + v[c][e].w * v[c][e].w); }
            const float rstd = 1.f / sqrtf(wave_sum(s) * (1.f / DM) + EPS);
            float* op = outp + (size_t)(m0 + r) * DM + 8 * F.lane;
#pragma unroll
            for (int c = 0; c < 2; ++c) { *(f32x4*)(op + c * 512) = v[c][0] * rstd * gg[c][0]; *(f32x4*)(op + c * 512 + 4) = v[c][1] * rstd * gg[c][1]; } }
    }
}

__global__ void __launch_bounds__(NTHR, 2) mk_fwd(Args A) {
    extern __shared__ __attribute__((aligned(16))) unsigned char lds[];
    Frame F;
    F.lds = (LAS unsigned char*)lds; F.ldsg = (char*)lds;
    F.tid = threadIdx.x; F.lane = F.tid & 63; F.wave = __builtin_amdgcn_readfirstlane(F.tid >> 6);
    F.G = gridDim.x; F.bid = blockIdx.x;
    F.ws = A.ws; F.ctl = (unsigned*)(A.ws + WS_CTL); F.dout = (unsigned char*)A.out;
    volatile LAS unsigned* MISC = (volatile LAS unsigned*)(F.lds + MISC_OFF);
    if (F.tid < 16) MISC[F.tid] = 0u;
    __syncthreads();
    XcdBarrier bar; bar.bar = F.ctl + CW_BAR; bar.x = 0; bar.st = nullptr;
    if (!MK_PER_PHASE) bar = xcd_barrier_post(F.ctl + CW_BAR, MISC + 8);
    const int lo = A.ph_lo, hi = A.ph_hi;
#ifndef PHMASK
#define PHMASK 0x7ffff
#endif
#define IN(k) (((PHMASK >> (k)) & 1) && lo <= (k) && (k) < hi)
#if MK_PROBE
#define SEAM(k) do { if (IN(k) && IN((k) + 1)) xcd_barrier(bar); if ((k) == PROBE_A) t_mark = __builtin_amdgcn_s_memrealtime(); } while (0)
#else
#define SEAM(k) do { if (IN(k) && IN((k) + 1)) xcd_barrier(bar); } while (0)
#endif
    unsigned char* ws = F.ws;
    const int* positions = (const int*)A.in[2];

#if MK_PROBE
    const unsigned long long t_k0 = __builtin_amdgcn_s_memrealtime(); unsigned long long t_mark = t_k0;
#endif
#if MK_REPS > 1
    for (int rep_ = 0; rep_ < MK_REPS; ++rep_) {
    if (rep_ > 0) { if (F.bid == 0 && F.tid < 128) { __hip_atomic_store(F.ctl + CW_CNT + F.tid, 0u, __ATOMIC_RELAXED, __HIP_MEMORY_SCOPE_AGENT); __hip_atomic_store(F.ctl + CW_CUR + F.tid, 0u, __ATOMIC_RELAXED, __HIP_MEMORY_SCOPE_AGENT); } xcd_barrier(bar); }
#endif
    if (IN(0)) { p0_prologue(F, A); } SEAM(0);
    if (IN(1)) {
        { pg8::Gemm g{(const bf16*)(ws + WS_A), (const bf16*)(ws + WS_WIN), 1024, nullptr}; pg8::StaticOrder S; S.init(M / 256, 6, F.G, F.bid, 0);
          EpiProj E{ws, positions, 1.f}; pg8::gemm_phase<EpiProj, pg8::StaticOrder, false>(F.lds, g, S, E); }
        { pg8::Gemm g{(const bf16*)(ws + WS_A8), (const bf16*)(ws + WS_WIN8), 1024, nullptr}; pg8::StaticOrder S; S.init(M / 256, 18, F.G, F.bid, 6, -6);
          EpiProj E{ws, positions, W8_INV}; pg8::gemm_phase<EpiProj, pg8::StaticOrder, false, 1>(F.lds, g, S, E); }
        kv_small(F);
    } SEAM(1);
    if (IN(2)) {
#ifndef NO_GLAA
        gla_a_phase(F, A);
#endif
#ifndef NO_DIL
        attn_phase<true>(F);
#endif
    } SEAM(2);
    if (IN(3)) { gla_scan(F);
        { pg8::Gemm g{(const bf16*)(ws + WS_A8), (const bf16*)(ws + WS_WGATE), 1024, nullptr}; pg8::StaticOrder S; S.init(M / 256, 8, F.G, F.bid);
        EpiGates E{(bf16*)(ws + WS_GATES), INP(11), W8_INV}; pg8::gemm_phase<EpiGates, pg8::StaticOrder, false, 1>(F.lds, g, S, E); } } SEAM(3);
    if (IN(4)) {
        gla_c_phase(F, A);
        dil_combine(F);
    } SEAM(4);
    if (IN(6)) { pg8::Gemm g{(const bf16*)(F.dout + DO_OGD), (const bf16*)(ws + WS_WBG), 1024, nullptr}; pg8::StaticOrder S; S.init(M / 256, 4, F.G, F.bid);
        EpiBranchFused E{(bf16*)(ws + WS_MERGED), (const bf16*)(ws + WS_GATES)}; pg8::gemm_phase<EpiBranchFused, pg8::StaticOrder, false>(F.lds, g, S, E); } SEAM(6);
    if (IN(7)) { pg8::Gemm g{(const bf16*)(ws + WS_MERGED), (const bf16*)(ws + WS_WMIX), 1024, nullptr}; pg8::StaticOrder S; S.init(M / 256, 4, F.G, F.bid);
        EpiResBf16 E{INP(0), nullptr, (bf16*)(ws + WS_A), ws + WS_H2F8}; pg8::gemm_phase<EpiResBf16, pg8::StaticOrder, false>(F.lds, g, S, E); } SEAM(7);
    if (IN(8)) {
        const int gw = F.bid * NWAVES + F.wave, NGW = F.G * NWAVES;
        LAS float* scr = (LAS float*)(F.lds + F.wave * 16384);
        constexpr int IPM = 16 * 32;
        for (int it = gw; it < 3 * NEXP * IPM; it += NGW) { const int mat = it / IPM, r = it % IPM, kind = mat / NEXP, e = mat % NEXP;
            if (kind == 0) transpose_item<RmGU, true>(INP(21) + (size_t)e * 1048576, 1024, 1024, (bf16*)(ws + WS_WGU), RmGU{e * 2048}, scr, r, F.lane, INP(18));
            else if (kind == 1) transpose_item<RmGU, true>(INP(23) + (size_t)e * 1048576, 1024, 1024, (bf16*)(ws + WS_WGU), RmGU{e * 2048 + 128}, scr, r, F.lane, INP(18));
            else transpose_item<RmId, true>(INP(25) + (size_t)e * 1048576, 1024, 1024, (bf16*)(ws + WS_WDN), RmId{e * 1024}, scr, r, F.lane); }
    }
    if (IN(9)) { pg8::Gemm g{(const bf16*)(ws + WS_H2F8), (const bf16*)(ws + WS_WXQ), 1024, nullptr};     pg8::StaticOrder S; S.init(M / 256, 2, F.G, F.bid);
        LAS float* rs = (LAS float*)(F.lds + TAB_OFF);
        { pg8::Unit u; for (int i = 0; i < 8 && S.next(i, u); ++i) {
              for (int r0 = F.wave * 32; r0 < F.wave * 32 + 32; r0 += 8) {
                  u32x4 w[8][2];
#pragma unroll
                  for (int q = 0; q < 8; ++q) { const bf16* xr = (const bf16*)(ws + WS_A) + ((size_t)u.pm * 256 + r0 + q) * DM + F.lane * 8; w[q][0] = *(const u32x4*)xr; w[q][1] = *(const u32x4*)(xr + 512); }
#pragma unroll
                  for (int q = 0; q < 8; ++q) { f32x4 a0, a1, b0, b1; unpack8f(w[q][0], a0, a1); unpack8f(w[q][1], b0, b1);
                      float ss = (a0[0] * a0[0] + a0[1] * a0[1]) + (a0[2] * a0[2] + a0[3] * a0[3]) + (a1[0] * a1[0] + a1[1] * a1[1]) + (a1[2] * a1[2] + a1[3] * a1[3])
                               + (b0[0] * b0[0] + b0[1] * b0[1]) + (b0[2] * b0[2] + b0[3] * b0[3]) + (b1[0] * b1[0] + b1[1] * b1[1]) + (b1[2] * b1[2] + b1[3] * b1[3]);
                      ss = wave_sum(ss); if (F.lane == 0) rs[i * 256 + r0 + q] = W8_INV / sqrtf(ss * (1.f / DM) + EPS); } } } }
        __syncthreads();
        EpiRowScaleBf16 E{(bf16*)(ws + WS_QX), 512, rs}; pg8::gemm_phase<EpiRowScaleBf16, pg8::StaticOrder, false, 1>(F.lds, g, S, E); } SEAM(9);
    if (IN(10)) { attn_phase<false>(F); } SEAM(10);
    if (IN(11)) { pg8::Gemm g{(const bf16*)(ws + WS_QX), (const bf16*)(ws + WS_WXO), 512, nullptr}; pg8::StaticOrder S; S.init(M / 256, 4, F.G, F.bid);
        EpiResBf16 E{nullptr, (const bf16*)(ws + WS_A), (bf16*)(ws + WS_A), ws + WS_H2F8}; pg8::gemm_phase<EpiResBf16, pg8::StaticOrder, false>(F.lds, g, S, E); } SEAM(11);
    if (IN(12)) { router_phase(F, A); } SEAM(12);
    if (IN(13)) { place_phase(F); } SEAM(13);
#define MOE_GU(half, wsh, cc) do { const MoeTab T = moe_tables(F, half); \
        pg8::Gemm g{(const bf16*)(ws + WS_H2F8), (const bf16*)(ws + WS_WGU), 1024, (const int*)(ws + WS_RTOK) + (half) * RT_CAP}; \
        pg8::MoeOrder S; S.init(T.nblk[0], 8, F.G, (cc)); S.blk_e = T.blk_e; \
        EpiSwiglu E{ws + (wsh), INP(22), INP(24), 8, (const float*)(ws + WS_RRS) + (half) * RT_CAP}; pg8::gemm_phase<EpiSwiglu, pg8::MoeOrder, true, 1>(F.lds, g, S, E); } while (0)
#define MOE_DN(half, wsh, wsy, nbv) do { const MoeTab T = moe_tables(F, half); nbv = T.nblk[0]; \
        pg8::Gemm g{(const bf16*)(ws + (wsh)), (const bf16*)(ws + WS_WDN), 1024, nullptr}; \
        pg8::MoeOrder S; S.init(T.nblk[0], 4, F.G, F.bid); S.blk_e = T.blk_e; \
        EpiDown E{(bf16*)(ws + (wsy)), INP(26), (const float*)(ws + WS_RGATE) + (half) * RT_CAP, 4}; pg8::gemm_phase<EpiDown, pg8::MoeOrder, false, 1>(F.lds, g, S, E); } while (0)
    if (IN(14)) { MOE_GU(0, WS_H, F.bid); } SEAM(14);
    if (IN(15)) { int nb0 = 0; MOE_DN(0, WS_H, WS_Y, nb0); const int rem = (nb0 * 4) % F.G; MOE_GU(1, WS_H1, (F.bid + F.G - rem) % F.G); } SEAM(15);
    if (IN(16)) { int nb1 = 0; MOE_DN(1, WS_H1, WS_Y1, nb1); combine_phase(F, A, 0, WS_Y); } SEAM(16);
    if (IN(17)) { combine_phase(F, A, 1, WS_Y1); }
#if MK_PROBE
    { xcd_barrier(bar); if (F.tid == 0) { const unsigned long long t1 = __builtin_amdgcn_s_memrealtime(), w = ((PROBE_A == 100 ? t1 : t_mark) - t_k0) * PROBE_K; while (__builtin_amdgcn_s_memrealtime() - t1 < w) __builtin_amdgcn_s_sleep(8); } __syncthreads(); }
#endif
#if MK_REPS > 1
    xcd_barrier(bar); }
#endif
#undef IN
#undef SEAM
}


extern "C" void kernel_launch(void* const* d_in, const int* in_sizes, int n_in, void* d_out, int out_size, void* d_ws, size_t ws_size, hipStream_t stream) {
    static int grid = 0;
    if (grid == 0) {
        if (n_in != 28 || out_size != M * DM || ws_size < WS_END) { fprintf(stderr, "kernel_launch: unexpected shapes (n_in %d, out %d, ws %zu)\n", n_in, out_size, ws_size); grid = -1; return; }
        int dev = 0, cus = 0, per_cu = 0;
        if (hipGetDevice(&dev) != hipSuccess || hipDeviceGetAttribute(&cus, hipDeviceAttributeMultiprocessorCount, dev) != hipSuccess) { grid = -1; return; }
        if (hipFuncSetAttribute((const void*)mk_fwd, hipFuncAttributeMaxDynamicSharedMemorySize, LDS_BYTES) != hipSuccess) { fprintf(stderr, "kernel_launch: hipFuncSetAttribute failed\n"); grid = -1; return; }
        if (hipOccupancyMaxActiveBlocksPerMultiprocessor(&per_cu, (const void*)mk_fwd, NTHR, LDS_BYTES) != hipSuccess || per_cu < 1) { fprintf(stderr, "kernel_launch: occupancy query says %d\n", per_cu); (void)hipGetLastError(); grid = -1; return; }
        grid = cus;
    }
    if (grid < 0) return;
#if MK_DIAG
    unsigned long long* sums = (unsigned long long*)((char*)d_ws + WS_DIAG);
    (void)hipMemsetAsync(sums, 0, 4096, stream);
    for (int run = 0; run < 2; ++run) {
        (void)hipMemsetAsync((char*)d_ws + 1 * MiB, run ? 0x3C : 0x00, WS_END - 1 * MiB, stream);
        (void)hipMemsetAsync(d_out, run ? 0x3D : 0x00, (size_t)M * DM * 4, stream);
        (void)hipMemsetAsync((char*)d_ws + WS_CTL, 0, CTL_ZERO_BYTES, stream);
        Args a{};
        for (int i = 0; i < 28; ++i) a.in[i] = d_in[i];
        a.out = (float*)d_out; a.ws = (unsigned char*)d_ws;
        for (int p = 0; p < NPH; ++p) { a.ph_lo = p; a.ph_hi = p + 1; hipLaunchKernelGGL(mk_fwd, dim3(grid), dim3(NTHR), LDS_BYTES, stream, a);
            diag_sums(p, (unsigned char*)d_ws, (unsigned char*)d_out, sums + run * 32 + p, stream); }
    }
    hipLaunchKernelGGL(k_verdict, dim3(1024), dim3(256), 0, stream, (const unsigned long long*)sums, (float*)d_out, (size_t)M * DM);
#else
    (void)hipMemsetAsync((char*)d_ws + WS_CTL, 0, CTL_ZERO_BYTES, stream);
    Args a{};
    for (int i = 0; i < 28; ++i) a.in[i] = d_in[i];
    a.out = (float*)d_out; a.ws = (unsigned char*)d_ws;
#if MK_PER_PHASE
    for (int p = 0; p < NPH; ++p) { a.ph_lo = p; a.ph_hi = p + 1; hipLaunchKernelGGL(mk_fwd, dim3(grid), dim3(NTHR), LDS_BYTES, stream, a); }
#else
    a.ph_lo = 0; a.ph_hi = NPH; hipLaunchKernelGGL(mk_fwd, dim3(grid), dim3(NTHR), LDS_BYTES, stream, a);
#endif
#endif
}
```

```cpp
#include <hip/hip_runtime.h>
#include <cstdio>
#include <cstdint>

#define LAS __attribute__((address_space(3)))
#define GAS __attribute__((address_space(1)))
typedef unsigned short bf16;
typedef short bf16x8 __attribute__((ext_vector_type(8)));
typedef short s16x4 __attribute__((ext_vector_type(4)));
typedef float f32x4 __attribute__((ext_vector_type(4)));
typedef float f32x16 __attribute__((ext_vector_type(16)));
typedef unsigned u32x4 __attribute__((ext_vector_type(4)));
typedef unsigned u32x2 __attribute__((ext_vector_type(2)));
typedef int i32x4 __attribute__((ext_vector_type(4)));
typedef int i32x8 __attribute__((ext_vector_type(8)));

typedef float f32x2 __attribute__((ext_vector_type(2)));
typedef __bf16 b16x2 __attribute__((ext_vector_type(2)));
__device__ __forceinline__ unsigned cvt_pk_bf16(float lo, float hi) { const f32x2 v = {lo, hi}; const b16x2 r = __builtin_convertvector(v, b16x2); return __builtin_bit_cast(unsigned, r); }
__device__ __forceinline__ u32x2 pack8_fp8(const f32x4& a, const f32x4& b) {
    unsigned lo = 0, hi = 0; lo = __builtin_amdgcn_cvt_pk_fp8_f32(a[0], a[1], lo, false); lo = __builtin_amdgcn_cvt_pk_fp8_f32(a[2], a[3], lo, true); hi = __builtin_amdgcn_cvt_pk_fp8_f32(b[0], b[1], hi, false); hi = __builtin_amdgcn_cvt_pk_fp8_f32(b[2], b[3], hi, true);
    u32x2 w; w.x = lo; w.y = hi; return w; }
__device__ __forceinline__ float bf2f(unsigned b) { return __uint_as_float(b << 16); }
__device__ __forceinline__ float bflo(unsigned w) { return __uint_as_float(w << 16); }
__device__ __forceinline__ float bfhi(unsigned w) { return __uint_as_float(w & 0xffff0000u); }
__device__ __forceinline__ unsigned f2bf(float f) { unsigned u = __float_as_uint(f); return (u + 0x7fffu + ((u >> 16) & 1u)) >> 16; }
__device__ __forceinline__ unsigned pk2(float lo, float hi) { return f2bf(lo) | (f2bf(hi) << 16); }

namespace pg8 {
constexpr int BM = 256, BK = 64, HALF = 128, HTB = HALF * BK * 2, STAGE_BYTES = 8 * HTB, NXCD = 8, WGM = 4;
__host__ __device__ __forceinline__ int lds_byte(int r, int c) { const int st = (r >> 4) * 2 + (c >> 5), rr = r & 15, cc = c & 31, ob = rr * 64 + cc * 2; return st * 1024 + (ob ^ (((ob >> 9) & 1) << 5)); }
__host__ __device__ __forceinline__ void stage_rc(int b, int& R, int& C) { const int st = b / 1024, sb = b % 1024, swz = sb ^ (((sb >> 9) & 1) << 5); R = (st >> 1) * 16 + swz / 64; C = (st & 1) * 32 + (swz % 64) / 2; }
__host__ __device__ __forceinline__ int perm32(int rho) { const int n = rho >> 4, i = rho & 15; return 8 * (i >> 2) + 4 * n + (i & 3); }

struct Unit { int pm, pn, pb, ord; };
struct Gemm { const bf16* A; const bf16* Bt; int K; const int* rowmap; };

struct StaticOrder {
    int nM, nN, nwg, G, c, pn0, pbd;
    __device__ __forceinline__ void init(int nM_, int nN_, int G_, int c_, int pn0_ = 0, int pbd_ = 0) { nM = nM_; nN = nN_; nwg = nM * nN; G = G_; c = c_; pn0 = pn0_; pbd = pbd_; }
    __device__ __forceinline__ bool next(int i, Unit& u) const {
        const long L = (long)i * G + c; if (L >= nwg) return false;
        int wgid = (int)L; { const int q = nwg / NXCD, r = nwg % NXCD, xcd = wgid % NXCD, off = wgid / NXCD; wgid = (xcd < r ? xcd * (q + 1) : r * (q + 1) + (xcd - r) * q) + off; }
        const int nig = WGM * nN, gid = wgid / nig, fm = gid * WGM, gsz = (nM - fm) < WGM ? (nM - fm) : WGM;
        u.pm = fm + ((wgid % nig) % gsz); u.pn = pn0 + (wgid % nig) / gsz; u.pb = u.pn + pbd; u.ord = i; return true;
    }
};
struct MoeOrder : StaticOrder {
    const LAS int* blk_e;
    __device__ __forceinline__ bool next(int i, Unit& u) const { if (!StaticOrder::next(i, u)) return false; u.pb = blk_e[u.pm] * nN + u.pn; return true; }
};

template <class Epi, class Sched, bool GATHER, int ES = 2>
__device__ __forceinline__ void gemm_phase(LAS unsigned char* lds, const Gemm g, const Sched& S, const Epi& E) {
    const int tid = threadIdx.x, wid = __builtin_amdgcn_readfirstlane(tid >> 6), lane = tid & 63, wr = wid >> 2, wc = wid & 3, fr = lane & 15, fq = lane >> 4;
    const int K = g.K, KB = K * ES  , nt = KB / (BK * 2);
    unsigned voffA[2], voffB[2]; int rA[2], cA2[2];
#pragma unroll
    for (int i = 0; i < 2; ++i) { int R, C; stage_rc(tid * 16 + i * 8192, R, C); const int Rb = Epi::PERM ? ((R & ~31) + perm32(R & 31)) : R;
        voffA[i] = (unsigned)(R * KB + C * 2); voffB[i] = (unsigned)(Rb * KB + C * 2); rA[i] = R; cA2[i] = C * 2; }
    const size_t kstep = (size_t)(BK * 2);
    const size_t hstep = (size_t)HALF * KB;
    const size_t tstep = 2 * hstep;
    const unsigned ldsw = (unsigned)wid * 1024u;
    const int aoff = lds_byte(wr * 64 + fr, fq * 8), boff = lds_byte(wc * 32 + fr, fq * 8);
#define PG8_SA(b, h) (((b) * 2 + (h)) * HTB)
#define PG8_SB(b, h) ((4 + (b) * 2 + (h)) * HTB)
#define PG8_STAGE(bufoff, gbase, voff) do { _Pragma("unroll") for (int _i = 0; _i < 2; ++_i) \
        __builtin_amdgcn_global_load_lds((const unsigned*)((const char*)(gbase) + (voff)[_i]), (LAS unsigned*)(lds + (bufoff) + ldsw + _i * 8192), 16, 0, 0); } while (0)
#define PG8_STAGE_G(bufoff, o0, o1, kb) do { \
        __builtin_amdgcn_global_load_lds((const unsigned*)((const char*)g.A + (size_t)(o0) + (kb)), (LAS unsigned*)(lds + (bufoff) + ldsw), 16, 0, 0); \
        __builtin_amdgcn_global_load_lds((const unsigned*)((const char*)g.A + (size_t)(o1) + (kb)), (LAS unsigned*)(lds + (bufoff) + ldsw + 8192), 16, 0, 0); } while (0)
#define PG8_CAT8(x0, x1) __builtin_shufflevector(__builtin_bit_cast(i32x4, x0), __builtin_bit_cast(i32x4, x1), 0, 1, 2, 3, 4, 5, 6, 7)
#define PG8_LDA(dst, b, h) do { if constexpr (ES == 2) { _Pragma("unroll") for (int m = 0; m < 4; ++m) _Pragma("unroll") for (int k = 0; k < 2; ++k) dst[m][k] = *(const LAS bf16x8*)(lds + PG8_SA(b, h) + aoff + m * 2048 + k * 1024); } \
        else { _Pragma("unroll") for (int m = 0; m < 4; ++m) dst##8[m] = PG8_CAT8(*(const LAS bf16x8*)(lds + PG8_SA(b, h) + aoff + m * 2048), *(const LAS bf16x8*)(lds + PG8_SA(b, h) + aoff + m * 2048 + 1024)); } } while (0)
#define PG8_LDB(dst, b, h) do { if constexpr (ES == 2) { _Pragma("unroll") for (int n = 0; n < 2; ++n) _Pragma("unroll") for (int k = 0; k < 2; ++k) dst[n][k] = *(const LAS bf16x8*)(lds + PG8_SB(b, h) + boff + n * 2048 + k * 1024); } \
        else { _Pragma("unroll") for (int n = 0; n < 2; ++n) dst##8[n] = PG8_CAT8(*(const LAS bf16x8*)(lds + PG8_SB(b, h) + boff + n * 2048), *(const LAS bf16x8*)(lds + PG8_SB(b, h) + boff + n * 2048 + 1024)); } } while (0)
#define PG8_MMA(ai, bj, At, Bt) do { __builtin_amdgcn_s_setprio(1); if constexpr (ES == 2) { _Pragma("unroll") for (int m = 0; m < 4; ++m) _Pragma("unroll") for (int n = 0; n < 2; ++n) _Pragma("unroll") for (int k = 0; k < 2; ++k) \
        acc[ai][bj][m][n] = __builtin_amdgcn_mfma_f32_16x16x32_bf16(Bt[n][k], At[m][k], acc[ai][bj][m][n], 0, 0, 0); } else { _Pragma("unroll") for (int m = 0; m < 4; ++m) _Pragma("unroll") for (int n = 0; n < 2; ++n) \
        asm volatile("v_mfma_scale_f32_16x16x128_f8f6f4 %0, %1, %2, %0, %3, %3 op_sel_hi:[0,0,0]" : "+v"(acc[ai][bj][m][n]) : "v"(Bt##8[n]), "v"(At##8[m]), "v"(sc1)); } \
        __builtin_amdgcn_s_setprio(0); } while (0)
#define PG8_WAIT_V(n) asm volatile("s_waitcnt vmcnt(" #n ")" ::: "memory")
#define PG8_WAIT_L(n) asm volatile("s_waitcnt lgkmcnt(" #n ")" ::: "memory")
#define PG8_BAR __builtin_amdgcn_s_barrier()
#define PG8_SCHED __builtin_amdgcn_sched_barrier(0)
#define PG8_ROWOFF(dst, U) do { _Pragma("unroll") for (int _h = 0; _h < 2; ++_h) _Pragma("unroll") for (int _i = 0; _i < 2; ++_i) \
        dst[_h][_i] = (unsigned)g.rowmap[(U).pm * BM + _h * HALF + rA[_i]] * (unsigned)KB + (unsigned)cA2[_i]; } while (0)
    Unit cur, nxt; int ui = 0;
    if (!S.next(0, cur)) return;
    f32x4 acc[2][2][4][2];
#pragma unroll
    for (int a = 0; a < 2; ++a)
#pragma unroll
        for (int b = 0; b < 2; ++b)
#pragma unroll
            for (int m = 0; m < 4; ++m)
#pragma unroll
                for (int n = 0; n < 2; ++n) acc[a][b][m][n] = (f32x4){0.f, 0.f, 0.f, 0.f};
    const int sc1 = 0x7f7f7f7f;
    bf16x8 At[4][2], B0[2][2], B1[2][2]; i32x8 At8[4], B08[2], B18[2];
    const char* cA = (const char*)g.A + (size_t)cur.pm * tstep; const char* cB = (const char*)g.Bt + (size_t)cur.pb * tstep;
    unsigned cO[2][2] = {{0u, 0u}, {0u, 0u}}, nO[2][2] = {{0u, 0u}, {0u, 0u}};
    bool has_next = S.next(1, nxt);
    if constexpr (GATHER) { PG8_ROWOFF(cO, cur); if (has_next) { PG8_ROWOFF(nO, nxt); } else { _Pragma("unroll") for (int h = 0; h < 2; ++h) _Pragma("unroll") for (int i = 0; i < 2; ++i) nO[h][i] = cO[h][i]; } }
    if constexpr (GATHER) {
        PG8_STAGE(PG8_SB(0, 0), cB, voffB); PG8_STAGE(PG8_SB(0, 1), cB + hstep, voffB); PG8_STAGE_G(PG8_SA(0, 0), cO[0][0], cO[0][1], 0); PG8_STAGE_G(PG8_SA(0, 1), cO[1][0], cO[1][1], 0);
        if (wr == 1) PG8_BAR;
        PG8_WAIT_V(2); PG8_BAR;
        PG8_STAGE(PG8_SB(1, 0), cB + kstep, voffB); PG8_STAGE_G(PG8_SA(1, 0), cO[0][0], cO[0][1], kstep); PG8_STAGE(PG8_SB(1, 1), cB + hstep + kstep, voffB);
        PG8_WAIT_V(6); PG8_BAR;
    } else {
        PG8_STAGE(PG8_SB(0, 0), cB, voffB); PG8_STAGE(PG8_SB(0, 1), cB + hstep, voffB); PG8_STAGE(PG8_SA(0, 0), cA, voffA); PG8_STAGE(PG8_SA(0, 1), cA + hstep, voffA);
        if (wr == 1) PG8_BAR;
        PG8_WAIT_V(2); PG8_BAR;
        PG8_STAGE(PG8_SB(1, 0), cB + kstep, voffB); PG8_STAGE(PG8_SA(1, 0), cA + kstep, voffA); PG8_STAGE(PG8_SB(1, 1), cB + hstep + kstep, voffB);
        PG8_WAIT_V(6); PG8_BAR;
    }
    for (;;) {
        const char* nA = has_next ? (const char*)g.A + (size_t)nxt.pm * tstep : cA; const char* nB = has_next ? (const char*)g.Bt + (size_t)nxt.pb * tstep : cB;
#pragma nounroll
        for (int t = 0; t < nt; t += 2) {
            const bool last = (t == nt - 2);
            const char* a1 = cA + (size_t)(t + 1) * kstep;
            const char* a2 = last ? nA : cA + (size_t)(t + 2) * kstep; const char* b2 = last ? nB : cB + (size_t)(t + 2) * kstep;
            const char* a3 = a2 + kstep; const char* b3 = b2 + kstep;
            const size_t k1 = (size_t)(t + 1) * kstep, k2 = last ? 0 : (size_t)(t + 2) * kstep, k3 = k2 + kstep;
            unsigned x00 = 0, x01 = 0, x10 = 0, x11 = 0;
            if constexpr (GATHER) { x00 = last ? nO[0][0] : cO[0][0]; x01 = last ? nO[0][1] : cO[0][1]; x10 = last ? nO[1][0] : cO[1][0]; x11 = last ? nO[1][1] : cO[1][1]; }
            if constexpr (Epi::HAS_MID) { if (t == nt / 2) E.mid(acc, cur, wr, wc, fr, fq); }
            PG8_LDB(B0, 0, 0); PG8_LDB(B1, 0, 1); PG8_SCHED; PG8_LDA(At, 0, 0);
            if constexpr (GATHER) PG8_STAGE_G(PG8_SA(1, 1), cO[1][0], cO[1][1], k1); else PG8_STAGE(PG8_SA(1, 1), a1 + hstep, voffA);
            PG8_WAIT_V(8); PG8_WAIT_L(0); PG8_BAR; PG8_MMA(0, 0, At, B0); PG8_MMA(0, 1, At, B1); PG8_BAR; PG8_SCHED;
            PG8_LDA(At, 0, 1); PG8_STAGE(PG8_SB(0, 0), b2, voffB); PG8_STAGE(PG8_SB(0, 1), b2 + hstep, voffB);
            if constexpr (GATHER) PG8_STAGE_G(PG8_SA(0, 0), x00, x01, k2); else PG8_STAGE(PG8_SA(0, 0), a2, voffA);
            PG8_WAIT_V(8); PG8_WAIT_L(0); PG8_BAR; PG8_MMA(1, 0, At, B0); PG8_MMA(1, 1, At, B1); PG8_BAR; PG8_SCHED;
            PG8_LDB(B0, 1, 0); PG8_LDB(B1, 1, 1); PG8_SCHED; PG8_LDA(At, 1, 0);
            if constexpr (GATHER) PG8_STAGE_G(PG8_SA(0, 1), x10, x11, k2); else PG8_STAGE(PG8_SA(0, 1), a2 + hstep, voffA);
            PG8_WAIT_V(8); PG8_WAIT_L(0); PG8_BAR; PG8_MMA(0, 0, At, B0); PG8_MMA(0, 1, At, B1); PG8_BAR; PG8_SCHED;
            PG8_LDA(At, 1, 1); PG8_STAGE(PG8_SB(1, 0), b3, voffB); PG8_STAGE(PG8_SB(1, 1), b3 + hstep, voffB);
            if constexpr (GATHER) PG8_STAGE_G(PG8_SA(1, 0), x00, x01, k3); else PG8_STAGE(PG8_SA(1, 0), a3, voffA);
            PG8_WAIT_V(8); PG8_WAIT_L(0); PG8_BAR; PG8_MMA(1, 0, At, B0); PG8_MMA(1, 1, At, B1); PG8_BAR; PG8_SCHED;
        }
        if constexpr (ES == 1) asm volatile("s_nop 15\n\ts_nop 15" ::: "memory");
        asm volatile("" : "+s"(cur.pm), "+s"(cur.pn), "+s"(cur.pb));
        if (wr == 0) PG8_BAR;
        Unit nn = cur; const bool has_nn = has_next && S.next(ui + 2, nn);
        unsigned tO[2][2] = {{0u, 0u}, {0u, 0u}};
        if constexpr (GATHER) { if (has_nn) { PG8_ROWOFF(tO, nn); } }
        E(acc, cur, wr, wc, fr, fq);
        if (!has_next) break;
#pragma unroll
        for (int a = 0; a < 2; ++a)
#pragma unroll
            for (int b = 0; b < 2; ++b)
#pragma unroll
                for (int m = 0; m < 4; ++m)
#pragma unroll
                    for (int n = 0; n < 2; ++n) acc[a][b][m][n] = (f32x4){0.f, 0.f, 0.f, 0.f};
        if constexpr (GATHER) {
#pragma unroll
            for (int h = 0; h < 2; ++h)
#pragma unroll
                for (int i = 0; i < 2; ++i) { cO[h][i] = nO[h][i]; nO[h][i] = has_nn ? tO[h][i] : nO[h][i]; } }
        cur = nxt; cA = nA; cB = nB; ++ui; nxt = nn; has_next = has_nn;
        if (wr == 1) PG8_BAR;
    }
    PG8_WAIT_V(0);
    PG8_BAR;
#undef PG8_SA
#undef PG8_SB
#undef PG8_STAGE
#undef PG8_STAGE_G
#undef PG8_LDA
#undef PG8_LDB
#undef PG8_MMA
#undef PG8_CAT8
#undef PG8_WAIT_V
#undef PG8_WAIT_L
#undef PG8_BAR
#undef PG8_SCHED
#undef PG8_ROWOFF
}
}

namespace att {
constexpr float SCALE = 0.08838834764831845f;
constexpr int NW = 8, QBLK = 32, KVBLK = 64, QB = NW * QBLK, D = 128;
constexpr int SHM_V = KVBLK * D * 2, SHM_K = KVBLK * D * 2;
constexpr int LDS_BYTES = 2 * SHM_V + 2 * SHM_K + NW * 64 * 4;
constexpr float THR = 8.f;
#define KSWZ(row, colB) ((row) * 256 + ((colB) ^ (((row) & 7) << 4)))
#define SBAR() __builtin_amdgcn_sched_barrier(0)
__device__ __forceinline__ int v_st(int k, int c) { const int kk = (k & ~0xC) | ((k & 4) << 1) | ((k & 8) >> 1); return ((kk >> 3) * 4 + (c >> 5)) * 512 + ((kk & 7) * 32 + (c & 31)) * 2; }
__device__ __forceinline__ int v_rd_base(int lane) { return ((lane & 3) << 3) | (((lane >> 2) & 3) << 6) | (((lane >> 4) & 1) << 5) | (((lane >> 5) & 1) << 8); }
constexpr int v_rd_off(int d0, int ks, int half) { return d0 * 512 + ks * 4096 + half * 2048; }
__device__ __forceinline__ int crow(int r, int hi) { return (r & 3) + 8 * (r >> 2) + 4 * hi; }
__device__ __forceinline__ unsigned cvtpk(float lo, float hi) { return cvt_pk_bf16(lo, hi); }
__device__ __forceinline__ bf16x8 load8(const bf16* p) { return *reinterpret_cast<const bf16x8*>(p); }
__device__ __forceinline__ void mask_tile(f32x16& p0, f32x16& p1, int dq, unsigned W) {
    const float NEG = -__builtin_inff();
#pragma unroll
    for (int r = 0; r < 16; ++r) {
        const int c = (r & 3) + 8 * (r >> 2);
        if ((unsigned)(dq - c) >= W) p0[r] = NEG;
        if ((unsigned)(dq - c - 32) >= W) p1[r] = NEG;
    }
}
__device__ __forceinline__ void partialSM(f32x16& p0, f32x16& p1, float& m_reg, float& mn, float& alpha) {
    float pmax = p0[0]; for (int r = 1; r < 16; ++r) pmax = fmaxf(pmax, p0[r]); for (int r = 0; r < 16; ++r) pmax = fmaxf(pmax, p1[r]);
    { auto rr = __builtin_amdgcn_permlane32_swap(__float_as_uint(pmax), __float_as_uint(pmax), false, false);
      pmax = fmaxf(__uint_as_float(rr[0]), __uint_as_float(rr[1])); }
    constexpr float C2 = 1.4426950408889634f * SCALE;
    if (__builtin_expect(__all((pmax - m_reg) * SCALE <= THR), 1)) { mn = m_reg; alpha = 1.f; }
    else { mn = fmaxf(m_reg, pmax); alpha = __builtin_amdgcn_exp2f((m_reg - mn) * C2); m_reg = mn; }
    const float mnL = -mn * C2;
    for (int r = 0; r < 16; ++r) p0[r] = fmaf(p0[r], C2, mnL); for (int r = 0; r < 16; ++r) p1[r] = fmaf(p1[r], C2, mnL);
    for (int r = 0; r < 16; ++r) p0[r] = __builtin_amdgcn_exp2f(p0[r]);
}
__device__ __forceinline__ void finishSM(f32x16& p0, f32x16& p1, float alpha, float& l_reg, bf16x8& pa0, bf16x8& pa1, bf16x8& pa2, bf16x8& pa3) {
    for (int r = 0; r < 16; ++r) p1[r] = __builtin_amdgcn_exp2f(p1[r]);
    float ps = 0; for (int r = 0; r < 16; ++r) ps += p0[r]; for (int r = 0; r < 16; ++r) ps += p1[r];
    { auto rr = __builtin_amdgcn_permlane32_swap(__float_as_uint(ps), __float_as_uint(ps), false, false);
      ps = __uint_as_float(rr[0]) + __uint_as_float(rr[1]); }
    l_reg = l_reg * alpha + ps;
#define PK4(P, B_, OUT) do { unsigned a0 = cvtpk(P[B_+0], P[B_+1]), a1 = cvtpk(P[B_+2], P[B_+3]);                          \
        unsigned b0 = cvtpk(P[B_+4], P[B_+5]), b1 = cvtpk(P[B_+6], P[B_+7]);                                             \
        auto r0 = __builtin_amdgcn_permlane32_swap(a0, b0, false, false); auto r1 = __builtin_amdgcn_permlane32_swap(a1, b1, false, false); \
        u32x4 w = {r0[0], r1[0], r0[1], r1[1]}; OUT = *reinterpret_cast<bf16x8*>(&w); } while (0)
    PK4(p0, 0, pa0); PK4(p0, 8, pa1); PK4(p1, 0, pa2); PK4(p1, 8, pa3);
#undef PK4
}
template <int KB, bool SK>
__device__ __forceinline__ void qkt(f32x16& p0, f32x16& p1, const char* K_lds, int r32, int hi, const bf16x8* qr, bool act) {
    if (SK && !act) { const float NEG = -__builtin_inff();
#pragma unroll
        for (int r = 0; r < 16; ++r) { p0[r] = NEG; p1[r] = NEG; } return; }
    p0 = f32x16{}; p1 = f32x16{};
    const char* kb[4];
#pragma unroll
    for (int dd = 0; dd < 4; ++dd) kb[dd] = K_lds + KB * SHM_K + KSWZ(r32, (dd * 16 + hi * 8) * 2);
#pragma unroll
    for (int d0 = 0; d0 < 8; ++d0) { const char* a = kb[d0 & 3] + (d0 >> 2) * 128;
        bf16x8 b0 = *reinterpret_cast<const bf16x8*>(a);
        bf16x8 b1 = *reinterpret_cast<const bf16x8*>(a + 32 * 256);
        p0 = __builtin_amdgcn_mfma_f32_32x32x16_bf16(b0, qr[d0], p0, 0, 0, 0);
        p1 = __builtin_amdgcn_mfma_f32_32x32x16_bf16(b1, qr[d0], p1, 0, 0, 0); }
}
template <int VB, bool SK>
__device__ __forceinline__ void pv_tile(f32x16* o, int vb0, bf16x8 pa0, bf16x8 pa1, bf16x8 pa2, bf16x8 pa3, bool act) {
    if (SK && !act) return;
#define TRRD(dst, off) asm volatile("ds_read_b64_tr_b16 %0, %1 offset:%2" : "=&v"(dst) : "v"(vb0), "i"(off) : "memory")
#define PV_D0(d0) do { s16x4 l0, l1, l2, l3, h0, h1, h2, h3; constexpr int b_ = VB * SHM_V + v_rd_off(d0, 0, 0); \
        TRRD(l0, b_); TRRD(h0, b_ + 2048); TRRD(l1, b_ + 4096); TRRD(h1, b_ + 6144); TRRD(l2, b_ + 8192); TRRD(h2, b_ + 10240); TRRD(l3, b_ + 12288); TRRD(h3, b_ + 14336); \
        asm volatile("s_waitcnt lgkmcnt(0)" ::: "memory"); SBAR();   \
        o[d0] = __builtin_amdgcn_mfma_f32_32x32x16_bf16(pa0, (bf16x8){l0[0], l0[1], l0[2], l0[3], h0[0], h0[1], h0[2], h0[3]}, o[d0], 0, 0, 0);   \
        o[d0] = __builtin_amdgcn_mfma_f32_32x32x16_bf16(pa1, (bf16x8){l1[0], l1[1], l1[2], l1[3], h1[0], h1[1], h1[2], h1[3]}, o[d0], 0, 0, 0);   \
        o[d0] = __builtin_amdgcn_mfma_f32_32x32x16_bf16(pa2, (bf16x8){l2[0], l2[1], l2[2], l2[3], h2[0], h2[1], h2[2], h2[3]}, o[d0], 0, 0, 0);   \
        o[d0] = __builtin_amdgcn_mfma_f32_32x32x16_bf16(pa3, (bf16x8){l3[0], l3[1], l3[2], l3[3], h3[0], h3[1], h3[2], h3[3]}, o[d0], 0, 0, 0); } while (0)
    PV_D0(0); PV_D0(1); PV_D0(2); PV_D0(3);
#undef PV_D0
#undef TRRD
}
struct BlockRef { bf16* Q; const bf16* K; float* L; int P0, qs, ks, ls, skv; };
struct Seam { bf16x8 qr[8]; bf16x8 st_v0, st_v1, st_k0, st_k1; };
__device__ __forceinline__ int swa_jlo(int P0, int W) { const int lowk = P0 - W + 1; return lowk > 0 ? lowk / KVBLK : 0; }
#define ROW(p, KS_, k0, rr) ((p) + (size_t)((k0) + (rr)) * (KS_) + sc)
#define VMW() asm volatile("s_waitcnt vmcnt(0)" ::: "memory")
#define VMWN(n) asm volatile("s_waitcnt vmcnt(%0)" :: "i"(n) : "memory")
#define SLOAD_H(Kp, Vp, KS_, k0) do { S.st_v0 = load8(ROW(Vp, KS_, k0, sr)); S.st_v1 = load8(ROW(Vp, KS_, k0, 32 + sr));              \
                         S.st_k0 = load8(ROW(Kp, KS_, k0, sr)); S.st_k1 = load8(ROW(Kp, KS_, k0, 32 + sr)); } while (0)
#define SWRITE_HK(bf) do { *(bf16x8*)(K_lds + (bf) * SHM_K + kws) = S.st_k0; *(bf16x8*)(K_lds + (bf) * SHM_K + kws + 32 * 256) = S.st_k1; } while (0)
#define SWRITE_HV(bf) do { *(bf16x8*)(V_lds + (bf) * SHM_V + vst0) = S.st_v0; *(bf16x8*)(V_lds + (bf) * SHM_V + vst1) = S.st_v1; } while (0)
#define SWRITE_H(bf) do { SWRITE_HV(bf); SWRITE_HK(bf); } while (0)
template <long VOFF>
__device__ __forceinline__ void prime(const BlockRef& cur, int W, char* lds, Seam& S) {
    const int tid = threadIdx.x, wid = __builtin_amdgcn_readfirstlane(tid >> 6), lane = tid & 63, r32 = lane & 31, hi = lane >> 5;
    const int sr = tid >> 4, sc = (tid & 15) * 8, kws = KSWZ(sr, sc * 2); char* K_lds = lds + 2 * SHM_V;
    const int kb0 = swa_jlo(cur.P0, W) * KVBLK;
    for (int d0 = 0; d0 < 8; ++d0) S.qr[d0] = load8(cur.Q + (size_t)(wid * QBLK + r32) * cur.qs + d0 * 16 + hi * 8);
    SLOAD_H(cur.K, cur.K + VOFF, cur.ks, kb0); VMW(); SWRITE_HK(0);
    __syncthreads();
}
template <bool SK, long VOFF>
__device__ __forceinline__ void block(const BlockRef& cur, const BlockRef& nxt, int W, char* lds, Seam& S) {
    const int tid = threadIdx.x, wid = __builtin_amdgcn_readfirstlane(tid >> 6), lane = tid & 63, r32 = lane & 31, hi = lane >> 5;
    const int skv = cur.skv;
    const int j_lo = swa_jlo(cur.P0, W);
    int j_hi = (cur.P0 + QB - 1) / KVBLK + 1; if (j_hi > skv / KVBLK) j_hi = skv / KVBLK;
    const int NT = j_hi - j_lo;
    const int kbn = swa_jlo(nxt.P0, W) * KVBLK;
    const int qlo = cur.P0 + wid * QBLK, qm = qlo + r32 - 4 * hi;
    char* V_lds = lds; char* K_lds = lds + 2 * SHM_V;
    float* ws = (float*)(lds + 2 * SHM_V + 2 * SHM_K) + wid * 64; float* li_l = ws, * al_l = ws + 32;
    float m_reg = -1e30f, l_reg = 0; f32x16 o[4] = {};
    const int sr = tid >> 4, sc = (tid & 15) * 8, vst0 = v_st(sr, sc), vst1 = v_st(32 + sr, sc), kws = KSWZ(sr, sc * 2);
    const int vb0 = (int)(uintptr_t)V_lds + v_rd_base(lane);
    const bf16* Kh = cur.K; const bf16* Vh = cur.K + VOFF; const int KS = cur.ks;
#define RESC(a) do { if (__any((a) < 1.f)) { if (hi == 0) al_l[r32] = (a); asm volatile("s_waitcnt lgkmcnt(0)" ::: "memory");              \
                     for (int d_ = 0; d_ < 4; ++d_) for (int r = 0; r < 16; ++r) o[d_][r] *= al_l[crow(r, hi)]; } } while (0)
#define KBASE(t) ((j_lo + (t)) * KVBLK)
#define ACT(t) (KBASE(t) <= qlo + QBLK - 1 && KBASE(t) + KVBLK - 1 >= qlo - W + 1)
#define MASKT(P0_, P1_, t) do { const int kb_ = KBASE(t); if ((!SK || ACT(t)) && (kb_ + KVBLK - 1 > qlo || kb_ <= qlo + QBLK - 1 - W)) mask_tile(P0_, P1_, qm - kb_, (unsigned)W); } while (0)
    constexpr int NQL = 8;
#define SEAM_K0() do { VMWN(NQL); SWRITE_HK(0); SBAR(); } while (0)
    f32x16 pA0, pA1, pB0, pB1; float mnA, mnB, alA, alB; bf16x8 pa0, pa1, pa2, pa3;
    SWRITE_HV(0); SBAR();
    if (NT > 1) { SLOAD_H(Kh, Vh, KS, KBASE(1)); }
    SBAR(); qkt<0, SK>(pA0, pA1, K_lds, r32, hi, S.qr, ACT(0));
    MASKT(pA0, pA1, 0); partialSM(pA0, pA1, m_reg, mnA, alA);
    if (NT > 1) { VMW(); SWRITE_H(1); }
    __syncthreads();
#define HALF_STEP(PX0, PX1, mnX, alX, PY0, PY1, alY, t, KB, VB, SB) do {                                                      \
        SBAR(); qkt<KB, SK>(PX0, PX1, K_lds, r32, hi, S.qr, ACT(t));                                             \
        finishSM(PY0, PY1, alY, l_reg, pa0, pa1, pa2, pa3); SBAR();                                                           \
        if ((t) + 1 < NT) { SLOAD_H(Kh, Vh, KS, KBASE((t) + 1)); SBAR(); }                                               \
        pv_tile<VB, SK>(o, vb0, pa0, pa1, pa2, pa3, ACT((t) - 1)); MASKT(PX0, PX1, (t)); partialSM(PX0, PX1, m_reg, mnX, alX);                                        \
        __syncthreads();                                                                                                      \
        if ((t) + 1 < NT) { VMW(); SWRITE_H(SB); }                                                                          \
        RESC(alX); __syncthreads(); } while (0)
    for (int t = 1; t + 1 < NT; t += 2) {
        HALF_STEP(pB0, pB1, mnB, alB, pA0, pA1, alA, t, 1, 0, 0);
        HALF_STEP(pA0, pA1, mnA, alA, pB0, pB1, alB, t + 1, 0, 1, 1);
    }
    const bool even = (NT & 1) == 0;
    if (even) { SBAR(); qkt<1, SK>(pB0, pB1, K_lds, r32, hi, S.qr, ACT(NT - 1)); SBAR(); }
    { SLOAD_H(nxt.K, nxt.K + VOFF, nxt.ks, kbn); SBAR();
#pragma unroll
      for (int d0 = 0; d0 < 8; ++d0) S.qr[d0] = load8(nxt.Q + (size_t)(wid * QBLK + r32) * nxt.qs + d0 * 16 + hi * 8); }
    SBAR();
    finishSM(pA0, pA1, alA, l_reg, pa0, pa1, pa2, pa3); SBAR();
    pv_tile<0, SK>(o, vb0, pa0, pa1, pa2, pa3, ACT(even ? NT - 2 : NT - 1));
    if (even) { MASKT(pB0, pB1, NT - 1); partialSM(pB0, pB1, m_reg, mnB, alB); __syncthreads(); RESC(alB);
        finishSM(pB0, pB1, alB, l_reg, pa0, pa1, pa2, pa3); SBAR(); pv_tile<1, SK>(o, vb0, pa0, pa1, pa2, pa3, ACT(NT - 1)); }
    SBAR(); SEAM_K0();
    if (hi == 0) li_l[r32] = l_reg; asm volatile("s_waitcnt lgkmcnt(0)" ::: "memory");
    if (cur.L != nullptr && hi == 0) cur.L[(size_t)(wid * QBLK + r32) * cur.ls] = m_reg * SCALE + __logf(l_reg);
    float rli[16];
#pragma unroll
    for (int r = 0; r < 16; ++r) rli[r] = __builtin_amdgcn_rcpf(li_l[crow(r, hi)]);
    bf16* Op = cur.Q + (size_t)(wid * QBLK + 4 * hi) * cur.qs + r32; const size_t qstep = (size_t)cur.qs;
#pragma unroll
    for (int r = 0; r < 16; ++r) {
        asm volatile("" : "+v"(Op));
#pragma unroll
        for (int d0 = 0; d0 < 4; ++d0) { const float v = o[d0][r] * rli[r];
            const float vn = __shfl_xor(v, 1);
            if ((r32 & 1) == 0) *(unsigned*)(Op + d0 * 32) = cvtpk(v, vn); }
        Op += ((r & 3) == 3) ? 5 * qstep : qstep; }
    __syncthreads();
#undef RESC
#undef KBASE
#undef ACT
#undef MASKT
#undef SEAM_K0
#undef HALF_STEP
}
#undef ROW
#undef VMW
#undef VMWN
#undef SLOAD_H
#undef SWRITE_HK
#undef SWRITE_HV
#undef SWRITE_H
#undef KSWZ
}

constexpr int NWAVES = 8, NTHR = 512;
constexpr int M = 65536, DM = 1024, SEQ = 8192, NBATCH = 8;
constexpr int N1 = 6144;
constexpr int ROPE_POS = 9216;
constexpr float EPS = 1e-5f;
constexpr int NEXP = 32, HALF_TOK = 32768, RT_CAP = 139264;
constexpr int MAXBLK = 544;
constexpr int NPH = 19;
#ifndef MK_REPS
#define MK_REPS 1
#endif
#ifndef MK_PROBE
#define MK_PROBE 0
#define PROBE_A 0
#define PROBE_K 1
#endif
#ifndef MK_DIAG
#define MK_DIAG 0
#endif
#ifndef MK_PER_PHASE
#define MK_PER_PHASE 0
#endif

constexpr size_t MiB = 1u << 20;
constexpr size_t WS_CTL = 0, CTL_ZERO_BYTES = 1 * MiB;
constexpr size_t WS_WIN = 1 * MiB, WS_WGATE = 14 * MiB, WS_WBG = 18 * MiB, WS_WBD = 19 * MiB, WS_WMIX = 20 * MiB, WS_WXQ = 22 * MiB, WS_WXKV = 23 * MiB, WS_WXO = 25 * MiB, WS_WR = 26 * MiB;
constexpr size_t WS_ROPE = 27 * MiB, WS_MEMN = 32 * MiB, WS_KVM = 36 * MiB, WS_DECAY = 40 * MiB;
constexpr size_t WS_TOPE = 41 * MiB, WS_TGATE = 42 * MiB, WS_TSLOT = 43 * MiB, WS_RTOK = 44 * MiB, WS_RGATE = 46 * MiB;
constexpr size_t WS_RRS = 47 * MiB + 512 * 1024, WS_RSTD3 = 48 * MiB + 768 * 1024;
constexpr size_t WS_A = 49 * MiB;
constexpr size_t WS_QG = 177 * MiB, WS_KG = 209 * MiB, WS_VG = 241 * MiB, WS_RG = 305 * MiB, WS_ALR = 369 * MiB, WS_LSE = 373 * MiB;
constexpr size_t WS_QD = 376 * MiB, WS_KD = 568 * MiB, WS_VD = 760 * MiB, WS_A8 = 952 * MiB, WS_WIN8 = 1016 * MiB, WS_END = 1021 * MiB;
constexpr size_t WS_GATES = WS_KD, WS_MERGED = 824 * MiB;
constexpr size_t WS_QX = WS_QD;
constexpr size_t WS_WGU = 177 * MiB, WS_WDN = 920 * MiB, WS_H2F8 = 273 * MiB;
constexpr float W8_SCALE = 64.f, W8_INV = 1.f / 64.f;
constexpr size_t WS_H = 376 * MiB, WS_H1 = 512 * MiB, WS_Y = 648 * MiB, WS_Y1 = 177 * MiB;
static_assert(WS_RGATE + 2 * (size_t)RT_CAP * 4 <= WS_RRS && WS_RRS + 2 * (size_t)RT_CAP * 4 <= WS_RSTD3 && WS_RSTD3 + (size_t)M * 4 <= WS_A, "ws map (row tables)");
static_assert(WS_Y + (size_t)RT_CAP * 2048 <= WS_WDN && WS_WDN + 32 * MiB <= WS_A8 && WS_H + (size_t)RT_CAP * 1024 <= WS_H1 && WS_H1 + (size_t)RT_CAP * 1024 <= WS_Y && WS_Y1 + (size_t)RT_CAP * 2048 <= WS_H1 && WS_RTOK + 2 * (size_t)RT_CAP * 4 <= WS_RGATE && WS_RGATE + 2 * (size_t)RT_CAP * 4 <= WS_A, "ws map");
constexpr size_t DO_OGD = 0, DO_ST = 128 * MiB;
constexpr int CW_BAR = 4096, CW_CNT = 8192, CW_CUR = 8320;
constexpr int RING_BYTES = 131072, MISC_OFF = RING_BYTES, TAB_OFF = RING_BYTES + 1024, LDS_BYTES = 147456;

#define XB_TMO      128
#define XB_XCNT(j)  (256  + 64 * (j))
#define XB_XSUB(j)  (1280 + 64 * (j))
#define XB_XGEN(j)  (2304 + 64 * (j))
#define XB_TOP      3328
#define XB_TOPGEN   3392
#define XCD_BAR_WORDS 3456
#define XB_SPIN_CAP (1u << 18)
__device__ __forceinline__ unsigned xb_ld(unsigned* p)              { return __hip_atomic_load(p, __ATOMIC_RELAXED, __HIP_MEMORY_SCOPE_AGENT); }
__device__ __forceinline__ unsigned xb_add(unsigned* p, unsigned v) { return __hip_atomic_fetch_add(p, v, __ATOMIC_RELAXED, __HIP_MEMORY_SCOPE_AGENT); }
__device__ __forceinline__ unsigned xb_xcc_id() { return (unsigned)__builtin_amdgcn_s_getreg((3 << 11) | 20) & 0xFu; }
#define XB_SPIN(cond, bar) do { unsigned _sp = 0; while (cond) { __builtin_amdgcn_s_sleep(1); \
    if ((++_sp & 255u) == 0u) { if (xb_ld(&(bar)[XB_TMO])) break; if (_sp > XB_SPIN_CAP) { atomicAdd(&(bar)[XB_TMO], 1u); break; } } } } while (0)
struct XcdBarrier { unsigned* bar; unsigned x; volatile LAS unsigned* st; };
__device__ __forceinline__ XcdBarrier xcd_barrier_post(unsigned* bar, volatile LAS unsigned* st) {
    XcdBarrier b; b.bar = bar; b.x = xb_xcc_id(); b.st = st;
    if (threadIdx.x == 0) (void)xb_add(&bar[XB_XCNT(b.x)], 1u);
    return b;
}
__device__ __forceinline__ void xcd_barrier_complete(unsigned* bar, unsigned x, unsigned& nloc, unsigned& nx) {
    const unsigned G = gridDim.x * gridDim.y * gridDim.z;
    unsigned sum, cnt, mine, sp = 0u;
    for (;;) {
        sum = 0u; cnt = 0u; mine = 0u;
#pragma unroll
        for (unsigned j = 0; j < 16; ++j) { const unsigned c = xb_ld(&bar[XB_XCNT(j)]); sum += c; cnt += (c > 0u) ? 1u : 0u; mine = (j == x) ? c : mine; }
        if (sum == G) break;
        __builtin_amdgcn_s_sleep(1);
        if ((++sp & 255u) == 0u) { if (xb_ld(&bar[XB_TMO])) break; if (sp > XB_SPIN_CAP) { atomicAdd(&bar[XB_TMO], 1u); break; } }
    }
    nloc = mine > 0u ? mine : 1u; nx = cnt > 0u ? cnt : 1u;
}
__device__ __forceinline__ void xcd_barrier(const XcdBarrier& b) {
    asm volatile("s_waitcnt vmcnt(0)" ::: "memory");
    __syncthreads();
    if (threadIdx.x == 0) {
        unsigned* bar = b.bar;
        __builtin_amdgcn_s_waitcnt(0);
        unsigned nloc = b.st[0], nx = b.st[1];
        if (nloc == 0u) { xcd_barrier_complete(bar, b.x, nloc, nx); b.st[0] = nloc; b.st[1] = nx; }
        const unsigned old = xb_add(&bar[XB_XSUB(b.x)], 1u);
        const unsigned gen = old / nloc;
        if (old + 1u == (gen + 1u) * nloc) {
            __builtin_amdgcn_fence(__ATOMIC_RELEASE, "agent");
            asm volatile("s_waitcnt vmcnt(0)" ::: "memory");
            const unsigned og = xb_add(&bar[XB_TOP], 1u);
            const unsigned tg = og / nx;
            if (og + 1u == (tg + 1u) * nx) xb_add(&bar[XB_TOPGEN], 1u);
            else XB_SPIN(xb_ld(&bar[XB_TOPGEN]) == tg, bar);
            __builtin_amdgcn_fence(__ATOMIC_ACQUIRE, "agent");
            xb_add(&bar[XB_XGEN(b.x)], 1u);
            asm volatile("s_waitcnt vmcnt(0)" ::: "memory");
        } else {
            XB_SPIN(xb_ld(&bar[XB_XGEN(b.x)]) == gen, bar);
            __builtin_amdgcn_fence(__ATOMIC_ACQUIRE, "agent");
            asm volatile("s_waitcnt vmcnt(0)" ::: "memory");
        }
    }
    __syncthreads();
}

struct Frame {
    LAS unsigned char* lds; char* ldsg;
    unsigned* ctl; unsigned char* ws; unsigned char* dout;
    int tid, lane, wave, G, bid;
};
struct Args { const void* in[28]; float* out; unsigned char* ws; int ph_lo, ph_hi; };
#define INP(k) ((const float*)A.in[k])
#define LDS_WAIT() asm volatile("s_waitcnt lgkmcnt(0)" ::: "memory")
__device__ __forceinline__ float wave_sum(float v) {
#pragma unroll
    for (int o = 1; o < 64; o <<= 1) v += __shfl_xor(v, o);
    return v;
}
template <class RM, bool F8 = false>
__device__ __forceinline__ void transpose_item(const float* W, int K, int N, bf16* WT, const RM& rm, LAS float* scr, int item, int lane, const float* kgain = nullptr, int dpitch = 0, int doff = 0, int ncount = 0) {
    const int NC = ncount ? ncount : N;
    const int nblk = (NC + 31) / 32, kb = item / nblk, nb = item % nblk, k0 = 64 * kb, n0 = 32 * nb;
    const int ncol = n0 + (lane & 31);
    float tv[32];
    { const float* wp = W + (size_t)(k0 + (lane >> 5)) * N + (ncol < NC ? ncol : 0);
#pragma unroll
      for (int i = 0; i < 32; ++i) tv[i] = wp[(size_t)(2 * i) * N]; }
#pragma unroll
    for (int i = 0; i < 32; ++i) { const int kk = 2 * i + (lane >> 5); scr[kk * 33 + (lane & 31)] = ncol < NC ? (kgain ? tv[i] * kgain[k0 + kk] : tv[i]) : 0.f; }
    LDS_WAIT(); asm volatile("" ::: "memory");
    const int c = lane & 7;
#pragma unroll
    for (int j = 0; j < 4; ++j) { const int n = (lane >> 3) + 8 * j; const LAS float* s = scr + (8 * c) * 33 + n;
        const int dr = (n0 + n < NC) ? rm(n0 + n) : -1;
        if constexpr (F8) { const f32x4 a = {s[0 * 33] * W8_SCALE, s[1 * 33] * W8_SCALE, s[2 * 33] * W8_SCALE, s[3 * 33] * W8_SCALE}, b = {s[4 * 33] * W8_SCALE, s[5 * 33] * W8_SCALE, s[6 * 33] * W8_SCALE, s[7 * 33] * W8_SCALE};
            if (dr >= 0) *(u32x2*)((unsigned char*)WT + (size_t)dr * (dpitch ? dpitch : K) + doff + k0 + 8 * c) = pack8_fp8(a, b); }
        else { u32x4 o; o.x = cvt_pk_bf16(s[0 * 33], s[1 * 33]); o.y = cvt_pk_bf16(s[2 * 33], s[3 * 33]); o.z = cvt_pk_bf16(s[4 * 33], s[5 * 33]); o.w = cvt_pk_bf16(s[6 * 33], s[7 * 33]);
            if (dr >= 0) *(u32x4*)(WT + (size_t)dr * (dpitch ? dpitch : K) + doff + k0 + 8 * c) = o; } }
    LDS_WAIT(); asm volatile("" ::: "memory");
}
struct RmId { int off; __device__ int operator()(int n) const { return off + n; } };
struct RmWin { __device__ int operator()(int n) const {
    if (n < 1536) return n;
    if (n < 1552) return -1;
    if (n < 4624) { const int j = n - 1552, seg = j / 1536, jj = j % 1536, hd = jj >> 7, i = jj & 127; return 1536 + seg * 1536 + hd * 128 + ((i < 64) ? 2 * i : 2 * (i - 64) + 1); }
    return 4608 + (n - 4624); } };
struct RmWin8 { __device__ int operator()(int j) const { if (j >= 3072) return j; const int seg = j / 1536, jj = j % 1536, hd = jj >> 7, i = jj & 127; return seg * 1536 + hd * 128 + ((i < 64) ? 2 * i : 2 * (i - 64) + 1); } };
struct RmGate { __device__ int operator()(int n) const { return ((n & 1023) >> 7) * 256 + (n >> 10) * 128 + (n & 127); } };
struct RmGU { int base; __device__ int operator()(int n) const { return base + (n >> 7) * 256 + (n & 127); } };

template <int NR>
__device__ __forceinline__ void rms_rows_to_bf16(const float* xrow, const float* g, bf16* orow, int lane, unsigned char* orow8 = nullptr) {
    f32x4 v[NR][4];
#pragma unroll
    for (int r = 0; r < NR; ++r) { const f32x4* xr = (const f32x4*)(xrow + (size_t)r * DM) + lane;
#pragma unroll
        for (int j = 0; j < 4; ++j) v[r][j] = xr[64 * j]; }
    const f32x4* gr = (const f32x4*)g + lane; f32x4 gg[4];
#pragma unroll
    for (int j = 0; j < 4; ++j) gg[j] = gr[64 * j];
#pragma unroll
    for (int r = 0; r < NR; ++r) { float s = 0.f;
#pragma unroll
        for (int j = 0; j < 4; ++j) s += (v[r][j].x * v[r][j].x + v[r][j].y * v[r][j].y) + (v[r][j].z * v[r][j].z + v[r][j].w * v[r][j].w);
        const float rstd = 1.f / sqrtf(wave_sum(s) * (1.f / DM) + EPS);
        u32x2* o8 = (u32x2*)(orow + (size_t)r * DM) + lane;
#pragma unroll
        for (int j = 0; j < 4; ++j) { const float y0 = v[r][j].x * rstd * gg[j].x, y1 = v[r][j].y * rstd * gg[j].y, y2 = v[r][j].z * rstd * gg[j].z, y3 = v[r][j].w * rstd * gg[j].w;
            u32x2 w; w.x = cvt_pk_bf16(y0, y1); w.y = cvt_pk_bf16(y2, y3); o8[64 * j] = w;
            if (orow8) { unsigned q = 0; q = __builtin_amdgcn_cvt_pk_fp8_f32(y0, y1, q, false); q = __builtin_amdgcn_cvt_pk_fp8_f32(y2, y3, q, true); ((unsigned*)(orow8 + (size_t)r * DM))[lane + 64 * j] = q; } } }
}

__device__ __forceinline__ void p0_prologue(Frame& F, const Args& A) {
    LAS float* scr = (LAS float*)(F.lds + F.wave * 8448);
    LAS unsigned char* l_wa = F.lds + 69632;
    const int gw = F.bid * NWAVES + F.wave, NGW = F.G * NWAVES;
    unsigned char* ws = F.ws;
    { const float* win = INP(4);
      for (int i = F.tid; i < 16 * 1024; i += NTHR) { const int k = i >> 4, j = i & 15; *(LAS bf16*)(l_wa + j * 2048 + ((((k >> 3) ^ j) << 4) | ((k & 7) << 1))) = (bf16)f2bf(win[(size_t)k * 6160 + 1536 + j]); } }
    __syncthreads();
    constexpr int I_IN = 16 * 48, I_IN8 = 16 * 144, I_GATE = 16 * 64, I_BG = 8 * 32, I_MIX = 16 * 32, I_XQ = 16 * 16, I_XKV = 16 * 32, I_XO = 8 * 32;
    constexpr int NIT = I_IN + I_IN8 + I_GATE + 2 * I_BG + I_MIX + I_XQ + I_XKV + I_XO;
    for (int it = gw; it < NIT; it += NGW) {
        int r = it;
        if (r < I_IN) { transpose_item(INP(4), 1024, 6160, (bf16*)(ws + WS_WIN), RmId{0}, scr, r, F.lane, nullptr, 0, 0, 1536); continue; } r -= I_IN;
        if (r < I_IN8) { transpose_item<RmWin8, true>(INP(4) + 1552, 1024, 6160, (bf16*)(ws + WS_WIN8), RmWin8{}, scr, r, F.lane, nullptr, 0, 0, 4608); continue; } r -= I_IN8;
        if (r < I_GATE) { transpose_item<RmGate, true>(INP(10), 1024, 2048, (bf16*)(ws + WS_WGATE), RmGate{}, scr, r, F.lane); continue; } r -= I_GATE;
        if (r < I_BG) { transpose_item(INP(8), 512, 1024, (bf16*)(ws + WS_WBG), RmId{0}, scr, r, F.lane, nullptr, 1024, 0); continue; } r -= I_BG;
        if (r < I_BG) { transpose_item(INP(9), 512, 1024, (bf16*)(ws + WS_WBG), RmId{0}, scr, r, F.lane, nullptr, 1024, 512); continue; } r -= I_BG;
        if (r < I_MIX) { transpose_item(INP(12), 1024, 1024, (bf16*)(ws + WS_WMIX), RmId{0}, scr, r, F.lane); continue; } r -= I_MIX;
        if (r < I_XQ) { transpose_item<RmId, true>(INP(15), 1024, 512, (bf16*)(ws + WS_WXQ), RmId{0}, scr, r, F.lane, INP(13)); continue; } r -= I_XQ;
        if (r < I_XKV) { transpose_item(INP(16), 1024, 1024, (bf16*)(ws + WS_WXKV), RmId{0}, scr, r, F.lane); continue; } r -= I_XKV;
        transpose_item(INP(17), 512, 1024, (bf16*)(ws + WS_WXO), RmId{0}, scr, r, F.lane);
    }
    const int gt = F.bid * NTHR + F.tid, NGT = F.G * NTHR;
    { bf16* wr = (bf16*)(ws + WS_WR); const float* w = INP(19); const float* g3 = INP(18);
      for (int i = gt; i < NEXP * 1024; i += NGT) { const int e = i >> 10, k = i & 1023; wr[i] = (bf16)f2bf(g3[k] * w[k * NEXP + e]); } }
    { float* tab = (float*)(ws + WS_ROPE);
      for (int i = gt; i < ROPE_POS * 64; i += NGT) { const int pos = i >> 6, fi = i & 63;
          const float inv = (float)exp2(-(double)fi * (13.287712379549449 / 64.0));
          const float ang = (float)pos * inv;
          const double xr = (double)ang * 0.15915494309189535, fr_ = xr - rint(xr);
          const float xf = (float)fr_;
          tab[2 * i] = __builtin_amdgcn_cosf(xf); tab[2 * i + 1] = __builtin_amdgcn_sinf(xf); } }
    for (int m = gw; m < NBATCH * 256; m += NGW) rms_rows_to_bf16<1>(INP(1) + (size_t)m * DM, INP(14), (bf16*)(ws + WS_MEMN) + (size_t)m * DM, F.lane);
    { const int fr = F.lane & 15, fq = F.lane >> 4; float* alr = (float*)(ws + WS_ALR);
      for (int gidx = gw; gidx < M / 16; gidx += NGW) { const size_t row0 = (size_t)gidx * 16; bf16* arow = (bf16*)(ws + WS_A) + row0 * DM;
#pragma unroll
          for (int q = 0; q < 4; ++q) rms_rows_to_bf16<4>(INP(0) + (row0 + 4 * q) * DM, INP(3), arow + (size_t)(4 * q) * DM, F.lane, ws + WS_A8 + (row0 + 4 * q) * DM);
          asm volatile("s_waitcnt vmcnt(0)" ::: "memory");
          f32x4 c = {0.f, 0.f, 0.f, 0.f}; const bf16* ap = arow + (size_t)fr * DM + 8 * fq;
#pragma unroll 8
          for (int kk = 0; kk < 32; ++kk) { const bf16x8 af = *(const bf16x8*)(ap + 32 * kk); const int ch = 4 * kk + fq;
              const bf16x8 bfr = *(const LAS bf16x8*)(l_wa + fr * 2048 + ((ch ^ fr) << 4)); c = __builtin_amdgcn_mfma_f32_16x16x32_bf16(af, bfr, c, 0, 0, 0); }
#pragma unroll
          for (int r = 0; r < 4; ++r) alr[(row0 + 4 * fq + r) * 16 + fr] = c[r]; } }
}

#define EPI_ROWS(ai, m) (u.pm * 256 + wr * 64 + fr + (ai) * 128 + (m) * 16)
__device__ __forceinline__ u32x4 pack8f(const f32x4& a, const f32x4& b) { u32x4 w; w.x = cvt_pk_bf16(a[0], a[1]); w.y = cvt_pk_bf16(a[2], a[3]); w.z = cvt_pk_bf16(b[0], b[1]); w.w = cvt_pk_bf16(b[2], b[3]); return w; }
__device__ __forceinline__ void unpack8f(const u32x4& w, f32x4& a, f32x4& b) { a = (f32x4){bflo(w.x), bfhi(w.x), bflo(w.y), bfhi(w.y)}; b = (f32x4){bflo(w.z), bfhi(w.z), bflo(w.w), bfhi(w.w)}; }

struct EpiProj {
    static constexpr bool PERM = true, HAS_MID = false;
    unsigned char* ws; const int* pos; float asc;
    __device__ __forceinline__ void operator()(const f32x4 (&acc)[2][2][4][2], const pg8::Unit& u, int wr, int wc, int fr, int fq) const {
        const int pn = u.pn, cw = wc * 32 + 8 * fq;
        bf16* base; int ldc, coff; float sc = 1.f; bool rope = false;
        if (pn == 0) { base = (bf16*)(ws + WS_QG); ldc = 256; coff = 0; sc = 0.125f; }
        else if (pn == 1) { base = (bf16*)(ws + WS_KG); ldc = 256; coff = 0; }
        else if (pn < 4) { base = (bf16*)(ws + WS_VG); ldc = 512; coff = (pn - 2) * 256; }
        else if (pn < 6) { base = (bf16*)(ws + WS_RG); ldc = 512; coff = (pn - 4) * 256; }
        else if (pn < 12) { base = (bf16*)(ws + WS_QD); ldc = 1536; coff = (pn - 6) * 256; rope = true; }
        else if (pn < 18) { base = (bf16*)(ws + WS_KD); ldc = 1536; coff = (pn - 12) * 256; rope = true; }
        else { base = (bf16*)(ws + WS_VD); ldc = 1536; coff = (pn - 18) * 256; }
        sc *= asc;
        const float* tab = (const float*)(ws + WS_ROPE);
        if (rope) {
#pragma unroll
            for (int ai = 0; ai < 2; ++ai) { int pp[4]; f32x4 cs[4][2];
#pragma unroll
                for (int m = 0; m < 4; ++m) pp[m] = pos[EPI_ROWS(ai, m)];
#pragma unroll
                for (int m = 0; m < 4; ++m) { int p = pp[m]; p = p < 0 ? 0 : (p >= ROPE_POS ? ROPE_POS - 1 : p); const float* tp = tab + ((size_t)p * 64 + 16 * wc + 4 * fq) * 2; cs[m][0] = *(const f32x4*)tp; cs[m][1] = *(const f32x4*)(tp + 4); }
#pragma unroll
                for (int m = 0; m < 4; ++m) { bf16* rowp = base + (size_t)EPI_ROWS(ai, m) * ldc + coff + cw; const f32x4 cs0 = cs[m][0], cs1 = cs[m][1];
#pragma unroll
                    for (int bj = 0; bj < 2; ++bj) { f32x4 v0 = acc[ai][bj][m][0] * asc, v1 = acc[ai][bj][m][1] * asc;
                        v0 = (f32x4){v0[0] * cs0[0] - v0[1] * cs0[1], v0[1] * cs0[0] + v0[0] * cs0[1], v0[2] * cs0[2] - v0[3] * cs0[3], v0[3] * cs0[2] + v0[2] * cs0[3]};
                        v1 = (f32x4){v1[0] * cs1[0] - v1[1] * cs1[1], v1[1] * cs1[0] + v1[0] * cs1[1], v1[2] * cs1[2] - v1[3] * cs1[3], v1[3] * cs1[2] + v1[2] * cs1[3]};
                        *(u32x4*)(rowp + bj * 128) = pack8f(v0, v1); } }
                asm volatile("" ::: "memory"); }
            return;
        }
#pragma unroll
        for (int ai = 0; ai < 2; ++ai)
#pragma unroll
            for (int m = 0; m < 4; ++m) { bf16* rowp = base + (size_t)EPI_ROWS(ai, m) * ldc + coff + cw;
#pragma unroll
                for (int bj = 0; bj < 2; ++bj) *(u32x4*)(rowp + bj * 128) = pack8f(acc[ai][bj][m][0] * sc, acc[ai][bj][m][1] * sc); }
    }
};
template <int ACT  > struct EpiBf16 {
    static constexpr bool PERM = true, HAS_MID = false;
    bf16* O; int ldc; const float* bias; float scale;
    __device__ __forceinline__ void operator()(const f32x4 (&acc)[2][2][4][2], const pg8::Unit& u, int wr, int wc, int fr, int fq) const {
        const int col0 = u.pn * 256 + wc * 32 + 8 * fq;
        f32x4 bv[2][2];
#pragma unroll
        for (int bj = 0; bj < 2; ++bj)
#pragma unroll
            for (int n = 0; n < 2; ++n) bv[bj][n] = bias ? *(const f32x4*)(bias + col0 + bj * 128 + 4 * n) : (f32x4){0.f, 0.f, 0.f, 0.f};
#pragma unroll
        for (int ai = 0; ai < 2; ++ai)
#pragma unroll
            for (int m = 0; m < 4; ++m) { bf16* rowp = O + (size_t)EPI_ROWS(ai, m) * ldc + col0;
#pragma unroll
                for (int bj = 0; bj < 2; ++bj) { f32x4 v0 = acc[ai][bj][m][0] * scale + bv[bj][0], v1 = acc[ai][bj][m][1] * scale + bv[bj][1];
                    if (ACT == 1) {
#pragma unroll
                        for (int j = 0; j < 4; ++j) { v0[j] = __builtin_amdgcn_rcpf(1.f + __expf(-v0[j])); v1[j] = __builtin_amdgcn_rcpf(1.f + __expf(-v1[j])); } }
                    *(u32x4*)(rowp + bj * 128) = pack8f(v0, v1); } }
    }
};
struct EpiGates {
    static constexpr bool PERM = true, HAS_MID = false;
    bf16* O; const float* bias; float scale;
    __device__ __forceinline__ void operator()(const f32x4 (&acc)[2][2][4][2], const pg8::Unit& u, int wr, int wc, int fr, int fq) const {
        const int c0 = u.pn * 128 + wc * 32 + 8 * fq;
        f32x4 bv[2][2];
#pragma unroll
        for (int bj = 0; bj < 2; ++bj)
#pragma unroll
            for (int n = 0; n < 2; ++n) bv[bj][n] = *(const f32x4*)(bias + bj * 1024 + c0 + 4 * n);
#pragma unroll
        for (int ai = 0; ai < 2; ++ai)
#pragma unroll
            for (int m = 0; m < 4; ++m) { bf16* rowp = O + (size_t)EPI_ROWS(ai, m) * 2048 + c0; f32x4 rt[2], gd[2];
#pragma unroll
                for (int n = 0; n < 2; ++n)
#pragma unroll
                    for (int h = 0; h < 2; ++h) {
                        const f32x2 y1 = (f32x2){acc[ai][0][m][n][2 * h], acc[ai][0][m][n][2 * h + 1]} * scale + (f32x2){bv[0][n][2 * h], bv[0][n][2 * h + 1]}, y2 = (f32x2){acc[ai][1][m][n][2 * h], acc[ai][1][m][n][2 * h + 1]} * scale + (f32x2){bv[1][n][2 * h], bv[1][n][2 * h + 1]};
                        const f32x2 z1 = {fminf(fmaxf(y1.x, -30.f), 30.f), fminf(fmaxf(y1.y, -30.f), 30.f)}, z2 = {fminf(fmaxf(y2.x, -30.f), 30.f), fminf(fmaxf(y2.y, -30.f), 30.f)};
                        const f32x2 t1 = z1 * -1.4426950408889634f, t2 = z2 * -1.4426950408889634f;
                        const f32x2 d1 = (f32x2){__builtin_amdgcn_exp2f(t1.x), __builtin_amdgcn_exp2f(t1.y)} + 1.f, d2 = (f32x2){__builtin_amdgcn_exp2f(t2.x), __builtin_amdgcn_exp2f(t2.y)} + 1.f;
                        const f32x2 dd = d1 * d2, q = {__builtin_amdgcn_rcpf(dd.x), __builtin_amdgcn_rcpf(dd.y)};
                        const f32x2 g2 = q * d1, r = (d2 * d2) * q;
                        rt[n][2 * h] = r.x; rt[n][2 * h + 1] = r.y; gd[n][2 * h] = g2.x; gd[n][2 * h + 1] = g2.y; }
                *(u32x4*)rowp = pack8f(rt[0], rt[1]); *(u32x4*)(rowp + 1024) = pack8f(gd[0], gd[1]); }
    }
};
struct EpiBranchFused {
    static constexpr bool PERM = true, HAS_MID = true;
    bf16* mg; const bf16* gates;
    __device__ __forceinline__ void mid(f32x4 (&acc)[2][2][4][2], const pg8::Unit& u, int wr, int wc, int fr, int fq) const {
        const int col0 = u.pn * 256 + wc * 32 + 8 * fq;
#pragma unroll
        for (int ai = 0; ai < 2; ++ai) { u32x4 rt[4][2];
#pragma unroll
            for (int m = 0; m < 4; ++m) { const size_t row = EPI_ROWS(ai, m);
#pragma unroll
                for (int bj = 0; bj < 2; ++bj) rt[m][bj] = *(const u32x4*)(gates + row * 2048 + col0 + bj * 128); }
#pragma unroll
            for (int m = 0; m < 4; ++m)
#pragma unroll
                for (int bj = 0; bj < 2; ++bj) { f32x4 a0, a1; unpack8f(rt[m][bj], a0, a1); acc[ai][bj][m][0] *= a0; acc[ai][bj][m][1] *= a1; }
            asm volatile("" ::: "memory"); }
    }
    __device__ __forceinline__ void operator()(const f32x4 (&acc)[2][2][4][2], const pg8::Unit& u, int wr, int wc, int fr, int fq) const {
        const int col0 = u.pn * 256 + wc * 32 + 8 * fq;
#pragma unroll
        for (int ai = 0; ai < 2; ++ai) { u32x4 g2[4][2];
#pragma unroll
            for (int m = 0; m < 4; ++m) { const size_t row = EPI_ROWS(ai, m);
#pragma unroll
                for (int bj = 0; bj < 2; ++bj) g2[m][bj] = *(const u32x4*)(gates + row * 2048 + 1024 + col0 + bj * 128); }
#pragma unroll
            for (int m = 0; m < 4; ++m) { const size_t row = EPI_ROWS(ai, m);
#pragma unroll
                for (int bj = 0; bj < 2; ++bj) { f32x4 b0, b1; unpack8f(g2[m][bj], b0, b1); *(u32x4*)(mg + row * 1024 + col0 + bj * 128) = pack8f(acc[ai][bj][m][0] * b0, acc[ai][bj][m][1] * b1); } }
            asm volatile("" ::: "memory"); }
    }
};
struct EpiResBf16 {
    static constexpr bool PERM = true, HAS_MID = false;
    const float* resf; const bf16* resb; bf16* out; unsigned char* out8;
    __device__ __forceinline__ void operator()(const f32x4 (&acc)[2][2][4][2], const pg8::Unit& u, int wr, int wc, int fr, int fq) const {
        const int col0 = u.pn * 256 + wc * 32 + 8 * fq;
        if (!resf) {
            u32x4 w[2][4][2];
#pragma unroll
            for (int ai = 0; ai < 2; ++ai)
#pragma unroll
                for (int m = 0; m < 4; ++m) { const size_t off = (size_t)EPI_ROWS(ai, m) * DM + col0;
#pragma unroll
                    for (int bj = 0; bj < 2; ++bj) w[ai][m][bj] = *(const u32x4*)(resb + off + bj * 128); }
#pragma unroll
            for (int ai = 0; ai < 2; ++ai)
#pragma unroll
                for (int m = 0; m < 4; ++m) { const size_t off = (size_t)EPI_ROWS(ai, m) * DM + col0;
#pragma unroll
                    for (int bj = 0; bj < 2; ++bj) { f32x4 r0, r1; unpack8f(w[ai][m][bj], r0, r1); const f32x4 v0 = r0 + acc[ai][bj][m][0], v1 = r1 + acc[ai][bj][m][1]; *(u32x4*)(out + off + bj * 128) = pack8f(v0, v1);
                        if (out8) *(u32x2*)(out8 + off + bj * 128) = pack8_fp8(v0, v1); } }
            return;
        }
#pragma unroll
        for (int ai = 0; ai < 2; ++ai) { f32x4 rv[4][2][2];
#pragma unroll
            for (int m = 0; m < 4; ++m) { const size_t off = (size_t)EPI_ROWS(ai, m) * DM + col0;
#pragma unroll
                for (int bj = 0; bj < 2; ++bj) {
                    if (resf) { rv[m][bj][0] = *(const f32x4*)(resf + off + bj * 128); rv[m][bj][1] = *(const f32x4*)(resf + off + bj * 128 + 4); }
                    else { const u32x4 w = *(const u32x4*)(resb + off + bj * 128); unpack8f(w, rv[m][bj][0], rv[m][bj][1]); } } }
#pragma unroll
            for (int m = 0; m < 4; ++m) { const size_t off = (size_t)EPI_ROWS(ai, m) * DM + col0;
#pragma unroll
                for (int bj = 0; bj < 2; ++bj) { const f32x4 v0 = rv[m][bj][0] + acc[ai][bj][m][0], v1 = rv[m][bj][1] + acc[ai][bj][m][1]; *(u32x4*)(out + off + bj * 128) = pack8f(v0, v1);
                    if (out8) *(u32x2*)(out8 + off + bj * 128) = pack8_fp8(v0, v1); } }
            asm volatile("" ::: "memory"); }
    }
};
struct EpiRowScaleBf16 {
    static constexpr bool PERM = true, HAS_MID = false;
    bf16* O; int ldc; const LAS float* rs;
    __device__ __forceinline__ void operator()(const f32x4 (&acc)[2][2][4][2], const pg8::Unit& u, int wr, int wc, int fr, int fq) const {
        const int col0 = u.pn * 256 + wc * 32 + 8 * fq;
#pragma unroll
        for (int ai = 0; ai < 2; ++ai)
#pragma unroll
            for (int m = 0; m < 4; ++m) { const float r = rs[u.ord * 256 + wr * 64 + fr + ai * 128 + m * 16]; bf16* rowp = O + (size_t)EPI_ROWS(ai, m) * ldc + col0;
#pragma unroll
                for (int bj = 0; bj < 2; ++bj) *(u32x4*)(rowp + bj * 128) = pack8f(acc[ai][bj][m][0] * r, acc[ai][bj][m][1] * r); }
    }
};
__device__ __forceinline__ f32x2 swiglu2(const f32x2 a, const f32x2 b) {
    const f32x2 gl = {fminf(a.x, 7.f), fminf(a.y, 7.f)}, ln = {fminf(fmaxf(b.x, -7.f), 7.f), fminf(fmaxf(b.y, -7.f), 7.f)};
    const f32x2 t = gl * (-1.702f * 1.4426950408889634f);
    const f32x2 d = (f32x2){__builtin_amdgcn_exp2f(t.x), __builtin_amdgcn_exp2f(t.y)} + 1.f;
    const f32x2 r = {__builtin_amdgcn_rcpf(d.x), __builtin_amdgcn_rcpf(d.y)};
    return (gl * r) * (ln + 1.f);
}
struct EpiSwiglu {
    static constexpr bool PERM = true, HAS_MID = false;
    unsigned char* H; const float* bg; const float* bu; int nN; const float* rs;
    __device__ __forceinline__ void operator()(const f32x4 (&acc)[2][2][4][2], const pg8::Unit& u, int wr, int wc, int fr, int fq) const {
        const int e = u.pb / nN, c0 = u.pn * 128 + wc * 32 + 8 * fq;
        const f32x4 g0 = *(const f32x4*)(bg + e * 1024 + c0), g1 = *(const f32x4*)(bg + e * 1024 + c0 + 4), u0 = *(const f32x4*)(bu + e * 1024 + c0), u1 = *(const f32x4*)(bu + e * 1024 + c0 + 4);
        float rr[2][4];
#pragma unroll
        for (int ai = 0; ai < 2; ++ai)
#pragma unroll
            for (int m = 0; m < 4; ++m) rr[ai][m] = rs[EPI_ROWS(ai, m)];
#pragma unroll
        for (int ai = 0; ai < 2; ++ai)
#pragma unroll
            for (int m = 0; m < 4; ++m) { const float rq = rr[ai][m] * W8_INV; const f32x4 a0 = acc[ai][0][m][0] * rq + g0, a1 = acc[ai][0][m][1] * rq + g1, b0 = acc[ai][1][m][0] * rq + u0, b1 = acc[ai][1][m][1] * rq + u1;
                const f32x2 p0 = swiglu2((f32x2){a0[0], a0[1]}, (f32x2){b0[0], b0[1]}), p1 = swiglu2((f32x2){a0[2], a0[3]}, (f32x2){b0[2], b0[3]}), p2 = swiglu2((f32x2){a1[0], a1[1]}, (f32x2){b1[0], b1[1]}), p3 = swiglu2((f32x2){a1[2], a1[3]}, (f32x2){b1[2], b1[3]});
                const f32x4 r0 = {p0.x, p0.y, p1.x, p1.y}, r1 = {p2.x, p2.y, p3.x, p3.y};
                *(u32x2*)(H + (size_t)EPI_ROWS(ai, m) * 1024 + c0) = pack8_fp8(r0, r1); }
    }
};
struct EpiDown {
    static constexpr bool PERM = true, HAS_MID = false;
    bf16* Y; const float* bd; const float* rgate; int nN;
    __device__ __forceinline__ void operator()(const f32x4 (&acc)[2][2][4][2], const pg8::Unit& u, int wr, int wc, int fr, int fq) const {
        const int e = u.pb / nN, col0 = u.pn * 256 + wc * 32 + 8 * fq;
        f32x4 bv[2][2];
#pragma unroll
        for (int bj = 0; bj < 2; ++bj)
#pragma unroll
            for (int n = 0; n < 2; ++n) bv[bj][n] = *(const f32x4*)(bd + e * 1024 + col0 + bj * 128 + 4 * n);
        float gt[2][4];
#pragma unroll
        for (int ai = 0; ai < 2; ++ai)
#pragma unroll
            for (int m = 0; m < 4; ++m) gt[ai][m] = rgate[EPI_ROWS(ai, m)];
#pragma unroll
        for (int ai = 0; ai < 2; ++ai)
#pragma unroll
            for (int m = 0; m < 4; ++m) { const int row = EPI_ROWS(ai, m);
#pragma unroll
                for (int bj = 0; bj < 2; ++bj) *(u32x4*)(Y + (size_t)row * 1024 + col0 + bj * 128) = pack8f((acc[ai][bj][m][0] * W8_INV + bv[bj][0]) * gt[ai][m], (acc[ai][bj][m][1] * W8_INV + bv[bj][1]) * gt[ai][m]); }
    }
};

__device__ __forceinline__ bf16x8 frag_n(const LAS unsigned char* base, int pitch, int r0, int k0, int lane) {
    return *(const LAS bf16x8*)(base + (r0 + (lane & 15)) * pitch + (k0 + 8 * (lane >> 4)) * 2);
}
__device__ __forceinline__ bf16x8 frag_t(const LAS unsigned char* base, int pitch, int k0, int n0, int lane) {
    const int i = lane & 15, gq = lane >> 4, q = i >> 2, p = i & 3;
    const unsigned a0 = (unsigned)(uintptr_t)(base + (k0 + 8 * gq + q) * pitch + (n0 + 4 * p) * 2), a1 = a0 + 4u * (unsigned)pitch;
    s16x4 lo, hi;
    asm volatile("ds_read_b64_tr_b16 %0, %2\n\tds_read_b64_tr_b16 %1, %3\n\ts_waitcnt lgkmcnt(0)" : "=&v"(lo), "=&v"(hi) : "v"(a0), "v"(a1) : "memory");
    return (bf16x8){lo[0], lo[1], lo[2], lo[3], hi[0], hi[1], hi[2], hi[3]};
}
#define MFMA16(a, b, c) __builtin_amdgcn_mfma_f32_16x16x32_bf16(a, b, c, 0, 0, 0)

__device__ __forceinline__ float log_sigmoid_fast(float z) { return fminf(z, 0.f) - __logf(1.f + __expf(-fabsf(z))); }
__device__ __forceinline__ void gla_a_phase(Frame& F, const Args& A) {
    unsigned char* ws = F.ws;
    LAS unsigned char* L = F.lds;
    LAS float* l_alr = (LAS float*)L;
    constexpr int PK = 272, PV = 528;
    LAS unsigned char* l_kd = L + 4096;
    LAS unsigned char* l_v = L + 4096 + 64 * PK;
    LAS float* l_tot = (LAS float*)(L + 4096 + 64 * PK + 64 * PV);
    const int tid = F.tid, lane = F.lane, wid = F.wave;
    const int col = tid & 127, qt = tid >> 7;
    float pf_alr[2]; u32x4 pf_v[4], pf_k[2];
#define GLA_A_PREFETCH(it_) do { const int b_ = (it_) >> 8, c_ = ((it_) >> 1) & 127, hp_ = (it_) & 1; const size_t tk0 = (size_t)b_ * SEQ + (size_t)c_ * 64; \
        const float* alr_ = (const float*)(ws + WS_ALR) + tk0 * 16; pf_alr[0] = alr_[tid]; pf_alr[1] = alr_[tid + 512]; \
        const bf16* vg_ = (const bf16*)(ws + WS_VG) + tk0 * 512 + hp_ * 256; const bf16* kg_ = (const bf16*)(ws + WS_KG) + tk0 * 256 + hp_ * 128; \
        _Pragma("unroll") for (int q_ = 0; q_ < 4; ++q_) { const int i_ = tid + q_ * 512; pf_v[q_] = *(const u32x4*)(vg_ + (size_t)(i_ >> 5) * 512 + (i_ & 31) * 8); } \
        _Pragma("unroll") for (int q_ = 0; q_ < 2; ++q_) { const int i_ = tid + q_ * 512; pf_k[q_] = *(const u32x4*)(kg_ + (size_t)(i_ >> 4) * 256 + (i_ & 15) * 8); } } while (0)
    int it = F.bid; if (it >= NBATCH * 256) return;
    GLA_A_PREFETCH(it);
    int hp_loaded = -1; float w2c[16]; float b2 = 0.f;
#pragma unroll
    for (int j = 0; j < 16; ++j) w2c[j] = 0.f;
    for (; it < NBATCH * 256; it += F.G) {
        const int b = it >> 8, c = (it >> 1) & 127, hp = it & 1;
        l_alr[tid] = pf_alr[0]; l_alr[tid + 512] = pf_alr[1];
#pragma unroll
        for (int q = 0; q < 4; ++q) { const int i = tid + q * 512; *(LAS u32x4*)(l_v + (i >> 5) * PV + (i & 31) * 16) = pf_v[q]; }
#pragma unroll
        for (int q = 0; q < 2; ++q) { const int i = tid + q * 512; *(LAS u32x4*)(l_kd + (i >> 4) * PK + (i & 15) * 16) = pf_k[q]; }
        __syncthreads();
        if (it + F.G < NBATCH * 256) GLA_A_PREFETCH(it + F.G);
        {   const int gc = hp * 128 + col;
            if (hp != hp_loaded) { hp_loaded = hp; b2 = INP(6)[gc];
#pragma unroll
                for (int jj = 0; jj < 16; ++jj) w2c[jj] = INP(5)[jj * 256 + gc]; }
            float bc[16]; float run = 0.f;
#pragma unroll
            for (int i = 0; i < 16; ++i) { const int t = qt * 16 + i; float z = b2;
#pragma unroll
                for (int jj = 0; jj < 16; ++jj) z = fmaf(l_alr[t * 16 + jj], w2c[jj], z);
                run += log_sigmoid_fast(z) * (1.f / 16.f); bc[i] = run; }
            l_tot[qt * 128 + col] = run;
            __syncthreads();
            const float q0 = l_tot[col], q1 = l_tot[128 + col], q2 = l_tot[256 + col], q3 = l_tot[384 + col];
            const float blast = (q0 + q1) + (q2 + q3), pre = (qt > 0 ? q0 : 0.f) + (qt > 1 ? q1 : 0.f) + (qt > 2 ? q2 : 0.f);
#pragma unroll
            for (int i = 0; i < 16; ++i) { const int t = qt * 16 + i; LAS bf16* kp = (LAS bf16*)(l_kd + t * PK + col * 2);
                *kp = (bf16)f2bf(bf2f(*kp) * __expf(blast - (pre + bc[i]))); }
            if (qt == 0) ((float*)(ws + WS_DECAY))[((size_t)(b * 4 + hp * 2 + (col >> 6)) * 128 + c) * 64 + (col & 63)] = __expf(blast);
        }
        __syncthreads();
        const int hh = wid >> 2, j = wid & 3;
        f32x4 acc[4][2];
#pragma unroll
        for (int mt = 0; mt < 4; ++mt)
#pragma unroll
            for (int nt = 0; nt < 2; ++nt) acc[mt][nt] = (f32x4){0.f, 0.f, 0.f, 0.f};
#pragma unroll
        for (int ks = 0; ks < 2; ++ks) { bf16x8 a[4], bb[2];
#pragma unroll
            for (int mt = 0; mt < 4; ++mt) a[mt] = frag_t(l_kd, PK, 32 * ks, hh * 64 + 16 * mt, lane);
#pragma unroll
            for (int nt = 0; nt < 2; ++nt) bb[nt] = frag_t(l_v, PV, 32 * ks, hh * 128 + 32 * j + 16 * nt, lane);
            __builtin_amdgcn_sched_barrier(0);
#pragma unroll
            for (int mt = 0; mt < 4; ++mt)
#pragma unroll
                for (int nt = 0; nt < 2; ++nt) acc[mt][nt] = MFMA16(a[mt], bb[nt], acc[mt][nt]); }
        __syncthreads();
        { LAS unsigned char* l_st = l_kd + hh * (64 * 272) + (4 * (lane >> 4)) * 272 + (32 * j + (lane & 15)) * 2;
#pragma unroll
          for (int mt = 0; mt < 4; ++mt)
#pragma unroll
              for (int nt = 0; nt < 2; ++nt)
#pragma unroll
                  for (int r = 0; r < 4; ++r) *(LAS bf16*)(l_st + (16 * mt + r) * 272 + 32 * nt) = (bf16)f2bf(acc[mt][nt][r]); }
        __syncthreads();
        { bf16* st = (bf16*)(F.dout + DO_ST) + ((size_t)(b * 4 + hp * 2) * 128 + c) * 8192;
#pragma unroll
          for (int q = 0; q < 4; ++q) { const int i = tid + q * 512, h2 = i >> 10, dk = (i >> 4) & 63, c16 = i & 15;
              const u32x4 w = *(const LAS u32x4*)(l_kd + h2 * (64 * 272) + dk * 272 + c16 * 16);
              *(u32x4*)(st + (size_t)h2 * 128 * 8192 + dk * 128 + c16 * 8) = w; } }
        __syncthreads();
    }
#undef GLA_A_PREFETCH
}

__device__ __forceinline__ void gla_scan(Frame& F) {
    unsigned* st = (unsigned*)(F.dout + DO_ST); const float* dec = (const float*)(F.ws + WS_DECAY);
    for (int idx = F.bid * NTHR + F.tid; idx < 32 * 4096; idx += F.G * NTHR) {
        const int bh = idx >> 12, e2 = idx & 4095, dk = e2 >> 6;
        unsigned* p = st + (size_t)bh * 128 * 4096 + e2; const float* dp = dec + (size_t)bh * 128 * 64 + dk;
        float s0 = 0.f, s1 = 0.f;
#pragma unroll 32
        for (int c = 0; c < 128; ++c) { const unsigned kv = p[(size_t)c * 4096]; const float d = dp[c * 64];
            p[(size_t)c * 4096] = cvt_pk_bf16(s0, s1);
            s0 = fmaf(d, s0, bflo(kv)); s1 = fmaf(d, s1, bfhi(kv)); }
    }
}

__device__ __forceinline__ void gla_c_phase(Frame& F, const Args& A) {
    unsigned char* ws = F.ws;
    LAS unsigned char* L = F.lds;
    LAS float* l_alr = (LAS float*)L;
    constexpr int PQ = 272, PV = 528, PP = 144;
    LAS unsigned char* l_qh = L + 4096;
    LAS unsigned char* l_kt = L + 21504;
    LAS unsigned char* l_v = L + 38912;
    LAS unsigned char* l_s = L + 72704;
    LAS unsigned char* l_p = L + 107520;
    LAS float* l_tot = (LAS float*)(L + 125952);
    LAS float* l_ss = (LAS float*)(L + 128000);
    const int tid = F.tid, lane = F.lane, wid = F.wave;
    const int col = tid & 127, qt = tid >> 7;
    float pf_alr[2]; u32x4 pf_v[4], pf_s[4], pf_q[2], pf_k[2], pf_r[4];
#define GLA_C_PREFETCH(it_) do { const int b_ = (it_) >> 8, c_ = ((it_) >> 1) & 127, hp_ = (it_) & 1; const size_t tk0 = (size_t)b_ * SEQ + (size_t)c_ * 64; \
        const float* alr_ = (const float*)(ws + WS_ALR) + tk0 * 16; pf_alr[0] = alr_[tid]; pf_alr[1] = alr_[tid + 512]; \
        const bf16* vg_ = (const bf16*)(ws + WS_VG) + tk0 * 512 + hp_ * 256; const bf16* rg_ = (const bf16*)(ws + WS_RG) + tk0 * 512 + hp_ * 256; \
        _Pragma("unroll") for (int q_ = 0; q_ < 4; ++q_) { const int i_ = tid + q_ * 512; pf_v[q_] = *(const u32x4*)(vg_ + (size_t)(i_ >> 5) * 512 + (i_ & 31) * 8); pf_r[q_] = *(const u32x4*)(rg_ + (size_t)(i_ >> 5) * 512 + (i_ & 31) * 8); } \
        _Pragma("unroll") for (int q_ = 0; q_ < 4; ++q_) { const int i_ = tid + q_ * 512, hh_ = i_ >> 10, r_ = (i_ >> 4) & 63, ch_ = i_ & 15; \
            pf_s[q_] = *(const u32x4*)((const bf16*)(F.dout + DO_ST) + ((size_t)(b_ * 4 + hp_ * 2 + hh_) * 128 + c_) * 8192 + r_ * 128 + ch_ * 8); } \
        const bf16* qg_ = (const bf16*)(ws + WS_QG) + tk0 * 256 + hp_ * 128; const bf16* kg_ = (const bf16*)(ws + WS_KG) + tk0 * 256 + hp_ * 128; \
        _Pragma("unroll") for (int q_ = 0; q_ < 2; ++q_) { const int i_ = tid + q_ * 512; pf_q[q_] = *(const u32x4*)(qg_ + (size_t)(i_ >> 4) * 256 + (i_ & 15) * 8); pf_k[q_] = *(const u32x4*)(kg_ + (size_t)(i_ >> 4) * 256 + (i_ & 15) * 8); } } while (0)
    int it = F.bid; if (it >= NBATCH * 256) return;
    GLA_C_PREFETCH(it);
    int hp_loaded = -1; float w2c[16]; float b2 = 0.f;
#pragma unroll
    for (int j = 0; j < 16; ++j) w2c[j] = 0.f;
    for (; it < NBATCH * 256; it += F.G) {
        const int b = it >> 8, c = (it >> 1) & 127, hp = it & 1;
        const size_t tok0 = (size_t)b * SEQ + (size_t)c * 64;
        l_alr[tid] = pf_alr[0]; l_alr[tid + 512] = pf_alr[1];
#pragma unroll
        for (int q = 0; q < 4; ++q) { const int i = tid + q * 512; *(LAS u32x4*)(l_v + (i >> 5) * PV + (i & 31) * 16) = pf_v[q]; }
#pragma unroll
        for (int q = 0; q < 4; ++q) { const int i = tid + q * 512, hh = i >> 10, r = (i >> 4) & 63, ch = i & 15; *(LAS u32x4*)(l_s + hh * (64 * PQ) + r * PQ + ch * 16) = pf_s[q]; }
#pragma unroll
        for (int q = 0; q < 2; ++q) { const int i = tid + q * 512; *(LAS u32x4*)(l_qh + (i >> 4) * PQ + (i & 15) * 16) = pf_q[q]; *(LAS u32x4*)(l_kt + (i >> 4) * PQ + (i & 15) * 16) = pf_k[q]; }
        u32x4 cur_r[4];
#pragma unroll
        for (int q = 0; q < 4; ++q) cur_r[q] = pf_r[q];
        __syncthreads();
        if (it + F.G < NBATCH * 256) GLA_C_PREFETCH(it + F.G);
        const int hh = wid >> 2, j = wid & 3, head = hp * 2 + hh;
        {
            const int gc = hp * 128 + col;
            if (hp != hp_loaded) { hp_loaded = hp; b2 = INP(6)[gc];
#pragma unroll
                for (int jj = 0; jj < 16; ++jj) w2c[jj] = INP(5)[jj * 256 + gc]; }
            float bc[16]; float run = 0.f;
#pragma unroll
            for (int i = 0; i < 16; ++i) { const int t = qt * 16 + i; float z = b2;
#pragma unroll
                for (int jj = 0; jj < 16; ++jj) z = fmaf(l_alr[t * 16 + jj], w2c[jj], z);
                run += log_sigmoid_fast(z) * (1.f / 16.f); bc[i] = run; }
            l_tot[qt * 128 + col] = run;
            __syncthreads();
            float pre = 0.f;
#pragma unroll
            for (int q = 0; q < 3; ++q) pre += (q < qt) ? l_tot[q * 128 + col] : 0.f;
#pragma unroll
            for (int i = 0; i < 16; ++i) { const int t = qt * 16 + i; const float bb = pre + bc[i];
                LAS bf16* qp = (LAS bf16*)(l_qh + t * PQ + col * 2); LAS bf16* kp = (LAS bf16*)(l_kt + t * PQ + col * 2);
                *qp = (bf16)f2bf(bf2f(*qp) * __expf(bb)); *kp = (bf16)f2bf(bf2f(*kp) * __expf(-bb)); }
        }
        __syncthreads();
        {
            f32x4 sc4[4];
#pragma unroll
            for (int nt = 0; nt < 4; ++nt) sc4[nt] = (f32x4){0.f, 0.f, 0.f, 0.f};
#pragma unroll
            for (int ks = 0; ks < 2; ++ks) { const bf16x8 a = frag_n(l_qh, PQ, 16 * j, hh * 64 + 32 * ks, lane);
#pragma unroll
                for (int nt = 0; nt < 4; ++nt) sc4[nt] = MFMA16(a, frag_n(l_kt, PQ, 16 * nt, hh * 64 + 32 * ks, lane), sc4[nt]); }
#pragma unroll
            for (int nt = 0; nt < 4; ++nt)
#pragma unroll
                for (int r = 0; r < 4; ++r) { const int t = 16 * j + 4 * (lane >> 4) + r, s2 = 16 * nt + (lane & 15);
                    *(LAS bf16*)(l_p + hh * (64 * PP) + t * PP + s2 * 2) = (bf16)f2bf(s2 <= t ? sc4[nt][r] : 0.f); }
        }
        __syncthreads();
        f32x4 acc[4][2];
#pragma unroll
        for (int mt = 0; mt < 4; ++mt)
#pragma unroll
            for (int nt = 0; nt < 2; ++nt) acc[mt][nt] = (f32x4){0.f, 0.f, 0.f, 0.f};
#pragma unroll
        for (int ks = 0; ks < 2; ++ks) {
            bf16x8 bb[2];
#pragma unroll
            for (int nt = 0; nt < 2; ++nt) bb[nt] = frag_t(l_s + hh * (64 * PQ), PQ, 32 * ks, 32 * j + 16 * nt, lane);
            __builtin_amdgcn_sched_barrier(0);
#pragma unroll
            for (int mt = 0; mt < 4; ++mt) { const bf16x8 a = frag_n(l_qh, PQ, 16 * mt, hh * 64 + 32 * ks, lane);
#pragma unroll
                for (int nt = 0; nt < 2; ++nt) acc[mt][nt] = MFMA16(a, bb[nt], acc[mt][nt]); } }
#pragma unroll
        for (int ks = 0; ks < 2; ++ks) {
            bf16x8 bb[2];
#pragma unroll
            for (int nt = 0; nt < 2; ++nt) bb[nt] = frag_t(l_v, PV, 32 * ks, hh * 128 + 32 * j + 16 * nt, lane);
            __builtin_amdgcn_sched_barrier(0);
#pragma unroll
            for (int mt = 0; mt < 4; ++mt) { const bf16x8 a = frag_n(l_p + hh * (64 * PP), PP, 16 * mt, 32 * ks, lane);
#pragma unroll
                for (int nt = 0; nt < 2; ++nt) acc[mt][nt] = MFMA16(a, bb[nt], acc[mt][nt]); } }
#pragma unroll
        for (int mt = 0; mt < 4; ++mt)
#pragma unroll
            for (int r = 0; r < 4; ++r) { float q = acc[mt][0][r] * acc[mt][0][r] + acc[mt][1][r] * acc[mt][1][r];
                q += __shfl_xor(q, 1); q += __shfl_xor(q, 2); q += __shfl_xor(q, 4); q += __shfl_xor(q, 8);
                if ((lane & 15) == 0) l_ss[(hh * 64 + 16 * mt + 4 * (lane >> 4) + r) * 4 + j] = q; }
        __syncthreads();
        {
            const float* gng = INP(7); const float g0 = gng[head * 128 + 32 * j + (lane & 15)], g1 = gng[head * 128 + 32 * j + 16 + (lane & 15)];
            LAS unsigned char* l_o = l_v + (4 * (lane >> 4)) * PV + (hh * 128 + 32 * j + (lane & 15)) * 2;
#pragma unroll
            for (int mt = 0; mt < 4; ++mt)
#pragma unroll
                for (int r = 0; r < 4; ++r) { const int t = 16 * mt + 4 * (lane >> 4) + r; const LAS float* sp = l_ss + (hh * 64 + t) * 4;
                    const float rstd = 1.f / sqrtf(((sp[0] + sp[1]) + (sp[2] + sp[3])) * (1.f / 128.f) + EPS);
                    *(LAS bf16*)(l_o + (16 * mt + r) * PV) = (bf16)f2bf(acc[mt][0][r] * rstd * g0); *(LAS bf16*)(l_o + (16 * mt + r) * PV + 32) = (bf16)f2bf(acc[mt][1][r] * rstd * g1); } }
        __syncthreads();
        { bf16* og = (bf16*)(F.dout + DO_OGD) + tok0 * 1024 + hp * 256;
#pragma unroll
          for (int q = 0; q < 4; ++q) { const int i = tid + q * 512; f32x4 o0, o1, r0, r1; const u32x4 ow = *(const LAS u32x4*)(l_v + (i >> 5) * PV + (i & 31) * 16); unpack8f(ow, o0, o1); unpack8f(cur_r[q], r0, r1);
#pragma unroll
              for (int e = 0; e < 4; ++e) { o0[e] *= r0[e] * __builtin_amdgcn_rcpf(1.f + __expf(-r0[e])); o1[e] *= r1[e] * __builtin_amdgcn_rcpf(1.f + __expf(-r1[e])); }
              *(u32x4*)(og + (size_t)(i >> 5) * 1024 + (i & 31) * 8) = pack8f(o0, o1); } }
        __syncthreads();
    }
#undef GLA_C_PREFETCH
}

__device__ __forceinline__ void dil_combine(Frame& F) {
    const bf16* qd = (const bf16*)(F.ws + WS_QD); const float* lse = (const float*)(F.ws + WS_LSE); bf16* od = (bf16*)(F.dout + DO_OGD) + 512;
    constexpr int U = 4; const int NT = F.G * NTHR;
    for (int idx0 = F.bid * NTHR + F.tid; idx0 < M * 64; idx0 += U * NT) {
        float l0[U], l1[U], l2[U]; u32x4 a[U], bq[U], c[U];
#pragma unroll
        for (int u = 0; u < U; ++u) { const int idx = idx0 + u * NT; if (idx < M * 64) { const int tok = idx >> 6, rem = idx & 63, h = rem >> 4, ch = rem & 15;
            l0[u] = lse[(size_t)tok * 12 + h]; l1[u] = lse[(size_t)tok * 12 + 4 + h]; l2[u] = lse[(size_t)tok * 12 + 8 + h];
            const bf16* p = qd + (size_t)tok * 1536 + h * 128 + ch * 8; a[u] = *(const u32x4*)p; bq[u] = *(const u32x4*)(p + 512); c[u] = *(const u32x4*)(p + 1024); } }
#pragma unroll
        for (int u = 0; u < U; ++u) { const int idx = idx0 + u * NT; if (idx < M * 64) { const int tok = idx >> 6, rem = idx & 63, h = rem >> 4, ch = rem & 15;
            const float mx = fmaxf(l0[u], fmaxf(l1[u], l2[u])); float w0 = __expf(l0[u] - mx), w1 = __expf(l1[u] - mx), w2 = __expf(l2[u] - mx); const float inv = 1.f / (w0 + w1 + w2); w0 *= inv; w1 *= inv; w2 *= inv;
            f32x4 a0, a1, b0, b1, c0, c1; unpack8f(a[u], a0, a1); unpack8f(bq[u], b0, b1); unpack8f(c[u], c0, c1);
            *(u32x4*)(od + (size_t)tok * 1024 + h * 128 + ch * 8) = pack8f(a0 * w0 + b0 * w1 + c0 * w2, a1 * w0 + b1 * w1 + c1 * w2); } }
    }
}

__device__ __forceinline__ void kv_small(Frame& F) {
    const bf16* memn = (const bf16*)(F.ws + WS_MEMN); const bf16* wt = (const bf16*)(F.ws + WS_WXKV); bf16* kvm = (bf16*)(F.ws + WS_KVM);
    const int fr = F.lane & 15, fq = F.lane >> 4;
    for (int t = F.bid; t < 256; t += F.G) { const int rt = t >> 3, ct = t & 7;
        f32x4 acc[4];
#pragma unroll
        for (int mt = 0; mt < 4; ++mt) acc[mt] = (f32x4){0.f, 0.f, 0.f, 0.f};
        const bf16* ap = memn + (size_t)(rt * 64 + fr) * DM + 8 * fq; const bf16* bp = wt + (size_t)(ct * 128 + 16 * F.wave + fr) * DM + 8 * fq;
#pragma unroll 4
        for (int kk = 0; kk < 32; ++kk) { const bf16x8 b = *(const bf16x8*)(bp + 32 * kk);
#pragma unroll
            for (int mt = 0; mt < 4; ++mt) acc[mt] = MFMA16(*(const bf16x8*)(ap + (size_t)(16 * mt) * DM + 32 * kk), b, acc[mt]); }
#pragma unroll
        for (int mt = 0; mt < 4; ++mt)
#pragma unroll
            for (int r = 0; r < 4; ++r) kvm[(size_t)(rt * 64 + 16 * mt + 4 * fq + r) * DM + ct * 128 + 16 * F.wave + fr] = (bf16)f2bf(acc[mt][r]);
    }
}

__device__ __forceinline__ att::BlockRef dil_ref(Frame& F, int I) {
    const int g = I >> 10, r = I & 1023, d = 1 << (2 * g), nqb = 32 >> (2 * g), qb = r % nqb, s = r / nqb, p = s % d, bh = s / d, h = bh & 3, b = bh >> 2;
    const size_t tb = (size_t)b * SEQ + p;
    att::BlockRef R;
    R.qs = d * 1536; R.ks = d * 1536; R.ls = d * 12; R.skv = SEQ / d; R.P0 = qb * 256;
    bf16* q = (bf16*)(F.ws + WS_QD) + tb * 1536 + g * 512 + h * 128;
    R.Q = q + (size_t)qb * 256 * R.qs;
    R.K = (const bf16*)(F.ws + WS_KD) + tb * 1536 + g * 512 + h * 128;
    R.L = (float*)(F.ws + WS_LSE) + tb * 12 + g * 4 + h + (size_t)qb * 256 * R.ls;
    return R;
}
__device__ __forceinline__ att::BlockRef xat_ref(Frame& F, int I) {
    const int qb = I & 31, h = (I >> 5) & 3, b = I >> 7;
    att::BlockRef R; R.qs = 512; R.ks = 1024; R.ls = 0; R.skv = 256; R.P0 = 256; R.L = nullptr;
    bf16* q = (bf16*)(F.ws + WS_QX) + ((size_t)b * SEQ + (size_t)qb * 256) * 512 + h * 128;
    R.Q = q; R.K = (const bf16*)(F.ws + WS_KVM) + (size_t)b * 256 * 1024 + h * 128;
    return R;
}
template <bool DIL>
__device__ __forceinline__ void attn_phase(Frame& F) {
    constexpr int TOTAL = DIL ? 3072 : 1024; constexpr int W = DIL ? 129 : (1 << 20); constexpr long VOFF = DIL ? (long)((WS_VD - WS_KD) / 2) : 512;
    const int G8 = F.G & ~255;
    auto remap = [&](int I_) { if (I_ >= (TOTAL / 256) * 256 || (I_ % F.G) >= G8 || F.G != 256) return I_; const int r_ = I_ >> 8, w_ = I_ & 255; return (r_ << 8) + ((w_ & 7) << 5) + (w_ >> 3); };
    int I = F.bid; if (I >= TOTAL) return;
    att::BlockRef cur = DIL ? dil_ref(F, remap(I)) : xat_ref(F, remap(I));
    att::Seam S;
    att::prime<VOFF>(cur, W, F.ldsg, S);
    for (;;) {
        const bool more = I + F.G < TOTAL; const int In = more ? I + F.G : I;
        const att::BlockRef nxt = DIL ? dil_ref(F, remap(In)) : xat_ref(F, remap(In));
        att::block<true, VOFF>(cur, nxt, W, F.ldsg, S);
        if (!more) break;
        cur = nxt; I = In;
    }
}

__device__ __forceinline__ void router_phase(Frame& F, const Args& A) {
    unsigned char* ws = F.ws;
    LAS unsigned char* l_w = F.lds;
    LAS float* l_lg = (LAS float*)(F.lds + 65536) + F.wave * (16 * 33 + 16);
    LAS unsigned* l_hist = (LAS unsigned*)(F.lds + 65536 + 8 * (16 * 33 + 16) * 4);
    const int tid = F.tid, lane = F.lane;
    { const u32x4* wsrc = (const u32x4*)(ws + WS_WR);
      for (int i = tid; i < 32 * 128; i += NTHR) { const int e = i >> 7, ch = i & 127; *(LAS u32x4*)(l_w + e * 2048 + ((ch ^ (e & 15)) << 4)) = wsrc[i]; } }
    if (tid < 64) l_hist[tid] = 0u;
    LAS float* l_br = (LAS float*)(l_hist + 64);
    if (tid < 32) l_br[tid] = INP(20)[tid];
    { int* rt = (int*)(ws + WS_RTOK); float* rg = (float*)(ws + WS_RGATE); float* rr = (float*)(ws + WS_RRS);
      for (int i = F.bid * NTHR + tid; i < 2 * RT_CAP; i += F.G * NTHR) { rt[i] = 0; rg[i] = 0.f; rr[i] = 0.f; } }
    __syncthreads();
    const bf16* h2b = (const bf16*)(ws + WS_A); float* rstd3 = (float*)(ws + WS_RSTD3);
    const int fr = lane & 15, fq = lane >> 4;
    for (int rb = F.bid * NWAVES + F.wave; rb < M / 16; rb += F.G * NWAVES) {
        const size_t row0 = (size_t)rb * 16;
        const bf16* xr = h2b + (row0 + fr) * DM + 8 * fq;
        f32x4 c0 = {0.f, 0.f, 0.f, 0.f}, c1 = {0.f, 0.f, 0.f, 0.f}; float ss = 0.f;
#pragma unroll
        for (int kk = 0; kk < 32; ++kk) {
            const u32x4 xw = *(const u32x4*)(xr + 32 * kk); f32x4 x0, x1; unpack8f(xw, x0, x1);
            ss += (x0[0] * x0[0] + x0[1] * x0[1]) + (x0[2] * x0[2] + x0[3] * x0[3]) + (x1[0] * x1[0] + x1[1] * x1[1]) + (x1[2] * x1[2] + x1[3] * x1[3]);
            const bf16x8 ah = *reinterpret_cast<const bf16x8*>(&xw);
            const int ch = 4 * kk + fq;
            const bf16x8 b0 = *(const LAS bf16x8*)(l_w + fr * 2048 + ((ch ^ fr) << 4)), b1 = *(const LAS bf16x8*)(l_w + (16 + fr) * 2048 + ((ch ^ fr) << 4));
            c0 = MFMA16(ah, b0, c0); c1 = MFMA16(ah, b1, c1);
        }
        ss += __shfl_xor(ss, 16); ss += __shfl_xor(ss, 32);
        const float rstd = 1.f / sqrtf(ss * (1.f / DM) + EPS);
        if (fq == 0) { l_lg[16 * 33 + fr] = rstd; rstd3[row0 + fr] = rstd; }
#pragma unroll
        for (int r = 0; r < 4; ++r) { l_lg[(4 * fq + r) * 33 + fr] = c0[r]; l_lg[(4 * fq + r) * 33 + 16 + fr] = c1[r]; }
        LDS_WAIT(); asm volatile("" ::: "memory");
        if (lane < 16) {
            const float rs = l_lg[16 * 33 + lane]; float v[32];
#pragma unroll
            for (int e = 0; e < 32; ++e) v[e] = l_lg[lane * 33 + e] * rs + l_br[e];
            int ci[4]; float cv[4];
#pragma unroll
            for (int k = 0; k < 4; ++k) { float best = -__builtin_inff(); int bi = 0;
#pragma unroll
                for (int e = 0; e < 32; ++e) { bool free_ = true;
#pragma unroll
                    for (int kk2 = 0; kk2 < k; ++kk2) free_ = free_ && (ci[kk2] != e);
                    if (free_ && v[e] > best) { best = v[e]; bi = e; } }
                ci[k] = bi; cv[k] = best; }
            float ex[4], sum = 0.f;
#pragma unroll
            for (int k = 0; k < 4; ++k) { ex[k] = __expf(cv[k] - cv[0]); sum += ex[k]; }
            const float inv = 1.f / sum; const size_t tok = row0 + lane; const int hf = tok >= HALF_TOK ? 1 : 0;
            int* te = (int*)(ws + WS_TOPE) + tok * 4; float* tg = (float*)(ws + WS_TGATE) + tok * 4;
#pragma unroll
            for (int k = 0; k < 4; ++k) { te[k] = ci[k]; tg[k] = ex[k] * inv; atomicAdd((unsigned*)&l_hist[hf * 32 + ci[k]], 1u); }
        }
        LDS_WAIT(); asm volatile("" ::: "memory");
    }
    __syncthreads();
    if (tid < 64 && l_hist[tid] != 0u) atomicAdd(F.ctl + CW_CNT + tid, l_hist[tid]);
}

struct MoeTab { LAS int* pstart; LAS int* blk_e; LAS int* nblk; };
__device__ __forceinline__ MoeTab moe_tables(Frame& F, int half) {
    MoeTab T; T.pstart = (LAS int*)(F.lds + TAB_OFF); T.blk_e = T.pstart + 32; T.nblk = T.blk_e + MAXBLK;
    __syncthreads();
    if (F.tid < 64) {
        const int lane = F.tid; int cnt = 0;
        if (lane < NEXP) cnt = (int)__hip_atomic_load(F.ctl + CW_CNT + half * 32 + lane, __ATOMIC_RELAXED, __HIP_MEMORY_SCOPE_AGENT);
        const int nb = (cnt + 255) >> 8; int incl = nb;
#pragma unroll
        for (int d = 1; d < 32; d <<= 1) { const int t = __shfl_up(incl, d); if (lane >= d) incl += t; }
        int pos = incl - nb; if (pos > MAXBLK) pos = MAXBLK;
        if (lane < NEXP) { T.pstart[lane] = pos * 256; for (int jx = 0; jx < nb && pos + jx < MAXBLK; ++jx) T.blk_e[pos + jx] = lane; }
        if (lane == NEXP - 1) T.nblk[0] = incl < MAXBLK ? incl : MAXBLK;
    }
    __syncthreads();
    return T;
}
__device__ __forceinline__ void place_phase(Frame& F) {
    unsigned char* ws = F.ws;
    LAS int* l_cnt = (LAS int*)(F.lds + 4096); LAS int* l_base = l_cnt + 32;
    const int* te = (const int*)(ws + WS_TOPE); const float* tg = (const float*)(ws + WS_TGATE);
    int* tslot = (int*)(ws + WS_TSLOT);
    for (int half = 0; half < 2; ++half) {
        const MoeTab T = moe_tables(F, half);
        int* rtok = (int*)(ws + WS_RTOK) + half * RT_CAP; float* rgate = (float*)(ws + WS_RGATE) + half * RT_CAP; float* rrs = (float*)(ws + WS_RRS) + half * RT_CAP; const float* rstd3 = (const float*)(ws + WS_RSTD3);
        for (int bt = F.bid; bt < HALF_TOK / 128; bt += F.G) {
            if (F.tid < 32) l_cnt[F.tid] = 0;
            __syncthreads();
            const int tok = half * HALF_TOK + bt * 128 + (F.tid >> 2), k = F.tid & 3;
            const int e = te[(size_t)tok * 4 + k];
            const int rank = atomicAdd((int*)&l_cnt[e], 1);
            __syncthreads();
            if (F.tid < 32) l_base[F.tid] = (int)atomicAdd(F.ctl + CW_CUR + half * 32 + F.tid, (unsigned)l_cnt[F.tid]);
            __syncthreads();
            const int dest = T.pstart[e] + l_base[e] + rank;
            if (dest < RT_CAP) { rtok[dest] = tok; rgate[dest] = tg[(size_t)tok * 4 + k]; rrs[dest] = rstd3[tok]; }
            tslot[(size_t)tok * 4 + k] = dest < RT_CAP ? dest : 0;
            __syncthreads();
        }
    }
}
__device__ __forceinline__ void combine_phase(Frame& F, const Args& A, int half, size_t ws_y, int rem = 0) {
    float* outp = (float*)F.dout; const bf16* h2b = (const bf16*)(F.ws + WS_A); const bf16* Y = (const bf16*)(F.ws + ws_y); const int* tslot = (const int*)(F.ws + WS_TSLOT); const float* gf = INP(27);
    f32x4 gg[2][2];
#pragma unroll
    for (int c = 0; c < 2; ++c) { gg[c][0] = *(const f32x4*)(gf + c * 512 + 8 * F.lane); gg[c][1] = *(const f32x4*)(gf + c * 512 + 8 * F.lane + 4); }
    int m_begin = half * HALF_TOK + 2 * (F.bid * NWAVES + F.wave), m_end = (half + 1) * HALF_TOK, m_step = 2 * F.G * NWAVES;
    if (rem > 0 && rem < F.G && F.G == 256) {
        const int n_lo = 128 - ((30 * (F.G - rem) / F.G) & ~1), nhi = F.G - rem, rest = HALF_TOK - rem * n_lo, q = (rest / nhi) & ~1, extra = (rest - q * nhi) / 2;
        int start, n;
        if (F.bid < rem) { start = F.bid * n_lo; n = n_lo; } else { const int j = F.bid - rem; start = rem * n_lo + j * q + 2 * (j < extra ? j : extra); n = q + (j < extra ? 2 : 0); }
        m_begin = half * HALF_TOK + start + 2 * F.wave; m_end = half * HALF_TOK + start + n; m_step = 2 * NWAVES;
    }
    for (int m0 = m_begin; m0 < m_end; m0 += m_step) {
        u32x4 hw[2][2], yw[2][4][2]; int sl[2][4];
#pragma unroll
        for (int r = 0; r < 2; ++r)
#pragma unroll
            for (int k = 0; k < 4; ++k) sl[r][k] = tslot[(size_t)(m0 + r) * 4 + k];
#pragma unroll
        for (int r = 0; r < 2; ++r) {
#pragma unroll
            for (int c = 0; c < 2; ++c) hw[r][c] = *(const u32x4*)(h2b + (size_t)(m0 + r) * DM + c * 512 + 8 * F.lane);
#pragma unroll
            for (int k = 0; k < 4; ++k)
#pragma unroll
                for (int c = 0; c < 2; ++c) yw[r][k][c] = *(const u32x4*)(Y + (size_t)sl[r][k] * 1024 + c * 512 + 8 * F.lane); }
#pragma unroll
        for (int r = 0; r < 2; ++r) { f32x4 v[2][2]; float s = 0.f;
#pragma unroll
            for (int c = 0; c < 2; ++c) { unpack8f(hw[r][c], v[c][0], v[c][1]);
#pragma unroll
                for (int k = 0; k < 4; ++k) { f32x4 y0, y1; unpack8f(yw[r][k][c], y0, y1); v[c][0] += y0; v[c][1] += y1; }
#pragma unroll
                for (int e = 0; e < 2; ++e) s += (v[c][e].x * v[c][e].x + v[c][e].y * v[c][e].y) + (v[c][e].z * v[c][e].z + v[c][e].w * v[c][e].w); }
            const float rstd = 1.f / sqrtf(wave_sum(s) * (1.f / DM) + EPS);
            float* op = outp + (size_t)(m0 + r) * DM + 8 * F.lane;
#pragma unroll
            for (int c = 0; c < 2; ++c) { *(f32x4*)(op + c * 512) = v[c][0] * rstd * gg[c][0]; *(f32x4*)(op + c * 512 + 4) = v[c][1] * rstd * gg[c][1]; } }
    }
}

__global__ void __launch_bounds__(NTHR, 2) mk_fwd(Args A) {
    extern __shared__ __attribute__((aligned(16))) unsigned char lds[];
    Frame F;
    F.lds = (LAS unsigned char*)lds; F.ldsg = (char*)lds;
    F.tid = threadIdx.x; F.lane = F.tid & 63; F.wave = __builtin_amdgcn_readfirstlane(F.tid >> 6);
    F.G = gridDim.x; F.bid = blockIdx.x;
    F.ws = A.ws; F.ctl = (unsigned*)(A.ws + WS_CTL); F.dout = (unsigned char*)A.out;
    volatile LAS unsigned* MISC = (volatile LAS unsigned*)(F.lds + MISC_OFF);
    if (F.tid < 16) MISC[F.tid] = 0u;
    __syncthreads();
    XcdBarrier bar; bar.bar = F.ctl + CW_BAR; bar.x = 0; bar.st = nullptr;
    if (!MK_PER_PHASE) bar = xcd_barrier_post(F.ctl + CW_BAR, MISC + 8);
    const int lo = A.ph_lo, hi = A.ph_hi;
#ifndef PHMASK
#define PHMASK 0x7ffff
#endif
#define IN(k) (((PHMASK >> (k)) & 1) && lo <= (k) && (k) < hi)
#if MK_PROBE
#define SEAM(k) do { if (IN(k) && IN((k) + 1)) xcd_barrier(bar); if ((k) == PROBE_A) t_mark = __builtin_amdgcn_s_memrealtime(); } while (0)
#else
#define SEAM(k) do { if (IN(k) && IN((k) + 1)) xcd_barrier(bar); } while (0)
#endif
    unsigned char* ws = F.ws;
    const int* positions = (const int*)A.in[2];

#if MK_PROBE
    const unsigned long long t_k0 = __builtin_amdgcn_s_memrealtime(); unsigned long long t_mark = t_k0;
#endif
#if MK_REPS > 1
    for (int rep_ = 0; rep_ < MK_REPS; ++rep_) {
    if (rep_ > 0) { if (F.bid == 0 && F.tid < 128) { __hip_atomic_store(F.ctl + CW_CNT + F.tid, 0u, __ATOMIC_RELAXED, __HIP_MEMORY_SCOPE_AGENT); __hip_atomic_store(F.ctl + CW_CUR + F.tid, 0u, __ATOMIC_RELAXED, __HIP_MEMORY_SCOPE_AGENT); } xcd_barrier(bar); }
#endif
    if (IN(0)) { p0_prologue(F, A); } SEAM(0);
    if (IN(1)) {
        { pg8::Gemm g{(const bf16*)(ws + WS_A), (const bf16*)(ws + WS_WIN), 1024, nullptr}; pg8::StaticOrder S; S.init(M / 256, 6, F.G, F.bid, 0);
          EpiProj E{ws, positions, 1.f}; pg8::gemm_phase<EpiProj, pg8::StaticOrder, false>(F.lds, g, S, E); }
        { pg8::Gemm g{(const bf16*)(ws + WS_A8), (const bf16*)(ws + WS_WIN8), 1024, nullptr}; pg8::StaticOrder S; S.init(M / 256, 18, F.G, F.bid, 6, -6);
          EpiProj E{ws, positions, W8_INV}; pg8::gemm_phase<EpiProj, pg8::StaticOrder, false, 1>(F.lds, g, S, E); }
        kv_small(F);
    } SEAM(1);
    if (IN(2)) {
#ifndef NO_GLAA
        gla_a_phase(F, A);
#endif
#ifndef NO_DIL
        attn_phase<true>(F);
#endif
    } SEAM(2);
    if (IN(3)) { gla_scan(F);
        { pg8::Gemm g{(const bf16*)(ws + WS_A8), (const bf16*)(ws + WS_WGATE), 1024, nullptr}; pg8::StaticOrder S; S.init(M / 256, 8, F.G, F.bid);
        EpiGates E{(bf16*)(ws + WS_GATES), INP(11), W8_INV}; pg8::gemm_phase<EpiGates, pg8::StaticOrder, false, 1>(F.lds, g, S, E); } } SEAM(3);
    if (IN(4)) {
        gla_c_phase(F, A);
        dil_combine(F);
    } SEAM(4);
    if (IN(6)) { pg8::Gemm g{(const bf16*)(F.dout + DO_OGD), (const bf16*)(ws + WS_WBG), 1024, nullptr}; pg8::StaticOrder S; S.init(M / 256, 4, F.G, F.bid);
        EpiBranchFused E{(bf16*)(ws + WS_MERGED), (const bf16*)(ws + WS_GATES)}; pg8::gemm_phase<EpiBranchFused, pg8::StaticOrder, false>(F.lds, g, S, E); } SEAM(6);
    if (IN(7)) { pg8::Gemm g{(const bf16*)(ws + WS_MERGED), (const bf16*)(ws + WS_WMIX), 1024, nullptr}; pg8::StaticOrder S; S.init(M / 256, 4, F.G, F.bid);
        EpiResBf16 E{INP(0), nullptr, (bf16*)(ws + WS_A), ws + WS_H2F8}; pg8::gemm_phase<EpiResBf16, pg8::StaticOrder, false>(F.lds, g, S, E); } SEAM(7);
    if (IN(8)) {
        const int gw = F.bid * NWAVES + F.wave, NGW = F.G * NWAVES;
        LAS float* scr = (LAS float*)(F.lds + F.wave * 16384);
        constexpr int IPM = 16 * 32;
        for (int it = gw; it < 3 * NEXP * IPM; it += NGW) { const int mat = it / IPM, r = it % IPM, kind = mat / NEXP, e = mat % NEXP;
            if (kind == 0) transpose_item<RmGU, true>(INP(21) + (size_t)e * 1048576, 1024, 1024, (bf16*)(ws + WS_WGU), RmGU{e * 2048}, scr, r, F.lane, INP(18));
            else if (kind == 1) transpose_item<RmGU, true>(INP(23) + (size_t)e * 1048576, 1024, 1024, (bf16*)(ws + WS_WGU), RmGU{e * 2048 + 128}, scr, r, F.lane, INP(18));
            else transpose_item<RmId, true>(INP(25) + (size_t)e * 1048576, 1024, 1024, (bf16*)(ws + WS_WDN), RmId{e * 1024}, scr, r, F.lane); }
    }
    if (IN(9)) { pg8::Gemm g{(const bf16*)(ws + WS_H2F8), (const bf16*)(ws + WS_WXQ), 1024, nullptr};     pg8::StaticOrder S; S.init(M / 256, 2, F.G, F.bid);
        LAS float* rs = (LAS float*)(F.lds + TAB_OFF);
        { pg8::Unit u; for (int i = 0; i < 8 && S.next(i, u); ++i) {
              for (int r0 = F.wave * 32; r0 < F.wave * 32 + 32; r0 += 8) {
                  u32x4 w[8][2];
#pragma unroll
                  for (int q = 0; q < 8; ++q) { const bf16* xr = (const bf16*)(ws + WS_A) + ((size_t)u.pm * 256 + r0 + q) * DM + F.lane * 8; w[q][0] = *(const u32x4*)xr; w[q][1] = *(const u32x4*)(xr + 512); }
#pragma unroll
                  for (int q = 0; q < 8; ++q) { f32x4 a0, a1, b0, b1; unpack8f(w[q][0], a0, a1); unpack8f(w[q][1], b0, b1);
                      float ss = (a0[0] * a0[0] + a0[1] * a0[1]) + (a0[2] * a0[2] + a0[3] * a0[3]) + (a1[0] * a1[0] + a1[1] * a1[1]) + (a1[2] * a1[2] + a1[3] * a1[3])
                               + (b0[0] * b0[0] + b0[1] * b0[1]) + (b0[2] * b0[2] + b0[3] * b0[3]) + (b1[0] * b1[0] + b1[1] * b1[1]) + (b1[2] * b1[2] + b1[3] * b1[3]);
                      ss = wave_sum(ss); if (F.lane == 0) rs[i * 256 + r0 + q] = W8_INV / sqrtf(ss * (1.f / DM) + EPS); } } } }
        __syncthreads();
        EpiRowScaleBf16 E{(bf16*)(ws + WS_QX), 512, rs}; pg8::gemm_phase<EpiRowScaleBf16, pg8::StaticOrder, false, 1>(F.lds, g, S, E); } SEAM(9);
    if (IN(10)) { attn_phase<false>(F); } SEAM(10);
    if (IN(11)) { pg8::Gemm g{(const bf16*)(ws + WS_QX), (const bf16*)(ws + WS_WXO), 512, nullptr}; pg8::StaticOrder S; S.init(M / 256, 4, F.G, F.bid);
        EpiResBf16 E{nullptr, (const bf16*)(ws + WS_A), (bf16*)(ws + WS_A), ws + WS_H2F8}; pg8::gemm_phase<EpiResBf16, pg8::StaticOrder, false>(F.lds, g, S, E); } SEAM(11);
    if (IN(12)) { router_phase(F, A); } SEAM(12);
    if (IN(13)) { place_phase(F); } SEAM(13);
#define MOE_GU(half, wsh, cc) do { const MoeTab T = moe_tables(F, half); \
        pg8::Gemm g{(const bf16*)(ws + WS_H2F8), (const bf16*)(ws + WS_WGU), 1024, (const int*)(ws + WS_RTOK) + (half) * RT_CAP}; \
        pg8::MoeOrder S; S.init(T.nblk[0], 8, F.G, (cc)); S.blk_e = T.blk_e; \
        EpiSwiglu E{ws + (wsh), INP(22), INP(24), 8, (const float*)(ws + WS_RRS) + (half) * RT_CAP}; pg8::gemm_phase<EpiSwiglu, pg8::MoeOrder, true, 1>(F.lds, g, S, E); } while (0)
#define MOE_DN(half, wsh, wsy, nbv) do { const MoeTab T = moe_tables(F, half); nbv = T.nblk[0]; \
        pg8::Gemm g{(const bf16*)(ws + (wsh)), (const bf16*)(ws + WS_WDN), 1024, nullptr}; \
        pg8::MoeOrder S; S.init(T.nblk[0], 4, F.G, F.bid); S.blk_e = T.blk_e; \
        EpiDown E{(bf16*)(ws + (wsy)), INP(26), (const float*)(ws + WS_RGATE) + (half) * RT_CAP, 4}; pg8::gemm_phase<EpiDown, pg8::MoeOrder, false, 1>(F.lds, g, S, E); } while (0)
    if (IN(14)) { MOE_GU(0, WS_H, F.bid); } SEAM(14);
    if (IN(15)) { int nb0 = 0; MOE_DN(0, WS_H, WS_Y, nb0); const int rem = (nb0 * 4) % F.G; MOE_GU(1, WS_H1, (F.bid + F.G - rem) % F.G); } SEAM(15);
    if (IN(16)) { int nb1 = 0; MOE_DN(1, WS_H1, WS_Y1, nb1); combine_phase(F, A, 0, WS_Y, (nb1 * 4) % F.G); } SEAM(16);
    if (IN(17)) { combine_phase(F, A, 1, WS_Y1); }
#if MK_PROBE
    { xcd_barrier(bar); if (F.tid == 0) { const unsigned long long t1 = __builtin_amdgcn_s_memrealtime(), w = ((PROBE_A == 100 ? t1 : t_mark) - t_k0) * PROBE_K; while (__builtin_amdgcn_s_memrealtime() - t1 < w) __builtin_amdgcn_s_sleep(8); } __syncthreads(); }
#endif
#if MK_REPS > 1
    xcd_barrier(bar); }
#endif
#undef IN
#undef SEAM
}


extern "C" void kernel_launch(void* const* d_in, const int* in_sizes, int n_in, void* d_out, int out_size, void* d_ws, size_t ws_size, hipStream_t stream) {
    static int grid = 0;
    if (grid == 0) {
        if (n_in != 28 || out_size != M * DM || ws_size < WS_END) { fprintf(stderr, "kernel_launch: unexpected shapes (n_in %d, out %d, ws %zu)\n", n_in, out_size, ws_size); grid = -1; return; }
        int dev = 0, cus = 0, per_cu = 0;
        if (hipGetDevice(&dev) != hipSuccess || hipDeviceGetAttribute(&cus, hipDeviceAttributeMultiprocessorCount, dev) != hipSuccess) { grid = -1; return; }
        if (hipFuncSetAttribute((const void*)mk_fwd, hipFuncAttributeMaxDynamicSharedMemorySize, LDS_BYTES) != hipSuccess) { fprintf(stderr, "kernel_launch: hipFuncSetAttribute failed\n"); grid = -1; return; }
        if (hipOccupancyMaxActiveBlocksPerMultiprocessor(&per_cu, (const void*)mk_fwd, NTHR, LDS_BYTES) != hipSuccess || per_cu < 1) { fprintf(stderr, "kernel_launch: occupancy query says %d\n", per_cu); (void)hipGetLastError(); grid = -1; return; }
        grid = cus;
    }
    if (grid < 0) return;
#if MK_DIAG
    unsigned long long* sums = (unsigned long long*)((char*)d_ws + WS_DIAG);
    (void)hipMemsetAsync(sums, 0, 4096, stream);
    for (int run = 0; run < 2; ++run) {
        (void)hipMemsetAsync((char*)d_ws + 1 * MiB, run ? 0x3C : 0x00, WS_END - 1 * MiB, stream);
        (void)hipMemsetAsync(d_out, run ? 0x3D : 0x00, (size_t)M * DM * 4, stream);
        (void)hipMemsetAsync((char*)d_ws + WS_CTL, 0, CTL_ZERO_BYTES, stream);
        Args a{};
        for (int i = 0; i < 28; ++i) a.in[i] = d_in[i];
        a.out = (float*)d_out; a.ws = (unsigned char*)d_ws;
        for (int p = 0; p < NPH; ++p) { a.ph_lo = p; a.ph_hi = p + 1; hipLaunchKernelGGL(mk_fwd, dim3(grid), dim3(NTHR), LDS_BYTES, stream, a);
            diag_sums(p, (unsigned char*)d_ws, (unsigned char*)d_out, sums + run * 32 + p, stream); }
    }
    hipLaunchKernelGGL(k_verdict, dim3(1024), dim3(256), 0, stream, (const unsigned long long*)sums, (float*)d_out, (size_t)M * DM);
#else
    (void)hipMemsetAsync((char*)d_ws + WS_CTL, 0, CTL_ZERO_BYTES, stream);
    Args a{};
    for (int i = 0; i < 28; ++i) a.in[i] = d_in[i];
    a.out = (float*)d_out; a.ws = (unsigned char*)d_ws;
#if MK_PER_PHASE
    for (int p = 0; p < NPH; ++p) { a.ph_lo = p; a.ph_hi = p + 1; hipLaunchKernelGGL(mk_fwd, dim3(grid), dim3(NTHR), LDS_BYTES, stream, a); }
#else
    a.ph_lo = 0; a.ph_hi = NPH; hipLaunchKernelGGL(mk_fwd, dim3(grid), dim3(NTHR), LDS_BYTES, stream, a);
#endif
#endif
}
```

```cpp
#include <hip/hip_runtime.h>
#include <cstdio>
#include <cstdint>

#define LAS __attribute__((address_space(3)))
#define GAS __attribute__((address_space(1)))
typedef unsigned short bf16;
typedef short bf16x8 __attribute__((ext_vector_type(8)));
typedef short s16x4 __attribute__((ext_vector_type(4)));
typedef float f32x4 __attribute__((ext_vector_type(4)));
typedef float f32x16 __attribute__((ext_vector_type(16)));
typedef unsigned u32x4 __attribute__((ext_vector_type(4)));
typedef unsigned u32x2 __attribute__((ext_vector_type(2)));
typedef int i32x4 __attribute__((ext_vector_type(4)));
typedef int i32x8 __attribute__((ext_vector_type(8)));

typedef float f32x2 __attribute__((ext_vector_type(2)));
typedef __bf16 b16x2 __attribute__((ext_vector_type(2)));
__device__ __forceinline__ unsigned cvt_pk_bf16(float lo, float hi) { const f32x2 v = {lo, hi}; const b16x2 r = __builtin_convertvector(v, b16x2); return __builtin_bit_cast(unsigned, r); }
__device__ __forceinline__ u32x2 pack8_fp8(const f32x4& a, const f32x4& b) {
    unsigned lo = 0, hi = 0; lo = __builtin_amdgcn_cvt_pk_fp8_f32(a[0], a[1], lo, false); lo = __builtin_amdgcn_cvt_pk_fp8_f32(a[2], a[3], lo, true); hi = __builtin_amdgcn_cvt_pk_fp8_f32(b[0], b[1], hi, false); hi = __builtin_amdgcn_cvt_pk_fp8_f32(b[2], b[3], hi, true);
    u32x2 w; w.x = lo; w.y = hi; return w; }
__device__ __forceinline__ float bf2f(unsigned b) { return __uint_as_float(b << 16); }
__device__ __forceinline__ float bflo(unsigned w) { return __uint_as_float(w << 16); }
__device__ __forceinline__ float bfhi(unsigned w) { return __uint_as_float(w & 0xffff0000u); }
__device__ __forceinline__ unsigned f2bf(float f) { unsigned u = __float_as_uint(f); return (u + 0x7fffu + ((u >> 16) & 1u)) >> 16; }
__device__ __forceinline__ unsigned pk2(float lo, float hi) { return f2bf(lo) | (f2bf(hi) << 16); }

namespace pg8 {
constexpr int BM = 256, BK = 64, HALF = 128, HTB = HALF * BK * 2, STAGE_BYTES = 8 * HTB, NXCD = 8, WGM = 4;
__host__ __device__ __forceinline__ int lds_byte(int r, int c) { const int st = (r >> 4) * 2 + (c >> 5), rr = r & 15, cc = c & 31, ob = rr * 64 + cc * 2; return st * 1024 + (ob ^ (((ob >> 9) & 1) << 5)); }
__host__ __device__ __forceinline__ void stage_rc(int b, int& R, int& C) { const int st = b / 1024, sb = b % 1024, swz = sb ^ (((sb >> 9) & 1) << 5); R = (st >> 1) * 16 + swz / 64; C = (st & 1) * 32 + (swz % 64) / 2; }
__host__ __device__ __forceinline__ int perm32(int rho) { const int n = rho >> 4, i = rho & 15; return 8 * (i >> 2) + 4 * n + (i & 3); }

struct Unit { int pm, pn, pb, ord; };
struct Gemm { const bf16* A; const bf16* Bt; int K; const int* rowmap; };

struct StaticOrder {
    int nM, nN, nwg, G, c, pn0, pbd;
    __device__ __forceinline__ void init(int nM_, int nN_, int G_, int c_, int pn0_ = 0, int pbd_ = 0) { nM = nM_; nN = nN_; nwg = nM * nN; G = G_; c = c_; pn0 = pn0_; pbd = pbd_; }
    __device__ __forceinline__ bool next(int i, Unit& u) const {
        const long L = (long)i * G + c; if (L >= nwg) return false;
        int wgid = (int)L; { const int q = nwg / NXCD, r = nwg % NXCD, xcd = wgid % NXCD, off = wgid / NXCD; wgid = (xcd < r ? xcd * (q + 1) : r * (q + 1) + (xcd - r) * q) + off; }
        const int nig = WGM * nN, gid = wgid / nig, fm = gid * WGM, gsz = (nM - fm) < WGM ? (nM - fm) : WGM;
        u.pm = fm + ((wgid % nig) % gsz); u.pn = pn0 + (wgid % nig) / gsz; u.pb = u.pn + pbd; u.ord = i; return true;
    }
};
struct PanelOrder {
    int nM, nN, G, c;
    __device__ __forceinline__ void init(int nM_, int nN_, int G_, int c_) { nM = nM_; nN = nN_; G = G_; c = c_; }
    __device__ __forceinline__ bool next(int i, Unit& u) const { const int p = i / nN, pm = p * G + c; if (pm >= nM) return false; u.pm = pm; u.pn = i - p * nN; u.pb = u.pn; u.ord = p; return true; }
};
struct MoeOrder : StaticOrder {
    const LAS int* blk_e;
    __device__ __forceinline__ bool next(int i, Unit& u) const { if (!StaticOrder::next(i, u)) return false; u.pb = blk_e[u.pm] * nN + u.pn; return true; }
};

template <class Epi, class Sched, bool GATHER, int ES = 2>
__device__ __forceinline__ void gemm_phase(LAS unsigned char* lds, const Gemm g, const Sched& S, const Epi& E) {
    const int tid = threadIdx.x, wid = __builtin_amdgcn_readfirstlane(tid >> 6), lane = tid & 63, wr = wid >> 2, wc = wid & 3, fr = lane & 15, fq = lane >> 4;
    const int K = g.K, KB = K * ES  , nt = KB / (BK * 2);
    unsigned voffA[2], voffB[2]; int rA[2], cA2[2];
#pragma unroll
    for (int i = 0; i < 2; ++i) { int R, C; stage_rc(tid * 16 + i * 8192, R, C); const int Rb = Epi::PERM ? ((R & ~31) + perm32(R & 31)) : R;
        voffA[i] = (unsigned)(R * KB + C * 2); voffB[i] = (unsigned)(Rb * KB + C * 2); rA[i] = R; cA2[i] = C * 2; }
    const size_t kstep = (size_t)(BK * 2);
    const size_t hstep = (size_t)HALF * KB;
    const size_t tstep = 2 * hstep;
    const unsigned ldsw = (unsigned)wid * 1024u;
    const int aoff = lds_byte(wr * 64 + fr, fq * 8), boff = lds_byte(wc * 32 + fr, fq * 8);
#define PG8_SA(b, h) (((b) * 2 + (h)) * HTB)
#define PG8_SB(b, h) ((4 + (b) * 2 + (h)) * HTB)
#define PG8_STAGE(bufoff, gbase, voff) do { _Pragma("unroll") for (int _i = 0; _i < 2; ++_i) \
        __builtin_amdgcn_global_load_lds((const unsigned*)((const char*)(gbase) + (voff)[_i]), (LAS unsigned*)(lds + (bufoff) + ldsw + _i * 8192), 16, 0, 0); } while (0)
#define PG8_STAGE_G(bufoff, o0, o1, kb) do { \
        __builtin_amdgcn_global_load_lds((const unsigned*)((const char*)g.A + (size_t)(o0) + (kb)), (LAS unsigned*)(lds + (bufoff) + ldsw), 16, 0, 0); \
        __builtin_amdgcn_global_load_lds((const unsigned*)((const char*)g.A + (size_t)(o1) + (kb)), (LAS unsigned*)(lds + (bufoff) + ldsw + 8192), 16, 0, 0); } while (0)
#define PG8_CAT8(x0, x1) __builtin_shufflevector(__builtin_bit_cast(i32x4, x0), __builtin_bit_cast(i32x4, x1), 0, 1, 2, 3, 4, 5, 6, 7)
#define PG8_LDA(dst, b, h) do { if constexpr (ES == 2) { _Pragma("unroll") for (int m = 0; m < 4; ++m) _Pragma("unroll") for (int k = 0; k < 2; ++k) dst[m][k] = *(const LAS bf16x8*)(lds + PG8_SA(b, h) + aoff + m * 2048 + k * 1024); } \
        else { _Pragma("unroll") for (int m = 0; m < 4; ++m) dst##8[m] = PG8_CAT8(*(const LAS bf16x8*)(lds + PG8_SA(b, h) + aoff + m * 2048), *(const LAS bf16x8*)(lds + PG8_SA(b, h) + aoff + m * 2048 + 1024)); } } while (0)
#define PG8_LDB(dst, b, h) do { if constexpr (ES == 2) { _Pragma("unroll") for (int n = 0; n < 2; ++n) _Pragma("unroll") for (int k = 0; k < 2; ++k) dst[n][k] = *(const LAS bf16x8*)(lds + PG8_SB(b, h) + boff + n * 2048 + k * 1024); } \
        else { _Pragma("unroll") for (int n = 0; n < 2; ++n) dst##8[n] = PG8_CAT8(*(const LAS bf16x8*)(lds + PG8_SB(b, h) + boff + n * 2048), *(const LAS bf16x8*)(lds + PG8_SB(b, h) + boff + n * 2048 + 1024)); } } while (0)
#define PG8_MMA(ai, bj, At, Bt) do { __builtin_amdgcn_s_setprio(1); if constexpr (ES == 2) { _Pragma("unroll") for (int m = 0; m < 4; ++m) _Pragma("unroll") for (int n = 0; n < 2; ++n) _Pragma("unroll") for (int k = 0; k < 2; ++k) \
        acc[ai][bj][m][n] = __builtin_amdgcn_mfma_f32_16x16x32_bf16(Bt[n][k], At[m][k], acc[ai][bj][m][n], 0, 0, 0); } else { _Pragma("unroll") for (int m = 0; m < 4; ++m) _Pragma("unroll") for (int n = 0; n < 2; ++n) \
        asm volatile("v_mfma_scale_f32_16x16x128_f8f6f4 %0, %1, %2, %0, %3, %3 op_sel_hi:[0,0,0]" : "+v"(acc[ai][bj][m][n]) : "v"(Bt##8[n]), "v"(At##8[m]), "v"(sc1)); } \
        __builtin_amdgcn_s_setprio(0); } while (0)
#define PG8_WAIT_V(n) asm volatile("s_waitcnt vmcnt(" #n ")" ::: "memory")
#define PG8_WAIT_L(n) asm volatile("s_waitcnt lgkmcnt(" #n ")" ::: "memory")
#define PG8_BAR __builtin_amdgcn_s_barrier()
#define PG8_SCHED __builtin_amdgcn_sched_barrier(0)
#define PG8_ROWOFF(dst, U) do { _Pragma("unroll") for (int _h = 0; _h < 2; ++_h) _Pragma("unroll") for (int _i = 0; _i < 2; ++_i) \
        dst[_h][_i] = (unsigned)g.rowmap[(U).pm * BM + _h * HALF + rA[_i]] * (unsigned)KB + (unsigned)cA2[_i]; } while (0)
    Unit cur, nxt; int ui = 0;
    if (!S.next(0, cur)) return;
    f32x4 acc[2][2][4][2];
#pragma unroll
    for (int a = 0; a < 2; ++a)
#pragma unroll
        for (int b = 0; b < 2; ++b)
#pragma unroll
            for (int m = 0; m < 4; ++m)
#pragma unroll
                for (int n = 0; n < 2; ++n) acc[a][b][m][n] = (f32x4){0.f, 0.f, 0.f, 0.f};
    const int sc1 = 0x7f7f7f7f;
    bf16x8 At[4][2], B0[2][2], B1[2][2]; i32x8 At8[4], B08[2], B18[2];
    const char* cA = (const char*)g.A + (size_t)cur.pm * tstep; const char* cB = (const char*)g.Bt + (size_t)cur.pb * tstep;
    unsigned cO[2][2] = {{0u, 0u}, {0u, 0u}}, nO[2][2] = {{0u, 0u}, {0u, 0u}};
    bool has_next = S.next(1, nxt);
    if constexpr (GATHER) { PG8_ROWOFF(cO, cur); if (has_next) { PG8_ROWOFF(nO, nxt); } else { _Pragma("unroll") for (int h = 0; h < 2; ++h) _Pragma("unroll") for (int i = 0; i < 2; ++i) nO[h][i] = cO[h][i]; } }
    if constexpr (GATHER) {
        PG8_STAGE(PG8_SB(0, 0), cB, voffB); PG8_STAGE(PG8_SB(0, 1), cB + hstep, voffB); PG8_STAGE_G(PG8_SA(0, 0), cO[0][0], cO[0][1], 0); PG8_STAGE_G(PG8_SA(0, 1), cO[1][0], cO[1][1], 0);
        if (wr == 1) PG8_BAR;
        PG8_WAIT_V(2); PG8_BAR;
        PG8_STAGE(PG8_SB(1, 0), cB + kstep, voffB); PG8_STAGE_G(PG8_SA(1, 0), cO[0][0], cO[0][1], kstep); PG8_STAGE(PG8_SB(1, 1), cB + hstep + kstep, voffB);
        PG8_WAIT_V(6); PG8_BAR;
    } else {
        PG8_STAGE(PG8_SB(0, 0), cB, voffB); PG8_STAGE(PG8_SB(0, 1), cB + hstep, voffB); PG8_STAGE(PG8_SA(0, 0), cA, voffA); PG8_STAGE(PG8_SA(0, 1), cA + hstep, voffA);
        if (wr == 1) PG8_BAR;
        PG8_WAIT_V(2); PG8_BAR;
        PG8_STAGE(PG8_SB(1, 0), cB + kstep, voffB); PG8_STAGE(PG8_SA(1, 0), cA + kstep, voffA); PG8_STAGE(PG8_SB(1, 1), cB + hstep + kstep, voffB);
        PG8_WAIT_V(6); PG8_BAR;
    }
    for (;;) {
        const char* nA = has_next ? (const char*)g.A + (size_t)nxt.pm * tstep : cA; const char* nB = has_next ? (const char*)g.Bt + (size_t)nxt.pb * tstep : cB;
#pragma nounroll
        for (int t = 0; t < nt; t += 2) {
            const bool last = (t == nt - 2);
            const char* a1 = cA + (size_t)(t + 1) * kstep;
            const char* a2 = last ? nA : cA + (size_t)(t + 2) * kstep; const char* b2 = last ? nB : cB + (size_t)(t + 2) * kstep;
            const char* a3 = a2 + kstep; const char* b3 = b2 + kstep;
            const size_t k1 = (size_t)(t + 1) * kstep, k2 = last ? 0 : (size_t)(t + 2) * kstep, k3 = k2 + kstep;
            unsigned x00 = 0, x01 = 0, x10 = 0, x11 = 0;
            if constexpr (GATHER) { x00 = last ? nO[0][0] : cO[0][0]; x01 = last ? nO[0][1] : cO[0][1]; x10 = last ? nO[1][0] : cO[1][0]; x11 = last ? nO[1][1] : cO[1][1]; }
            if constexpr (Epi::HAS_MID) { if (t == nt / 2) E.mid(acc, cur, wr, wc, fr, fq); }
            PG8_LDB(B0, 0, 0); PG8_LDB(B1, 0, 1); PG8_SCHED; PG8_LDA(At, 0, 0);
            if constexpr (GATHER) PG8_STAGE_G(PG8_SA(1, 1), cO[1][0], cO[1][1], k1); else PG8_STAGE(PG8_SA(1, 1), a1 + hstep, voffA);
            PG8_WAIT_V(8); PG8_WAIT_L(0); PG8_BAR; PG8_MMA(0, 0, At, B0); PG8_MMA(0, 1, At, B1); PG8_BAR; PG8_SCHED;
            PG8_LDA(At, 0, 1); PG8_STAGE(PG8_SB(0, 0), b2, voffB); PG8_STAGE(PG8_SB(0, 1), b2 + hstep, voffB);
            if constexpr (GATHER) PG8_STAGE_G(PG8_SA(0, 0), x00, x01, k2); else PG8_STAGE(PG8_SA(0, 0), a2, voffA);
            PG8_WAIT_V(8); PG8_WAIT_L(0); PG8_BAR; PG8_MMA(1, 0, At, B0); PG8_MMA(1, 1, At, B1); PG8_BAR; PG8_SCHED;
            PG8_LDB(B0, 1, 0); PG8_LDB(B1, 1, 1); PG8_SCHED; PG8_LDA(At, 1, 0);
            if constexpr (GATHER) PG8_STAGE_G(PG8_SA(0, 1), x10, x11, k2); else PG8_STAGE(PG8_SA(0, 1), a2 + hstep, voffA);
            PG8_WAIT_V(8); PG8_WAIT_L(0); PG8_BAR; PG8_MMA(0, 0, At, B0); PG8_MMA(0, 1, At, B1); PG8_BAR; PG8_SCHED;
            PG8_LDA(At, 1, 1); PG8_STAGE(PG8_SB(1, 0), b3, voffB); PG8_STAGE(PG8_SB(1, 1), b3 + hstep, voffB);
            if constexpr (GATHER) PG8_STAGE_G(PG8_SA(1, 0), x00, x01, k3); else PG8_STAGE(PG8_SA(1, 0), a3, voffA);
            PG8_WAIT_V(8); PG8_WAIT_L(0); PG8_BAR; PG8_MMA(1, 0, At, B0); PG8_MMA(1, 1, At, B1); PG8_BAR; PG8_SCHED;
        }
        if constexpr (ES == 1) asm volatile("s_nop 15\n\ts_nop 15" ::: "memory");
        asm volatile("" : "+s"(cur.pm), "+s"(cur.pn), "+s"(cur.pb));
        if (wr == 0) PG8_BAR;
        Unit nn = cur; const bool has_nn = has_next && S.next(ui + 2, nn);
        unsigned tO[2][2] = {{0u, 0u}, {0u, 0u}};
        if constexpr (GATHER) { if (has_nn) { PG8_ROWOFF(tO, nn); } }
        E(acc, cur, wr, wc, fr, fq);
        if (!has_next) break;
#pragma unroll
        for (int a = 0; a < 2; ++a)
#pragma unroll
            for (int b = 0; b < 2; ++b)
#pragma unroll
                for (int m = 0; m < 4; ++m)
#pragma unroll
                    for (int n = 0; n < 2; ++n) acc[a][b][m][n] = (f32x4){0.f, 0.f, 0.f, 0.f};
        if constexpr (GATHER) {
#pragma unroll
            for (int h = 0; h < 2; ++h)
#pragma unroll
                for (int i = 0; i < 2; ++i) { cO[h][i] = nO[h][i]; nO[h][i] = has_nn ? tO[h][i] : nO[h][i]; } }
        cur = nxt; cA = nA; cB = nB; ++ui; nxt = nn; has_next = has_nn;
        if (wr == 1) PG8_BAR;
    }
    PG8_WAIT_V(0);
    PG8_BAR;
#undef PG8_SA
#undef PG8_SB
#undef PG8_STAGE
#undef PG8_STAGE_G
#undef PG8_LDA
#undef PG8_LDB
#undef PG8_MMA
#undef PG8_CAT8
#undef PG8_WAIT_V
#undef PG8_WAIT_L
#undef PG8_BAR
#undef PG8_SCHED
#undef PG8_ROWOFF
}
}

namespace att {
constexpr float SCALE = 0.08838834764831845f;
constexpr int NW = 8, QBLK = 32, KVBLK = 64, QB = NW * QBLK, D = 128;
constexpr int SHM_V = KVBLK * D * 2, SHM_K = KVBLK * D * 2;
constexpr int LDS_BYTES = 2 * SHM_V + 2 * SHM_K + NW * 64 * 4;
constexpr float THR = 8.f;
#define KSWZ(row, colB) ((row) * 256 + ((colB) ^ (((row) & 7) << 4)))
#define SBAR() __builtin_amdgcn_sched_barrier(0)
__device__ __forceinline__ int v_st(int k, int c) { const int kk = (k & ~0xC) | ((k & 4) << 1) | ((k & 8) >> 1); return ((kk >> 3) * 4 + (c >> 5)) * 512 + ((kk & 7) * 32 + (c & 31)) * 2; }
__device__ __forceinline__ int v_rd_base(int lane) { return ((lane & 3) << 3) | (((lane >> 2) & 3) << 6) | (((lane >> 4) & 1) << 5) | (((lane >> 5) & 1) << 8); }
constexpr int v_rd_off(int d0, int ks, int half) { return d0 * 512 + ks * 4096 + half * 2048; }
__device__ __forceinline__ int crow(int r, int hi) { return (r & 3) + 8 * (r >> 2) + 4 * hi; }
__device__ __forceinline__ unsigned cvtpk(float lo, float hi) { return cvt_pk_bf16(lo, hi); }
__device__ __forceinline__ bf16x8 load8(const bf16* p) { return *reinterpret_cast<const bf16x8*>(p); }
template <bool F8> __device__ __forceinline__ u32x4 load_raw(const bf16* base, size_t eoff) {
    if constexpr (F8) { const u32x2 w = *reinterpret_cast<const u32x2*>(reinterpret_cast<const unsigned char*>(base) + eoff); return (u32x4){w.x, w.y, 0u, 0u}; }
    else return *reinterpret_cast<const u32x4*>(base + eoff); }
template <bool F8> __device__ __forceinline__ bf16x8 cvt_in(const u32x4& raw) {
    if constexpr (F8) { const f32x2 a = __builtin_amdgcn_cvt_pk_f32_fp8((int)raw.x, false), b = __builtin_amdgcn_cvt_pk_f32_fp8((int)raw.x, true), c = __builtin_amdgcn_cvt_pk_f32_fp8((int)raw.y, false), d = __builtin_amdgcn_cvt_pk_f32_fp8((int)raw.y, true);
        const u32x4 w = {cvt_pk_bf16(a.x, a.y), cvt_pk_bf16(b.x, b.y), cvt_pk_bf16(c.x, c.y), cvt_pk_bf16(d.x, d.y)}; return *reinterpret_cast<const bf16x8*>(&w); }
    else return *reinterpret_cast<const bf16x8*>(&raw); }
__device__ __forceinline__ void mask_tile(f32x16& p0, f32x16& p1, int dq, unsigned W) {
    const float NEG = -__builtin_inff();
#pragma unroll
    for (int r = 0; r < 16; ++r) {
        const int c = (r & 3) + 8 * (r >> 2);
        if ((unsigned)(dq - c) >= W) p0[r] = NEG;
        if ((unsigned)(dq - c - 32) >= W) p1[r] = NEG;
    }
}
__device__ __forceinline__ void partialSM(f32x16& p0, f32x16& p1, float& m_reg, float& mn, float& alpha) {
    float pmax = p0[0]; for (int r = 1; r < 16; ++r) pmax = fmaxf(pmax, p0[r]); for (int r = 0; r < 16; ++r) pmax = fmaxf(pmax, p1[r]);
    { auto rr = __builtin_amdgcn_permlane32_swap(__float_as_uint(pmax), __float_as_uint(pmax), false, false);
      pmax = fmaxf(__uint_as_float(rr[0]), __uint_as_float(rr[1])); }
    constexpr float C2 = 1.4426950408889634f * SCALE;
    if (__builtin_expect(__all((pmax - m_reg) * SCALE <= THR), 1)) { mn = m_reg; alpha = 1.f; }
    else { mn = fmaxf(m_reg, pmax); alpha = __builtin_amdgcn_exp2f((m_reg - mn) * C2); m_reg = mn; }
    const float mnL = -mn * C2;
    for (int r = 0; r < 16; ++r) p0[r] = fmaf(p0[r], C2, mnL); for (int r = 0; r < 16; ++r) p1[r] = fmaf(p1[r], C2, mnL);
    for (int r = 0; r < 16; ++r) p0[r] = __builtin_amdgcn_exp2f(p0[r]);
}
__device__ __forceinline__ void finishSM(f32x16& p0, f32x16& p1, float alpha, float& l_reg, bf16x8& pa0, bf16x8& pa1, bf16x8& pa2, bf16x8& pa3) {
    for (int r = 0; r < 16; ++r) p1[r] = __builtin_amdgcn_exp2f(p1[r]);
    float ps = 0; for (int r = 0; r < 16; ++r) ps += p0[r]; for (int r = 0; r < 16; ++r) ps += p1[r];
    { auto rr = __builtin_amdgcn_permlane32_swap(__float_as_uint(ps), __float_as_uint(ps), false, false);
      ps = __uint_as_float(rr[0]) + __uint_as_float(rr[1]); }
    l_reg = l_reg * alpha + ps;
#define PK4(P, B_, OUT) do { unsigned a0 = cvtpk(P[B_+0], P[B_+1]), a1 = cvtpk(P[B_+2], P[B_+3]);                          \
        unsigned b0 = cvtpk(P[B_+4], P[B_+5]), b1 = cvtpk(P[B_+6], P[B_+7]);                                             \
        auto r0 = __builtin_amdgcn_permlane32_swap(a0, b0, false, false); auto r1 = __builtin_amdgcn_permlane32_swap(a1, b1, false, false); \
        u32x4 w = {r0[0], r1[0], r0[1], r1[1]}; OUT = *reinterpret_cast<bf16x8*>(&w); } while (0)
    PK4(p0, 0, pa0); PK4(p0, 8, pa1); PK4(p1, 0, pa2); PK4(p1, 8, pa3);
#undef PK4
}
template <int KB, bool SK>
__device__ __forceinline__ void qkt(f32x16& p0, f32x16& p1, const char* K_lds, int r32, int hi, const bf16x8* qr, bool act) {
    if (SK && !act) { const float NEG = -__builtin_inff();
#pragma unroll
        for (int r = 0; r < 16; ++r) { p0[r] = NEG; p1[r] = NEG; } return; }
    p0 = f32x16{}; p1 = f32x16{};
    const char* kb[4];
#pragma unroll
    for (int dd = 0; dd < 4; ++dd) kb[dd] = K_lds + KB * SHM_K + KSWZ(r32, (dd * 16 + hi * 8) * 2);
#pragma unroll
    for (int d0 = 0; d0 < 8; ++d0) { const char* a = kb[d0 & 3] + (d0 >> 2) * 128;
        bf16x8 b0 = *reinterpret_cast<const bf16x8*>(a);
        bf16x8 b1 = *reinterpret_cast<const bf16x8*>(a + 32 * 256);
        p0 = __builtin_amdgcn_mfma_f32_32x32x16_bf16(b0, qr[d0], p0, 0, 0, 0);
        p1 = __builtin_amdgcn_mfma_f32_32x32x16_bf16(b1, qr[d0], p1, 0, 0, 0); }
}
template <int VB, bool SK>
__device__ __forceinline__ void pv_tile(f32x16* o, int vb0, bf16x8 pa0, bf16x8 pa1, bf16x8 pa2, bf16x8 pa3, bool act) {
    if (SK && !act) return;
#define TRRD(dst, off) asm volatile("ds_read_b64_tr_b16 %0, %1 offset:%2" : "=&v"(dst) : "v"(vb0), "i"(off) : "memory")
#define PV_D0(d0) do { s16x4 l0, l1, l2, l3, h0, h1, h2, h3; constexpr int b_ = VB * SHM_V + v_rd_off(d0, 0, 0); \
        TRRD(l0, b_); TRRD(h0, b_ + 2048); TRRD(l1, b_ + 4096); TRRD(h1, b_ + 6144); TRRD(l2, b_ + 8192); TRRD(h2, b_ + 10240); TRRD(l3, b_ + 12288); TRRD(h3, b_ + 14336); \
        asm volatile("s_waitcnt lgkmcnt(0)" ::: "memory"); SBAR();   \
        o[d0] = __builtin_amdgcn_mfma_f32_32x32x16_bf16(pa0, (bf16x8){l0[0], l0[1], l0[2], l0[3], h0[0], h0[1], h0[2], h0[3]}, o[d0], 0, 0, 0);   \
        o[d0] = __builtin_amdgcn_mfma_f32_32x32x16_bf16(pa1, (bf16x8){l1[0], l1[1], l1[2], l1[3], h1[0], h1[1], h1[2], h1[3]}, o[d0], 0, 0, 0);   \
        o[d0] = __builtin_amdgcn_mfma_f32_32x32x16_bf16(pa2, (bf16x8){l2[0], l2[1], l2[2], l2[3], h2[0], h2[1], h2[2], h2[3]}, o[d0], 0, 0, 0);   \
        o[d0] = __builtin_amdgcn_mfma_f32_32x32x16_bf16(pa3, (bf16x8){l3[0], l3[1], l3[2], l3[3], h3[0], h3[1], h3[2], h3[3]}, o[d0], 0, 0, 0); } while (0)
    PV_D0(0); PV_D0(1); PV_D0(2); PV_D0(3);
#undef PV_D0
#undef TRRD
}
struct BlockRef { bf16* Q; const bf16* K; float* L; bf16* O; int P0, qs, ks, ls, skv, os; };
struct Seam { u32x4 qraw[8]; u32x4 st_v0, st_v1, st_k0, st_k1; };
__device__ __forceinline__ int swa_jlo(int P0, int W) { const int lowk = P0 - W + 1; return lowk > 0 ? lowk / KVBLK : 0; }
#define ROW(KS_, k0, rr) ((size_t)((k0) + (rr)) * (KS_) + sc)
#define VMW() asm volatile("s_waitcnt vmcnt(0)" ::: "memory")
#define VMWN(n) asm volatile("s_waitcnt vmcnt(%0)" :: "i"(n) : "memory")
#define SLOAD_H(Kp, KS_, k0) do { S.st_v0 = load_raw<F8>(Kp, VOFF + ROW(KS_, k0, sr)); S.st_v1 = load_raw<F8>(Kp, VOFF + ROW(KS_, k0, 32 + sr));              \
                         S.st_k0 = load_raw<F8>(Kp, ROW(KS_, k0, sr)); S.st_k1 = load_raw<F8>(Kp, ROW(KS_, k0, 32 + sr)); } while (0)
#define SWRITE_HK(bf) do { *(bf16x8*)(K_lds + (bf) * SHM_K + kws) = cvt_in<F8>(S.st_k0); *(bf16x8*)(K_lds + (bf) * SHM_K + kws + 32 * 256) = cvt_in<F8>(S.st_k1); } while (0)
#define SWRITE_HV(bf) do { *(bf16x8*)(V_lds + (bf) * SHM_V + vst0) = cvt_in<F8>(S.st_v0); *(bf16x8*)(V_lds + (bf) * SHM_V + vst1) = cvt_in<F8>(S.st_v1); } while (0)
#define SWRITE_H(bf) do { SWRITE_HV(bf); SWRITE_HK(bf); } while (0)
template <long VOFF, bool F8>
__device__ __forceinline__ void prime(const BlockRef& cur, int W, char* lds, Seam& S) {
    const int tid = threadIdx.x, wid = __builtin_amdgcn_readfirstlane(tid >> 6), lane = tid & 63, r32 = lane & 31, hi = lane >> 5;
    const int sr = tid >> 4, sc = (tid & 15) * 8, kws = KSWZ(sr, sc * 2); char* K_lds = lds + 2 * SHM_V;
    const int kb0 = swa_jlo(cur.P0, W) * KVBLK;
    for (int d0 = 0; d0 < 8; ++d0) S.qraw[d0] = load_raw<F8>(cur.Q, (size_t)(wid * QBLK + r32) * cur.qs + d0 * 16 + hi * 8);
    SLOAD_H(cur.K, cur.ks, kb0); VMW(); SWRITE_HK(0);
    __syncthreads();
}
template <bool SK, long VOFF, bool F8>
__device__ __forceinline__ void block(const BlockRef& cur, const BlockRef& nxt, int W, char* lds, Seam& S) {
    const int tid = threadIdx.x, wid = __builtin_amdgcn_readfirstlane(tid >> 6), lane = tid & 63, r32 = lane & 31, hi = lane >> 5;
    const int skv = cur.skv;
    const int j_lo = swa_jlo(cur.P0, W);
    int j_hi = (cur.P0 + QB - 1) / KVBLK + 1; if (j_hi > skv / KVBLK) j_hi = skv / KVBLK;
    const int NT = j_hi - j_lo;
    const int kbn = swa_jlo(nxt.P0, W) * KVBLK;
    const int qlo = cur.P0 + wid * QBLK, qm = qlo + r32 - 4 * hi;
    char* V_lds = lds; char* K_lds = lds + 2 * SHM_V;
    float* ws = (float*)(lds + 2 * SHM_V + 2 * SHM_K) + wid * 64; float* li_l = ws, * al_l = ws + 32;
    float m_reg = -1e30f, l_reg = 0; f32x16 o[4] = {};
    const int sr = tid >> 4, sc = (tid & 15) * 8, vst0 = v_st(sr, sc), vst1 = v_st(32 + sr, sc), kws = KSWZ(sr, sc * 2);
    const int vb0 = (int)(uintptr_t)V_lds + v_rd_base(lane);
    const bf16* Kh = cur.K; const int KS = cur.ks;
    bf16x8 qr[8];
#pragma unroll
    for (int d0 = 0; d0 < 8; ++d0) qr[d0] = cvt_in<F8>(S.qraw[d0]);
#define RESC(a) do { if (__any((a) < 1.f)) { if (hi == 0) al_l[r32] = (a); asm volatile("s_waitcnt lgkmcnt(0)" ::: "memory");              \
                     for (int d_ = 0; d_ < 4; ++d_) for (int r = 0; r < 16; ++r) o[d_][r] *= al_l[crow(r, hi)]; } } while (0)
#define KBASE(t) ((j_lo + (t)) * KVBLK)
#define ACT(t) (KBASE(t) <= qlo + QBLK - 1 && KBASE(t) + KVBLK - 1 >= qlo - W + 1)
#define MASKT(P0_, P1_, t) do { const int kb_ = KBASE(t); if ((!SK || ACT(t)) && (kb_ + KVBLK - 1 > qlo || kb_ <= qlo + QBLK - 1 - W)) mask_tile(P0_, P1_, qm - kb_, (unsigned)W); } while (0)
    constexpr int NQL = 8;
#define SEAM_K0() do { VMWN(NQL); SWRITE_HK(0); SBAR(); } while (0)
    f32x16 pA0, pA1, pB0, pB1; float mnA, mnB, alA, alB; bf16x8 pa0, pa1, pa2, pa3;
    SWRITE_HV(0); SBAR();
    if (NT > 1) { SLOAD_H(Kh, KS, KBASE(1)); }
    SBAR(); qkt<0, SK>(pA0, pA1, K_lds, r32, hi, qr, ACT(0));
    MASKT(pA0, pA1, 0); partialSM(pA0, pA1, m_reg, mnA, alA);
    if (NT > 1) { VMW(); SWRITE_H(1); }
    __syncthreads();
#define HALF_STEP(PX0, PX1, mnX, alX, PY0, PY1, alY, t, KB, VB, SB) do {                                                      \
        SBAR(); qkt<KB, SK>(PX0, PX1, K_lds, r32, hi, qr, ACT(t));                                             \
        finishSM(PY0, PY1, alY, l_reg, pa0, pa1, pa2, pa3); SBAR();                                                           \
        if ((t) + 1 < NT) { SLOAD_H(Kh, KS, KBASE((t) + 1)); SBAR(); }                                               \
        pv_tile<VB, SK>(o, vb0, pa0, pa1, pa2, pa3, ACT((t) - 1)); MASKT(PX0, PX1, (t)); partialSM(PX0, PX1, m_reg, mnX, alX);                                        \
        __syncthreads();                                                                                                      \
        if ((t) + 1 < NT) { VMW(); SWRITE_H(SB); }                                                                          \
        RESC(alX); __syncthreads(); } while (0)
    for (int t = 1; t + 1 < NT; t += 2) {
        HALF_STEP(pB0, pB1, mnB, alB, pA0, pA1, alA, t, 1, 0, 0);
        HALF_STEP(pA0, pA1, mnA, alA, pB0, pB1, alB, t + 1, 0, 1, 1);
    }
    const bool even = (NT & 1) == 0;
    if (even) { SBAR(); qkt<1, SK>(pB0, pB1, K_lds, r32, hi, qr, ACT(NT - 1)); SBAR(); }
    { SLOAD_H(nxt.K, nxt.ks, kbn); SBAR();
#pragma unroll
      for (int d0 = 0; d0 < 8; ++d0) S.qraw[d0] = load_raw<F8>(nxt.Q, (size_t)(wid * QBLK + r32) * nxt.qs + d0 * 16 + hi * 8); }
    SBAR();
    finishSM(pA0, pA1, alA, l_reg, pa0, pa1, pa2, pa3); SBAR();
    pv_tile<0, SK>(o, vb0, pa0, pa1, pa2, pa3, ACT(even ? NT - 2 : NT - 1));
    if (even) { MASKT(pB0, pB1, NT - 1); partialSM(pB0, pB1, m_reg, mnB, alB); __syncthreads(); RESC(alB);
        finishSM(pB0, pB1, alB, l_reg, pa0, pa1, pa2, pa3); SBAR(); pv_tile<1, SK>(o, vb0, pa0, pa1, pa2, pa3, ACT(NT - 1)); }
    SBAR(); SEAM_K0();
    if (hi == 0) li_l[r32] = l_reg; asm volatile("s_waitcnt lgkmcnt(0)" ::: "memory");
    if (cur.L != nullptr && hi == 0) cur.L[(size_t)(wid * QBLK + r32) * cur.ls] = m_reg * SCALE + __logf(l_reg);
    float rli[16];
#pragma unroll
    for (int r = 0; r < 16; ++r) rli[r] = __builtin_amdgcn_rcpf(li_l[crow(r, hi)]);
    bf16* Op = cur.O + (size_t)(wid * QBLK + 4 * hi) * cur.os + r32; const size_t qstep = (size_t)cur.os;
#pragma unroll
    for (int r = 0; r < 16; ++r) {
        asm volatile("" : "+v"(Op));
#pragma unroll
        for (int d0 = 0; d0 < 4; ++d0) { const float v = o[d0][r] * rli[r];
            const float vn = __shfl_xor(v, 1);
            if ((r32 & 1) == 0) *(unsigned*)(Op + d0 * 32) = cvtpk(v, vn); }
        Op += ((r & 3) == 3) ? 5 * qstep : qstep; }
    __syncthreads();
#undef RESC
#undef KBASE
#undef ACT
#undef MASKT
#undef SEAM_K0
#undef HALF_STEP
}
#undef ROW
#undef VMW
#undef VMWN
#undef SLOAD_H
#undef SWRITE_HK
#undef SWRITE_HV
#undef SWRITE_H
#undef KSWZ
}

constexpr int NWAVES = 8, NTHR = 512;
constexpr int M = 65536, DM = 1024, SEQ = 8192, NBATCH = 8;
constexpr int N1 = 6144;
constexpr int ROPE_POS = 9216;
constexpr float EPS = 1e-5f;
constexpr int NEXP = 32, HALF_TOK = 32768, RT_CAP = 139264;
constexpr int MAXBLK = 544;
constexpr int NPH = 19;
#ifndef MK_REPS
#define MK_REPS 1
#endif
#ifndef MK_PROBE
#define MK_PROBE 0
#define PROBE_A 0
#define PROBE_K 1
#endif
#ifndef MK_DIAG
#define MK_DIAG 0
#endif
#ifndef MK_PER_PHASE
#define MK_PER_PHASE 0
#endif

constexpr size_t MiB = 1u << 20;
constexpr size_t WS_CTL = 0, CTL_ZERO_BYTES = 1 * MiB;
constexpr size_t WS_WIN = 1 * MiB, WS_WGATE = 14 * MiB, WS_WBG = 18 * MiB, WS_WBD = 19 * MiB, WS_WMIX = 20 * MiB, WS_WXQ = 22 * MiB, WS_WXKV = 23 * MiB, WS_WXO = 25 * MiB, WS_WR = 26 * MiB;
constexpr size_t WS_ROPE = 27 * MiB, WS_MEMN = 32 * MiB, WS_KVM = 36 * MiB, WS_DECAY = 40 * MiB;
constexpr size_t WS_TOPE = 41 * MiB, WS_TGATE = 42 * MiB, WS_TSLOT = 43 * MiB, WS_RTOK = 44 * MiB, WS_RGATE = 46 * MiB;
constexpr size_t WS_RRS = 47 * MiB + 512 * 1024, WS_RSTD3 = 48 * MiB + 768 * 1024;
constexpr size_t WS_A = 49 * MiB;
constexpr size_t WS_QG = 177 * MiB, WS_KG = 209 * MiB, WS_VG = 241 * MiB, WS_RG = 305 * MiB, WS_ALR = 369 * MiB, WS_LSE = 373 * MiB;
constexpr size_t WS_QD = 376 * MiB, WS_KD = 568 * MiB, WS_VD = 760 * MiB, WS_A8 = 952 * MiB, WS_WIN8 = 1016 * MiB, WS_END = 1021 * MiB;
constexpr size_t WS_Q8 = 568 * MiB, WS_K8 = 664 * MiB, WS_V8 = 760 * MiB;
constexpr size_t WS_GATES = WS_KD, WS_MERGED = 824 * MiB;
constexpr size_t WS_QX = WS_QD;
constexpr size_t WS_WGU = 177 * MiB, WS_WDN = 337 * MiB, WS_H2F8 = 273 * MiB;
constexpr float W8_SCALE = 64.f, W8_INV = 1.f / 64.f, A8_SCALE = 16.f, A8_INV = 1.f / 16.f;
constexpr size_t WS_H = 376 * MiB, WS_H1 = 512 * MiB, WS_Y = 648 * MiB, WS_Y1 = 177 * MiB;
static_assert(WS_RGATE + 2 * (size_t)RT_CAP * 4 <= WS_RRS && WS_RRS + 2 * (size_t)RT_CAP * 4 <= WS_RSTD3 && WS_RSTD3 + (size_t)M * 4 <= WS_A, "ws map (row tables)");
static_assert(WS_Y + (size_t)RT_CAP * 1024 <= WS_A8 && WS_H2F8 + 64 * MiB <= WS_WDN && WS_WDN + 32 * MiB <= WS_ALR && WS_H + (size_t)RT_CAP * 1024 <= WS_H1 && WS_H1 + (size_t)RT_CAP * 1024 <= WS_Y && WS_Y1 + (size_t)RT_CAP * 1024 <= WS_WDN && WS_RTOK + 2 * (size_t)RT_CAP * 4 <= WS_RGATE && WS_RGATE + 2 * (size_t)RT_CAP * 4 <= WS_A, "ws map");
constexpr size_t DO_OGD = 0, DO_ST = 128 * MiB;
constexpr int CW_BAR = 4096, CW_CNT = 8192, CW_CUR = 8320;
constexpr int RING_BYTES = 131072, MISC_OFF = RING_BYTES, TAB_OFF = RING_BYTES + 1024, LDS_BYTES = 147456;

#define XB_TMO      128
#define XB_XCNT(j)  (256  + 64 * (j))
#define XB_XSUB(j)  (1280 + 64 * (j))
#define XB_XGEN(j)  (2304 + 64 * (j))
#define XB_TOP      3328
#define XB_TOPGEN   3392
#define XCD_BAR_WORDS 3456
#define XB_SPIN_CAP (1u << 18)
__device__ __forceinline__ unsigned xb_ld(unsigned* p)              { return __hip_atomic_load(p, __ATOMIC_RELAXED, __HIP_MEMORY_SCOPE_AGENT); }
__device__ __forceinline__ unsigned xb_add(unsigned* p, unsigned v) { return __hip_atomic_fetch_add(p, v, __ATOMIC_RELAXED, __HIP_MEMORY_SCOPE_AGENT); }
__device__ __forceinline__ unsigned xb_xcc_id() { return (unsigned)__builtin_amdgcn_s_getreg((3 << 11) | 20) & 0xFu; }
#define XB_SPIN(cond, bar) do { unsigned _sp = 0; while (cond) { __builtin_amdgcn_s_sleep(1); \
    if ((++_sp & 255u) == 0u) { if (xb_ld(&(bar)[XB_TMO])) break; if (_sp > XB_SPIN_CAP) { atomicAdd(&(bar)[XB_TMO], 1u); break; } } } } while (0)
struct XcdBarrier { unsigned* bar; unsigned x; volatile LAS unsigned* st; };
__device__ __forceinline__ XcdBarrier xcd_barrier_post(unsigned* bar, volatile LAS unsigned* st) {
    XcdBarrier b; b.bar = bar; b.x = xb_xcc_id(); b.st = st;
    if (threadIdx.x == 0) (void)xb_add(&bar[XB_XCNT(b.x)], 1u);
    return b;
}
__device__ __forceinline__ void xcd_barrier_complete(unsigned* bar, unsigned x, unsigned& nloc, unsigned& nx) {
    const unsigned G = gridDim.x * gridDim.y * gridDim.z;
    unsigned sum, cnt, mine, sp = 0u;
    for (;;) {
        sum = 0u; cnt = 0u; mine = 0u;
#pragma unroll
        for (unsigned j = 0; j < 16; ++j) { const unsigned c = xb_ld(&bar[XB_XCNT(j)]); sum += c; cnt += (c > 0u) ? 1u : 0u; mine = (j == x) ? c : mine; }
        if (sum == G) break;
        __builtin_amdgcn_s_sleep(1);
        if ((++sp & 255u) == 0u) { if (xb_ld(&bar[XB_TMO])) break; if (sp > XB_SPIN_CAP) { atomicAdd(&bar[XB_TMO], 1u); break; } }
    }
    nloc = mine > 0u ? mine : 1u; nx = cnt > 0u ? cnt : 1u;
}
__device__ __forceinline__ void xcd_barrier(const XcdBarrier& b) {
    asm volatile("s_waitcnt vmcnt(0)" ::: "memory");
    __syncthreads();
    if (threadIdx.x == 0) {
        unsigned* bar = b.bar;
        __builtin_amdgcn_s_waitcnt(0);
        unsigned nloc = b.st[0], nx = b.st[1];
        if (nloc == 0u) { xcd_barrier_complete(bar, b.x, nloc, nx); b.st[0] = nloc; b.st[1] = nx; }
        const unsigned old = xb_add(&bar[XB_XSUB(b.x)], 1u);
        const unsigned gen = old / nloc;
        if (old + 1u == (gen + 1u) * nloc) {
            __builtin_amdgcn_fence(__ATOMIC_RELEASE, "agent");
            asm volatile("s_waitcnt vmcnt(0)" ::: "memory");
            const unsigned og = xb_add(&bar[XB_TOP], 1u);
            const unsigned tg = og / nx;
            if (og + 1u == (tg + 1u) * nx) xb_add(&bar[XB_TOPGEN], 1u);
            else XB_SPIN(xb_ld(&bar[XB_TOPGEN]) == tg, bar);
            __builtin_amdgcn_fence(__ATOMIC_ACQUIRE, "agent");
            xb_add(&bar[XB_XGEN(b.x)], 1u);
            asm volatile("s_waitcnt vmcnt(0)" ::: "memory");
        } else {
            XB_SPIN(xb_ld(&bar[XB_XGEN(b.x)]) == gen, bar);
            __builtin_amdgcn_fence(__ATOMIC_ACQUIRE, "agent");
            asm volatile("s_waitcnt vmcnt(0)" ::: "memory");
        }
    }
    __syncthreads();
}

struct Frame {
    LAS unsigned char* lds; char* ldsg;
    unsigned* ctl; unsigned char* ws; unsigned char* dout;
    int tid, lane, wave, G, bid;
};
struct Args { const void* in[28]; float* out; unsigned char* ws; int ph_lo, ph_hi; };
#define INP(k) ((const float*)A.in[k])
#define LDS_WAIT() asm volatile("s_waitcnt lgkmcnt(0)" ::: "memory")
__device__ __forceinline__ float wave_sum(float v) {
#pragma unroll
    for (int o = 1; o < 64; o <<= 1) v += __shfl_xor(v, o);
    return v;
}
template <class RM, bool F8 = false>
__device__ __forceinline__ void transpose_item(const float* W, int K, int N, bf16* WT, const RM& rm, LAS float* scr, int item, int lane, const float* kgain = nullptr, int dpitch = 0, int doff = 0, int ncount = 0) {
    const int NC = ncount ? ncount : N;
    const int nblk = (NC + 31) / 32, kb = item / nblk, nb = item % nblk, k0 = 64 * kb, n0 = 32 * nb;
    const int ncol = n0 + (lane & 31);
    float tv[32];
    { const float* wp = W + (size_t)(k0 + (lane >> 5)) * N + (ncol < NC ? ncol : 0);
#pragma unroll
      for (int i = 0; i < 32; ++i) tv[i] = wp[(size_t)(2 * i) * N]; }
#pragma unroll
    for (int i = 0; i < 32; ++i) { const int kk = 2 * i + (lane >> 5); scr[kk * 33 + (lane & 31)] = ncol < NC ? (kgain ? tv[i] * kgain[k0 + kk] : tv[i]) : 0.f; }
    LDS_WAIT(); asm volatile("" ::: "memory");
    const int c = lane & 7;
#pragma unroll
    for (int j = 0; j < 4; ++j) { const int n = (lane >> 3) + 8 * j; const LAS float* s = scr + (8 * c) * 33 + n;
        const int dr = (n0 + n < NC) ? rm(n0 + n) : -1;
        if constexpr (F8) { const f32x4 a = {s[0 * 33] * W8_SCALE, s[1 * 33] * W8_SCALE, s[2 * 33] * W8_SCALE, s[3 * 33] * W8_SCALE}, b = {s[4 * 33] * W8_SCALE, s[5 * 33] * W8_SCALE, s[6 * 33] * W8_SCALE, s[7 * 33] * W8_SCALE};
            if (dr >= 0) *(u32x2*)((unsigned char*)WT + (size_t)dr * (dpitch ? dpitch : K) + doff + k0 + 8 * c) = pack8_fp8(a, b); }
        else { u32x4 o; o.x = cvt_pk_bf16(s[0 * 33], s[1 * 33]); o.y = cvt_pk_bf16(s[2 * 33], s[3 * 33]); o.z = cvt_pk_bf16(s[4 * 33], s[5 * 33]); o.w = cvt_pk_bf16(s[6 * 33], s[7 * 33]);
            if (dr >= 0) *(u32x4*)(WT + (size_t)dr * (dpitch ? dpitch : K) + doff + k0 + 8 * c) = o; } }
    LDS_WAIT(); asm volatile("" ::: "memory");
}
struct RmId { int off; __device__ int operator()(int n) const { return off + n; } };
struct RmWin { __device__ int operator()(int n) const {
    if (n < 1536) return n;
    if (n < 1552) return -1;
    if (n < 4624) { const int j = n - 1552, seg = j / 1536, jj = j % 1536, hd = jj >> 7, i = jj & 127; return 1536 + seg * 1536 + hd * 128 + ((i < 64) ? 2 * i : 2 * (i - 64) + 1); }
    return 4608 + (n - 4624); } };
struct RmWin8 { __device__ int operator()(int j) const { if (j >= 3072) return j; const int seg = j / 1536, jj = j % 1536, hd = jj >> 7, i = jj & 127; return seg * 1536 + hd * 128 + ((i < 64) ? 2 * i : 2 * (i - 64) + 1); } };
struct RmGate { __device__ int operator()(int n) const { return ((n & 1023) >> 7) * 256 + (n >> 10) * 128 + (n & 127); } };
struct RmGU { int base; __device__ int operator()(int n) const { return base + (n >> 7) * 256 + (n & 127); } };

template <int NR>
__device__ __forceinline__ void rms_rows_to_bf16(const float* xrow, const float* g, bf16* orow, int lane, unsigned char* orow8 = nullptr) {
    f32x4 v[NR][4];
#pragma unroll
    for (int r = 0; r < NR; ++r) { const f32x4* xr = (const f32x4*)(xrow + (size_t)r * DM) + lane;
#pragma unroll
        for (int j = 0; j < 4; ++j) v[r][j] = xr[64 * j]; }
    const f32x4* gr = (const f32x4*)g + lane; f32x4 gg[4];
#pragma unroll
    for (int j = 0; j < 4; ++j) gg[j] = gr[64 * j];
#pragma unroll
    for (int r = 0; r < NR; ++r) { float s = 0.f;
#pragma unroll
        for (int j = 0; j < 4; ++j) s += (v[r][j].x * v[r][j].x + v[r][j].y * v[r][j].y) + (v[r][j].z * v[r][j].z + v[r][j].w * v[r][j].w);
        const float rstd = 1.f / sqrtf(wave_sum(s) * (1.f / DM) + EPS);
        u32x2* o8 = (u32x2*)(orow + (size_t)r * DM) + lane;
#pragma unroll
        for (int j = 0; j < 4; ++j) { const float y0 = v[r][j].x * rstd * gg[j].x, y1 = v[r][j].y * rstd * gg[j].y, y2 = v[r][j].z * rstd * gg[j].z, y3 = v[r][j].w * rstd * gg[j].w;
            u32x2 w; w.x = cvt_pk_bf16(y0, y1); w.y = cvt_pk_bf16(y2, y3); o8[64 * j] = w;
            if (orow8) { unsigned q = 0; q = __builtin_amdgcn_cvt_pk_fp8_f32(y0, y1, q, false); q = __builtin_amdgcn_cvt_pk_fp8_f32(y2, y3, q, true); ((unsigned*)(orow8 + (size_t)r * DM))[lane + 64 * j] = q; } } }
}

__device__ __forceinline__ void p0_prologue(Frame& F, const Args& A) {
    LAS float* scr = (LAS float*)(F.lds + F.wave * 8448);
    LAS unsigned char* l_wa = F.lds + 69632;
    const int gw = F.bid * NWAVES + F.wave, NGW = F.G * NWAVES;
    unsigned char* ws = F.ws;
    { const float* win = INP(4);
      for (int i = F.tid; i < 16 * 1024; i += NTHR) { const int k = i >> 4, j = i & 15; *(LAS bf16*)(l_wa + j * 2048 + ((((k >> 3) ^ j) << 4) | ((k & 7) << 1))) = (bf16)f2bf(win[(size_t)k * 6160 + 1536 + j]); } }
    __syncthreads();
    constexpr int I_IN = 16 * 48, I_IN8 = 16 * 144, I_GATE = 16 * 64, I_BG = 8 * 32, I_MIX = 16 * 32, I_XQ = 16 * 16, I_XKV = 16 * 32, I_XO = 8 * 32;
    constexpr int NIT = I_IN + I_IN8 + I_GATE + 2 * I_BG + I_MIX + I_XQ + I_XKV + I_XO;
    for (int it = gw; it < NIT; it += NGW) {
        int r = it;
        if (r < I_IN) { transpose_item(INP(4), 1024, 6160, (bf16*)(ws + WS_WIN), RmId{0}, scr, r, F.lane, nullptr, 0, 0, 1536); continue; } r -= I_IN;
        if (r < I_IN8) { transpose_item<RmWin8, true>(INP(4) + 1552, 1024, 6160, (bf16*)(ws + WS_WIN8), RmWin8{}, scr, r, F.lane, nullptr, 0, 0, 4608); continue; } r -= I_IN8;
        if (r < I_GATE) { transpose_item<RmGate, true>(INP(10), 1024, 2048, (bf16*)(ws + WS_WGATE), RmGate{}, scr, r, F.lane); continue; } r -= I_GATE;
        if (r < I_BG) { transpose_item(INP(8), 512, 1024, (bf16*)(ws + WS_WBG), RmId{0}, scr, r, F.lane, nullptr, 1024, 0); continue; } r -= I_BG;
        if (r < I_BG) { transpose_item(INP(9), 512, 1024, (bf16*)(ws + WS_WBG), RmId{0}, scr, r, F.lane, nullptr, 1024, 512); continue; } r -= I_BG;
        if (r < I_MIX) { transpose_item(INP(12), 1024, 1024, (bf16*)(ws + WS_WMIX), RmId{0}, scr, r, F.lane); continue; } r -= I_MIX;
        if (r < I_XQ) { transpose_item<RmId, true>(INP(15), 1024, 512, (bf16*)(ws + WS_WXQ), RmId{0}, scr, r, F.lane, INP(13)); continue; } r -= I_XQ;
        if (r < I_XKV) { transpose_item(INP(16), 1024, 1024, (bf16*)(ws + WS_WXKV), RmId{0}, scr, r, F.lane); continue; } r -= I_XKV;
        transpose_item(INP(17), 512, 1024, (bf16*)(ws + WS_WXO), RmId{0}, scr, r, F.lane);
    }
    const int gt = F.bid * NTHR + F.tid, NGT = F.G * NTHR;
    { bf16* wr = (bf16*)(ws + WS_WR); const float* w = INP(19); const float* g3 = INP(18);
      for (int i = gt; i < NEXP * 1024; i += NGT) { const int e = i >> 10, k = i & 1023; wr[i] = (bf16)f2bf(g3[k] * w[k * NEXP + e]); } }
    { float* tab = (float*)(ws + WS_ROPE);
      for (int i = gt; i < ROPE_POS * 64; i += NGT) { const int pos = i >> 6, fi = i & 63;
          const float inv = (float)exp2(-(double)fi * (13.287712379549449 / 64.0));
          const float ang = (float)pos * inv;
          const double xr = (double)ang * 0.15915494309189535, fr_ = xr - rint(xr);
          const float xf = (float)fr_;
          tab[2 * i] = __builtin_amdgcn_cosf(xf); tab[2 * i + 1] = __builtin_amdgcn_sinf(xf); } }
    for (int m = gw; m < NBATCH * 256; m += NGW) rms_rows_to_bf16<1>(INP(1) + (size_t)m * DM, INP(14), (bf16*)(ws + WS_MEMN) + (size_t)m * DM, F.lane);
    { const int fr = F.lane & 15, fq = F.lane >> 4; float* alr = (float*)(ws + WS_ALR);
      for (int gidx = gw; gidx < M / 16; gidx += NGW) { const size_t row0 = (size_t)gidx * 16; bf16* arow = (bf16*)(ws + WS_A) + row0 * DM;
#pragma unroll
          for (int q = 0; q < 4; ++q) rms_rows_to_bf16<4>(INP(0) + (row0 + 4 * q) * DM, INP(3), arow + (size_t)(4 * q) * DM, F.lane, ws + WS_A8 + (row0 + 4 * q) * DM);
          asm volatile("s_waitcnt vmcnt(0)" ::: "memory");
          f32x4 c = {0.f, 0.f, 0.f, 0.f}; const bf16* ap = arow + (size_t)fr * DM + 8 * fq;
#pragma unroll 8
          for (int kk = 0; kk < 32; ++kk) { const bf16x8 af = *(const bf16x8*)(ap + 32 * kk); const int ch = 4 * kk + fq;
              const bf16x8 bfr = *(const LAS bf16x8*)(l_wa + fr * 2048 + ((ch ^ fr) << 4)); c = __builtin_amdgcn_mfma_f32_16x16x32_bf16(af, bfr, c, 0, 0, 0); }
#pragma unroll
          for (int r = 0; r < 4; ++r) alr[(row0 + 4 * fq + r) * 16 + fr] = c[r]; } }
}

#define EPI_ROWS(ai, m) (u.pm * 256 + wr * 64 + fr + (ai) * 128 + (m) * 16)
__device__ __forceinline__ u32x4 pack8f(const f32x4& a, const f32x4& b) { u32x4 w; w.x = cvt_pk_bf16(a[0], a[1]); w.y = cvt_pk_bf16(a[2], a[3]); w.z = cvt_pk_bf16(b[0], b[1]); w.w = cvt_pk_bf16(b[2], b[3]); return w; }
__device__ __forceinline__ void unpack8f(const u32x4& w, f32x4& a, f32x4& b) { a = (f32x4){bflo(w.x), bfhi(w.x), bflo(w.y), bfhi(w.y)}; b = (f32x4){bflo(w.z), bfhi(w.z), bflo(w.w), bfhi(w.w)}; }

struct EpiProj {
    static constexpr bool PERM = true, HAS_MID = false;
    unsigned char* ws; const int* pos; float asc;
    __device__ __forceinline__ void operator()(const f32x4 (&acc)[2][2][4][2], const pg8::Unit& u, int wr, int wc, int fr, int fq) const {
        const int pn = u.pn, cw = wc * 32 + 8 * fq;
        bf16* base; int ldc, coff; float sc = 1.f; bool rope = false;
        if (pn == 0) { base = (bf16*)(ws + WS_QG); ldc = 256; coff = 0; sc = 0.125f; }
        else if (pn == 1) { base = (bf16*)(ws + WS_KG); ldc = 256; coff = 0; }
        else if (pn < 4) { base = (bf16*)(ws + WS_VG); ldc = 512; coff = (pn - 2) * 256; }
        else if (pn < 6) { base = (bf16*)(ws + WS_RG); ldc = 512; coff = (pn - 4) * 256; }
        else if (pn < 12) { base = (bf16*)(ws + WS_Q8); ldc = 1536; coff = (pn - 6) * 256; rope = true; }
        else if (pn < 18) { base = (bf16*)(ws + WS_K8); ldc = 1536; coff = (pn - 12) * 256; rope = true; }
        else { base = (bf16*)(ws + WS_V8); ldc = 1536; coff = (pn - 18) * 256; }
        sc *= asc;
        const float* tab = (const float*)(ws + WS_ROPE);
        if (rope) {
#pragma unroll
            for (int ai = 0; ai < 2; ++ai) { int pp[4]; f32x4 cs[4][2];
#pragma unroll
                for (int m = 0; m < 4; ++m) pp[m] = pos[EPI_ROWS(ai, m)];
#pragma unroll
                for (int m = 0; m < 4; ++m) { int p = pp[m]; p = p < 0 ? 0 : (p >= ROPE_POS ? ROPE_POS - 1 : p); const float* tp = tab + ((size_t)p * 64 + 16 * wc + 4 * fq) * 2; cs[m][0] = *(const f32x4*)tp; cs[m][1] = *(const f32x4*)(tp + 4); }
#pragma unroll
                for (int m = 0; m < 4; ++m) { unsigned char* rowp = (unsigned char*)base + (size_t)EPI_ROWS(ai, m) * ldc + coff + cw; const f32x4 cs0 = cs[m][0], cs1 = cs[m][1];
#pragma unroll
                    for (int bj = 0; bj < 2; ++bj) { f32x4 v0 = acc[ai][bj][m][0] * asc, v1 = acc[ai][bj][m][1] * asc;
                        v0 = (f32x4){v0[0] * cs0[0] - v0[1] * cs0[1], v0[1] * cs0[0] + v0[0] * cs0[1], v0[2] * cs0[2] - v0[3] * cs0[3], v0[3] * cs0[2] + v0[2] * cs0[3]};
                        v1 = (f32x4){v1[0] * cs1[0] - v1[1] * cs1[1], v1[1] * cs1[0] + v1[0] * cs1[1], v1[2] * cs1[2] - v1[3] * cs1[3], v1[3] * cs1[2] + v1[2] * cs1[3]};
                        *(u32x2*)(rowp + bj * 128) = pack8_fp8(v0, v1); } }
                asm volatile("" ::: "memory"); }
            return;
        }
        if (pn >= 18) {
#pragma unroll
            for (int ai = 0; ai < 2; ++ai)
#pragma unroll
                for (int m = 0; m < 4; ++m) { unsigned char* rowp = (unsigned char*)base + (size_t)EPI_ROWS(ai, m) * ldc + coff + cw;
#pragma unroll
                    for (int bj = 0; bj < 2; ++bj) *(u32x2*)(rowp + bj * 128) = pack8_fp8(acc[ai][bj][m][0] * sc, acc[ai][bj][m][1] * sc); }
            return;
        }
#pragma unroll
        for (int ai = 0; ai < 2; ++ai)
#pragma unroll
            for (int m = 0; m < 4; ++m) { bf16* rowp = base + (size_t)EPI_ROWS(ai, m) * ldc + coff + cw;
#pragma unroll
                for (int bj = 0; bj < 2; ++bj) *(u32x4*)(rowp + bj * 128) = pack8f(acc[ai][bj][m][0] * sc, acc[ai][bj][m][1] * sc); }
    }
};
template <int ACT  > struct EpiBf16 {
    static constexpr bool PERM = true, HAS_MID = false;
    bf16* O; int ldc; const float* bias; float scale;
    __device__ __forceinline__ void operator()(const f32x4 (&acc)[2][2][4][2], const pg8::Unit& u, int wr, int wc, int fr, int fq) const {
        const int col0 = u.pn * 256 + wc * 32 + 8 * fq;
        f32x4 bv[2][2];
#pragma unroll
        for (int bj = 0; bj < 2; ++bj)
#pragma unroll
            for (int n = 0; n < 2; ++n) bv[bj][n] = bias ? *(const f32x4*)(bias + col0 + bj * 128 + 4 * n) : (f32x4){0.f, 0.f, 0.f, 0.f};
#pragma unroll
        for (int ai = 0; ai < 2; ++ai)
#pragma unroll
            for (int m = 0; m < 4; ++m) { bf16* rowp = O + (size_t)EPI_ROWS(ai, m) * ldc + col0;
#pragma unroll
                for (int bj = 0; bj < 2; ++bj) { f32x4 v0 = acc[ai][bj][m][0] * scale + bv[bj][0], v1 = acc[ai][bj][m][1] * scale + bv[bj][1];
                    if (ACT == 1) {
#pragma unroll
                        for (int j = 0; j < 4; ++j) { v0[j] = __builtin_amdgcn_rcpf(1.f + __expf(-v0[j])); v1[j] = __builtin_amdgcn_rcpf(1.f + __expf(-v1[j])); } }
                    *(u32x4*)(rowp + bj * 128) = pack8f(v0, v1); } }
    }
};
__device__ __forceinline__ size_t gate_slot(int pm, int cg, int wr, int wc, int aim, int fr, int fq) { asm volatile("" : "+v"(fq));
    return ((((size_t)(pm * 8 + cg) * 8 + (wr * 4 + wc)) * 8 + aim) * 64 + (fq * 16 + fr)) * 8; }
constexpr size_t GATE_PLANE = (size_t)M * 1024;
struct EpiGates {
    static constexpr bool PERM = true, HAS_MID = false;
    bf16* O; const float* bias; float scale;
    __device__ __forceinline__ void operator()(const f32x4 (&acc)[2][2][4][2], const pg8::Unit& u, int wr, int wc, int fr, int fq) const {
        const int c0 = u.pn * 128 + wc * 32 + 8 * fq;
        bf16* ob = O + gate_slot(u.pm, u.pn, wr, wc, 0, fr, fq);
        f32x4 bv[2][2];
#pragma unroll
        for (int bj = 0; bj < 2; ++bj)
#pragma unroll
            for (int n = 0; n < 2; ++n) bv[bj][n] = *(const f32x4*)(bias + bj * 1024 + c0 + 4 * n);
#pragma unroll
        for (int ai = 0; ai < 2; ++ai)
#pragma unroll
            for (int m = 0; m < 4; ++m) { bf16* rowp = ob + (ai * 4 + m) * 512; f32x4 rt[2], gd[2];
#pragma unroll
                for (int n = 0; n < 2; ++n)
#pragma unroll
                    for (int h = 0; h < 2; ++h) {
                        const f32x2 y1 = (f32x2){acc[ai][0][m][n][2 * h], acc[ai][0][m][n][2 * h + 1]} * scale + (f32x2){bv[0][n][2 * h], bv[0][n][2 * h + 1]}, y2 = (f32x2){acc[ai][1][m][n][2 * h], acc[ai][1][m][n][2 * h + 1]} * scale + (f32x2){bv[1][n][2 * h], bv[1][n][2 * h + 1]};
                        const f32x2 z1 = {fminf(fmaxf(y1.x, -30.f), 30.f), fminf(fmaxf(y1.y, -30.f), 30.f)}, z2 = {fminf(fmaxf(y2.x, -30.f), 30.f), fminf(fmaxf(y2.y, -30.f), 30.f)};
                        const f32x2 t1 = z1 * -1.4426950408889634f, t2 = z2 * -1.4426950408889634f;
                        const f32x2 d1 = (f32x2){__builtin_amdgcn_exp2f(t1.x), __builtin_amdgcn_exp2f(t1.y)} + 1.f, d2 = (f32x2){__builtin_amdgcn_exp2f(t2.x), __builtin_amdgcn_exp2f(t2.y)} + 1.f;
                        const f32x2 dd = d1 * d2, q = {__builtin_amdgcn_rcpf(dd.x), __builtin_amdgcn_rcpf(dd.y)};
                        const f32x2 g2 = q * d1, r = (d2 * d2) * q;
                        rt[n][2 * h] = r.x; rt[n][2 * h + 1] = r.y; gd[n][2 * h] = g2.x; gd[n][2 * h + 1] = g2.y; }
                *(u32x4*)rowp = pack8f(rt[0], rt[1]); *(u32x4*)(rowp + GATE_PLANE) = pack8f(gd[0], gd[1]); }
    }
};
struct EpiBranchFused {
    static constexpr bool PERM = true, HAS_MID = true;
    bf16* mg; const bf16* gates;
    __device__ __forceinline__ void mid(f32x4 (&acc)[2][2][4][2], const pg8::Unit& u, int wr, int wc, int fr, int fq) const {
        const bf16* gb = gates + gate_slot(u.pm, 2 * u.pn, wr, wc, 0, fr, fq);
#pragma unroll
        for (int ai = 0; ai < 2; ++ai) { u32x4 rt[4][2];
#pragma unroll
            for (int m = 0; m < 4; ++m) { const size_t row = EPI_ROWS(ai, m);
#pragma unroll
                for (int bj = 0; bj < 2; ++bj) rt[m][bj] = *(const u32x4*)(gb + bj * 32768 + (ai * 4 + m) * 512); }
#pragma unroll
            for (int m = 0; m < 4; ++m)
#pragma unroll
                for (int bj = 0; bj < 2; ++bj) { f32x4 a0, a1; unpack8f(rt[m][bj], a0, a1); acc[ai][bj][m][0] *= a0; acc[ai][bj][m][1] *= a1; }
            asm volatile("" ::: "memory"); }
    }
    __device__ __forceinline__ void operator()(const f32x4 (&acc)[2][2][4][2], const pg8::Unit& u, int wr, int wc, int fr, int fq) const {
        const int col0 = u.pn * 256 + wc * 32 + 8 * fq;
        const bf16* gb = gates + GATE_PLANE + gate_slot(u.pm, 2 * u.pn, wr, wc, 0, fr, fq);
#pragma unroll
        for (int ai = 0; ai < 2; ++ai) { u32x4 g2[4][2];
#pragma unroll
            for (int m = 0; m < 4; ++m) { const size_t row = EPI_ROWS(ai, m);
#pragma unroll
                for (int bj = 0; bj < 2; ++bj) g2[m][bj] = *(const u32x4*)(gb + bj * 32768 + (ai * 4 + m) * 512); }
#pragma unroll
            for (int m = 0; m < 4; ++m) { const size_t row = EPI_ROWS(ai, m);
#pragma unroll
                for (int bj = 0; bj < 2; ++bj) { f32x4 b0, b1; unpack8f(g2[m][bj], b0, b1); *(u32x4*)(mg + row * 1024 + col0 + bj * 128) = pack8f(acc[ai][bj][m][0] * b0, acc[ai][bj][m][1] * b1); } }
            asm volatile("" ::: "memory"); }
    }
};
struct EpiResBf16 {
    static constexpr bool PERM = true, HAS_MID = false;
    const float* resf; const bf16* resb; bf16* out; unsigned char* out8;
    __device__ __forceinline__ void operator()(const f32x4 (&acc)[2][2][4][2], const pg8::Unit& u, int wr, int wc, int fr, int fq) const {
        const int col0 = u.pn * 256 + wc * 32 + 8 * fq;
        if (!resf) {
            u32x4 w[2][4][2];
#pragma unroll
            for (int ai = 0; ai < 2; ++ai)
#pragma unroll
                for (int m = 0; m < 4; ++m) { const size_t off = (size_t)EPI_ROWS(ai, m) * DM + col0;
#pragma unroll
                    for (int bj = 0; bj < 2; ++bj) w[ai][m][bj] = *(const u32x4*)(resb + off + bj * 128); }
#pragma unroll
            for (int ai = 0; ai < 2; ++ai)
#pragma unroll
                for (int m = 0; m < 4; ++m) { const size_t off = (size_t)EPI_ROWS(ai, m) * DM + col0;
#pragma unroll
                    for (int bj = 0; bj < 2; ++bj) { f32x4 r0, r1; unpack8f(w[ai][m][bj], r0, r1); const f32x4 v0 = r0 + acc[ai][bj][m][0], v1 = r1 + acc[ai][bj][m][1]; *(u32x4*)(out + off + bj * 128) = pack8f(v0, v1);
                        if (out8) *(u32x2*)(out8 + off + bj * 128) = pack8_fp8(v0, v1); } }
            return;
        }
#pragma unroll
        for (int ai = 0; ai < 2; ++ai) { f32x4 rv[4][2][2];
#pragma unroll
            for (int m = 0; m < 4; ++m) { const size_t off = (size_t)EPI_ROWS(ai, m) * DM + col0;
#pragma unroll
                for (int bj = 0; bj < 2; ++bj) {
                    if (resf) { rv[m][bj][0] = *(const f32x4*)(resf + off + bj * 128); rv[m][bj][1] = *(const f32x4*)(resf + off + bj * 128 + 4); }
                    else { const u32x4 w = *(const u32x4*)(resb + off + bj * 128); unpack8f(w, rv[m][bj][0], rv[m][bj][1]); } } }
#pragma unroll
            for (int m = 0; m < 4; ++m) { const size_t off = (size_t)EPI_ROWS(ai, m) * DM + col0;
#pragma unroll
                for (int bj = 0; bj < 2; ++bj) { const f32x4 v0 = rv[m][bj][0] + acc[ai][bj][m][0], v1 = rv[m][bj][1] + acc[ai][bj][m][1]; *(u32x4*)(out + off + bj * 128) = pack8f(v0, v1);
                    if (out8) *(u32x2*)(out8 + off + bj * 128) = pack8_fp8(v0, v1); } }
            asm volatile("" ::: "memory"); }
    }
};
struct EpiRowScaleBf16 {
    static constexpr bool PERM = true, HAS_MID = false;
    bf16* O; int ldc; const LAS float* rs;
    __device__ __forceinline__ void operator()(const f32x4 (&acc)[2][2][4][2], const pg8::Unit& u, int wr, int wc, int fr, int fq) const {
        const int col0 = u.pn * 256 + wc * 32 + 8 * fq;
#pragma unroll
        for (int ai = 0; ai < 2; ++ai)
#pragma unroll
            for (int m = 0; m < 4; ++m) { const float r = rs[u.ord * 256 + wr * 64 + fr + ai * 128 + m * 16]; bf16* rowp = O + (size_t)EPI_ROWS(ai, m) * ldc + col0;
#pragma unroll
                for (int bj = 0; bj < 2; ++bj) *(u32x4*)(rowp + bj * 128) = pack8f(acc[ai][bj][m][0] * r, acc[ai][bj][m][1] * r); }
    }
};
__device__ __forceinline__ f32x2 swiglu2(const f32x2 a, const f32x2 b) {
    const f32x2 gl = {fminf(a.x, 7.f), fminf(a.y, 7.f)}, ln = {fminf(fmaxf(b.x, -7.f), 7.f), fminf(fmaxf(b.y, -7.f), 7.f)};
    const f32x2 t = gl * (-1.702f * 1.4426950408889634f);
    const f32x2 d = (f32x2){__builtin_amdgcn_exp2f(t.x), __builtin_amdgcn_exp2f(t.y)} + 1.f;
    const f32x2 r = {__builtin_amdgcn_rcpf(d.x), __builtin_amdgcn_rcpf(d.y)};
    return (gl * r) * (ln + 1.f);
}
struct EpiSwiglu {
    static constexpr bool PERM = true, HAS_MID = false;
    unsigned char* H; const float* bg; const float* bu; int nN; const float* rs;
    __device__ __forceinline__ void operator()(const f32x4 (&acc)[2][2][4][2], const pg8::Unit& u, int wr, int wc, int fr, int fq) const {
        const int e = u.pb / nN, c0 = u.pn * 128 + wc * 32 + 8 * fq;
        const f32x4 g0 = *(const f32x4*)(bg + e * 1024 + c0), g1 = *(const f32x4*)(bg + e * 1024 + c0 + 4), u0 = *(const f32x4*)(bu + e * 1024 + c0), u1 = *(const f32x4*)(bu + e * 1024 + c0 + 4);
        float rr[2][4];
#pragma unroll
        for (int ai = 0; ai < 2; ++ai)
#pragma unroll
            for (int m = 0; m < 4; ++m) rr[ai][m] = rs[EPI_ROWS(ai, m)];
#pragma unroll
        for (int ai = 0; ai < 2; ++ai)
#pragma unroll
            for (int m = 0; m < 4; ++m) { const float rq = rr[ai][m] * W8_INV; const f32x4 a0 = acc[ai][0][m][0] * rq + g0, a1 = acc[ai][0][m][1] * rq + g1, b0 = acc[ai][1][m][0] * rq + u0, b1 = acc[ai][1][m][1] * rq + u1;
                const f32x2 p0 = swiglu2((f32x2){a0[0], a0[1]}, (f32x2){b0[0], b0[1]}), p1 = swiglu2((f32x2){a0[2], a0[3]}, (f32x2){b0[2], b0[3]}), p2 = swiglu2((f32x2){a1[0], a1[1]}, (f32x2){b1[0], b1[1]}), p3 = swiglu2((f32x2){a1[2], a1[3]}, (f32x2){b1[2], b1[3]});
                const f32x4 r0 = {p0.x, p0.y, p1.x, p1.y}, r1 = {p2.x, p2.y, p3.x, p3.y};
                *(u32x2*)(H + (size_t)EPI_ROWS(ai, m) * 1024 + c0) = pack8_fp8(r0, r1); }
    }
};
struct EpiDown {
    static constexpr bool PERM = true, HAS_MID = false;
    unsigned char* Y; const float* bd; const float* rgate; int nN;
    __device__ __forceinline__ void operator()(const f32x4 (&acc)[2][2][4][2], const pg8::Unit& u, int wr, int wc, int fr, int fq) const {
        const int e = u.pb / nN, col0 = u.pn * 256 + wc * 32 + 8 * fq;
        f32x4 bv[2][2];
#pragma unroll
        for (int bj = 0; bj < 2; ++bj)
#pragma unroll
            for (int n = 0; n < 2; ++n) bv[bj][n] = *(const f32x4*)(bd + e * 1024 + col0 + bj * 128 + 4 * n);
#pragma unroll
        for (int ai = 0; ai < 2; ++ai)
#pragma unroll
            for (int m = 0; m < 4; ++m) { const int row = EPI_ROWS(ai, m);
#pragma unroll
                for (int bj = 0; bj < 2; ++bj) *(u32x2*)(Y + (size_t)row * 1024 + col0 + bj * 128) = pack8_fp8((acc[ai][bj][m][0] * W8_INV + bv[bj][0]) * A8_SCALE, (acc[ai][bj][m][1] * W8_INV + bv[bj][1]) * A8_SCALE); }
    }
};

__device__ __forceinline__ bf16x8 frag_n(const LAS unsigned char* base, int pitch, int r0, int k0, int lane) {
    return *(const LAS bf16x8*)(base + (r0 + (lane & 15)) * pitch + (k0 + 8 * (lane >> 4)) * 2);
}
__device__ __forceinline__ bf16x8 frag_t(const LAS unsigned char* base, int pitch, int k0, int n0, int lane) {
    const int i = lane & 15, gq = lane >> 4, q = i >> 2, p = i & 3;
    const unsigned a0 = (unsigned)(uintptr_t)(base + (k0 + 8 * gq + q) * pitch + (n0 + 4 * p) * 2), a1 = a0 + 4u * (unsigned)pitch;
    s16x4 lo, hi;
    asm volatile("ds_read_b64_tr_b16 %0, %2\n\tds_read_b64_tr_b16 %1, %3\n\ts_waitcnt lgkmcnt(0)" : "=&v"(lo), "=&v"(hi) : "v"(a0), "v"(a1) : "memory");
    return (bf16x8){lo[0], lo[1], lo[2], lo[3], hi[0], hi[1], hi[2], hi[3]};
}
#define MFMA16(a, b, c) __builtin_amdgcn_mfma_f32_16x16x32_bf16(a, b, c, 0, 0, 0)

__device__ __forceinline__ float log_sigmoid_fast(float z) { return fminf(z, 0.f) - __logf(1.f + __expf(-fabsf(z))); }
__device__ __forceinline__ void gla_a_phase(Frame& F, const Args& A) {
    unsigned char* ws = F.ws;
    LAS unsigned char* L = F.lds;
    LAS float* l_alr = (LAS float*)L;
    constexpr int PK = 272, PV = 528;
    LAS unsigned char* l_kd = L + 4096;
    LAS unsigned char* l_v = L + 4096 + 64 * PK;
    LAS float* l_tot = (LAS float*)(L + 4096 + 64 * PK + 64 * PV);
    const int tid = F.tid, lane = F.lane, wid = F.wave;
    const int col = tid & 127, qt = tid >> 7;
    float pf_alr[2]; u32x4 pf_v[4], pf_k[2];
#define GLA_A_PREFETCH(it_) do { const int b_ = (it_) >> 8, c_ = ((it_) >> 1) & 127, hp_ = (it_) & 1; const size_t tk0 = (size_t)b_ * SEQ + (size_t)c_ * 64; \
        const float* alr_ = (const float*)(ws + WS_ALR) + tk0 * 16; pf_alr[0] = alr_[tid]; pf_alr[1] = alr_[tid + 512]; \
        const bf16* vg_ = (const bf16*)(ws + WS_VG) + tk0 * 512 + hp_ * 256; const bf16* kg_ = (const bf16*)(ws + WS_KG) + tk0 * 256 + hp_ * 128; \
        _Pragma("unroll") for (int q_ = 0; q_ < 4; ++q_) { const int i_ = tid + q_ * 512; pf_v[q_] = *(const u32x4*)(vg_ + (size_t)(i_ >> 5) * 512 + (i_ & 31) * 8); } \
        _Pragma("unroll") for (int q_ = 0; q_ < 2; ++q_) { const int i_ = tid + q_ * 512; pf_k[q_] = *(const u32x4*)(kg_ + (size_t)(i_ >> 4) * 256 + (i_ & 15) * 8); } } while (0)
    int it = F.bid; if (it >= NBATCH * 256) return;
    GLA_A_PREFETCH(it);
    int hp_loaded = -1; float w2c[16]; float b2 = 0.f;
#pragma unroll
    for (int j = 0; j < 16; ++j) w2c[j] = 0.f;
    for (; it < NBATCH * 256; it += F.G) {
        const int b = it >> 8, c = (it >> 1) & 127, hp = it & 1;
        l_alr[tid] = pf_alr[0]; l_alr[tid + 512] = pf_alr[1];
#pragma unroll
        for (int q = 0; q < 4; ++q) { const int i = tid + q * 512; *(LAS u32x4*)(l_v + (i >> 5) * PV + (i & 31) * 16) = pf_v[q]; }
#pragma unroll
        for (int q = 0; q < 2; ++q) { const int i = tid + q * 512; *(LAS u32x4*)(l_kd + (i >> 4) * PK + (i & 15) * 16) = pf_k[q]; }
        __syncthreads();
        if (it + F.G < NBATCH * 256) GLA_A_PREFETCH(it + F.G);
        {   const int gc = hp * 128 + col;
            if (hp != hp_loaded) { hp_loaded = hp; b2 = INP(6)[gc];
#pragma unroll
                for (int jj = 0; jj < 16; ++jj) w2c[jj] = INP(5)[jj * 256 + gc]; }
            float bc[16]; float run = 0.f;
#pragma unroll
            for (int i = 0; i < 16; ++i) { const int t = qt * 16 + i; f32x2 zz = {b2, 0.f};
#pragma unroll
                for (int jj = 0; jj < 16; jj += 2) zz += (f32x2){l_alr[t * 16 + jj], l_alr[t * 16 + jj + 1]} * (f32x2){w2c[jj], w2c[jj + 1]};
                const float z = zz.x + zz.y;
                run += log_sigmoid_fast(z) * (1.f / 16.f); bc[i] = run; }
            l_tot[qt * 128 + col] = run;
            __syncthreads();
            const float q0 = l_tot[col], q1 = l_tot[128 + col], q2 = l_tot[256 + col], q3 = l_tot[384 + col];
            const float blast = (q0 + q1) + (q2 + q3), pre = (qt > 0 ? q0 : 0.f) + (qt > 1 ? q1 : 0.f) + (qt > 2 ? q2 : 0.f);
#pragma unroll
            for (int i = 0; i < 16; ++i) { const int t = qt * 16 + i; LAS bf16* kp = (LAS bf16*)(l_kd + t * PK + col * 2);
                *kp = (bf16)f2bf(bf2f(*kp) * __expf(blast - (pre + bc[i]))); }
            if (qt == 0) ((float*)(ws + WS_DECAY))[((size_t)(b * 4 + hp * 2 + (col >> 6)) * 128 + c) * 64 + (col & 63)] = __expf(blast);
        }
        __syncthreads();
        const int hh = wid >> 2, j = wid & 3;
        f32x4 acc[4][2];
#pragma unroll
        for (int mt = 0; mt < 4; ++mt)
#pragma unroll
            for (int nt = 0; nt < 2; ++nt) acc[mt][nt] = (f32x4){0.f, 0.f, 0.f, 0.f};
#pragma unroll
        for (int ks = 0; ks < 2; ++ks) { bf16x8 a[4], bb[2];
#pragma unroll
            for (int mt = 0; mt < 4; ++mt) a[mt] = frag_t(l_kd, PK, 32 * ks, hh * 64 + 16 * mt, lane);
#pragma unroll
            for (int nt = 0; nt < 2; ++nt) bb[nt] = frag_t(l_v, PV, 32 * ks, hh * 128 + 32 * j + 16 * nt, lane);
            __builtin_amdgcn_sched_barrier(0);
#pragma unroll
            for (int mt = 0; mt < 4; ++mt)
#pragma unroll
                for (int nt = 0; nt < 2; ++nt) acc[mt][nt] = MFMA16(a[mt], bb[nt], acc[mt][nt]); }
        __syncthreads();
        { LAS unsigned char* l_st = l_kd + hh * (64 * 272) + (4 * (lane >> 4)) * 272 + (32 * j + (lane & 15)) * 2;
#pragma unroll
          for (int mt = 0; mt < 4; ++mt)
#pragma unroll
              for (int nt = 0; nt < 2; ++nt)
#pragma unroll
                  for (int r = 0; r < 4; ++r) *(LAS bf16*)(l_st + (16 * mt + r) * 272 + 32 * nt) = (bf16)f2bf(acc[mt][nt][r]); }
        __syncthreads();
        { bf16* st = (bf16*)(F.dout + DO_ST) + ((size_t)(b * 4 + hp * 2) * 128 + c) * 8192;
#pragma unroll
          for (int q = 0; q < 4; ++q) { const int i = tid + q * 512, h2 = i >> 10, dk = (i >> 4) & 63, c16 = i & 15;
              const u32x4 w = *(const LAS u32x4*)(l_kd + h2 * (64 * 272) + dk * 272 + c16 * 16);
              *(u32x4*)(st + (size_t)h2 * 128 * 8192 + dk * 128 + c16 * 8) = w; } }
        __syncthreads();
    }
#undef GLA_A_PREFETCH
}

__device__ __forceinline__ void gla_scan(Frame& F) {
    unsigned* st = (unsigned*)(F.dout + DO_ST); const float* dec = (const float*)(F.ws + WS_DECAY);
    for (int idx = F.bid * NTHR + F.tid; idx < 32 * 4096; idx += F.G * NTHR) {
        const int bh = idx >> 12, e2 = idx & 4095, dk = e2 >> 6;
        unsigned* p = st + (size_t)bh * 128 * 4096 + e2; const float* dp = dec + (size_t)bh * 128 * 64 + dk;
        float s0 = 0.f, s1 = 0.f;
#pragma unroll 32
        for (int c = 0; c < 128; ++c) { const unsigned kv = p[(size_t)c * 4096]; const float d = dp[c * 64];
            p[(size_t)c * 4096] = cvt_pk_bf16(s0, s1);
            s0 = fmaf(d, s0, bflo(kv)); s1 = fmaf(d, s1, bfhi(kv)); }
    }
}

__device__ __forceinline__ void gla_c_phase(Frame& F, const Args& A) {
    unsigned char* ws = F.ws;
    LAS unsigned char* L = F.lds;
    LAS float* l_alr = (LAS float*)L;
    constexpr int PQ = 272, PV = 528, PP = 144;
    LAS unsigned char* l_qh = L + 4096;
    LAS unsigned char* l_kt = L + 21504;
    LAS unsigned char* l_v = L + 38912;
    LAS unsigned char* l_s = L + 72704;
    LAS unsigned char* l_p = L + 107520;
    LAS float* l_tot = (LAS float*)(L + 125952);
    LAS float* l_ss = (LAS float*)(L + 128000);
    const int tid = F.tid, lane = F.lane, wid = F.wave;
    const int col = tid & 127, qt = tid >> 7;
    float pf_alr[2]; u32x4 pf_v[4], pf_s[4], pf_q[2], pf_k[2], pf_r[4];
#define GLA_C_PREFETCH(it_) do { const int b_ = (it_) >> 8, c_ = ((it_) >> 1) & 127, hp_ = (it_) & 1; const size_t tk0 = (size_t)b_ * SEQ + (size_t)c_ * 64; \
        const float* alr_ = (const float*)(ws + WS_ALR) + tk0 * 16; pf_alr[0] = alr_[tid]; pf_alr[1] = alr_[tid + 512]; \
        const bf16* vg_ = (const bf16*)(ws + WS_VG) + tk0 * 512 + hp_ * 256; const bf16* rg_ = (const bf16*)(ws + WS_RG) + tk0 * 512 + hp_ * 256; \
        _Pragma("unroll") for (int q_ = 0; q_ < 4; ++q_) { const int i_ = tid + q_ * 512; pf_v[q_] = *(const u32x4*)(vg_ + (size_t)(i_ >> 5) * 512 + (i_ & 31) * 8); pf_r[q_] = *(const u32x4*)(rg_ + (size_t)(i_ >> 5) * 512 + (i_ & 31) * 8); } \
        _Pragma("unroll") for (int q_ = 0; q_ < 4; ++q_) { const int i_ = tid + q_ * 512, hh_ = i_ >> 10, r_ = (i_ >> 4) & 63, ch_ = i_ & 15; \
            pf_s[q_] = *(const u32x4*)((const bf16*)(F.dout + DO_ST) + ((size_t)(b_ * 4 + hp_ * 2 + hh_) * 128 + c_) * 8192 + r_ * 128 + ch_ * 8); } \
        const bf16* qg_ = (const bf16*)(ws + WS_QG) + tk0 * 256 + hp_ * 128; const bf16* kg_ = (const bf16*)(ws + WS_KG) + tk0 * 256 + hp_ * 128; \
        _Pragma("unroll") for (int q_ = 0; q_ < 2; ++q_) { const int i_ = tid + q_ * 512; pf_q[q_] = *(const u32x4*)(qg_ + (size_t)(i_ >> 4) * 256 + (i_ & 15) * 8); pf_k[q_] = *(const u32x4*)(kg_ + (size_t)(i_ >> 4) * 256 + (i_ & 15) * 8); } } while (0)
    int it = F.bid; if (it >= NBATCH * 256) return;
    GLA_C_PREFETCH(it);
    int hp_loaded = -1; float w2c[16]; float b2 = 0.f;
#pragma unroll
    for (int j = 0; j < 16; ++j) w2c[j] = 0.f;
    for (; it < NBATCH * 256; it += F.G) {
        const int b = it >> 8, c = (it >> 1) & 127, hp = it & 1;
        const size_t tok0 = (size_t)b * SEQ + (size_t)c * 64;
        l_alr[tid] = pf_alr[0]; l_alr[tid + 512] = pf_alr[1];
#pragma unroll
        for (int q = 0; q < 4; ++q) { const int i = tid + q * 512; *(LAS u32x4*)(l_v + (i >> 5) * PV + (i & 31) * 16) = pf_v[q]; }
#pragma unroll
        for (int q = 0; q < 4; ++q) { const int i = tid + q * 512, hh = i >> 10, r = (i >> 4) & 63, ch = i & 15; *(LAS u32x4*)(l_s + hh * (64 * PQ) + r * PQ + ch * 16) = pf_s[q]; }
#pragma unroll
        for (int q = 0; q < 2; ++q) { const int i = tid + q * 512; *(LAS u32x4*)(l_qh + (i >> 4) * PQ + (i & 15) * 16) = pf_q[q]; *(LAS u32x4*)(l_kt + (i >> 4) * PQ + (i & 15) * 16) = pf_k[q]; }
        u32x4 cur_r[4];
#pragma unroll
        for (int q = 0; q < 4; ++q) cur_r[q] = pf_r[q];
        __syncthreads();
        if (it + F.G < NBATCH * 256) GLA_C_PREFETCH(it + F.G);
        const int hh = wid >> 2, j = wid & 3, head = hp * 2 + hh;
        {
            const int gc = hp * 128 + col;
            if (hp != hp_loaded) { hp_loaded = hp; b2 = INP(6)[gc];
#pragma unroll
                for (int jj = 0; jj < 16; ++jj) w2c[jj] = INP(5)[jj * 256 + gc]; }
            float bc[16]; float run = 0.f;
#pragma unroll
            for (int i = 0; i < 16; ++i) { const int t = qt * 16 + i; f32x2 zz = {b2, 0.f};
#pragma unroll
                for (int jj = 0; jj < 16; jj += 2) zz += (f32x2){l_alr[t * 16 + jj], l_alr[t * 16 + jj + 1]} * (f32x2){w2c[jj], w2c[jj + 1]};
                const float z = zz.x + zz.y;
                run += log_sigmoid_fast(z) * (1.f / 16.f); bc[i] = run; }
            l_tot[qt * 128 + col] = run;
            __syncthreads();
            float pre = 0.f;
#pragma unroll
            for (int q = 0; q < 3; ++q) pre += (q < qt) ? l_tot[q * 128 + col] : 0.f;
#pragma unroll
            for (int i = 0; i < 16; ++i) { const int t = qt * 16 + i; const float bb = pre + bc[i];
                LAS bf16* qp = (LAS bf16*)(l_qh + t * PQ + col * 2); LAS bf16* kp = (LAS bf16*)(l_kt + t * PQ + col * 2);
                *qp = (bf16)f2bf(bf2f(*qp) * __expf(bb)); *kp = (bf16)f2bf(bf2f(*kp) * __expf(-bb)); }
        }
        __syncthreads();
        {
            f32x4 sc4[4];
#pragma unroll
            for (int nt = 0; nt < 4; ++nt) sc4[nt] = (f32x4){0.f, 0.f, 0.f, 0.f};
#pragma unroll
            for (int ks = 0; ks < 2; ++ks) { const bf16x8 a = frag_n(l_qh, PQ, 16 * j, hh * 64 + 32 * ks, lane);
#pragma unroll
                for (int nt = 0; nt < 4; ++nt) sc4[nt] = MFMA16(a, frag_n(l_kt, PQ, 16 * nt, hh * 64 + 32 * ks, lane), sc4[nt]); }
#pragma unroll
            for (int nt = 0; nt < 4; ++nt)
#pragma unroll
                for (int r = 0; r < 4; ++r) { const int t = 16 * j + 4 * (lane >> 4) + r, s2 = 16 * nt + (lane & 15);
                    *(LAS bf16*)(l_p + hh * (64 * PP) + t * PP + s2 * 2) = (bf16)f2bf(s2 <= t ? sc4[nt][r] : 0.f); }
        }
        __syncthreads();
        f32x4 acc[4][2];
#pragma unroll
        for (int mt = 0; mt < 4; ++mt)
#pragma unroll
            for (int nt = 0; nt < 2; ++nt) acc[mt][nt] = (f32x4){0.f, 0.f, 0.f, 0.f};
#pragma unroll
        for (int ks = 0; ks < 2; ++ks) {
            bf16x8 bb[2];
#pragma unroll
            for (int nt = 0; nt < 2; ++nt) bb[nt] = frag_t(l_s + hh * (64 * PQ), PQ, 32 * ks, 32 * j + 16 * nt, lane);
            __builtin_amdgcn_sched_barrier(0);
#pragma unroll
            for (int mt = 0; mt < 4; ++mt) { const bf16x8 a = frag_n(l_qh, PQ, 16 * mt, hh * 64 + 32 * ks, lane);
#pragma unroll
                for (int nt = 0; nt < 2; ++nt) acc[mt][nt] = MFMA16(a, bb[nt], acc[mt][nt]); } }
#pragma unroll
        for (int ks = 0; ks < 2; ++ks) {
            bf16x8 bb[2];
#pragma unroll
            for (int nt = 0; nt < 2; ++nt) bb[nt] = frag_t(l_v, PV, 32 * ks, hh * 128 + 32 * j + 16 * nt, lane);
            __builtin_amdgcn_sched_barrier(0);
#pragma unroll
            for (int mt = 0; mt < 4; ++mt) { const bf16x8 a = frag_n(l_p + hh * (64 * PP), PP, 16 * mt, 32 * ks, lane);
#pragma unroll
                for (int nt = 0; nt < 2; ++nt) acc[mt][nt] = MFMA16(a, bb[nt], acc[mt][nt]); } }
#pragma unroll
        for (int mt = 0; mt < 4; ++mt)
#pragma unroll
            for (int r = 0; r < 4; ++r) { float q = acc[mt][0][r] * acc[mt][0][r] + acc[mt][1][r] * acc[mt][1][r];
                q += __shfl_xor(q, 1); q += __shfl_xor(q, 2); q += __shfl_xor(q, 4); q += __shfl_xor(q, 8);
                if ((lane & 15) == 0) l_ss[(hh * 64 + 16 * mt + 4 * (lane >> 4) + r) * 4 + j] = q; }
        __syncthreads();
        {
            const float* gng = INP(7); const float g0 = gng[head * 128 + 32 * j + (lane & 15)], g1 = gng[head * 128 + 32 * j + 16 + (lane & 15)];
            LAS unsigned char* l_o = l_v + (4 * (lane >> 4)) * PV + (hh * 128 + 32 * j + (lane & 15)) * 2;
#pragma unroll
            for (int mt = 0; mt < 4; ++mt)
#pragma unroll
                for (int r = 0; r < 4; ++r) { const int t = 16 * mt + 4 * (lane >> 4) + r; const LAS float* sp = l_ss + (hh * 64 + t) * 4;
                    const float rstd = 1.f / sqrtf(((sp[0] + sp[1]) + (sp[2] + sp[3])) * (1.f / 128.f) + EPS);
                    *(LAS bf16*)(l_o + (16 * mt + r) * PV) = (bf16)f2bf(acc[mt][0][r] * rstd * g0); *(LAS bf16*)(l_o + (16 * mt + r) * PV + 32) = (bf16)f2bf(acc[mt][1][r] * rstd * g1); } }
        __syncthreads();
        { bf16* og = (bf16*)(F.dout + DO_OGD) + tok0 * 1024 + hp * 256;
#pragma unroll
          for (int q = 0; q < 4; ++q) { const int i = tid + q * 512; f32x4 o0, o1, r0, r1; const u32x4 ow = *(const LAS u32x4*)(l_v + (i >> 5) * PV + (i & 31) * 16); unpack8f(ow, o0, o1); unpack8f(cur_r[q], r0, r1);
#pragma unroll
              for (int e = 0; e < 4; ++e) { o0[e] *= r0[e] * __builtin_amdgcn_rcpf(1.f + __expf(-r0[e])); o1[e] *= r1[e] * __builtin_amdgcn_rcpf(1.f + __expf(-r1[e])); }
              *(u32x4*)(og + (size_t)(i >> 5) * 1024 + (i & 31) * 8) = pack8f(o0, o1); } }
        __syncthreads();
    }
#undef GLA_C_PREFETCH
}

__device__ __forceinline__ void dil_combine(Frame& F) {
    const bf16* qd = (const bf16*)(F.ws + WS_QD); const float* lse = (const float*)(F.ws + WS_LSE); bf16* od = (bf16*)(F.dout + DO_OGD) + 512;
    constexpr int U = 4; const int NT = F.G * NTHR;
    for (int idx0 = F.bid * NTHR + F.tid; idx0 < M * 64; idx0 += U * NT) {
        float l0[U], l1[U], l2[U]; u32x4 a[U], bq[U], c[U];
#pragma unroll
        for (int u = 0; u < U; ++u) { const int idx = idx0 + u * NT; if (idx < M * 64) { const int tok = idx >> 6, rem = idx & 63, h = rem >> 4, ch = rem & 15;
            l0[u] = lse[(size_t)tok * 12 + h]; l1[u] = lse[(size_t)tok * 12 + 4 + h]; l2[u] = lse[(size_t)tok * 12 + 8 + h];
            const bf16* p = qd + (size_t)tok * 1536 + h * 128 + ch * 8; a[u] = *(const u32x4*)p; bq[u] = *(const u32x4*)(p + 512); c[u] = *(const u32x4*)(p + 1024); } }
#pragma unroll
        for (int u = 0; u < U; ++u) { const int idx = idx0 + u * NT; if (idx < M * 64) { const int tok = idx >> 6, rem = idx & 63, h = rem >> 4, ch = rem & 15;
            const float mx = fmaxf(l0[u], fmaxf(l1[u], l2[u])); float w0 = __expf(l0[u] - mx), w1 = __expf(l1[u] - mx), w2 = __expf(l2[u] - mx); const float inv = 1.f / (w0 + w1 + w2); w0 *= inv; w1 *= inv; w2 *= inv;
            f32x4 a0, a1, b0, b1, c0, c1; unpack8f(a[u], a0, a1); unpack8f(bq[u], b0, b1); unpack8f(c[u], c0, c1);
            *(u32x4*)(od + (size_t)tok * 1024 + h * 128 + ch * 8) = pack8f(a0 * w0 + b0 * w1 + c0 * w2, a1 * w0 + b1 * w1 + c1 * w2); } }
    }
}

__device__ __forceinline__ void kv_small(Frame& F) {
    const bf16* memn = (const bf16*)(F.ws + WS_MEMN); const bf16* wt = (const bf16*)(F.ws + WS_WXKV); bf16* kvm = (bf16*)(F.ws + WS_KVM);
    const int fr = F.lane & 15, fq = F.lane >> 4;
    for (int t = F.bid; t < 256; t += F.G) { const int rt = t >> 3, ct = t & 7;
        f32x4 acc[4];
#pragma unroll
        for (int mt = 0; mt < 4; ++mt) acc[mt] = (f32x4){0.f, 0.f, 0.f, 0.f};
        const bf16* ap = memn + (size_t)(rt * 64 + fr) * DM + 8 * fq; const bf16* bp = wt + (size_t)(ct * 128 + 16 * F.wave + fr) * DM + 8 * fq;
#pragma unroll 8
        for (int kk = 0; kk < 32; ++kk) { const bf16x8 b = *(const bf16x8*)(bp + 32 * kk);
#pragma unroll
            for (int mt = 0; mt < 4; ++mt) acc[mt] = MFMA16(*(const bf16x8*)(ap + (size_t)(16 * mt) * DM + 32 * kk), b, acc[mt]); }
#pragma unroll
        for (int mt = 0; mt < 4; ++mt)
#pragma unroll
            for (int r = 0; r < 4; ++r) kvm[(size_t)(rt * 64 + 16 * mt + 4 * fq + r) * DM + ct * 128 + 16 * F.wave + fr] = (bf16)f2bf(acc[mt][r]);
    }
}

__device__ __forceinline__ att::BlockRef dil_ref(Frame& F, int I) {
    const int g = I >> 10, r = I & 1023, d = 1 << (2 * g), nqb = 32 >> (2 * g), qb = r % nqb, s = r / nqb, p = s % d, bh = s / d, h = bh & 3, b = bh >> 2;
    const size_t tb = (size_t)b * SEQ + p;
    att::BlockRef R;
    R.qs = d * 1536; R.ks = d * 1536; R.os = d * 1536; R.ls = d * 12; R.skv = SEQ / d; R.P0 = qb * 256;
    const size_t e0 = tb * 1536 + g * 512 + h * 128;
    R.Q = (bf16*)(F.ws + WS_Q8 + e0 + (size_t)qb * 256 * R.qs);
    R.K = (const bf16*)(F.ws + WS_K8 + e0);
    R.O = (bf16*)(F.ws + WS_QD) + e0 + (size_t)qb * 256 * R.os;
    R.L = (float*)(F.ws + WS_LSE) + tb * 12 + g * 4 + h + (size_t)qb * 256 * R.ls;
    return R;
}
__device__ __forceinline__ att::BlockRef xat_ref(Frame& F, int I) {
    const int qb = I & 31, h = (I >> 5) & 3, b = I >> 7;
    att::BlockRef R; R.qs = 512; R.ks = 1024; R.os = 512; R.ls = 0; R.skv = 256; R.P0 = 256; R.L = nullptr;
    bf16* q = (bf16*)(F.ws + WS_QX) + ((size_t)b * SEQ + (size_t)qb * 256) * 512 + h * 128;
    R.Q = q; R.O = q; R.K = (const bf16*)(F.ws + WS_KVM) + (size_t)b * 256 * 1024 + h * 128;
    return R;
}
template <bool DIL>
__device__ __forceinline__ void attn_phase(Frame& F) {
    constexpr int TOTAL = DIL ? 3072 : 1024; constexpr int W = DIL ? 129 : (1 << 20); constexpr long VOFF = DIL ? (long)(WS_V8 - WS_K8) : 512;
    const int G8 = F.G & ~255;
    auto remap = [&](int I_) { if (I_ >= (TOTAL / 256) * 256 || (I_ % F.G) >= G8 || F.G != 256) return I_; const int r_ = I_ >> 8, w_ = I_ & 255; return (r_ << 8) + ((w_ & 7) << 5) + (w_ >> 3); };
    int I = F.bid; if (I >= TOTAL) return;
    att::BlockRef cur = DIL ? dil_ref(F, remap(I)) : xat_ref(F, remap(I));
    att::Seam S;
    att::prime<VOFF, DIL>(cur, W, F.ldsg, S);
    for (;;) {
        const bool more = I + F.G < TOTAL; const int In = more ? I + F.G : I;
        const att::BlockRef nxt = DIL ? dil_ref(F, remap(In)) : xat_ref(F, remap(In));
        att::block<true, VOFF, DIL>(cur, nxt, W, F.ldsg, S);
        if (!more) break;
        cur = nxt; I = In;
    }
}

__device__ __forceinline__ void xattn_own_panels(Frame& F) {
    constexpr int W = 1 << 20; constexpr long VOFF = 512;
    const int npan = (F.bid < M / 256) ? ((M / 256 - 1 - F.bid) / F.G + 1) : 0, n = npan * 4;
    if (n == 0) return;
    auto item = [&](int j) { const int pm = (j >> 2) * F.G + F.bid, h = j & 3; return ((pm >> 5) << 7) | (h << 5) | (pm & 31); };
    int j = 0;
    att::BlockRef cur = xat_ref(F, item(0));
    att::Seam S;
    att::prime<VOFF, false>(cur, W, F.ldsg, S);
    for (;;) {
        const bool more = j + 1 < n; const int jn = more ? j + 1 : j;
        const att::BlockRef nxt = xat_ref(F, item(jn));
        att::block<true, VOFF, false>(cur, nxt, W, F.ldsg, S);
        if (!more) break;
        cur = nxt; j = jn;
    }
}

__device__ __forceinline__ void router_phase(Frame& F, const Args& A) {
    unsigned char* ws = F.ws;
    LAS unsigned char* l_w = F.lds;
    LAS float* l_lg = (LAS float*)(F.lds + 65536) + F.wave * (16 * 33 + 16);
    LAS unsigned* l_hist = (LAS unsigned*)(F.lds + 65536 + 8 * (16 * 33 + 16) * 4);
    const int tid = F.tid, lane = F.lane;
    { const u32x4* wsrc = (const u32x4*)(ws + WS_WR);
      for (int i = tid; i < 32 * 128; i += NTHR) { const int e = i >> 7, ch = i & 127; *(LAS u32x4*)(l_w + e * 2048 + ((ch ^ (e & 15)) << 4)) = wsrc[i]; } }
    if (tid < 64) l_hist[tid] = 0u;
    LAS float* l_br = (LAS float*)(l_hist + 64);
    if (tid < 32) l_br[tid] = INP(20)[tid];
    { int* rt = (int*)(ws + WS_RTOK); float* rg = (float*)(ws + WS_RGATE); float* rr = (float*)(ws + WS_RRS);
      for (int i = F.bid * NTHR + tid; i < 2 * RT_CAP; i += F.G * NTHR) { rt[i] = 0; rg[i] = 0.f; rr[i] = 0.f; } }
    __syncthreads();
    const bf16* h2b = (const bf16*)(ws + WS_A); float* rstd3 = (float*)(ws + WS_RSTD3);
    const int fr = lane & 15, fq = lane >> 4;
    for (int rbi = F.wave; ; rbi += NWAVES) { const int pm_ = (rbi >> 4) * F.G + F.bid; if (pm_ >= M / 256) break; const int rb = pm_ * 16 + (rbi & 15);
        const size_t row0 = (size_t)rb * 16;
        const bf16* xr = h2b + (row0 + fr) * DM + 16 * fq;
        unsigned char* o8 = ws + WS_H2F8 + (row0 + fr) * DM + 16 * fq;
        f32x4 c0 = {0.f, 0.f, 0.f, 0.f}, c1 = {0.f, 0.f, 0.f, 0.f}; float ss = 0.f;
#pragma unroll
        for (int kk = 0; kk < 16; ++kk) {
            const u32x4 xa = *(const u32x4*)(xr + 64 * kk), xb = *(const u32x4*)(xr + 64 * kk + 8); f32x4 x0, x1, y0, y1; unpack8f(xa, x0, x1); unpack8f(xb, y0, y1);
            ss += (x0[0] * x0[0] + x0[1] * x0[1]) + (x0[2] * x0[2] + x0[3] * x0[3]) + (x1[0] * x1[0] + x1[1] * x1[1]) + (x1[2] * x1[2] + x1[3] * x1[3]);
            ss += (y0[0] * y0[0] + y0[1] * y0[1]) + (y0[2] * y0[2] + y0[3] * y0[3]) + (y1[0] * y1[0] + y1[1] * y1[1]) + (y1[2] * y1[2] + y1[3] * y1[3]);
            { const u32x2 lo = pack8_fp8(x0, x1), hi = pack8_fp8(y0, y1); u32x4 o; o.x = lo.x; o.y = lo.y; o.z = hi.x; o.w = hi.y; *(u32x4*)(o8 + 64 * kk) = o; }
#pragma unroll
            for (int s = 0; s < 2; ++s) { const u32x4 xw = s ? xb : xa; const bf16x8 ah = *reinterpret_cast<const bf16x8*>(&xw);
                const int ch = 8 * kk + 2 * fq + s;
                const bf16x8 b0 = *(const LAS bf16x8*)(l_w + fr * 2048 + ((ch ^ fr) << 4)), b1 = *(const LAS bf16x8*)(l_w + (16 + fr) * 2048 + ((ch ^ fr) << 4));
                c0 = MFMA16(ah, b0, c0); c1 = MFMA16(ah, b1, c1); }
        }
        ss += __shfl_xor(ss, 16); ss += __shfl_xor(ss, 32);
        const float rstd = 1.f / sqrtf(ss * (1.f / DM) + EPS);
        if (fq == 0) { l_lg[16 * 33 + fr] = rstd; rstd3[row0 + fr] = rstd; }
#pragma unroll
        for (int r = 0; r < 4; ++r) { l_lg[(4 * fq + r) * 33 + fr] = c0[r]; l_lg[(4 * fq + r) * 33 + 16 + fr] = c1[r]; }
        LDS_WAIT(); asm volatile("" ::: "memory");
        if (lane < 16) {
            const float rs = l_lg[16 * 33 + lane]; float v[32];
#pragma unroll
            for (int e = 0; e < 32; ++e) v[e] = l_lg[lane * 33 + e] * rs + l_br[e];
            int ci[4]; float cv[4];
#pragma unroll
            for (int k = 0; k < 4; ++k) { float best = -__builtin_inff(); int bi = 0;
#pragma unroll
                for (int e = 0; e < 32; ++e) { bool free_ = true;
#pragma unroll
                    for (int kk2 = 0; kk2 < k; ++kk2) free_ = free_ && (ci[kk2] != e);
                    if (free_ && v[e] > best) { best = v[e]; bi = e; } }
                ci[k] = bi; cv[k] = best; }
            float ex[4], sum = 0.f;
#pragma unroll
            for (int k = 0; k < 4; ++k) { ex[k] = __expf(cv[k] - cv[0]); sum += ex[k]; }
            const float inv = 1.f / sum; const size_t tok = row0 + lane; const int hf = tok >= HALF_TOK ? 1 : 0;
            int* te = (int*)(ws + WS_TOPE) + tok * 4; float* tg = (float*)(ws + WS_TGATE) + tok * 4;
#pragma unroll
            for (int k = 0; k < 4; ++k) { te[k] = ci[k]; tg[k] = ex[k] * inv; atomicAdd((unsigned*)&l_hist[hf * 32 + ci[k]], 1u); }
        }
        LDS_WAIT(); asm volatile("" ::: "memory");
    }
    __syncthreads();
    if (tid < 64 && l_hist[tid] != 0u) atomicAdd(F.ctl + CW_CNT + tid, l_hist[tid]);
}

struct MoeTab { LAS int* pstart; LAS int* blk_e; LAS int* nblk; };
__device__ __forceinline__ MoeTab moe_tables(Frame& F, int half) {
    MoeTab T; T.pstart = (LAS int*)(F.lds + TAB_OFF); T.blk_e = T.pstart + 32; T.nblk = T.blk_e + MAXBLK;
    __syncthreads();
    if (F.tid < 64) {
        const int lane = F.tid; int cnt = 0;
        if (lane < NEXP) cnt = (int)__hip_atomic_load(F.ctl + CW_CNT + half * 32 + lane, __ATOMIC_RELAXED, __HIP_MEMORY_SCOPE_AGENT);
        const int nb = (cnt + 255) >> 8; int incl = nb;
#pragma unroll
        for (int d = 1; d < 32; d <<= 1) { const int t = __shfl_up(incl, d); if (lane >= d) incl += t; }
        int pos = incl - nb; if (pos > MAXBLK) pos = MAXBLK;
        if (lane < NEXP) { T.pstart[lane] = pos * 256; for (int jx = 0; jx < nb && pos + jx < MAXBLK; ++jx) T.blk_e[pos + jx] = lane; }
        if (lane == NEXP - 1) T.nblk[0] = incl < MAXBLK ? incl : MAXBLK;
    }
    __syncthreads();
    return T;
}
__device__ __forceinline__ void place_phase(Frame& F) {
    unsigned char* ws = F.ws;
    LAS int* l_cnt = (LAS int*)(F.lds + 4096); LAS int* l_base = l_cnt + 32;
    const int* te = (const int*)(ws + WS_TOPE); const float* tg = (const float*)(ws + WS_TGATE);
    int* tslot = (int*)(ws + WS_TSLOT);
    for (int half = 0; half < 2; ++half) {
        const MoeTab T = moe_tables(F, half);
        int* rtok = (int*)(ws + WS_RTOK) + half * RT_CAP; float* rgate = (float*)(ws + WS_RGATE) + half * RT_CAP; float* rrs = (float*)(ws + WS_RRS) + half * RT_CAP; const float* rstd3 = (const float*)(ws + WS_RSTD3);
        for (int bt = F.bid; bt < HALF_TOK / 128; bt += F.G) {
            if (F.tid < 32) l_cnt[F.tid] = 0;
            __syncthreads();
            const int tok = half * HALF_TOK + bt * 128 + (F.tid >> 2), k = F.tid & 3;
            const int e = te[(size_t)tok * 4 + k];
            const int rank = atomicAdd((int*)&l_cnt[e], 1);
            __syncthreads();
            if (F.tid < 32) l_base[F.tid] = (int)atomicAdd(F.ctl + CW_CUR + half * 32 + F.tid, (unsigned)l_cnt[F.tid]);
            __syncthreads();
            const int dest = T.pstart[e] + l_base[e] + rank;
            if (dest < RT_CAP) { rtok[dest] = tok; rgate[dest] = tg[(size_t)tok * 4 + k]; rrs[dest] = rstd3[tok]; }
            tslot[(size_t)tok * 4 + k] = dest < RT_CAP ? dest : 0;
            __syncthreads();
        }
    }
}
__device__ __forceinline__ void combine_phase(Frame& F, const Args& A, int half, size_t ws_y, int rem = 0) {
    float* outp = (float*)F.dout; const bf16* h2b = (const bf16*)(F.ws + WS_A); const unsigned char* Y = F.ws + ws_y; const int* tslot = (const int*)(F.ws + WS_TSLOT); const float* tgate = (const float*)(F.ws + WS_TGATE); const float* gf = INP(27);
    f32x4 gg[2][2];
#pragma unroll
    for (int c = 0; c < 2; ++c) { gg[c][0] = *(const f32x4*)(gf + c * 512 + 8 * F.lane); gg[c][1] = *(const f32x4*)(gf + c * 512 + 8 * F.lane + 4); }
    int m_begin = half * HALF_TOK + 2 * (F.bid * NWAVES + F.wave), m_end = (half + 1) * HALF_TOK, m_step = 2 * F.G * NWAVES;
    if (rem > 0 && rem < F.G && F.G == 256) {
        const int n_lo = 128 - ((30 * (F.G - rem) / F.G) & ~1), nhi = F.G - rem, rest = HALF_TOK - rem * n_lo, q = (rest / nhi) & ~1, extra = (rest - q * nhi) / 2;
        int start, n;
        if (F.bid < rem) { start = F.bid * n_lo; n = n_lo; } else { const int j = F.bid - rem; start = rem * n_lo + j * q + 2 * (j < extra ? j : extra); n = q + (j < extra ? 2 : 0); }
        m_begin = half * HALF_TOK + start + 2 * F.wave; m_end = half * HALF_TOK + start + n; m_step = 2 * NWAVES;
    }
    for (int m0 = m_begin; m0 < m_end; m0 += m_step) {
        u32x4 hw[2][2]; u32x2 yw[2][4][2]; int sl[2][4]; float gk[2][4];
#pragma unroll
        for (int r = 0; r < 2; ++r)
#pragma unroll
            for (int k = 0; k < 4; ++k) { sl[r][k] = tslot[(size_t)(m0 + r) * 4 + k]; gk[r][k] = tgate[(size_t)(m0 + r) * 4 + k]; }
#pragma unroll
        for (int r = 0; r < 2; ++r) {
#pragma unroll
            for (int c = 0; c < 2; ++c) hw[r][c] = *(const u32x4*)(h2b + (size_t)(m0 + r) * DM + c * 512 + 8 * F.lane);
#pragma unroll
            for (int k = 0; k < 4; ++k)
#pragma unroll
                for (int c = 0; c < 2; ++c) yw[r][k][c] = *(const u32x2*)(Y + (size_t)sl[r][k] * 1024 + c * 512 + 8 * F.lane); }
#pragma unroll
        for (int r = 0; r < 2; ++r) { f32x4 v[2][2]; float s = 0.f;
#pragma unroll
            for (int c = 0; c < 2; ++c) { unpack8f(hw[r][c], v[c][0], v[c][1]);
#pragma unroll
                for (int k = 0; k < 4; ++k) { const f32x2 ya = __builtin_amdgcn_cvt_pk_f32_fp8((int)yw[r][k][c].x, false), yb = __builtin_amdgcn_cvt_pk_f32_fp8((int)yw[r][k][c].x, true), yc = __builtin_amdgcn_cvt_pk_f32_fp8((int)yw[r][k][c].y, false), yd = __builtin_amdgcn_cvt_pk_f32_fp8((int)yw[r][k][c].y, true);
                    const float gs = gk[r][k] * A8_INV; v[c][0] += (f32x4){ya.x, ya.y, yb.x, yb.y} * gs; v[c][1] += (f32x4){yc.x, yc.y, yd.x, yd.y} * gs; }
#pragma unroll
                for (int e = 0; e < 2; ++e) s += (v[c][e].x * v[c][e].x + v[c][e].y * v[c][e].y) + (v[c][e].z * v[c][e].z + v[c][e].w * v[c][e].w); }
            const float rstd = 1.f / sqrtf(wave_sum(s) * (1.f / DM) + EPS);
            float* op = outp + (size_t)(m0 + r) * DM + 8 * F.lane;
#pragma unroll
            for (int c = 0; c < 2; ++c) { *(f32x4*)(op + c * 512) = v[c][0] * rstd * gg[c][0]; *(f32x4*)(op + c * 512 + 4) = v[c][1] * rstd * gg[c][1]; } }
    }
}

__global__ void __launch_bounds__(NTHR, 2) mk_fwd(Args A) {
    extern __shared__ __attribute__((aligned(16))) unsigned char lds[];
    Frame F;
    F.lds = (LAS unsigned char*)lds; F.ldsg = (char*)lds;
    F.tid = threadIdx.x; F.lane = F.tid & 63; F.wave = __builtin_amdgcn_readfirstlane(F.tid >> 6);
    F.G = gridDim.x; F.bid = blockIdx.x;
    F.ws = A.ws; F.ctl = (unsigned*)(A.ws + WS_CTL); F.dout = (unsigned char*)A.out;
    volatile LAS unsigned* MISC = (volatile LAS unsigned*)(F.lds + MISC_OFF);
    if (F.tid < 16) MISC[F.tid] = 0u;
    __syncthreads();
    XcdBarrier bar; bar.bar = F.ctl + CW_BAR; bar.x = 0; bar.st = nullptr;
    if (!MK_PER_PHASE) bar = xcd_barrier_post(F.ctl + CW_BAR, MISC + 8);
    const int lo = A.ph_lo, hi = A.ph_hi;
#ifndef PHMASK
#define PHMASK 0x7ffff
#endif
#define IN(k) (((PHMASK >> (k)) & 1) && lo <= (k) && (k) < hi)
#if MK_PROBE
#define SEAM(k) do { if (IN(k) && IN((k) + 1)) xcd_barrier(bar); if ((k) == PROBE_A) t_mark = __builtin_amdgcn_s_memrealtime(); } while (0)
#else
#define SEAM(k) do { if (IN(k) && IN((k) + 1)) xcd_barrier(bar); } while (0)
#endif
    unsigned char* ws = F.ws;
    const int* positions = (const int*)A.in[2];

#if MK_PROBE
    const unsigned long long t_k0 = __builtin_amdgcn_s_memrealtime(); unsigned long long t_mark = t_k0;
#endif
#if MK_REPS > 1
    for (int rep_ = 0; rep_ < MK_REPS; ++rep_) {
    if (rep_ > 0) { if (F.bid == 0 && F.tid < 128) { __hip_atomic_store(F.ctl + CW_CNT + F.tid, 0u, __ATOMIC_RELAXED, __HIP_MEMORY_SCOPE_AGENT); __hip_atomic_store(F.ctl + CW_CUR + F.tid, 0u, __ATOMIC_RELAXED, __HIP_MEMORY_SCOPE_AGENT); } xcd_barrier(bar); }
#endif
    if (IN(0)) { p0_prologue(F, A); } SEAM(0);
    if (IN(1)) {
        { pg8::Gemm g{(const bf16*)(ws + WS_A), (const bf16*)(ws + WS_WIN), 1024, nullptr}; pg8::StaticOrder S; S.init(M / 256, 6, F.G, F.bid, 0);
          EpiProj E{ws, positions, 1.f}; pg8::gemm_phase<EpiProj, pg8::StaticOrder, false>(F.lds, g, S, E); }
        { pg8::Gemm g{(const bf16*)(ws + WS_A8), (const bf16*)(ws + WS_WIN8), 1024, nullptr}; pg8::StaticOrder S; S.init(M / 256, 18, F.G, F.bid, 6, -6);
          EpiProj E{ws, positions, W8_INV}; pg8::gemm_phase<EpiProj, pg8::StaticOrder, false, 1>(F.lds, g, S, E); }
        kv_small(F);
    } SEAM(1);
    if (IN(2)) {
        if ((F.bid & 1) == 0) { gla_a_phase(F, A); __syncthreads(); attn_phase<true>(F); }
        else { attn_phase<true>(F); __syncthreads(); gla_a_phase(F, A); }
    } SEAM(2);
    if (IN(3)) { gla_scan(F);
        { pg8::Gemm g{(const bf16*)(ws + WS_A8), (const bf16*)(ws + WS_WGATE), 1024, nullptr}; pg8::StaticOrder S; S.init(M / 256, 8, F.G, F.bid);
        EpiGates E{(bf16*)(ws + WS_GATES), INP(11), W8_INV}; pg8::gemm_phase<EpiGates, pg8::StaticOrder, false, 1>(F.lds, g, S, E); } } SEAM(3);
    if (IN(4)) {
        if ((F.bid & 1) == 0) { gla_c_phase(F, A); dil_combine(F); }
        else { dil_combine(F); __syncthreads(); gla_c_phase(F, A); }
    } SEAM(4);
#define OWN_CHAIN_SYNC() do { asm volatile("s_waitcnt vmcnt(0)" ::: "memory"); __builtin_amdgcn_fence(__ATOMIC_RELEASE, "workgroup"); __syncthreads(); __builtin_amdgcn_fence(__ATOMIC_ACQUIRE, "workgroup"); } while (0)
    if (IN(6)) { pg8::Gemm g{(const bf16*)(F.dout + DO_OGD), (const bf16*)(ws + WS_WBG), 1024, nullptr}; pg8::PanelOrder S; S.init(M / 256, 4, F.G, F.bid);
        EpiBranchFused E{(bf16*)(ws + WS_MERGED), (const bf16*)(ws + WS_GATES)}; pg8::gemm_phase<EpiBranchFused, pg8::PanelOrder, false>(F.lds, g, S, E); }
    if (IN(6) && IN(7)) OWN_CHAIN_SYNC();
    if (IN(7)) {
        auto p8_share = [&]() {
            const int gw = F.bid * NWAVES + F.wave, NGW = F.G * NWAVES;
            LAS float* scr = (LAS float*)(F.lds + F.wave * 16384);
            LAS float* l_g3 = (LAS float*)(F.lds + TAB_OFF);
            for (int i = F.tid; i < 1024; i += NTHR) l_g3[i] = INP(18)[i];
            __syncthreads();
            constexpr int IPM = 16 * 32, NIT8 = 3 * NEXP * IPM;
            float tva[32], tvb[32];
#define P8_LOAD(it_, tv_) do { const int mat_ = (it_) / IPM, r_ = (it_) % IPM, kind_ = mat_ / NEXP, e_ = mat_ % NEXP; \
                const float* wp_ = (kind_ == 0 ? INP(21) : kind_ == 1 ? INP(23) : INP(25)) + (size_t)e_ * 1048576 + (size_t)(64 * (r_ >> 5) + (F.lane >> 5)) * 1024 + 32 * (r_ & 31) + (F.lane & 31); \
                _Pragma("unroll") for (int i_ = 0; i_ < 32; ++i_) tv_[i_] = wp_[(size_t)(2 * i_) * 1024]; } while (0)
#define P8_FINISH(it_, tv_) do { const int mat_ = (it_) / IPM, r_ = (it_) % IPM, kind_ = mat_ / NEXP, e_ = mat_ % NEXP, k0_ = 64 * (r_ >> 5), n0_ = 32 * (r_ & 31); \
                _Pragma("unroll") for (int i_ = 0; i_ < 32; ++i_) { const int kk_ = 2 * i_ + (F.lane >> 5); scr[kk_ * 33 + (F.lane & 31)] = kind_ < 2 ? tv_[i_] * l_g3[k0_ + kk_] : tv_[i_]; } \
                LDS_WAIT(); asm volatile("" ::: "memory"); \
                const int c_ = F.lane & 7; \
                _Pragma("unroll") for (int j_ = 0; j_ < 4; ++j_) { const int n_ = n0_ + (F.lane >> 3) + 8 * j_; const LAS float* s_ = scr + (8 * c_) * 33 + (F.lane >> 3) + 8 * j_; \
                    const f32x4 a_ = {s_[0 * 33] * W8_SCALE, s_[1 * 33] * W8_SCALE, s_[2 * 33] * W8_SCALE, s_[3 * 33] * W8_SCALE}, b_ = {s_[4 * 33] * W8_SCALE, s_[5 * 33] * W8_SCALE, s_[6 * 33] * W8_SCALE, s_[7 * 33] * W8_SCALE}; \
                    unsigned char* d_ = kind_ < 2 ? ws + WS_WGU + (size_t)(e_ * 2048 + (kind_ == 1 ? 128 : 0) + (n_ >> 7) * 256 + (n_ & 127)) * 1024 : ws + WS_WDN + (size_t)(e_ * 1024 + n_) * 1024; \
                    *(u32x2*)(d_ + k0_ + 8 * c_) = pack8_fp8(a_, b_); } \
                LDS_WAIT(); asm volatile("" ::: "memory"); } while (0)
            int it = gw;
            if (it < NIT8) P8_LOAD(it, tva);
            for (; it < NIT8; it += 2 * NGW) {
                if (it + NGW < NIT8) P8_LOAD(it + NGW, tvb);
                P8_FINISH(it, tva);
                if (it + NGW < NIT8) { if (it + 2 * NGW < NIT8) P8_LOAD(it + 2 * NGW, tva); P8_FINISH(it + NGW, tvb); }
            }
            __syncthreads();
        };
        if ((F.bid & 1) == 0) p8_share();
        { pg8::Gemm g{(const bf16*)(ws + WS_MERGED), (const bf16*)(ws + WS_WMIX), 1024, nullptr}; pg8::PanelOrder S; S.init(M / 256, 4, F.G, F.bid);
        EpiResBf16 E{INP(0), nullptr, (bf16*)(ws + WS_A), nullptr}; pg8::gemm_phase<EpiResBf16, pg8::PanelOrder, false>(F.lds, g, S, E); }
        if ((F.bid & 1) != 0) p8_share();
    }
    if (IN(7) && IN(9)) OWN_CHAIN_SYNC();
    if (IN(9)) { pg8::Gemm g{(const bf16*)(ws + WS_H2F8), (const bf16*)(ws + WS_WXQ), 1024, nullptr};     pg8::PanelOrder S; S.init(M / 256, 2, F.G, F.bid);
        LAS float* rs = (LAS float*)(F.lds + TAB_OFF);
        { pg8::Unit u; for (int i = 0; i < 8 && S.next(2 * i, u); ++i) {
              for (int r0 = F.wave * 32; r0 < F.wave * 32 + 32; r0 += 8) {
                  u32x4 w[8][2];
#pragma unroll
                  for (int q = 0; q < 8; ++q) { const bf16* xr = (const bf16*)(ws + WS_A) + ((size_t)u.pm * 256 + r0 + q) * DM + F.lane * 8; w[q][0] = *(const u32x4*)xr; w[q][1] = *(const u32x4*)(xr + 512); }
#pragma unroll
                  for (int q = 0; q < 8; ++q) { f32x4 a0, a1, b0, b1; unpack8f(w[q][0], a0, a1); unpack8f(w[q][1], b0, b1);
                      { unsigned char* o8 = ws + WS_H2F8 + ((size_t)u.pm * 256 + r0 + q) * DM + F.lane * 8; *(u32x2*)o8 = pack8_fp8(a0, a1); *(u32x2*)(o8 + 512) = pack8_fp8(b0, b1); }
                      float ss = (a0[0] * a0[0] + a0[1] * a0[1]) + (a0[2] * a0[2] + a0[3] * a0[3]) + (a1[0] * a1[0] + a1[1] * a1[1]) + (a1[2] * a1[2] + a1[3] * a1[3])
                               + (b0[0] * b0[0] + b0[1] * b0[1]) + (b0[2] * b0[2] + b0[3] * b0[3]) + (b1[0] * b1[0] + b1[1] * b1[1]) + (b1[2] * b1[2] + b1[3] * b1[3]);
                      ss = wave_sum(ss); if (F.lane == 0) rs[i * 256 + r0 + q] = W8_INV / sqrtf(ss * (1.f / DM) + EPS); } } } }
        asm volatile("s_waitcnt vmcnt(0)" ::: "memory");
        __syncthreads();
        EpiRowScaleBf16 E{(bf16*)(ws + WS_QX), 512, rs}; pg8::gemm_phase<EpiRowScaleBf16, pg8::PanelOrder, false, 1>(F.lds, g, S, E); }
    if (IN(9) && IN(10)) OWN_CHAIN_SYNC();
    if (IN(10)) { xattn_own_panels(F); }
    if (IN(10) && IN(11)) OWN_CHAIN_SYNC();
    if (IN(11)) { pg8::Gemm g{(const bf16*)(ws + WS_QX), (const bf16*)(ws + WS_WXO), 512, nullptr}; pg8::PanelOrder S; S.init(M / 256, 4, F.G, F.bid);
        EpiResBf16 E{nullptr, (const bf16*)(ws + WS_A), (bf16*)(ws + WS_A), nullptr}; pg8::gemm_phase<EpiResBf16, pg8::PanelOrder, false>(F.lds, g, S, E); }
    if (IN(11) && IN(12)) OWN_CHAIN_SYNC();
    if (IN(12)) { router_phase(F, A); } SEAM(12);
    if (IN(13)) { place_phase(F); } SEAM(13);
#define MOE_GU(half, wsh, cc) do { const MoeTab T = moe_tables(F, half); \
        pg8::Gemm g{(const bf16*)(ws + WS_H2F8), (const bf16*)(ws + WS_WGU), 1024, (const int*)(ws + WS_RTOK) + (half) * RT_CAP}; \
        pg8::MoeOrder S; S.init(T.nblk[0], 8, F.G, (cc)); S.blk_e = T.blk_e; \
        EpiSwiglu E{ws + (wsh), INP(22), INP(24), 8, (const float*)(ws + WS_RRS) + (half) * RT_CAP}; pg8::gemm_phase<EpiSwiglu, pg8::MoeOrder, true, 1>(F.lds, g, S, E); } while (0)
#define MOE_DN(half, wsh, wsy, nbv) do { const MoeTab T = moe_tables(F, half); nbv = T.nblk[0]; \
        pg8::Gemm g{(const bf16*)(ws + (wsh)), (const bf16*)(ws + WS_WDN), 1024, nullptr}; \
        pg8::MoeOrder S; S.init(T.nblk[0], 4, F.G, F.bid); S.blk_e = T.blk_e; \
        EpiDown E{ws + (wsy), INP(26), (const float*)(ws + WS_RGATE) + (half) * RT_CAP, 4}; pg8::gemm_phase<EpiDown, pg8::MoeOrder, false, 1>(F.lds, g, S, E); } while (0)
    if (IN(14)) { MOE_GU(0, WS_H, F.bid); } SEAM(14);
    if (IN(15)) {
        if ((F.bid & 1) == 0) { int nb0 = 0; MOE_DN(0, WS_H, WS_Y, nb0); const int rem = (nb0 * 4) % F.G; MOE_GU(1, WS_H1, (F.bid + F.G - rem) % F.G); }
        else { const MoeTab T0 = moe_tables(F, 0); const int rem = (T0.nblk[0] * 4) % F.G; MOE_GU(1, WS_H1, (F.bid + F.G - rem) % F.G); int nb0 = 0; MOE_DN(0, WS_H, WS_Y, nb0); }
    } SEAM(15);
    if (IN(16)) { int nb1 = 0; MOE_DN(1, WS_H1, WS_Y1, nb1); combine_phase(F, A, 0, WS_Y, (nb1 * 4) % F.G); } SEAM(16);
    if (IN(17)) { combine_phase(F, A, 1, WS_Y1); }
#if MK_PROBE
    { xcd_barrier(bar); if (F.tid == 0) { const unsigned long long t1 = __builtin_amdgcn_s_memrealtime(), w = ((PROBE_A == 100 ? t1 : t_mark) - t_k0) * PROBE_K; while (__builtin_amdgcn_s_memrealtime() - t1 < w) __builtin_amdgcn_s_sleep(8); } __syncthreads(); }
#endif
#if MK_REPS > 1
    xcd_barrier(bar); }
#endif
#undef IN
#undef SEAM
}


extern "C" void kernel_launch(void* const* d_in, const int* in_sizes, int n_in, void* d_out, int out_size, void* d_ws, size_t ws_size, hipStream_t stream) {
    static int grid = 0;
    if (grid == 0) {
        if (n_in != 28 || out_size != M * DM || ws_size < WS_END) { fprintf(stderr, "kernel_launch: unexpected shapes (n_in %d, out %d, ws %zu)\n", n_in, out_size, ws_size); grid = -1; return; }
        int dev = 0, cus = 0, per_cu = 0;
        if (hipGetDevice(&dev) != hipSuccess || hipDeviceGetAttribute(&cus, hipDeviceAttributeMultiprocessorCount, dev) != hipSuccess) { grid = -1; return; }
        if (hipFuncSetAttribute((const void*)mk_fwd, hipFuncAttributeMaxDynamicSharedMemorySize, LDS_BYTES) != hipSuccess) { fprintf(stderr, "kernel_launch: hipFuncSetAttribute failed\n"); grid = -1; return; }
        if (hipOccupancyMaxActiveBlocksPerMultiprocessor(&per_cu, (const void*)mk_fwd, NTHR, LDS_BYTES) != hipSuccess || per_cu < 1) { fprintf(stderr, "kernel_launch: occupancy query says %d\n", per_cu); (void)hipGetLastError(); grid = -1; return; }
        grid = cus;
    }
    if (grid < 0) return;
#if MK_DIAG
    unsigned long long* sums = (unsigned long long*)((char*)d_ws + WS_DIAG);
    (void)hipMemsetAsync(sums, 0, 4096, stream);
    for (int run = 0; run < 2; ++run) {
        (void)hipMemsetAsync((char*)d_ws + 1 * MiB, run ? 0x3C : 0x00, WS_END - 1 * MiB, stream);
        (void)hipMemsetAsync(d_out, run ? 0x3D : 0x00, (size_t)M * DM * 4, stream);
        (void)hipMemsetAsync((char*)d_ws + WS_CTL, 0, CTL_ZERO_BYTES, stream);
        Args a{};
        for (int i = 0; i < 28; ++i) a.in[i] = d_in[i];
        a.out = (float*)d_out; a.ws = (unsigned char*)d_ws;
        for (int p = 0; p < NPH; ++p) { a.ph_lo = p; a.ph_hi = p + 1; hipLaunchKernelGGL(mk_fwd, dim3(grid), dim3(NTHR), LDS_BYTES, stream, a);
            diag_sums(p, (unsigned char*)d_ws, (unsigned char*)d_out, sums + run * 32 + p, stream); }
    }
    hipLaunchKernelGGL(k_verdict, dim3(1024), dim3(256), 0, stream, (const unsigned long long*)sums, (float*)d_out, (size_t)M * DM);
#else
    (void)hipMemsetAsync((char*)d_ws + WS_CTL, 0, CTL_ZERO_BYTES, stream);
    Args a{};
    for (int i = 0; i < 28; ++i) a.in[i] = d_in[i];
    a.out = (float*)d_out; a.ws = (unsigned char*)d_ws;
#if MK_PER_PHASE
    for (int p = 0; p < NPH; ++p) { a.ph_lo = p; a.ph_hi = p + 1; hipLaunchKernelGGL(mk_fwd, dim3(grid), dim3(NTHR), LDS_BYTES, stream, a); }
#else
    a.ph_lo = 0; a.ph_hi = NPH; hipLaunchKernelGGL(mk_fwd, dim3(grid), dim3(NTHR), LDS_BYTES, stream, a);
#endif
#endif
}
```
